# Optimizing an MI355X kernel written in HIP

```python
import jax
import jax.numpy as jnp
from jax import lax
import numpy as np

D_MODEL = 1024
BATCH = 8
SEQ = 2048
DEPTH = 4

GRID_W = 64
CTX_LEN = 256
EPS = 1e-6
NEG_INF = -1e30

BRANCH_W = 512
N_BRANCH = 3
CONV_K = 3
ATT_HEADS = 8
ATT_KV_HEADS = 2
ATT_GROUP = ATT_HEADS // ATT_KV_HEADS
HEAD_DIM = 64
WINDOW = 128
Q_BLOCK = 128
ROPE_BASE = 10000.0
GLA_HEADS = 4
GLA_DK = 64
GLA_DV = 128
GLA_RANK = 16
GLA_TAU = 16.0
GLA_CHUNK = 64
D_FF = 3584
N_EXPERTS = 8
TOP_K = 2
N_DENSE = (DEPTH + 1) // 2
N_MOE = DEPTH // 2

PROJ_SPLITS = (BRANCH_W, BRANCH_W, BRANCH_W,
               ATT_HEADS * HEAD_DIM, ATT_KV_HEADS * HEAD_DIM, ATT_KV_HEADS * HEAD_DIM,
               GLA_HEADS * GLA_DK, GLA_HEADS * GLA_DK, GLA_HEADS * GLA_DV, GLA_HEADS * GLA_DV,
               2 * GLA_RANK, N_BRANCH * D_MODEL)
D_IN = sum(PROJ_SPLITS)

kernel_name = 'hybrid_dit_conv_swa_gla_moe'


def rmsnorm(x, g):
    xf = x.astype(jnp.float32)
    y = xf * lax.rsqrt(jnp.mean(xf * xf, axis=-1, keepdims=True) + EPS)
    return (y * g.astype(jnp.float32)).astype(x.dtype)


def modulate(h, shift, scale):
    return h * (1 + scale) + shift


def split_proj(p):
    outs = []
    off = 0
    for w in PROJ_SPLITS:
        outs.append(p[..., off:off + w])
        off += w
    return outs


def axial_rope_angles(n):
    rows = n // GRID_W
    row = jnp.repeat(jnp.arange(rows, dtype=jnp.float32), GRID_W)
    col = jnp.tile(jnp.arange(GRID_W, dtype=jnp.float32), rows)
    half = HEAD_DIM // 2
    inv_freq = ROPE_BASE ** (-jnp.arange(0, half, 2, dtype=jnp.float32) / half)
    ang_r = row[:, None] * inv_freq
    ang_c = col[:, None] * inv_freq
    return (jnp.cos(ang_r), jnp.sin(ang_r), jnp.cos(ang_c), jnp.sin(ang_c))


def rope_half(x, cos, sin):
    x1, x2 = jnp.split(x, 2, axis=-1)
    cos = cos[:, None, :]
    sin = sin[:, None, :]
    return jnp.concatenate([x1 * cos - x2 * sin, x2 * cos + x1 * sin], axis=-1)


def axial_rope(x, angles):
    cos_r, sin_r, cos_c, sin_c = angles
    xf = x.astype(jnp.float32)
    half = HEAD_DIM // 2
    y = jnp.concatenate([rope_half(xf[..., :half], cos_r, sin_r),
                         rope_half(xf[..., half:], cos_c, sin_c)], axis=-1)
    return y.astype(x.dtype)


def short_conv(b_gate, c_gate, u, w):
    z = c_gate * u
    zp = jnp.pad(z, ((0, 0), (1, 1), (0, 0)))
    y = zp[:, :-2] * w[0] + zp[:, 1:-1] * w[1] + zp[:, 2:] * w[2]
    return b_gate * y


def window_attention(q, k, v, k_ctx, v_ctx, sink):
    bsz, n = q.shape[:2]
    nb = n // Q_BLOCK
    qb = q.reshape(bsz, nb, Q_BLOCK, ATT_KV_HEADS, ATT_GROUP, HEAD_DIM)

    def blocks_with_halo(t):
        tp = jnp.pad(t, ((0, 0), (Q_BLOCK, Q_BLOCK), (0, 0), (0, 0)))
        tp = tp.reshape(bsz, nb + 2, Q_BLOCK, ATT_KV_HEADS, HEAD_DIM)
        return jnp.concatenate([tp[:, :-2], tp[:, 1:-1], tp[:, 2:]], axis=2)

    kw = blocks_with_halo(k)
    vw = blocks_with_halo(v)
    scale = HEAD_DIM ** -0.5
    s_lat = jnp.einsum('bnqkgd,bnjkd->bkgnqj', qb, kw, preferred_element_type=jnp.float32) * scale
    s_ctx = jnp.einsum('bnqkgd,bjkd->bkgnqj', qb, k_ctx, preferred_element_type=jnp.float32) * scale
    qpos = jnp.arange(nb)[:, None, None] * Q_BLOCK + jnp.arange(Q_BLOCK)[None, :, None]
    kpos = (jnp.arange(nb)[:, None, None] - 1) * Q_BLOCK + jnp.arange(3 * Q_BLOCK)[None, None, :]
    valid = (jnp.abs(kpos - qpos) <= WINDOW) & (kpos >= 0) & (kpos < n)
    s_lat = jnp.where(valid, s_lat, NEG_INF)
    s_sink = jnp.broadcast_to(sink.astype(jnp.float32).reshape(ATT_KV_HEADS, ATT_GROUP, 1, 1, 1),
                              s_lat.shape[:-1] + (1,))
    p = jax.nn.softmax(jnp.concatenate([s_lat, s_ctx, s_sink], axis=-1), axis=-1)
    nk = 3 * Q_BLOCK
    p_lat = p[..., :nk].astype(v.dtype)
    p_ctx = p[..., nk:nk + k_ctx.shape[1]].astype(v.dtype)
    o = (jnp.einsum('bkgnqj,bnjkd->bnqkgd', p_lat, vw)
         + jnp.einsum('bkgnqj,bjkd->bnqkgd', p_ctx, v_ctx))
    return o.reshape(bsz, n, ATT_HEADS * HEAD_DIM)


def context_attention(q, k, v, sink):
    bsz, m = q.shape[:2]
    qg = q.reshape(bsz, m, ATT_KV_HEADS, ATT_GROUP, HEAD_DIM)
    s = jnp.einsum('bqkgd,bjkd->bkgqj', qg, k, preferred_element_type=jnp.float32) * (HEAD_DIM ** -0.5)
    s_sink = jnp.broadcast_to(sink.astype(jnp.float32).reshape(ATT_KV_HEADS, ATT_GROUP, 1, 1),
                              s.shape[:-1] + (1,))
    p = jax.nn.softmax(jnp.concatenate([s, s_sink], axis=-1), axis=-1)
    o = jnp.einsum('bkgqj,bjkd->bqkgd', p[..., :m].astype(v.dtype), v)
    return o.reshape(bsz, m, ATT_HEADS * HEAD_DIM)


def gla_chunked(q, k, v, log_a, s0, with_output):
    bsz, n, h, _ = q.shape
    dv = v.shape[-1]
    nc = n // GLA_CHUNK

    def chunks(t):
        return t.reshape(bsz, nc, GLA_CHUNK, h, t.shape[-1])

    q, k, v, log_a = chunks(q), chunks(k), chunks(v), chunks(log_a)
    b = jnp.cumsum(log_a, axis=2)
    b_last = b[:, :, -1]
    k_end = k * jnp.exp(b_last[:, :, None] - b)
    d_state = jnp.einsum('bcshd,bcshv->cbhdv', k_end, v)
    decay = jnp.exp(b_last).transpose(1, 0, 2, 3)[..., None]

    def step(s, inp):
        dec, ds = inp
        return dec * s + ds, s

    s_final, s_enter = lax.scan(step, s0, (decay, d_state))
    if not with_output:
        return None, s_final
    q_dec = q * jnp.exp(b)
    k_inv = k * jnp.exp(-b)
    lower = jnp.tril(jnp.ones((GLA_CHUNK, GLA_CHUNK), dtype=bool))
    att = jnp.where(lower, jnp.einsum('bclhd,bcshd->bchls', q_dec, k_inv), 0.0)
    o = (jnp.einsum('bchls,bcshv->bclhv', att, v)
         + jnp.einsum('bclhd,cbhdv->bclhv', q_dec, s_enter))
    return o.reshape(bsz, n, h, dv), s_final


def gla_inputs(q, k, v, a, w2, bias):
    bsz, n, _ = q.shape
    f32 = jnp.float32
    qf = q.astype(f32).reshape(bsz, n, GLA_HEADS, GLA_DK) * (GLA_DK ** -0.5)
    kf = k.astype(f32).reshape(bsz, n, GLA_HEADS, GLA_DK)
    vf = v.astype(f32).reshape(bsz, n, GLA_HEADS, GLA_DV)
    af = a.astype(f32)
    log_a = []
    for d in range(2):
        z = af[..., d * GLA_RANK:(d + 1) * GLA_RANK] @ w2[d].astype(f32) + bias[d].astype(f32)
        log_a.append((jax.nn.log_sigmoid(z) / GLA_TAU).reshape(bsz, n, GLA_HEADS, GLA_DK))
    return qf, kf, vf, log_a


def gla_bidir(qf, kf, vf, log_a, s0_fwd, s0_bwd, with_output):
    rev = lambda t: t[:, ::-1]
    o_f, s_f = gla_chunked(qf, kf, vf, log_a[0], s0_fwd, with_output)
    o_b, s_b = gla_chunked(rev(qf), rev(kf), rev(vf), rev(log_a[1]), s0_bwd, with_output)
    o = o_f + rev(o_b) if with_output else None
    return o, s_f, s_b


def gla_output(o, r, g):
    bsz, n = o.shape[:2]
    o = o * lax.rsqrt(jnp.mean(o * o, axis=-1, keepdims=True) + EPS)
    o = o.reshape(bsz, n, GLA_HEADS * GLA_DV) * g.astype(jnp.float32)
    return (o * jax.nn.silu(r.astype(jnp.float32))).astype(r.dtype)


def merge_branches(branches, gate_logits, w_branch, w_out):
    y = jnp.stack(branches, axis=2)
    y = jnp.einsum('btim,imd->btid', y, w_branch)
    g = jax.nn.sigmoid(gate_logits.reshape(gate_logits.shape[:-1] + (N_BRANCH, D_MODEL)))
    return jnp.sum(g * y, axis=2) @ w_out


def parallel_mixers(hx, hc, angles, w_in, conv_w, sink, gla_w2, gla_b, gla_g, w_branch, w_out, ctx_out):
    bsz, n, _ = hx.shape
    m = hc.shape[1]
    (cb_x, cc_x, cu_x, qa_x, ka_x, va_x, qg_x, kg_x, vg_x, rg_x, ag_x, gate_x) = split_proj(hx @ w_in)
    (cb_c, cc_c, cu_c, qa_c, ka_c, va_c, qg_c, kg_c, vg_c, rg_c, ag_c, gate_c) = split_proj(hc @ w_in)
    ya_x = short_conv(cb_x, cc_x, cu_x, conv_w)
    k_ctx = ka_c.reshape(bsz, m, ATT_KV_HEADS, HEAD_DIM)
    v_ctx = va_c.reshape(bsz, m, ATT_KV_HEADS, HEAD_DIM)
    q_x = axial_rope(qa_x.reshape(bsz, n, ATT_HEADS, HEAD_DIM), angles)
    k_x = axial_rope(ka_x.reshape(bsz, n, ATT_KV_HEADS, HEAD_DIM), angles)
    v_x = va_x.reshape(bsz, n, ATT_KV_HEADS, HEAD_DIM)
    yb_x = window_attention(q_x, k_x, v_x, k_ctx, v_ctx, sink)
    s0 = jnp.zeros((bsz, GLA_HEADS, GLA_DK, GLA_DV), jnp.float32)
    o_c, s_f, s_b = gla_bidir(*gla_inputs(qg_c, kg_c, vg_c, ag_c, gla_w2, gla_b), s0, s0, ctx_out)
    o_x, _, _ = gla_bidir(*gla_inputs(qg_x, kg_x, vg_x, ag_x, gla_w2, gla_b), s_f, s_b, True)
    yc_x = gla_output(o_x, rg_x, gla_g)
    y_x = merge_branches((ya_x, yb_x, yc_x), gate_x, w_branch, w_out)
    if not ctx_out:
        return y_x, None
    ya_c = short_conv(cb_c, cc_c, cu_c, conv_w)
    yb_c = context_attention(qa_c.reshape(bsz, m, ATT_HEADS, HEAD_DIM), k_ctx, v_ctx, sink)
    yc_c = gla_output(o_c, rg_c, gla_g)
    y_c = merge_branches((ya_c, yb_c, yc_c), gate_c, w_branch, w_out)
    return y_x, y_c


def swiglu(h, w1, w3, w2):
    return (jax.nn.silu(h @ w1) * (h @ w3)) @ w2


def moe_swiglu(h, router_w, w1, w3, w2):
    logits = (h @ router_w).astype(jnp.float32)
    top_v, top_i = lax.top_k(logits, TOP_K)
    top_p = jax.nn.softmax(top_v, axis=-1)
    gates = jnp.sum(jax.nn.one_hot(top_i, N_EXPERTS, dtype=jnp.float32) * top_p[..., None], axis=-2)
    gates = gates.astype(h.dtype)
    out = jnp.zeros_like(h)
    for e in range(N_EXPERTS):
        out = out + gates[..., e:e + 1] * swiglu(h, w1[e], w3[e], w2[e])
    return out


def channel_mixer(h, l, ffn_w1, ffn_w3, ffn_w2, router_w, moe_w1, moe_w3, moe_w2):
    j = l // 2
    if l % 2 == 0:
        return swiglu(h, ffn_w1[j], ffn_w3[j], ffn_w2[j])
    return moe_swiglu(h, router_w[j], moe_w1[j], moe_w3[j], moe_w2[j])


def setup_inputs(seed: int = 0) -> dict:
    key = jax.random.key(seed)
    ks = jax.random.split(key, 24)
    D = D_MODEL

    def nrm(k, shape, s):
        return jax.random.normal(k, shape, jnp.float32) * s

    return {
        'x': nrm(ks[0], (BATCH, SEQ, D), 1.0),
        'c': nrm(ks[1], (BATCH, D), 1.0),
        'ctx': nrm(ks[2], (BATCH, CTX_LEN, D), 1.0),
        'c_ctx': nrm(ks[3], (D,), 1.0),
        'w_mod': nrm(ks[4], (DEPTH, D, 6 * D), 0.5 * D ** -0.5),
        'b_mod': nrm(ks[5], (DEPTH, 6 * D), 0.02),
        'norm1_g': 1.0 + nrm(ks[6], (DEPTH, D), 0.1),
        'norm2_g': 1.0 + nrm(ks[7], (DEPTH, D), 0.1),
        'w_in': nrm(ks[8], (DEPTH, D, D_IN), D ** -0.5),
        'conv_w': nrm(ks[9], (DEPTH, CONV_K, BRANCH_W), CONV_K ** -0.5),
        'attn_sink': nrm(ks[10], (DEPTH, ATT_HEADS), 0.5),
        'gla_w2': nrm(ks[11], (DEPTH, 2, GLA_RANK, GLA_HEADS * GLA_DK), GLA_RANK ** -0.5),
        'gla_b': 1.0 + nrm(ks[12], (DEPTH, 2, GLA_HEADS * GLA_DK), 0.5),
        'gla_norm_g': 1.0 + nrm(ks[13], (DEPTH, GLA_HEADS * GLA_DV), 0.1),
        'w_branch': nrm(ks[14], (DEPTH, N_BRANCH, BRANCH_W, D), BRANCH_W ** -0.5),
        'w_out': nrm(ks[15], (DEPTH, D, D), D ** -0.5),
        'ffn_w1': nrm(ks[16], (N_DENSE, D, D_FF), D ** -0.5),
        'ffn_w3': nrm(ks[17], (N_DENSE, D, D_FF), D ** -0.5),
        'ffn_w2': nrm(ks[18], (N_DENSE, D_FF, D), D_FF ** -0.5),
        'router_w': nrm(ks[19], (N_MOE, D, N_EXPERTS), D ** -0.5),
        'moe_w1': nrm(ks[20], (N_MOE, N_EXPERTS, D, D_FF), D ** -0.5),
        'moe_w3': nrm(ks[21], (N_MOE, N_EXPERTS, D, D_FF), D ** -0.5),
        'moe_w2': nrm(ks[22], (N_MOE, N_EXPERTS, D_FF, D), D_FF ** -0.5),
        'final_norm_g': 1.0 + nrm(ks[23], (D,), 0.1),
    }


def reference(x, c, ctx, c_ctx, w_mod, b_mod, norm1_g, norm2_g, w_in, conv_w, attn_sink, gla_w2, gla_b,
              gla_norm_g, w_branch, w_out, ffn_w1, ffn_w3, ffn_w2, router_w, moe_w1, moe_w3, moe_w2,
              final_norm_g):
    angles = axial_rope_angles(x.shape[1])
    silu_c = jax.nn.silu(c)
    silu_cc = jax.nn.silu(c_ctx)
    for l in range(DEPTH):
        last = l == DEPTH - 1
        mod_x = jnp.split((silu_c @ w_mod[l] + b_mod[l])[:, None, :], 6, axis=-1)
        mod_c = jnp.split(silu_cc @ w_mod[l] + b_mod[l], 6, axis=-1)
        hx = modulate(rmsnorm(x, norm1_g[l]), mod_x[0], mod_x[1])
        hc = modulate(rmsnorm(ctx, norm1_g[l]), mod_c[0], mod_c[1])
        y_x, y_c = parallel_mixers(hx, hc, angles, w_in[l], conv_w[l], attn_sink[l], gla_w2[l], gla_b[l],
                                   gla_norm_g[l], w_branch[l], w_out[l], not last)
        x = x + mod_x[2] * y_x
        hx2 = modulate(rmsnorm(x, norm2_g[l]), mod_x[3], mod_x[4])
        x = x + mod_x[5] * channel_mixer(hx2, l, ffn_w1, ffn_w3, ffn_w2, router_w, moe_w1, moe_w3, moe_w2)
        if not last:
            ctx = ctx + mod_c[2] * y_c
            hc2 = modulate(rmsnorm(ctx, norm2_g[l]), mod_c[3], mod_c[4])
            ctx = ctx + mod_c[5] * channel_mixer(hc2, l, ffn_w1, ffn_w3, ffn_w2, router_w, moe_w1, moe_w3, moe_w2)
    return rmsnorm(x, final_norm_g)
```

```cpp
#include <hip/hip_runtime.h>
#include <stdint.h>
#include <stddef.h>

#define LAS __attribute__((address_space(3)))
typedef unsigned short bf16_t;
typedef short bf16x8 __attribute__((ext_vector_type(8)));
typedef float f32x4 __attribute__((ext_vector_type(4)));
typedef float f32x2 __attribute__((ext_vector_type(2)));
typedef unsigned u32x4 __attribute__((ext_vector_type(4)));
typedef unsigned u32x2 __attribute__((ext_vector_type(2)));

constexpr int D = 1024, NBATCH = 8, SEQ = 2048, CTXL = 256, DEPTH = 4;
constexpr int TL = NBATCH * SEQ, TC = NBATCH * CTXL, T = TL + TC;
constexpr int DIN = 6944, NP = 7168;
constexpr int DFF = 3584, NUP = 2 * DFF;
constexpr int NEXP = 8;
constexpr int MAXR = 2 * T + NEXP * 256;
constexpr int P_CB = 0, P_CC = 512, P_CU = 1024, P_QA = 1536, P_KA = 2048, P_VA = 2176, P_QG = 2304, P_KG = 2560, P_VG = 2816, P_RG = 3328, P_GATE = 3840, P_AG = 6912;
constexpr float EPS = 1e-6f;

constexpr size_t al256(size_t x) { return (x + 255) & ~(size_t)255; }
constexpr size_t WS_CTL = 0;                                   constexpr size_t CTL_BYTES = 65536;
constexpr size_t WS_MOD = WS_CTL + CTL_BYTES;                  constexpr size_t MOD_BYTES = (size_t)DEPTH * 9 * 6 * D * 4;
constexpr size_t WS_CS = al256(WS_MOD + MOD_BYTES);            constexpr size_t CS_BYTES = 64 * 16 * 8;
constexpr size_t WS_XS = al256(WS_CS + CS_BYTES);              constexpr size_t XS_BYTES = (size_t)T * D * 4;
constexpr size_t WS_H = al256(WS_XS + XS_BYTES);               constexpr size_t H_BYTES = (size_t)T * D * 2;
constexpr size_t WS_PH = al256(WS_H + H_BYTES);                constexpr size_t PH_BYTES = (size_t)MAXR * DFF * 2;
constexpr size_t WS_BR = al256(WS_PH + PH_BYTES);              constexpr size_t BR_BYTES = (size_t)T * 1536 * 2;
constexpr size_t WS_R3 = al256(WS_BR + BR_BYTES);              constexpr size_t R3_BYTES = (size_t)T * 3072 * 2;
constexpr size_t WS_YB = al256(WS_R3 + R3_BYTES);              constexpr size_t YB_BYTES = (size_t)MAXR * D * 2;
constexpr size_t WS_QR = al256(WS_YB + YB_BYTES);              constexpr size_t QR_BYTES = (size_t)T * 512 * 2;
constexpr size_t WS_KV = al256(WS_QR + QR_BYTES);              constexpr size_t KV_BYTES = (size_t)T * 256 * 2;
constexpr size_t WS_TOPK = al256(WS_KV + KV_BYTES);            constexpr size_t TOPK_BYTES = (size_t)T * 16;
constexpr size_t WS_POS = al256(WS_TOPK + TOPK_BYTES);         constexpr size_t POS_BYTES = (size_t)T * 8;
constexpr size_t WS_IDX = al256(WS_POS + POS_BYTES);           constexpr size_t IDX_BYTES = (size_t)MAXR * 4;
constexpr size_t WS_WIN = al256(WS_IDX + IDX_BYTES);           constexpr size_t WIN_BYTES = (size_t)DEPTH * NP * D * 2;
constexpr size_t WS_WBR = al256(WS_WIN + WIN_BYTES);           constexpr size_t WBR_BYTES = (size_t)DEPTH * 3072 * 512 * 2;
constexpr size_t WS_WO3 = al256(WS_WBR + WBR_BYTES);           constexpr size_t WO3_BYTES = (size_t)DEPTH * D * 3072 * 2;
constexpr size_t WS_WUPD = al256(WS_WO3 + WO3_BYTES);          constexpr size_t WUPD_BYTES = (size_t)2 * NUP * D * 2;
constexpr size_t WS_WDND = al256(WS_WUPD + WUPD_BYTES);        constexpr size_t WDND_BYTES = (size_t)2 * D * DFF * 2;
constexpr size_t WS_WUPM = al256(WS_WDND + WDND_BYTES);        constexpr size_t WUPM_BYTES = (size_t)NEXP * NUP * D * 2;
constexpr size_t WS_WDNM = al256(WS_WUPM + WUPM_BYTES);        constexpr size_t WDNM_BYTES = (size_t)NEXP * D * DFF * 2;
constexpr size_t WS_END = al256(WS_WDNM + WDNM_BYTES);
constexpr int CW_CNT = 0;
constexpr int CW_FILL = 128;
constexpr int CW_TEXP = 1024;
constexpr int CW_NT = 1536;

__device__ __forceinline__ unsigned cvt_pk_bf16(float lo, float hi) { unsigned r; asm volatile("v_cvt_pk_bf16_f32 %0, %1, %2" : "=v"(r) : "v"(lo), "v"(hi)); return r; }
__device__ __forceinline__ float bf_lo(unsigned w) { return __uint_as_float(w << 16); }
__device__ __forceinline__ float bf_hi(unsigned w) { return __uint_as_float(w & 0xffff0000u); }
__device__ __forceinline__ float bf2f(bf16_t b) { return __uint_as_float(((unsigned)b) << 16); }
__device__ __forceinline__ bf16_t f2bf(float f) { return (bf16_t)(cvt_pk_bf16(f, 0.f) & 0xffffu); }
__device__ __forceinline__ float sigmoidf_(float x) { return 1.0f / (1.0f + __expf(-x)); }
__device__ __forceinline__ float siluf_(float x) { return x / (1.0f + __expf(-x)); }
__device__ __forceinline__ float wave_sum(float v) {
#pragma unroll
    for (int o = 32; o >= 1; o >>= 1) v += __shfl_xor(v, o);
    return v;
}
__device__ __forceinline__ float wave_max(float v) {
#pragma unroll
    for (int o = 32; o >= 1; o >>= 1) v = fmaxf(v, __shfl_xor(v, o));
    return v;
}
__device__ __forceinline__ int mod_row(int row) { return row < TL ? (row >> 11) : 8; }

namespace pg8 {
constexpr int BM = 256, BK = 64, HALF = 128, HTB = HALF * BK * 2, STAGE_BYTES = 8 * HTB, NXCD = 8, WGM = 8;
__host__ __device__ __forceinline__ int lds_byte(int r, int c) { const int st = (r >> 4) * 2 + (c >> 5), rr = r & 15, cc = c & 31, ob = rr * 64 + cc * 2; return st * 1024 + (ob ^ (((ob >> 9) & 1) << 5)); }
__host__ __device__ __forceinline__ void stage_rc(int b, int& R, int& C) { const int st = b / 1024, sb = b % 1024, swz = sb ^ (((sb >> 9) & 1) << 5); R = (st >> 1) * 16 + swz / 64; C = (st & 1) * 32 + (swz % 64) / 2; }
__host__ __device__ __forceinline__ int perm32(int rho) { const int n = rho >> 4, i = rho & 15; return 8 * (i >> 2) + 4 * n + (i & 3); }
struct Unit { int pm, pn; };

__device__ __forceinline__ bool static_next(int i, int G, int c, int nM, int nN, Unit& u) {
    const int nwg = nM * nN; const long L = (long)i * G + c; if (L >= nwg) return false;
    int wgid = (int)L; { const int q = nwg / NXCD, r = nwg % NXCD, xcd = wgid % NXCD, off = wgid / NXCD; wgid = (xcd < r ? xcd * (q + 1) : r * (q + 1) + (xcd - r) * q) + off; }
    const int nig = WGM * nN, gid = wgid / nig, fm = gid * WGM, gsz = (nM - fm) < WGM ? (nM - fm) : WGM;
    u.pm = fm + ((wgid % nig) % gsz); u.pn = (wgid % nig) / gsz; return true;
}

template <int MODE> struct Prob {
    const bf16_t* A; const bf16_t* Bt; int lda, ldb, K, nM, nN, G, c; const LAS int* texp; size_t bexp;
    __device__ __forceinline__ bool next(int i, Unit& u) const { return static_next(i, G, c, nM, nN, u); }
    __device__ __forceinline__ const char* a_base(const Unit& u) const { const bf16_t* p = A + (size_t)u.pm * BM * lda; if (MODE == 1) p += (u.pn >> 2) * 512; return (const char*)p; }
    __device__ __forceinline__ const char* b_base(const Unit& u) const { const bf16_t* p = Bt + (size_t)u.pn * BM * ldb; if (MODE == 2) p += (size_t)texp[u.pm] * bexp; return (const char*)p; }
};

template <class Epi, class PB>
__device__ __forceinline__ void gemm_phase(LAS unsigned char* lds, const PB& P, const Epi& E) {
    const int tid = threadIdx.x, wid = __builtin_amdgcn_readfirstlane(tid >> 6), lane = tid & 63, wr = wid >> 2, wc = wid & 3, fr = lane & 15, fq = lane >> 4;
    const int K = P.K, nt = K / BK;
    unsigned voffA[2], voffB[2];
#pragma unroll
    for (int i = 0; i < 2; ++i) { int R, C; stage_rc(tid * 16 + i * 8192, R, C); const int Rb = Epi::PERM ? ((R & ~31) + perm32(R & 31)) : R;
        voffA[i] = (unsigned)(R * P.lda + C) * 2u; voffB[i] = (unsigned)(Rb * P.ldb + C) * 2u; }
    const size_t kstep = (size_t)(BK * 2);
    const size_t hstepA = (size_t)HALF * P.lda * 2, hstepB = (size_t)HALF * P.ldb * 2;
    const unsigned ldsw = (unsigned)wid * 1024u;
    const int aoff = lds_byte(wr * 64 + fr, fq * 8), boff = lds_byte(wc * 32 + fr, fq * 8);
#define PG8_SA(b, h) (((b) * 2 + (h)) * HTB)
#define PG8_SB(b, h) ((4 + (b) * 2 + (h)) * HTB)
#define PG8_STAGE(bufoff, gbase, voff) do { _Pragma("unroll") for (int _i = 0; _i < 2; ++_i) \
        __builtin_amdgcn_global_load_lds((const unsigned*)((const char*)(gbase) + (voff)[_i]), (LAS unsigned*)(lds + (bufoff) + ldsw + _i * 8192), 16, 0, 0); } while (0)
#define PG8_LDA(dst, b, h) do { _Pragma("unroll") for (int m = 0; m < 4; ++m) _Pragma("unroll") for (int k = 0; k < 2; ++k) dst[m][k] = *(const LAS bf16x8*)(lds + PG8_SA(b, h) + aoff + m * 2048 + k * 1024); } while (0)
#define PG8_LDB(dst, b, h) do { _Pragma("unroll") for (int n = 0; n < 2; ++n) _Pragma("unroll") for (int k = 0; k < 2; ++k) dst[n][k] = *(const LAS bf16x8*)(lds + PG8_SB(b, h) + boff + n * 2048 + k * 1024); } while (0)
#define PG8_MMA(ai, bj, At, Bt) do { __builtin_amdgcn_s_setprio(1); _Pragma("unroll") for (int m = 0; m < 4; ++m) _Pragma("unroll") for (int n = 0; n < 2; ++n) _Pragma("unroll") for (int k = 0; k < 2; ++k) \
        acc[ai][bj][m][n] = __builtin_amdgcn_mfma_f32_16x16x32_bf16(Bt[n][k], At[m][k], acc[ai][bj][m][n], 0, 0, 0); __builtin_amdgcn_s_setprio(0); } while (0)
#define PG8_WAIT_V(n) asm volatile("s_waitcnt vmcnt(" #n ")" ::: "memory")
#define PG8_WAIT_L(n) asm volatile("s_waitcnt lgkmcnt(" #n ")" ::: "memory")
#define PG8_BAR __builtin_amdgcn_s_barrier()
#define PG8_SCHED __builtin_amdgcn_sched_barrier(0)
    Unit cur, nxt; int ui = 0;
    if (!P.next(0, cur)) return;
    f32x4 acc[2][2][4][2];
#pragma unroll
    for (int a = 0; a < 2; ++a)
#pragma unroll
        for (int b = 0; b < 2; ++b)
#pragma unroll
            for (int m = 0; m < 4; ++m)
#pragma unroll
                for (int n = 0; n < 2; ++n) acc[a][b][m][n] = (f32x4){0.f, 0.f, 0.f, 0.f};
    bf16x8 At[4][2], B0[2][2], B1[2][2];
    const char* cA = P.a_base(cur); const char* cB = P.b_base(cur);
    PG8_STAGE(PG8_SB(0, 0), cB, voffB); PG8_STAGE(PG8_SB(0, 1), cB + hstepB, voffB); PG8_STAGE(PG8_SA(0, 0), cA, voffA); PG8_STAGE(PG8_SA(0, 1), cA + hstepA, voffA);
    if (wr == 1) PG8_BAR;
    PG8_WAIT_V(2); PG8_BAR;
    PG8_STAGE(PG8_SB(1, 0), cB + kstep, voffB); PG8_STAGE(PG8_SA(1, 0), cA + kstep, voffA); PG8_STAGE(PG8_SB(1, 1), cB + hstepB + kstep, voffB);
    PG8_WAIT_V(6); PG8_BAR;
    for (;;) {
        const bool has_next = P.next(ui + 1, nxt);
        const char* nA = has_next ? P.a_base(nxt) : cA; const char* nB = has_next ? P.b_base(nxt) : cB;
        for (int t = 0; t < nt; t += 2) {
            const bool last = (t == nt - 2);
            const char* a1 = cA + (size_t)(t + 1) * kstep;
            const char* a2 = last ? nA : cA + (size_t)(t + 2) * kstep; const char* b2 = last ? nB : cB + (size_t)(t + 2) * kstep;
            const char* a3 = a2 + kstep; const char* b3 = b2 + kstep;
            PG8_LDB(B0, 0, 0); PG8_LDB(B1, 0, 1); PG8_SCHED; PG8_LDA(At, 0, 0); PG8_STAGE(PG8_SA(1, 1), a1 + hstepA, voffA);
            PG8_WAIT_V(8); PG8_WAIT_L(0); PG8_BAR; PG8_MMA(0, 0, At, B0); PG8_MMA(0, 1, At, B1); PG8_BAR; PG8_SCHED;
            PG8_LDA(At, 0, 1); PG8_STAGE(PG8_SB(0, 0), b2, voffB); PG8_STAGE(PG8_SB(0, 1), b2 + hstepB, voffB); PG8_STAGE(PG8_SA(0, 0), a2, voffA);
            PG8_WAIT_V(8); PG8_WAIT_L(0); PG8_BAR; PG8_MMA(1, 0, At, B0); PG8_MMA(1, 1, At, B1); PG8_BAR; PG8_SCHED;
            PG8_LDB(B0, 1, 0); PG8_LDB(B1, 1, 1); PG8_SCHED; PG8_LDA(At, 1, 0); PG8_STAGE(PG8_SA(0, 1), a2 + hstepA, voffA);
            PG8_WAIT_V(8); PG8_WAIT_L(0); PG8_BAR; PG8_MMA(0, 0, At, B0); PG8_MMA(0, 1, At, B1); PG8_BAR; PG8_SCHED;
            PG8_LDA(At, 1, 1); PG8_STAGE(PG8_SB(1, 0), b3, voffB); PG8_STAGE(PG8_SB(1, 1), b3 + hstepB, voffB); PG8_STAGE(PG8_SA(1, 0), a3, voffA);
            PG8_WAIT_V(8); PG8_WAIT_L(0); PG8_BAR; PG8_MMA(1, 0, At, B0); PG8_MMA(1, 1, At, B1); PG8_BAR; PG8_SCHED;
        }
        if (wr == 0) PG8_BAR;
        E(acc, cur, wr, wc, fr, fq);
        if (!has_next) break;
#pragma unroll
        for (int a = 0; a < 2; ++a)
#pragma unroll
            for (int b = 0; b < 2; ++b)
#pragma unroll
                for (int m = 0; m < 4; ++m)
#pragma unroll
                    for (int n = 0; n < 2; ++n) acc[a][b][m][n] = (f32x4){0.f, 0.f, 0.f, 0.f};
        cur = nxt; cA = nA; cB = nB; ++ui;
        if (wr == 1) PG8_BAR;
    }
    PG8_WAIT_V(0);
    PG8_BAR;
#undef PG8_SA
#undef PG8_SB
#undef PG8_STAGE
#undef PG8_LDA
#undef PG8_LDB
#undef PG8_MMA
#undef PG8_WAIT_V
#undef PG8_WAIT_L
#undef PG8_BAR
#undef PG8_SCHED
}

struct EpiBf16 {
    static constexpr bool PERM = true;
    bf16_t* O; int ldc; int pad_;
    __device__ __forceinline__ void operator()(const f32x4 (&acc)[2][2][4][2], const Unit& u, int wr, int wc, int fr, int fq) const {
        const int row0 = u.pm * BM + wr * 64 + fr, col0 = u.pn * BM + wc * 32 + 8 * fq;
#pragma unroll
        for (int ai = 0; ai < 2; ++ai)
#pragma unroll
            for (int m = 0; m < 4; ++m) { bf16_t* rowp = O + (size_t)(row0 + ai * HALF + m * 16) * ldc + col0;
#pragma unroll
                for (int bj = 0; bj < 2; ++bj) { const f32x4 v0 = acc[ai][bj][m][0], v1 = acc[ai][bj][m][1];
                    u32x4 w; w.x = cvt_pk_bf16(v0[0], v0[1]); w.y = cvt_pk_bf16(v0[2], v0[3]); w.z = cvt_pk_bf16(v1[0], v1[1]); w.w = cvt_pk_bf16(v1[2], v1[3]);
                    *(u32x4*)(rowp + bj * HALF) = w; } }
    }
};
struct EpiGate {
    static constexpr bool PERM = true;
    bf16_t* O; const bf16_t* Pg;
    __device__ __forceinline__ void operator()(const f32x4 (&acc)[2][2][4][2], const Unit& u, int wr, int wc, int fr, int fq) const {
        const int row0 = u.pm * BM + wr * 64 + fr, col0 = u.pn * BM + wc * 32 + 8 * fq;
#pragma unroll
        for (int ai = 0; ai < 2; ++ai)
#pragma unroll
            for (int m = 0; m < 4; ++m) { const size_t row = (size_t)(row0 + ai * HALF + m * 16); bf16_t* rowp = O + row * 3072 + col0; const bf16_t* gp = Pg + row * NP + P_GATE + col0;
#pragma unroll
                for (int bj = 0; bj < 2; ++bj) { const f32x4 v0 = acc[ai][bj][m][0], v1 = acc[ai][bj][m][1]; const u32x4 g = *(const u32x4*)(gp + bj * HALF);
                    u32x4 w;
                    w.x = cvt_pk_bf16(v0[0] * sigmoidf_(bf_lo(g.x)), v0[1] * sigmoidf_(bf_hi(g.x))); w.y = cvt_pk_bf16(v0[2] * sigmoidf_(bf_lo(g.y)), v0[3] * sigmoidf_(bf_hi(g.y)));
                    w.z = cvt_pk_bf16(v1[0] * sigmoidf_(bf_lo(g.z)), v1[1] * sigmoidf_(bf_hi(g.z))); w.w = cvt_pk_bf16(v1[2] * sigmoidf_(bf_lo(g.w)), v1[3] * sigmoidf_(bf_hi(g.w)));
                    *(u32x4*)(rowp + bj * HALF) = w; } }
    }
};
struct EpiResid {
    static constexpr bool PERM = false;
    float* X; const float* modg;
    __device__ __forceinline__ void operator()(const f32x4 (&acc)[2][2][4][2], const Unit& u, int wr, int wc, int fr, int fq) const {
        const int row0 = u.pm * BM + wr * 64 + fr, col0 = u.pn * BM + wc * 32 + 4 * fq;
        const float* mg = modg + (size_t)mod_row(u.pm * BM) * 6144 + col0;
        f32x4 gv[2][2];
#pragma unroll
        for (int bj = 0; bj < 2; ++bj)
#pragma unroll
            for (int n = 0; n < 2; ++n) gv[bj][n] = *(const f32x4*)(mg + bj * HALF + n * 16);
#pragma unroll
        for (int ai = 0; ai < 2; ++ai)
#pragma unroll
            for (int m = 0; m < 4; ++m) { float* rowp = X + (size_t)(row0 + ai * HALF + m * 16) * D + col0;
#pragma unroll
                for (int bj = 0; bj < 2; ++bj)
#pragma unroll
                    for (int n = 0; n < 2; ++n) { f32x4* p = (f32x4*)(rowp + bj * HALF + n * 16); *p = *p + gv[bj][n] * acc[ai][bj][m][n]; } }
    }
};
struct EpiSwiglu {
    static constexpr bool PERM = true;
    bf16_t* O;
    __device__ __forceinline__ void operator()(const f32x4 (&acc)[2][2][4][2], const Unit& u, int wr, int wc, int fr, int fq) const {
        const int row0 = u.pm * BM + wr * 64 + fr, col0 = u.pn * HALF + wc * 32 + 8 * fq;
#pragma unroll
        for (int ai = 0; ai < 2; ++ai)
#pragma unroll
            for (int m = 0; m < 4; ++m) { bf16_t* rowp = O + (size_t)(row0 + ai * HALF + m * 16) * DFF + col0;
                const f32x4 a0 = acc[ai][0][m][0], a1 = acc[ai][0][m][1], b0 = acc[ai][1][m][0], b1 = acc[ai][1][m][1];
                u32x4 w; w.x = cvt_pk_bf16(siluf_(a0[0]) * b0[0], siluf_(a0[1]) * b0[1]); w.y = cvt_pk_bf16(siluf_(a0[2]) * b0[2], siluf_(a0[3]) * b0[3]);
                w.z = cvt_pk_bf16(siluf_(a1[0]) * b1[0], siluf_(a1[1]) * b1[1]); w.w = cvt_pk_bf16(siluf_(a1[2]) * b1[2], siluf_(a1[3]) * b1[3]);
                *(u32x4*)rowp = w; }
    }
};
}

struct GemmArgs { const bf16_t* A; const bf16_t* Bt; const unsigned* ctl; size_t bexp; int lda, ldb, K, nM, nN, moe_j; };

template <int MODE, class Epi> __global__ void __launch_bounds__(512, 2) k_gemm(GemmArgs ga, Epi E) {
    extern __shared__ __attribute__((aligned(16))) unsigned char shm[];
    LAS unsigned char* lds = (LAS unsigned char*)shm;
    LAS int* texp = (LAS int*)(lds + pg8::STAGE_BYTES);
    pg8::Prob<MODE> P; P.A = ga.A; P.Bt = ga.Bt; P.lda = ga.lda; P.ldb = ga.ldb; P.K = ga.K; P.nM = ga.nM; P.nN = ga.nN; P.G = gridDim.x; P.c = blockIdx.x; P.texp = texp; P.bexp = ga.bexp;
    if (MODE == 2) {
        if (threadIdx.x < 256) texp[threadIdx.x] = (int)ga.ctl[CW_TEXP + ga.moe_j * 256 + threadIdx.x];
        P.nM = (int)ga.ctl[CW_NT + ga.moe_j];
        __syncthreads();
    }
    pg8::gemm_phase<Epi, pg8::Prob<MODE>>(lds, P, E);
}

struct CvtJob { const float* s0; const float* s1; bf16_t* dst; int ldw, ldd, kd0, K, Nd, kind; };
__global__ void __launch_bounds__(512) k_convert(CvtJob j) {
    __shared__ float tile[256 * 33];
    const int tid = threadIdx.x, nn = tid & 31, kk = tid >> 5;
    const int kch = j.K / 256, nitems = (j.Nd / 32) * kch;
    for (int it = blockIdx.x; it < nitems; it += gridDim.x) {
        const int nb = it / kch, kc = it % kch, n0 = nb * 32, k0 = kc * 256;
        const float* src = j.s0; int sc = n0;
        if (j.kind == 1) { sc = n0 < 3840 ? n0 : (n0 < 6912 ? n0 + 32 : (n0 < 6944 ? n0 - 3072 : -1)); }
        else if (j.kind == 2) { const int tj = n0 >> 8, r = n0 & 255; if (r < 128) { sc = tj * 128 + r; } else { src = j.s1; sc = tj * 128 + r - 128; } }
#pragma unroll 4
        for (int p = 0; p < 16; ++p) { const int k = p * 16 + kk; tile[k * 33 + nn] = sc >= 0 ? src[(size_t)(k0 + k) * j.ldw + sc + nn] : 0.f; }
        __syncthreads();
#pragma unroll
        for (int q = 0; q < 2; ++q) { const int ch = tid + q * 512, n = ch >> 5, k8 = (ch & 31) * 8;
            float v[8];
#pragma unroll
            for (int e = 0; e < 8; ++e) v[e] = tile[(k8 + e) * 33 + n];
            u32x4 w; w.x = cvt_pk_bf16(v[0], v[1]); w.y = cvt_pk_bf16(v[2], v[3]); w.z = cvt_pk_bf16(v[4], v[5]); w.w = cvt_pk_bf16(v[6], v[7]);
            *(u32x4*)(j.dst + (size_t)(n0 + n) * j.ldd + j.kd0 + k0 + k8) = w; }
        __syncthreads();
    }
}

__global__ void __launch_bounds__(512) k_init(const float* x, const float* ctx, float* XS, f32x2* CS) {
    const size_t n4 = (size_t)T * D / 4, nx4 = (size_t)TL * D / 4;
    for (size_t i = (size_t)blockIdx.x * 512 + threadIdx.x; i < n4; i += (size_t)gridDim.x * 512) ((f32x4*)XS)[i] = i < nx4 ? ((const f32x4*)x)[i] : ((const f32x4*)ctx)[i - nx4];
    if (blockIdx.x == 0) for (int i = threadIdx.x; i < 64 * 16; i += 512) { const int pos = i >> 4, f = i & 15; const float inv = powf(10000.0f, -(float)f / 16.0f); const float a = (float)pos * inv; CS[i] = (f32x2){cosf(a), sinf(a)}; }
}

__global__ void __launch_bounds__(512) k_mod(const float* c, const float* c_ctx, const float* w_mod, const float* b_mod, float* MOD) {
    __shared__ float sv[9 * 1024]; __shared__ float red[4 * 128 * 9];
    const int tid = threadIdx.x;
    for (int i = tid; i < 9 * 1024; i += 512) { const float v = i < 8192 ? c[i] : c_ctx[i - 8192]; sv[i] = siluf_(v); }
    __syncthreads();
    const int cl = tid & 127, kq = tid >> 7;
    for (int it = blockIdx.x; it < DEPTH * 48; it += gridDim.x) {
        const int l = it / 48, n = (it % 48) * 128 + cl;
        const float* w = w_mod + (size_t)l * D * 6144 + n;
        float a[9];
#pragma unroll
        for (int r = 0; r < 9; ++r) a[r] = 0.f;
#pragma unroll 4
        for (int k = kq * 256; k < kq * 256 + 256; ++k) { const float wv = w[(size_t)k * 6144];
#pragma unroll
            for (int r = 0; r < 9; ++r) a[r] += sv[r * 1024 + k] * wv; }
#pragma unroll
        for (int r = 0; r < 9; ++r) red[(kq * 128 + cl) * 9 + r] = a[r];
        __syncthreads();
        if (kq == 0) {
#pragma unroll
            for (int r = 0; r < 9; ++r) { const float s = red[cl * 9 + r] + red[(128 + cl) * 9 + r] + red[(256 + cl) * 9 + r] + red[(384 + cl) * 9 + r];
                MOD[((size_t)l * 9 + r) * 6144 + n] = s + b_mod[(size_t)l * 6144 + n]; }
        }
        __syncthreads();
    }
}

struct NormArgs { float* XS; bf16_t* H; const float* g; const float* mod_shift; const float* mod_scale;
                  const bf16_t* Y; const int* POS; const float* TOPKp; const float* mod_g5prev;
                  const float* router; float* TOPK; unsigned* cnt; int nrows; int pad_; };
template <bool COMBINE, bool ROUTE> __global__ void __launch_bounds__(512) k_norm(NormArgs a) {
    const int lane = threadIdx.x & 63, wid = threadIdx.x >> 6;
    for (int row = blockIdx.x * 8 + wid; row < a.nrows; row += gridDim.x * 8) {
        const int mr = mod_row(row);
        float* xr = a.XS + (size_t)row * D;
        f32x4 x[4];
#pragma unroll
        for (int j = 0; j < 4; ++j) x[j] = *(const f32x4*)(xr + 4 * (lane + 64 * j));
        if (COMBINE) {
            const int s1 = a.POS[2 * row], s2 = a.POS[2 * row + 1]; const float p1 = a.TOPKp[4 * row + 2], p2 = a.TOPKp[4 * row + 3];
#pragma unroll
            for (int j = 0; j < 4; ++j) { const int cc = 4 * (lane + 64 * j);
                const u32x2 y1 = *(const u32x2*)(a.Y + (size_t)s1 * D + cc), y2 = *(const u32x2*)(a.Y + (size_t)s2 * D + cc);
                const f32x4 mg = *(const f32x4*)(a.mod_g5prev + (size_t)mr * 6144 + cc);
                f32x4 e; e[0] = p1 * bf_lo(y1.x) + p2 * bf_lo(y2.x); e[1] = p1 * bf_hi(y1.x) + p2 * bf_hi(y2.x); e[2] = p1 * bf_lo(y1.y) + p2 * bf_lo(y2.y); e[3] = p1 * bf_hi(y1.y) + p2 * bf_hi(y2.y);
                x[j] = x[j] + mg * e; *(f32x4*)(xr + cc) = x[j]; }
        }
        float ss = 0.f;
#pragma unroll
        for (int j = 0; j < 4; ++j) ss += x[j][0] * x[j][0] + x[j][1] * x[j][1] + x[j][2] * x[j][2] + x[j][3] * x[j][3];
        ss = wave_sum(ss);
        const float rs = rsqrtf(ss * (1.0f / D) + EPS);
        f32x4 h[4];
#pragma unroll
        for (int j = 0; j < 4; ++j) { const int cc = 4 * (lane + 64 * j);
            const f32x4 g = *(const f32x4*)(a.g + cc), sh = *(const f32x4*)(a.mod_shift + (size_t)mr * 6144 + cc), sc = *(const f32x4*)(a.mod_scale + (size_t)mr * 6144 + cc);
            h[j] = (x[j] * rs * g) * (sc + 1.0f) + sh;
            u32x2 w; w.x = cvt_pk_bf16(h[j][0], h[j][1]); w.y = cvt_pk_bf16(h[j][2], h[j][3]);
            *(u32x2*)(a.H + (size_t)row * D + cc) = w; }
        if (ROUTE) {
            float lg[8];
#pragma unroll
            for (int e = 0; e < 8; ++e) lg[e] = 0.f;
#pragma unroll
            for (int j = 0; j < 4; ++j)
#pragma unroll
                for (int q = 0; q < 4; ++q) { const float* rw = a.router + (size_t)(4 * (lane + 64 * j) + q) * 8; const f32x4 r0 = *(const f32x4*)rw, r1 = *(const f32x4*)(rw + 4); const float hv = h[j][q];
                    lg[0] += hv * r0[0]; lg[1] += hv * r0[1]; lg[2] += hv * r0[2]; lg[3] += hv * r0[3]; lg[4] += hv * r1[0]; lg[5] += hv * r1[1]; lg[6] += hv * r1[2]; lg[7] += hv * r1[3]; }
#pragma unroll
            for (int e = 0; e < 8; ++e) lg[e] = wave_sum(lg[e]);
            if (lane == 0) {
                int e1 = 0; float v1 = lg[0];
#pragma unroll
                for (int e = 1; e < 8; ++e) if (lg[e] > v1) { v1 = lg[e]; e1 = e; }
                int e2 = -1; float v2 = -3.0e38f;
#pragma unroll
                for (int e = 0; e < 8; ++e) if (e != e1 && lg[e] > v2) { v2 = lg[e]; e2 = e; }
                const float p2 = 1.0f / (1.0f + __expf(v1 - v2)), p1 = 1.0f - p2;
                float* tk = a.TOPK + 4 * (size_t)row; tk[0] = __int_as_float(e1); tk[1] = __int_as_float(e2); tk[2] = p1; tk[3] = p2;
                atomicAdd(a.cnt + e1, 1u); atomicAdd(a.cnt + e2, 1u);
            }
        }
    }
}

__global__ void __launch_bounds__(512) k_route(const float* TOPK, const bf16_t* H, bf16_t* HS, int* POS, int* IDX, unsigned* ctl, int j, int nrows) {
    __shared__ unsigned sbase[16];
    const int lane = threadIdx.x & 63, wid = threadIdx.x >> 6;
    if (threadIdx.x == 0) { unsigned b = 0; for (int e = 0; e < 8; ++e) { sbase[e] = b; b += (ctl[CW_CNT + j * 64 + e] + 255u) & ~255u; } sbase[8] = b; }
    __syncthreads();
    if (blockIdx.x == 0) {
        if (threadIdx.x < 256) { const unsigned r0 = threadIdx.x * 256u; int e = 0;
            for (int q = 1; q < 8; ++q) if (r0 >= sbase[q]) e = q;
            ctl[CW_TEXP + j * 256 + threadIdx.x] = (unsigned)e; }
        if (threadIdx.x == 0) ctl[CW_NT + j] = sbase[8] / 256u;
    }
    for (int row = blockIdx.x * 8 + wid; row < nrows; row += gridDim.x * 8) {
        int s1 = 0, s2 = 0;
        if (lane == 0) { const int e1 = __float_as_int(TOPK[4 * (size_t)row]), e2 = __float_as_int(TOPK[4 * (size_t)row + 1]);
            s1 = (int)(sbase[e1] + atomicAdd(ctl + CW_FILL + j * 64 + e1, 1u)); s2 = (int)(sbase[e2] + atomicAdd(ctl + CW_FILL + j * 64 + e2, 1u));
            POS[2 * row] = s1; POS[2 * row + 1] = s2; IDX[s1] = row; IDX[s2] = row; }
        s1 = __shfl(s1, 0); s2 = __shfl(s2, 0);
        const u32x4* src = (const u32x4*)(H + (size_t)row * D);
#pragma unroll
        for (int q = 0; q < 2; ++q) { const u32x4 v = src[lane + 64 * q]; ((u32x4*)(HS + (size_t)s1 * D))[lane + 64 * q] = v; ((u32x4*)(HS + (size_t)s2 * D))[lane + 64 * q] = v; }
    }
}
__global__ void __launch_bounds__(512) k_route_pad(const bf16_t* H, bf16_t* HS, const unsigned* ctl, int j) {
    __shared__ unsigned sbase[16];
    if (threadIdx.x == 0) { unsigned b = 0; for (int e = 0; e < 8; ++e) { sbase[e] = b; b += (ctl[CW_CNT + j * 64 + e] + 255u) & ~255u; } sbase[8] = b; }
    __syncthreads();
    const int lane = threadIdx.x & 63, wid = threadIdx.x >> 6;
    for (int i = blockIdx.x * 8 + wid; i < 8 * 256; i += gridDim.x * 8) { const int e = i >> 8, r = i & 255; const unsigned s = sbase[e] + ctl[CW_CNT + j * 64 + e] + r;
        if (s < sbase[e + 1]) {
#pragma unroll
            for (int q = 0; q < 2; ++q) ((u32x4*)(HS + (size_t)s * D))[lane + 64 * q] = ((const u32x4*)H)[lane + 64 * q]; } }
}

__global__ void __launch_bounds__(512) k_tok(const bf16_t* P, bf16_t* BR, bf16_t* QR, bf16_t* KV, float* LA, const f32x2* CS, const float* conv_w, const float* gla_w2, const float* gla_b, int nrows) {
    __shared__ float w2s[2 * 16 * 256]; __shared__ float ags[8][32];
    const int tid = threadIdx.x, lane = tid & 63, wid = tid >> 6;
    for (int i = tid; i < 2 * 16 * 256; i += 512) w2s[i] = gla_w2[i];
    __syncthreads();
    for (int row = blockIdx.x * 8 + wid; row < nrows; row += gridDim.x * 8) {
        const bf16_t* pr = P + (size_t)row * NP;
        const bool lat = row < TL; const int sp = lat ? (row & (SEQ - 1)) : ((row - TL) & (CTXL - 1)); const int slen = lat ? SEQ : CTXL;
        { const int c0 = lane * 8; float z[3][8];
#pragma unroll
          for (int d = 0; d < 3; ++d) { const int sq = sp + d - 1; const bool ok = sq >= 0 && sq < slen;
              if (ok) { const bf16_t* q = pr + (ptrdiff_t)(d - 1) * NP; const u32x4 cc = *(const u32x4*)(q + P_CC + c0), cu = *(const u32x4*)(q + P_CU + c0);
                  z[d][0] = bf_lo(cc.x) * bf_lo(cu.x); z[d][1] = bf_hi(cc.x) * bf_hi(cu.x); z[d][2] = bf_lo(cc.y) * bf_lo(cu.y); z[d][3] = bf_hi(cc.y) * bf_hi(cu.y);
                  z[d][4] = bf_lo(cc.z) * bf_lo(cu.z); z[d][5] = bf_hi(cc.z) * bf_hi(cu.z); z[d][6] = bf_lo(cc.w) * bf_lo(cu.w); z[d][7] = bf_hi(cc.w) * bf_hi(cu.w); }
              else {
#pragma unroll
                  for (int e = 0; e < 8; ++e) z[d][e] = 0.f; } }
          const u32x4 cb = *(const u32x4*)(pr + P_CB + c0); float b[8] = {bf_lo(cb.x), bf_hi(cb.x), bf_lo(cb.y), bf_hi(cb.y), bf_lo(cb.z), bf_hi(cb.z), bf_lo(cb.w), bf_hi(cb.w)}; float y[8];
#pragma unroll
          for (int e = 0; e < 8; ++e) y[e] = b[e] * (z[0][e] * conv_w[c0 + e] + z[1][e] * conv_w[512 + c0 + e] + z[2][e] * conv_w[1024 + c0 + e]);
          u32x4 w; w.x = cvt_pk_bf16(y[0], y[1]); w.y = cvt_pk_bf16(y[2], y[3]); w.z = cvt_pk_bf16(y[4], y[5]); w.w = cvt_pk_bf16(y[6], y[7]);
          *(u32x4*)(BR + (size_t)row * 1536 + c0) = w; }
        { const int srow = sp >> 6, scol = sp & 63;
          for (int i = lane; i < 640; i += 64) { const int d = i & 63, sec = d >> 5, e = d & 31, f = e & 15; const bool hi = e >= 16;
              const int colp = (i < 512 ? P_QA + i : P_KA + (i - 512)); const float xv = bf2f(pr[colp]); const float xo = bf2f(pr[hi ? colp - 16 : colp + 16]);
              float o = xv;
              if (lat) { const f32x2 cs = CS[(sec ? scol : srow) * 16 + f]; o = hi ? (xv * cs.x + xo * cs.y) : (xv * cs.x - xo * cs.y); }
              if (i < 512) QR[(size_t)row * 512 + i] = f2bf(o * 0.125f); else KV[(size_t)row * 256 + (i - 512)] = f2bf(o); }
          for (int i = lane; i < 128; i += 64) KV[(size_t)row * 256 + 128 + i] = pr[P_VA + i]; }
        { if (lane < 32) ags[wid][lane] = bf2f(pr[P_AG + lane]);
          __builtin_amdgcn_wave_barrier();
          for (int i = lane; i < 512; i += 64) { const int d = i >> 8, cch = i & 255; float zz = gla_b[d * 256 + cch];
#pragma unroll
              for (int r = 0; r < 16; ++r) zz += ags[wid][d * 16 + r] * w2s[(d * 16 + r) * 256 + cch];
              const float ls = fminf(zz, 0.f) - log1pf(__expf(-fabsf(zz)));
              LA[(size_t)row * 512 + i] = ls * (1.0f / 16.0f); }
          __builtin_amdgcn_wave_barrier(); }
    }
}

__global__ void __launch_bounds__(512) k_attn(const bf16_t* QR, const bf16_t* KV, bf16_t* BR, const float* sink, int nrows) {
    __shared__ float qs[8][256];
    const int lane = threadIdx.x & 63, wid = threadIdx.x >> 6;
    for (int item = blockIdx.x * 8 + wid; item < nrows * 2; item += gridDim.x * 8) {
        const int row = item >> 1, kh = item & 1;
        const bool lat = row < TL; const int b = lat ? (row >> 11) : ((row - TL) >> 8); const int s = row & (SEQ - 1);
        const int lo = lat ? max(s - 128, 0) : 0, hi = lat ? min(s + 128, SEQ - 1) : -1; const int nwin = hi - lo + 1; const int ntot = nwin + CTXL;
        const int wbase = b * SEQ + lo, cbase = TL + b * CTXL;
#pragma unroll
        for (int q = 0; q < 4; ++q) qs[wid][q * 64 + lane] = bf2f(QR[(size_t)row * 512 + kh * 256 + q * 64 + lane]);
        __builtin_amdgcn_wave_barrier();
        float sc[4][9];
#pragma unroll
        for (int it = 0; it < 9; ++it) { const int jj = it * 64 + lane; const bool ok = jj < ntot;
            const int krow = jj < nwin ? wbase + jj : cbase + (jj - nwin);
            float d0 = 0.f, d1 = 0.f, d2 = 0.f, d3 = 0.f;
            if (ok) { const u32x4* kp = (const u32x4*)(KV + (size_t)krow * 256 + kh * 64);
#pragma unroll
                for (int c = 0; c < 8; ++c) { const u32x4 kw = kp[c]; const float kf[8] = {bf_lo(kw.x), bf_hi(kw.x), bf_lo(kw.y), bf_hi(kw.y), bf_lo(kw.z), bf_hi(kw.z), bf_lo(kw.w), bf_hi(kw.w)};
#pragma unroll
                    for (int e = 0; e < 8; ++e) { const float kv = kf[e]; const int dd = c * 8 + e; d0 += kv * qs[wid][dd]; d1 += kv * qs[wid][64 + dd]; d2 += kv * qs[wid][128 + dd]; d3 += kv * qs[wid][192 + dd]; } } }
            sc[0][it] = ok ? d0 : -3.0e38f; sc[1][it] = ok ? d1 : -3.0e38f; sc[2][it] = ok ? d2 : -3.0e38f; sc[3][it] = ok ? d3 : -3.0e38f; }
        float inv[4];
#pragma unroll
        for (int q = 0; q < 4; ++q) { const float sk = sink[kh * 4 + q]; float m = sk;
#pragma unroll
            for (int it = 0; it < 9; ++it) m = fmaxf(m, sc[q][it]);
            m = wave_max(m); float sum = 0.f;
#pragma unroll
            for (int it = 0; it < 9; ++it) { const float p = __expf(sc[q][it] - m); sc[q][it] = p; sum += p; }
            sum = wave_sum(sum) + __expf(sk - m); inv[q] = 1.0f / sum; }
        float o0 = 0.f, o1 = 0.f, o2 = 0.f, o3 = 0.f;
#pragma unroll
        for (int it = 0; it < 9; ++it) { const int jb = it * 64; int jn = ntot - jb; jn = jn < 0 ? 0 : (jn > 64 ? 64 : jn);
            for (int j = 0; j < jn; ++j) { const int jj = jb + j; const int krow = jj < nwin ? wbase + jj : cbase + (jj - nwin);
                const float v = bf2f(KV[(size_t)krow * 256 + 128 + kh * 64 + lane]);
                o0 += __shfl(sc[0][it], j) * v; o1 += __shfl(sc[1][it], j) * v; o2 += __shfl(sc[2][it], j) * v; o3 += __shfl(sc[3][it], j) * v; } }
        bf16_t* op = BR + (size_t)row * 1536 + 512 + kh * 256 + lane;
        op[0] = f2bf(o0 * inv[0]); op[64] = f2bf(o1 * inv[1]); op[128] = f2bf(o2 * inv[2]); op[192] = f2bf(o3 * inv[3]);
        __builtin_amdgcn_wave_barrier();
    }
}

__global__ void __launch_bounds__(128) k_gla_scan(const bf16_t* P, const float* LA, float* OG) {
    __shared__ float sa[16][64], sk[16][64], sq[16][64];
    const int b = blockIdx.x >> 3, h = (blockIdx.x >> 1) & 3, dir = blockIdx.x & 1, j = threadIdx.x;
    float S[64];
#pragma unroll
    for (int i = 0; i < 64; ++i) S[i] = 0.f;
    const int NT = CTXL + SEQ;
    for (int t0 = 0; t0 < NT; t0 += 16) {
        __syncthreads();
        for (int i = j; i < 16 * 64; i += 128) { const int tt = t0 + (i >> 6), ch = i & 63;
            const int row = tt < CTXL ? TL + b * CTXL + (dir ? CTXL - 1 - tt : tt) : b * SEQ + (dir ? SEQ - 1 - (tt - CTXL) : (tt - CTXL));
            sa[i >> 6][ch] = __expf(LA[(size_t)row * 512 + dir * 256 + h * 64 + ch]);
            sk[i >> 6][ch] = bf2f(P[(size_t)row * NP + P_KG + h * 64 + ch]);
            sq[i >> 6][ch] = bf2f(P[(size_t)row * NP + P_QG + h * 64 + ch]) * 0.125f; }
        __syncthreads();
        for (int u = 0; u < 16; ++u) { const int tt = t0 + u;
            const int row = tt < CTXL ? TL + b * CTXL + (dir ? CTXL - 1 - tt : tt) : b * SEQ + (dir ? SEQ - 1 - (tt - CTXL) : (tt - CTXL));
            const float v = bf2f(P[(size_t)row * NP + P_VG + h * 128 + j]); float o = 0.f;
#pragma unroll
            for (int i = 0; i < 64; ++i) { S[i] = sa[u][i] * S[i] + sk[u][i] * v; o += sq[u][i] * S[i]; }
            OG[((size_t)dir * T + row) * 512 + h * 128 + j] = o; }
    }
}
__global__ void __launch_bounds__(512) k_gla_out(const float* OG, const bf16_t* P, const float* g, bf16_t* BR, int nrows) {
    const int lane = threadIdx.x & 63, wid = threadIdx.x >> 6;
    for (int row = blockIdx.x * 8 + wid; row < nrows; row += gridDim.x * 8) {
        const int c0 = lane * 8; float o[8];
        const f32x4 a0 = *(const f32x4*)(OG + (size_t)row * 512 + c0), a1 = *(const f32x4*)(OG + (size_t)row * 512 + c0 + 4);
        const f32x4 b0 = *(const f32x4*)(OG + ((size_t)T + row) * 512 + c0), b1 = *(const f32x4*)(OG + ((size_t)T + row) * 512 + c0 + 4);
#pragma unroll
        for (int e = 0; e < 4; ++e) { o[e] = a0[e] + b0[e]; o[4 + e] = a1[e] + b1[e]; }
        float ss = 0.f;
#pragma unroll
        for (int e = 0; e < 8; ++e) ss += o[e] * o[e];
        ss += __shfl_xor(ss, 1); ss += __shfl_xor(ss, 2); ss += __shfl_xor(ss, 4); ss += __shfl_xor(ss, 8);
        const float rs = rsqrtf(ss * (1.0f / 128.0f) + EPS);
        const u32x4 rw = *(const u32x4*)(P + (size_t)row * NP + P_RG + c0); const float r[8] = {bf_lo(rw.x), bf_hi(rw.x), bf_lo(rw.y), bf_hi(rw.y), bf_lo(rw.z), bf_hi(rw.z), bf_lo(rw.w), bf_hi(rw.w)};
        float y[8];
#pragma unroll
        for (int e = 0; e < 8; ++e) y[e] = o[e] * rs * g[c0 + e] * siluf_(r[e]);
        u32x4 w; w.x = cvt_pk_bf16(y[0], y[1]); w.y = cvt_pk_bf16(y[2], y[3]); w.z = cvt_pk_bf16(y[4], y[5]); w.w = cvt_pk_bf16(y[6], y[7]);
        *(u32x4*)(BR + (size_t)row * 1536 + 1024 + c0) = w;
    }
}

__global__ void __launch_bounds__(512) k_final(const float* XS, const bf16_t* Y, const int* POS, const float* TOPK, const float* mod_g5, const float* g, float* out) {
    const int lane = threadIdx.x & 63, wid = threadIdx.x >> 6;
    for (int row = blockIdx.x * 8 + wid; row < TL; row += gridDim.x * 8) {
        const int mr = mod_row(row); const float* xr = XS + (size_t)row * D;
        const int s1 = POS[2 * row], s2 = POS[2 * row + 1]; const float p1 = TOPK[4 * row + 2], p2 = TOPK[4 * row + 3];
        f32x4 x[4]; float ss = 0.f;
#pragma unroll
        for (int j = 0; j < 4; ++j) { const int cc = 4 * (lane + 64 * j); x[j] = *(const f32x4*)(xr + cc);
            const u32x2 y1 = *(const u32x2*)(Y + (size_t)s1 * D + cc), y2 = *(const u32x2*)(Y + (size_t)s2 * D + cc);
            const f32x4 mg = *(const f32x4*)(mod_g5 + (size_t)mr * 6144 + cc);
            f32x4 e; e[0] = p1 * bf_lo(y1.x) + p2 * bf_lo(y2.x); e[1] = p1 * bf_hi(y1.x) + p2 * bf_hi(y2.x); e[2] = p1 * bf_lo(y1.y) + p2 * bf_lo(y2.y); e[3] = p1 * bf_hi(y1.y) + p2 * bf_hi(y2.y);
            x[j] = x[j] + mg * e; ss += x[j][0] * x[j][0] + x[j][1] * x[j][1] + x[j][2] * x[j][2] + x[j][3] * x[j][3]; }
        ss = wave_sum(ss); const float rs = rsqrtf(ss * (1.0f / D) + EPS);
#pragma unroll
        for (int j = 0; j < 4; ++j) { const int cc = 4 * (lane + 64 * j); const f32x4 gg = *(const f32x4*)(g + cc); *(f32x4*)(out + (size_t)row * D + cc) = x[j] * rs * gg; }
    }
}

template <int MODE, class Epi> static void launch_gemm(const GemmArgs& ga, const Epi& E, hipStream_t st) {
    static bool attr = false; const int lds = pg8::STAGE_BYTES + 1024;
    if (!attr) { (void)hipFuncSetAttribute((const void*)k_gemm<MODE, Epi>, hipFuncAttributeMaxDynamicSharedMemorySize, lds); attr = true; }
    hipLaunchKernelGGL((k_gemm<MODE, Epi>), dim3(256), dim3(512), lds, st, ga, E);
}
static void launch_cvt(const float* s0, const float* s1, bf16_t* dst, int ldw, int ldd, int kd0, int K, int Nd, int kind, hipStream_t st) {
    CvtJob j; j.s0 = s0; j.s1 = s1; j.dst = dst; j.ldw = ldw; j.ldd = ldd; j.kd0 = kd0; j.K = K; j.Nd = Nd; j.kind = kind;
    int items = (Nd / 32) * (K / 256); if (items > 2048) items = 2048;
    hipLaunchKernelGGL(k_convert, dim3(items), dim3(512), 0, st, j);
}

extern "C" void kernel_launch(void* const* d_in, const int* in_sizes, int n_in, void* d_out, int out_size, void* d_ws, size_t ws_size, hipStream_t stream) {
    (void)in_sizes; (void)out_size;
    if (n_in != 24 || ws_size < WS_END) return;
    const float* x = (const float*)d_in[0]; const float* c = (const float*)d_in[1]; const float* ctx = (const float*)d_in[2]; const float* c_ctx = (const float*)d_in[3];
    const float* w_mod = (const float*)d_in[4]; const float* b_mod = (const float*)d_in[5]; const float* norm1_g = (const float*)d_in[6]; const float* norm2_g = (const float*)d_in[7];
    const float* w_in = (const float*)d_in[8]; const float* conv_w = (const float*)d_in[9]; const float* attn_sink = (const float*)d_in[10]; const float* gla_w2 = (const float*)d_in[11];
    const float* gla_b = (const float*)d_in[12]; const float* gla_norm_g = (const float*)d_in[13]; const float* w_branch = (const float*)d_in[14]; const float* w_out = (const float*)d_in[15];
    const float* ffn_w1 = (const float*)d_in[16]; const float* ffn_w3 = (const float*)d_in[17]; const float* ffn_w2 = (const float*)d_in[18]; const float* router_w = (const float*)d_in[19];
    const float* moe_w1 = (const float*)d_in[20]; const float* moe_w3 = (const float*)d_in[21]; const float* moe_w2 = (const float*)d_in[22]; const float* final_g = (const float*)d_in[23];
    char* ws = (char*)d_ws;
    unsigned* CTL = (unsigned*)(ws + WS_CTL); float* MOD = (float*)(ws + WS_MOD); f32x2* CS = (f32x2*)(ws + WS_CS); float* XS = (float*)(ws + WS_XS); bf16_t* H = (bf16_t*)(ws + WS_H);
    bf16_t* PH = (bf16_t*)(ws + WS_PH); bf16_t* BR = (bf16_t*)(ws + WS_BR); char* R3 = ws + WS_R3; bf16_t* YB = (bf16_t*)(ws + WS_YB); bf16_t* QR = (bf16_t*)(ws + WS_QR); bf16_t* KV = (bf16_t*)(ws + WS_KV);
    float* TOPK = (float*)(ws + WS_TOPK); int* POS = (int*)(ws + WS_POS); int* IDX = (int*)(ws + WS_IDX);
    bf16_t* WIN = (bf16_t*)(ws + WS_WIN); bf16_t* WBR = (bf16_t*)(ws + WS_WBR); bf16_t* WO3 = (bf16_t*)(ws + WS_WO3); bf16_t* WUPD = (bf16_t*)(ws + WS_WUPD); bf16_t* WDND = (bf16_t*)(ws + WS_WDND);
    bf16_t* WUPM = (bf16_t*)(ws + WS_WUPM); bf16_t* WDNM = (bf16_t*)(ws + WS_WDNM);
    float* OG = (float*)R3; float* LA = (float*)(R3 + (size_t)2 * T * 512 * 4); bf16_t* MG3 = (bf16_t*)R3; bf16_t* HS = (bf16_t*)R3;

    (void)hipMemsetAsync(CTL, 0, CTL_BYTES, stream);
    hipLaunchKernelGGL(k_init, dim3(1024), dim3(512), 0, stream, x, ctx, XS, CS);
    hipLaunchKernelGGL(k_mod, dim3(192), dim3(512), 0, stream, c, c_ctx, w_mod, b_mod, MOD);
    for (int l = 0; l < DEPTH; ++l) {
        launch_cvt(w_in + (size_t)l * D * DIN, nullptr, WIN + (size_t)l * NP * D, DIN, D, 0, D, NP, 1, stream);
        for (int i = 0; i < 3; ++i) {
            launch_cvt(w_branch + ((size_t)l * 3 + i) * 512 * D, nullptr, WBR + ((size_t)l * 3072 + (size_t)i * 1024) * 512, D, 512, 0, 512, 1024, 0, stream);
            launch_cvt(w_out + (size_t)l * D * D, nullptr, WO3 + (size_t)l * D * 3072, D, 3072, i * 1024, D, D, 0, stream);
        }
    }
    for (int j = 0; j < 2; ++j) {
        launch_cvt(ffn_w1 + (size_t)j * D * DFF, ffn_w3 + (size_t)j * D * DFF, WUPD + (size_t)j * NUP * D, DFF, D, 0, D, NUP, 2, stream);
        launch_cvt(ffn_w2 + (size_t)j * DFF * D, nullptr, WDND + (size_t)j * D * DFF, D, DFF, 0, DFF, D, 0, stream);
    }
    for (int l = 0; l < DEPTH; ++l) {
        const bool last = (l == DEPTH - 1), moe = (l & 1); const int j = l >> 1; const int nrows = last ? TL : T; const int nMr = nrows / 256;
        const float* modl = MOD + (size_t)l * 9 * 6144;
        { NormArgs a{}; a.XS = XS; a.H = H; a.g = norm1_g + l * D; a.mod_shift = modl; a.mod_scale = modl + 1024; a.nrows = T;
          if (l > 0 && ((l - 1) & 1)) { a.Y = YB; a.POS = POS; a.TOPKp = TOPK; a.mod_g5prev = MOD + (size_t)(l - 1) * 9 * 6144 + 5 * 1024; hipLaunchKernelGGL((k_norm<true, false>), dim3(1024), dim3(512), 0, stream, a); }
          else hipLaunchKernelGGL((k_norm<false, false>), dim3(1024), dim3(512), 0, stream, a); }
        { GemmArgs ga{}; ga.A = H; ga.Bt = WIN + (size_t)l * NP * D; ga.lda = D; ga.ldb = D; ga.K = D; ga.nM = T / 256; ga.nN = NP / 256; pg8::EpiBf16 E{PH, NP, 0}; launch_gemm<0>(ga, E, stream); }
        hipLaunchKernelGGL(k_tok, dim3(1024), dim3(512), 0, stream, PH, BR, QR, KV, LA, CS, conv_w + (size_t)l * 3 * 512, gla_w2 + (size_t)l * 2 * 16 * 256, gla_b + (size_t)l * 2 * 256, T);
        hipLaunchKernelGGL(k_attn, dim3(2048), dim3(512), 0, stream, QR, KV, BR, attn_sink + l * 8, nrows);
        hipLaunchKernelGGL(k_gla_scan, dim3(64), dim3(128), 0, stream, PH, LA, OG);
        hipLaunchKernelGGL(k_gla_out, dim3(1024), dim3(512), 0, stream, OG, PH, gla_norm_g + l * 512, BR, nrows);
        { GemmArgs ga{}; ga.A = BR; ga.Bt = WBR + (size_t)l * 3072 * 512; ga.lda = 1536; ga.ldb = 512; ga.K = 512; ga.nM = nMr; ga.nN = 12; pg8::EpiGate E{MG3, PH}; launch_gemm<1>(ga, E, stream); }
        { GemmArgs ga{}; ga.A = MG3; ga.Bt = WO3 + (size_t)l * D * 3072; ga.lda = 3072; ga.ldb = 3072; ga.K = 3072; ga.nM = nMr; ga.nN = 4; pg8::EpiResid E{XS, modl + 2 * 1024}; launch_gemm<0>(ga, E, stream); }
        { NormArgs a{}; a.XS = XS; a.H = H; a.g = norm2_g + l * D; a.mod_shift = modl + 3 * 1024; a.mod_scale = modl + 4 * 1024; a.nrows = nrows;
          if (moe) { a.router = router_w + (size_t)j * D * 8; a.TOPK = TOPK; a.cnt = CTL + CW_CNT + j * 64; hipLaunchKernelGGL((k_norm<false, true>), dim3(1024), dim3(512), 0, stream, a); }
          else hipLaunchKernelGGL((k_norm<false, false>), dim3(1024), dim3(512), 0, stream, a); }
        if (!moe) {
            { GemmArgs ga{}; ga.A = H; ga.Bt = WUPD + (size_t)j * NUP * D; ga.lda = D; ga.ldb = D; ga.K = D; ga.nM = nMr; ga.nN = NUP / 256; pg8::EpiSwiglu E{PH}; launch_gemm<0>(ga, E, stream); }
            { GemmArgs ga{}; ga.A = PH; ga.Bt = WDND + (size_t)j * D * DFF; ga.lda = DFF; ga.ldb = DFF; ga.K = DFF; ga.nM = nMr; ga.nN = 4; pg8::EpiResid E{XS, modl + 5 * 1024}; launch_gemm<0>(ga, E, stream); }
        } else {
            for (int e = 0; e < NEXP; ++e) {
                const size_t eo = ((size_t)j * NEXP + e) * D * DFF;
                launch_cvt(moe_w1 + eo, moe_w3 + eo, WUPM + (size_t)e * NUP * D, DFF, D, 0, D, NUP, 2, stream);
                launch_cvt(moe_w2 + eo, nullptr, WDNM + (size_t)e * D * DFF, D, DFF, 0, DFF, D, 0, stream);
            }
            hipLaunchKernelGGL(k_route, dim3(1024), dim3(512), 0, stream, TOPK, H, HS, POS, IDX, CTL, j, nrows);
            hipLaunchKernelGGL(k_route_pad, dim3(256), dim3(512), 0, stream, H, HS, CTL, j);
            { GemmArgs ga{}; ga.A = HS; ga.Bt = WUPM; ga.lda = D; ga.ldb = D; ga.K = D; ga.nM = 0; ga.nN = NUP / 256; ga.ctl = CTL; ga.moe_j = j; ga.bexp = (size_t)NUP * D; pg8::EpiSwiglu E{PH}; launch_gemm<2>(ga, E, stream); }
            { GemmArgs ga{}; ga.A = PH; ga.Bt = WDNM; ga.lda = DFF; ga.ldb = DFF; ga.K = DFF; ga.nM = 0; ga.nN = 4; ga.ctl = CTL; ga.moe_j = j; ga.bexp = (size_t)D * DFF; pg8::EpiBf16 E{YB, D, 0}; launch_gemm<2>(ga, E, stream); }
        }
    }
    hipLaunchKernelGGL(k_final, dim3(1024), dim3(512), 0, stream, XS, YB, POS, TOPK, MOD + (size_t)3 * 9 * 6144 + 5 * 1024, final_g, (float*)d_out);
}
```

```cpp
#include <hip/hip_runtime.h>
#include <stdint.h>
#include <stddef.h>

#define LAS __attribute__((address_space(3)))
typedef unsigned short bf16_t;
typedef short bf16x8 __attribute__((ext_vector_type(8)));
typedef float f32x4 __attribute__((ext_vector_type(4)));
typedef float f32x2 __attribute__((ext_vector_type(2)));
typedef unsigned u32x4 __attribute__((ext_vector_type(4)));
typedef unsigned u32x2 __attribute__((ext_vector_type(2)));

constexpr int D = 1024, NBATCH = 8, SEQ = 2048, CTXL = 256, DEPTH = 4;
constexpr int TL = NBATCH * SEQ, TC = NBATCH * CTXL, T = TL + TC;
constexpr int DIN = 6944, NP = 7168;
constexpr int DFF = 3584, NUP = 2 * DFF;
constexpr int NEXP = 8;
constexpr int MAXR = 2 * T + NEXP * 256;
constexpr int P_CB = 0, P_CC = 512, P_CU = 1024, P_QA = 1536, P_KA = 2048, P_VA = 2176, P_QG = 2304, P_KG = 2560, P_VG = 2816, P_RG = 3328, P_GATE = 3840, P_AG = 6912;
constexpr float EPS = 1e-6f;
constexpr float LOG2E = 1.4426950408889634f, QSCALE = 0.125f * LOG2E;

constexpr size_t al256(size_t x) { return (x + 255) & ~(size_t)255; }
constexpr size_t WS_CTL = 0;                                   constexpr size_t CTL_BYTES = 65536;
constexpr size_t WS_MOD = WS_CTL + CTL_BYTES;                  constexpr size_t MOD_BYTES = (size_t)DEPTH * 9 * 6 * D * 4;
constexpr size_t WS_CS = al256(WS_MOD + MOD_BYTES);            constexpr size_t CS_BYTES = 64 * 16 * 8;
constexpr size_t WS_XS = al256(WS_CS + CS_BYTES);              constexpr size_t XS_BYTES = (size_t)T * D * 4;
constexpr size_t WS_H = al256(WS_XS + XS_BYTES);               constexpr size_t H_BYTES = (size_t)T * D * 2;
constexpr size_t WS_PH = al256(WS_H + H_BYTES);                constexpr size_t PH_BYTES = (size_t)MAXR * DFF * 2;
constexpr size_t WS_BR = al256(WS_PH + PH_BYTES);              constexpr size_t BR_BYTES = (size_t)T * 1536 * 2;
constexpr size_t WS_R3 = al256(WS_BR + BR_BYTES);              constexpr size_t R3_BYTES = (size_t)T * 3072 * 2;
constexpr size_t WS_YB = al256(WS_R3 + R3_BYTES);              constexpr size_t YB_BYTES = (size_t)MAXR * D * 2;
constexpr size_t WS_QR = al256(WS_YB + YB_BYTES);              constexpr size_t QR_BYTES = (size_t)T * 512 * 2;
constexpr size_t WS_KV = al256(WS_QR + QR_BYTES);              constexpr size_t KV_BYTES = (size_t)T * 256 * 2;
constexpr size_t WS_TOPK = al256(WS_KV + KV_BYTES);            constexpr size_t TOPK_BYTES = (size_t)T * 16;
constexpr size_t WS_POS = al256(WS_TOPK + TOPK_BYTES);         constexpr size_t POS_BYTES = (size_t)T * 8;
constexpr size_t WS_IDX = al256(WS_POS + POS_BYTES);           constexpr size_t IDX_BYTES = (size_t)MAXR * 4;
constexpr size_t WS_DEC = al256(WS_IDX + IDX_BYTES);           constexpr size_t DEC_BYTES = (size_t)(T / 64) * 4 * 2 * 64 * 4;
constexpr size_t WS_PART = al256(WS_DEC + DEC_BYTES);         constexpr size_t PART_BYTES = (size_t)7 * TC * D * 4;
constexpr size_t WS_WIN = al256(WS_PART + PART_BYTES);           constexpr size_t WIN_BYTES = (size_t)DEPTH * NP * D * 2;
constexpr size_t WS_WBR = al256(WS_WIN + WIN_BYTES);           constexpr size_t WBR_BYTES = (size_t)DEPTH * D * 1536 * 2;
constexpr size_t WS_WO3 = al256(WS_WBR + WBR_BYTES);           constexpr size_t WO3_BYTES = (size_t)DEPTH * D * D * 2;
constexpr size_t WS_WUPD = al256(WS_WO3 + WO3_BYTES);          constexpr size_t WUPD_BYTES = (size_t)2 * NUP * D * 2;
constexpr size_t WS_WDND = al256(WS_WUPD + WUPD_BYTES);        constexpr size_t WDND_BYTES = (size_t)2 * D * DFF * 2;
constexpr size_t WS_WUPM = al256(WS_WDND + WDND_BYTES);        constexpr size_t WUPM_BYTES = (size_t)NEXP * NUP * D * 2;
constexpr size_t WS_WDNM = al256(WS_WUPM + WUPM_BYTES);        constexpr size_t WDNM_BYTES = (size_t)NEXP * D * DFF * 2;
constexpr size_t WS_END = al256(WS_WDNM + WDNM_BYTES);
constexpr int CW_CNT = 0;
constexpr int CW_FILL = 128;
constexpr int CW_TEXP = 1024;
constexpr int CW_NT = 1536;

typedef __bf16 bf16x2_t __attribute__((ext_vector_type(2)));
__device__ __forceinline__ unsigned cvt_pk_bf16(float lo, float hi) { const f32x2 v = {lo, hi}; return __builtin_bit_cast(unsigned, __builtin_convertvector(v, bf16x2_t)); }
__device__ __forceinline__ float bf_lo(unsigned w) { return __uint_as_float(w << 16); }
__device__ __forceinline__ float bf_hi(unsigned w) { return __uint_as_float(w & 0xffff0000u); }
__device__ __forceinline__ float bf2f(bf16_t b) { return __uint_as_float(((unsigned)b) << 16); }
__device__ __forceinline__ bf16_t f2bf(float f) { return (bf16_t)(cvt_pk_bf16(f, 0.f) & 0xffffu); }
__device__ __forceinline__ float sigmoidf_(float x) { return __builtin_amdgcn_rcpf(1.0f + __builtin_amdgcn_exp2f(x * -1.4426950408889634f)); }
__device__ __forceinline__ float siluf_(float x) { return x * __builtin_amdgcn_rcpf(1.0f + __builtin_amdgcn_exp2f(x * -1.4426950408889634f)); }
__device__ __forceinline__ float shx(float v, int mask, int lane) { return __int_as_float(__builtin_amdgcn_ds_bpermute((lane ^ mask) << 2, __float_as_int(v))); }
__device__ __forceinline__ float shl_(float v, int src) { return __int_as_float(__builtin_amdgcn_ds_bpermute(src << 2, __float_as_int(v))); }
__device__ __forceinline__ float wave_sum(float v, int lane) {
#pragma unroll
    for (int o = 32; o >= 1; o >>= 1) v += shx(v, o, lane);
    return v;
}
__device__ __forceinline__ float wave_max(float v, int lane) {
#pragma unroll
    for (int o = 32; o >= 1; o >>= 1) v = fmaxf(v, shx(v, o, lane));
    return v;
}
__device__ __forceinline__ unsigned lds_add(LAS unsigned* p, unsigned v) { return __hip_atomic_fetch_add(p, v, __ATOMIC_RELAXED, __HIP_MEMORY_SCOPE_WORKGROUP); }
__device__ __forceinline__ f32x4 ldx_raw(const void* base, bool f32src, size_t idx) { if (f32src) return *(const f32x4*)((const float*)base + idx); const u32x2 w = *(const u32x2*)((const bf16_t*)base + idx); return (f32x4){__uint_as_float(w.x), __uint_as_float(w.y), 0.f, 0.f}; }
__device__ __forceinline__ f32x4 cvx(const f32x4 raw, bool f32src) { if (f32src) return raw; const unsigned a = __float_as_uint(raw[0]), b = __float_as_uint(raw[1]); return (f32x4){__uint_as_float(a << 16), __uint_as_float(a & 0xffff0000u), __uint_as_float(b << 16), __uint_as_float(b & 0xffff0000u)}; }
__device__ __forceinline__ void stx(bf16_t* p, const f32x4 v) { u32x2 w; w.x = cvt_pk_bf16(v[0], v[1]); w.y = cvt_pk_bf16(v[2], v[3]); *(u32x2*)p = w; }
__device__ __forceinline__ int mod_row(int row) { return row < TL ? (row >> 11) : 8; }
struct Ctx { int bid, nb, wv; };
__device__ __forceinline__ int tidx(const Ctx& cx) { int z = cx.wv << 6; asm volatile("" : "+s"(z)); return (int)__builtin_amdgcn_mbcnt_hi(~0u, __builtin_amdgcn_mbcnt_lo(~0u, (unsigned)z)); }
#define OPQ_S(x) asm volatile("" : "+s"(x))
__device__ __forceinline__ float row4_max(float v) { auto a = __builtin_amdgcn_permlane16_swap(__float_as_uint(v), __float_as_uint(v), false, false); v = fmaxf(__uint_as_float(a[0]), __uint_as_float(a[1]));
    auto b = __builtin_amdgcn_permlane32_swap(__float_as_uint(v), __float_as_uint(v), false, false); return fmaxf(__uint_as_float(b[0]), __uint_as_float(b[1])); }
__device__ __forceinline__ float row4_sum(float v) { auto a = __builtin_amdgcn_permlane16_swap(__float_as_uint(v), __float_as_uint(v), false, false); v = __uint_as_float(a[0]) + __uint_as_float(a[1]);
    auto b = __builtin_amdgcn_permlane32_swap(__float_as_uint(v), __float_as_uint(v), false, false); return __uint_as_float(b[0]) + __uint_as_float(b[1]); }

__device__ __forceinline__ u32x4 pack8(const float* v) { u32x4 w; w.x = cvt_pk_bf16(v[0], v[1]); w.y = cvt_pk_bf16(v[2], v[3]); w.z = cvt_pk_bf16(v[4], v[5]); w.w = cvt_pk_bf16(v[6], v[7]); return w; }
__device__ __forceinline__ void unpack8(const u32x4 w, float* v) { v[0] = bf_lo(w.x); v[1] = bf_hi(w.x); v[2] = bf_lo(w.y); v[3] = bf_hi(w.y); v[4] = bf_lo(w.z); v[5] = bf_hi(w.z); v[6] = bf_lo(w.w); v[7] = bf_hi(w.w); }
namespace pg8 {
constexpr int BM = 256, BK = 64, HALF = 128, HTB = HALF * BK * 2, STAGE_BYTES = 8 * HTB, NXCD = 8, WGM = 8;
constexpr int CSH_STR = 144, CSH_SLICE = 16 * CSH_STR;
__host__ __device__ __forceinline__ int lds_byte(int r, int c) { const int st = (r >> 4) * 2 + (c >> 5), rr = r & 15, cc = c & 31, ob = rr * 64 + cc * 2; return st * 1024 + (ob ^ (((ob >> 9) & 1) << 5)); }
__host__ __device__ __forceinline__ void stage_rc(int b, int& R, int& C) { const int st = b / 1024, sb = b % 1024, swz = sb ^ (((sb >> 9) & 1) << 5); R = (st >> 1) * 16 + swz / 64; C = (st & 1) * 32 + (swz % 64) / 2; }
__host__ __device__ __forceinline__ int perm32(int rho) { const int n = rho >> 4, i = rho & 15; return 8 * (i >> 2) + 4 * n + (i & 3); }
struct Unit { int pm, pn, kofs, kofsB, nt, part; };

__device__ __forceinline__ bool static_next(int i, int G, int c, int nM, int nN, Unit& u) {
    const int nwg = nM * nN; const long L = (long)i * G + c; if (L >= nwg) return false;
    int wgid = (int)L; { const int q = nwg / NXCD, r = nwg % NXCD, xcd = wgid % NXCD, off = wgid / NXCD; wgid = (xcd < r ? xcd * (q + 1) : r * (q + 1) + (xcd - r) * q) + off; }
    const int nig = WGM * nN, gid = wgid / nig, fm = gid * WGM, gsz = (nM - fm) < WGM ? (nM - fm) : WGM;
    u.pm = fm + ((wgid % nig) % gsz); u.pn = (wgid % nig) / gsz; return true;
}

template <int MODE> struct Prob {
    const bf16_t* A; const bf16_t* Bt; int lda, ldb, K, nM, nN, G, c; const LAS int* texp; size_t bexp; int nctx;
    __device__ __forceinline__ bool next(int i, Unit& u) const {
        u.kofs = 0; u.kofsB = 0; u.nt = K / BK; u.part = -1;
        if (MODE == 3) {
            const int idx = i + (c < nctx ? 0 : 1);
            if (idx == 0) { const int ct = c / 7; u.pm = 64 + (ct >> 2); u.pn = ct & 3; u.part = c - ct * 7; u.nt = K / (7 * BK); u.kofs = u.part * (K / 7); u.kofsB = u.kofs; return true; }
            return static_next(idx - 1, G, c, 64, 4, u);
        }
        if (MODE == 4) { const int seg = i % 3; u.kofs = seg * 512; u.kofsB = u.kofs; u.nt = 8; u.part = seg; return static_next(i / 3, G, c, 64, 4, u); }
        if (MODE == 5) { const int L = i * G + c; if (L >= 192) return false; const int ct = L / 6, sub = L - ct * 6; u.pm = 64 + (ct >> 2); u.pn = ct & 3; u.part = sub; u.nt = 8; u.kofs = (sub >> 1) * 1024 + (sub & 1) * 512; u.kofsB = (sub & 1) * 512; return true; }
        const bool ok = static_next(i, G, c, nM, nN, u);
        if (MODE == 1) { u.kofs = (u.pn >> 2) * 512; u.kofsB = u.kofs; }
        return ok;
    }
    __device__ __forceinline__ const char* a_base(const Unit& u, bool ablk) const { return (const char*)(A + (size_t)u.pm * BM * lda + (ablk ? 2 * u.kofs : u.kofs)); }
    __device__ __forceinline__ const char* b_base(const Unit& u) const { const bf16_t* p = Bt + (size_t)(MODE == 1 ? (u.pn & 3) : u.pn) * BM * ldb + 2 * u.kofsB; if (MODE == 2) p += (size_t)texp[u.pm] * bexp; return (const char*)p; }
};

template <class Epi, class PB, int ABLK>
__device__ __forceinline__ void gemm_phase(LAS unsigned char* lds, const PB& P, const Epi& E, const Ctx cx) {
    const int tid = tidx(cx), wid = __builtin_amdgcn_readfirstlane(tid >> 6), lane = tid & 63, wr = wid >> 2, wc = wid & 3, fr = lane & 15, fq = lane >> 4;
    unsigned voffA[2], voffB[2];
#pragma unroll
    for (int i = 0; i < 2; ++i) { int R, C; stage_rc(tid * 16 + i * 8192, R, C); const int Rb = (int)Epi::PERM == 2 ? (2 * (R & ~31) + perm32(R & 31)) : Epi::PERM ? ((R & ~31) + perm32(R & 31)) : R;
        voffA[i] = ABLK ? (unsigned)((((R >> 1) * (P.lda >> 5) + (C >> 5)) * 64 + (R & 1) * 32 + (C & 31)) * 2) : (unsigned)(R * P.lda + C) * 2u;     voffB[i] = (unsigned)((((Rb >> 1) * (P.ldb >> 5) + (C >> 5)) * 64 + (Rb & 1) * 32 + (C & 31)) * 2);     }
    const size_t kstep = (size_t)(BK * 4), kstepA = ABLK ? (size_t)(BK * 4) : (size_t)(BK * 2);
    const size_t hstepA = (size_t)HALF * P.lda * 2, hstepB = (size_t)((int)Epi::PERM == 2 ? 32 : HALF) * P.ldb * 2;
    const unsigned ldsw = (unsigned)wid * 1024u;
    const int aoff = lds_byte(wr * 64 + fr, fq * 8), boff = lds_byte(wc * 32 + fr, fq * 8);
#define PG8_SA(b, h) (((b) * 2 + (h)) * HTB)
#define PG8_SB(b, h) ((4 + (b) * 2 + (h)) * HTB)
#define PG8_STAGE(bufoff, gbase, voff) do { _Pragma("unroll") for (int _i = 0; _i < 2; ++_i) \
        __builtin_amdgcn_global_load_lds((const unsigned*)((const char*)(gbase) + (voff)[_i]), (LAS unsigned*)(lds + (bufoff) + ldsw + _i * 8192), 16, 0, 0); } while (0)
#define PG8_LDA(dst, b, h) do { _Pragma("unroll") for (int m = 0; m < 4; ++m) _Pragma("unroll") for (int k = 0; k < 2; ++k) dst[m][k] = *(const LAS bf16x8*)(lds + PG8_SA(b, h) + aoff + m * 2048 + k * 1024); } while (0)
#define PG8_LDB(dst, b, h) do { _Pragma("unroll") for (int n = 0; n < 2; ++n) _Pragma("unroll") for (int k = 0; k < 2; ++k) dst[n][k] = *(const LAS bf16x8*)(lds + PG8_SB(b, h) + boff + n * 2048 + k * 1024); } while (0)
#define PG8_MMA(ai, bj, At, Bt) do { __builtin_amdgcn_s_setprio(1); _Pragma("unroll") for (int m = 0; m < 4; ++m) _Pragma("unroll") for (int n = 0; n < 2; ++n) _Pragma("unroll") for (int k = 0; k < 2; ++k) \
        acc[ai][bj][m][n] = __builtin_amdgcn_mfma_f32_16x16x32_bf16(Bt[n][k], At[m][k], acc[ai][bj][m][n], 0, 0, 0); __builtin_amdgcn_s_setprio(0); } while (0)
#define PG8_WAIT_V(n) asm volatile("s_waitcnt vmcnt(" #n ")" ::: "memory")
#define PG8_WAIT_L(n) asm volatile("s_waitcnt lgkmcnt(" #n ")" ::: "memory")
#define PG8_BAR __builtin_amdgcn_s_barrier()
#define PG8_SCHED __builtin_amdgcn_sched_barrier(0)
    Unit cur, nxt; int ui = 0;
    if (!P.next(0, cur)) return;
    f32x4 acc[2][2][4][2];
#pragma unroll
    for (int a = 0; a < 2; ++a)
#pragma unroll
        for (int b = 0; b < 2; ++b)
#pragma unroll
            for (int m = 0; m < 4; ++m)
#pragma unroll
                for (int n = 0; n < 2; ++n) acc[a][b][m][n] = (f32x4){0.f, 0.f, 0.f, 0.f};
    bf16x8 At[4][2], B0[2][2], B1[2][2];
    const char* cA = P.a_base(cur, ABLK != 0); const char* cB = P.b_base(cur);
    PG8_STAGE(PG8_SB(0, 0), cB, voffB); PG8_STAGE(PG8_SB(0, 1), cB + hstepB, voffB); PG8_STAGE(PG8_SA(0, 0), cA, voffA); PG8_STAGE(PG8_SA(0, 1), cA + hstepA, voffA);
    if (wr == 1) PG8_BAR;
    PG8_WAIT_V(2); PG8_BAR;
    PG8_STAGE(PG8_SB(1, 0), cB + kstep, voffB); PG8_STAGE(PG8_SA(1, 0), cA + kstepA, voffA); PG8_STAGE(PG8_SB(1, 1), cB + hstepB + kstep, voffB);
    PG8_WAIT_V(6); PG8_BAR;
    for (;;) {
        const bool has_next = P.next(ui + 1, nxt);
        const char* nA = has_next ? P.a_base(nxt, ABLK != 0) : cA; const char* nB = has_next ? P.b_base(nxt) : cB;
        const int nt = cur.nt;
        for (int t = 0; t < nt; t += 2) {
            const bool last = (t == nt - 2);
            const char* a1 = cA + (size_t)(t + 1) * kstepA;
            const char* a2 = last ? nA : cA + (size_t)(t + 2) * kstepA; const char* b2 = last ? nB : cB + (size_t)(t + 2) * kstep;
            const char* a3 = a2 + kstepA; const char* b3 = b2 + kstep;
            PG8_LDB(B0, 0, 0); PG8_LDB(B1, 0, 1); PG8_SCHED; PG8_LDA(At, 0, 0); PG8_STAGE(PG8_SA(1, 1), a1 + hstepA, voffA);
            PG8_WAIT_V(8); PG8_WAIT_L(0); PG8_BAR; PG8_MMA(0, 0, At, B0); PG8_MMA(0, 1, At, B1); PG8_BAR; PG8_SCHED;
            PG8_LDA(At, 0, 1); PG8_STAGE(PG8_SB(0, 0), b2, voffB); PG8_STAGE(PG8_SB(0, 1), b2 + hstepB, voffB); PG8_STAGE(PG8_SA(0, 0), a2, voffA);
            PG8_WAIT_V(8); PG8_WAIT_L(0); PG8_BAR; PG8_MMA(1, 0, At, B0); PG8_MMA(1, 1, At, B1); PG8_BAR; PG8_SCHED;
            PG8_LDB(B0, 1, 0); PG8_LDB(B1, 1, 1); PG8_SCHED; PG8_LDA(At, 1, 0); PG8_STAGE(PG8_SA(0, 1), a2 + hstepA, voffA);
            PG8_WAIT_V(8); PG8_WAIT_L(0); PG8_BAR; PG8_MMA(0, 0, At, B0); PG8_MMA(0, 1, At, B1); PG8_BAR; PG8_SCHED;
            PG8_LDA(At, 1, 1); PG8_STAGE(PG8_SB(1, 0), b3, voffB); PG8_STAGE(PG8_SB(1, 1), b3 + hstepB, voffB); PG8_STAGE(PG8_SA(1, 0), a3, voffA);
            PG8_WAIT_V(8); PG8_WAIT_L(0); PG8_BAR; PG8_MMA(1, 0, At, B0); PG8_MMA(1, 1, At, B1); PG8_BAR; PG8_SCHED;
        }
        if (wr == 0) PG8_BAR;
        E(acc, cur, wr, wc, fr, fq);
        if (!has_next) break;
#pragma unroll
        for (int a = 0; a < 2; ++a)
#pragma unroll
            for (int b = 0; b < 2; ++b)
#pragma unroll
                for (int m = 0; m < 4; ++m)
#pragma unroll
                    for (int n = 0; n < 2; ++n) acc[a][b][m][n] = (f32x4){0.f, 0.f, 0.f, 0.f};
        cur = nxt; cA = nA; cB = nB; ++ui;
        if (wr == 1) PG8_BAR;
    }
    PG8_WAIT_V(0);
    PG8_BAR;
#undef PG8_SA
#undef PG8_SB
#undef PG8_STAGE
#undef PG8_LDA
#undef PG8_LDB
#undef PG8_MMA
#undef PG8_WAIT_V
#undef PG8_WAIT_L
#undef PG8_BAR
#undef PG8_SCHED
}

__device__ __forceinline__ void relay16(const f32x4 (&a)[2][2], LAS unsigned char* wp, const LAS unsigned char* rp, u32x4 (&x)[2]) {
#pragma unroll
    for (int bj = 0; bj < 2; ++bj) { u32x4 w; w.x = cvt_pk_bf16(a[bj][0][0], a[bj][0][1]); w.y = cvt_pk_bf16(a[bj][0][2], a[bj][0][3]); w.z = cvt_pk_bf16(a[bj][1][0], a[bj][1][1]); w.w = cvt_pk_bf16(a[bj][1][2], a[bj][1][3]);
        *(LAS u32x4*)(wp + bj * 64) = w; }
    asm volatile("" ::: "memory"); __builtin_amdgcn_wave_barrier();
    x[0] = *(const LAS u32x4*)rp; x[1] = *(const LAS u32x4*)(rp + 8 * CSH_STR);
    asm volatile("" ::: "memory"); __builtin_amdgcn_wave_barrier();
}
__device__ __forceinline__ u32x4 gate8x(const u32x4& x, const u32x4& g, const u32x4& o) {
    float xv[8], gv[8], ov[8]; unpack8(x, xv); unpack8(g, gv); unpack8(o, ov);
#pragma unroll
    for (int e = 0; e < 8; ++e) ov[e] += xv[e] * sigmoidf_(gv[e]);
    return pack8(ov);
}
struct EpiBf16 {
    static constexpr int PERM = 2;
    bf16_t* O; LAS unsigned char* sh; int ldc; int pad_;
    __device__ __forceinline__ void operator()(const f32x4 (&acc)[2][2][4][2], const Unit& u, int wr, int wc, int fr, int fq) const {
        LAS unsigned char* my = sh + (wr * 4 + wc) * CSH_SLICE; const int lane = fq * 16 + fr, r8 = lane >> 3, c8 = lane & 7;
        LAS unsigned char* wp = my + fr * CSH_STR + fq * 16; const LAS unsigned char* rp = my + r8 * CSH_STR + c8 * 16;
        bf16_t* ob = O + (size_t)(u.pm * BM + wr * 64 + r8) * ldc + u.pn * BM + wc * 64 + 8 * c8;
#pragma unroll
        for (int ai = 0; ai < 2; ++ai)
#pragma unroll
            for (int m = 0; m < 4; ++m) { u32x4 x[2];
                const f32x4 a[2][2] = {{acc[ai][0][m][0], acc[ai][0][m][1]}, {acc[ai][1][m][0], acc[ai][1][m][1]}};
                relay16(a, wp, rp, x);
                bf16_t* rowp = ob + (size_t)(ai * HALF + m * 16) * ldc;
                *(u32x4*)rowp = x[0]; *(u32x4*)(rowp + (size_t)8 * ldc) = x[1]; }
    }
};
struct EpiWin {
    static constexpr int PERM = 2;
    bf16_t* O; bf16_t* QR; bf16_t* KV; const f32x2* CS; LAS unsigned char* sh;
    __device__ __forceinline__ void operator()(const f32x4 (&acc)[2][2][4][2], const Unit& u, int wr, int wc, int fr, int fq) const {
        const int row0 = u.pm * BM + wr * 64 + fr;
        if (u.pn < 6 || u.pn > 8) {
            LAS unsigned char* my = sh + (wr * 4 + wc) * CSH_SLICE; const int lane = fq * 16 + fr, r8 = lane >> 3, c8 = lane & 7;
            LAS unsigned char* wp = my + fr * CSH_STR + fq * 16; const LAS unsigned char* rp = my + r8 * CSH_STR + c8 * 16;
            bf16_t* ob = O + (size_t)(u.pm * BM + wr * 64 + r8) * NP + u.pn * BM + wc * 64 + 8 * c8;
#pragma unroll
            for (int ai = 0; ai < 2; ++ai)
#pragma unroll
                for (int m = 0; m < 4; ++m) {
#pragma unroll
                    for (int bj = 0; bj < 2; ++bj) { const f32x4 v0 = acc[ai][bj][m][0], v1 = acc[ai][bj][m][1];
                        u32x4 w; w.x = cvt_pk_bf16(v0[0], v0[1]); w.y = cvt_pk_bf16(v0[2], v0[3]); w.z = cvt_pk_bf16(v1[0], v1[1]); w.w = cvt_pk_bf16(v1[2], v1[3]);
                        *(LAS u32x4*)(wp + bj * 64) = w; }
                    asm volatile("" ::: "memory"); __builtin_amdgcn_wave_barrier();
                    const u32x4 x0 = *(const LAS u32x4*)rp, x1 = *(const LAS u32x4*)(rp + 8 * CSH_STR);
                    asm volatile("" ::: "memory"); __builtin_amdgcn_wave_barrier();
                    bf16_t* rowp = ob + (size_t)(ai * HALF + m * 16) * NP;
                    *(u32x4*)rowp = x0; *(u32x4*)(rowp + (size_t)8 * NP) = x1; }
            return;
        }
        const bool lat = u.pm < 64; const bool isq = u.pn < 8; const bool rot = isq || wc < 2;
#pragma unroll
        for (int ai = 0; ai < 2; ++ai)
#pragma unroll
            for (int m = 0; m < 4; ++m) { const int row = row0 + ai * HALF + m * 16; const int sp = row & (SEQ - 1);
#pragma unroll
                for (int bj = 0; bj < 2; ++bj) { const f32x4 v0 = acc[ai][bj][m][0], v1 = acc[ai][bj][m][1]; float o[8];
                    const int ps = bj ? (sp & 63) : (sp >> 6);
                    f32x4 c01 = (f32x4){1.f, 0.f, 1.f, 0.f}, c23 = c01;
                    if (lat && rot) { const f32x4* cp = (const f32x4*)(CS + ps * 16 + 4 * fq); c01 = cp[0]; c23 = cp[1]; }
                    if (rot) {
                        o[0] = v0[0] * c01[0] - v0[1] * c01[1]; o[1] = v0[1] * c01[0] + v0[0] * c01[1]; o[2] = v0[2] * c01[2] - v0[3] * c01[3]; o[3] = v0[3] * c01[2] + v0[2] * c01[3];
                        o[4] = v1[0] * c23[0] - v1[1] * c23[1]; o[5] = v1[1] * c23[0] + v1[0] * c23[1]; o[6] = v1[2] * c23[2] - v1[3] * c23[3]; o[7] = v1[3] * c23[2] + v1[2] * c23[3];
                    } else { o[0] = v0[0]; o[1] = v0[1]; o[2] = v0[2]; o[3] = v0[3]; o[4] = v1[0]; o[5] = v1[1]; o[6] = v1[2]; o[7] = v1[3]; }
                    u32x4 w;
                    if (isq) { w.x = cvt_pk_bf16(o[0] * QSCALE, o[1] * QSCALE); w.y = cvt_pk_bf16(o[2] * QSCALE, o[3] * QSCALE); w.z = cvt_pk_bf16(o[4] * QSCALE, o[5] * QSCALE); w.w = cvt_pk_bf16(o[6] * QSCALE, o[7] * QSCALE);
                        *(u32x4*)(QR + (size_t)row * 512 + (u.pn - 6) * 256 + wc * 64 + bj * 32 + 8 * fq) = w; }
                    else { w.x = cvt_pk_bf16(o[0], o[1]); w.y = cvt_pk_bf16(o[2], o[3]); w.z = cvt_pk_bf16(o[4], o[5]); w.w = cvt_pk_bf16(o[6], o[7]);
                        *(u32x4*)(KV + (size_t)row * 256 + wc * 64 + bj * 32 + 8 * fq) = w; } } }
    }
};
__device__ __forceinline__ u32x4 gate8(const f32x4& v0, const f32x4& v1, const u32x4& g) {
    u32x4 w;
    w.x = cvt_pk_bf16(v0[0] * sigmoidf_(bf_lo(g.x)), v0[1] * sigmoidf_(bf_hi(g.x))); w.y = cvt_pk_bf16(v0[2] * sigmoidf_(bf_lo(g.y)), v0[3] * sigmoidf_(bf_hi(g.y)));
    w.z = cvt_pk_bf16(v1[0] * sigmoidf_(bf_lo(g.z)), v1[1] * sigmoidf_(bf_hi(g.z))); w.w = cvt_pk_bf16(v1[2] * sigmoidf_(bf_lo(g.w)), v1[3] * sigmoidf_(bf_hi(g.w))); return w; }
__device__ __forceinline__ u32x4 gate8acc(const f32x4& v0, const f32x4& v1, const u32x4& g, const u32x4& o) {
    u32x4 w;
    w.x = cvt_pk_bf16(bf_lo(o.x) + v0[0] * sigmoidf_(bf_lo(g.x)), bf_hi(o.x) + v0[1] * sigmoidf_(bf_hi(g.x))); w.y = cvt_pk_bf16(bf_lo(o.y) + v0[2] * sigmoidf_(bf_lo(g.y)), bf_hi(o.y) + v0[3] * sigmoidf_(bf_hi(g.y)));
    w.z = cvt_pk_bf16(bf_lo(o.z) + v1[0] * sigmoidf_(bf_lo(g.z)), bf_hi(o.z) + v1[1] * sigmoidf_(bf_hi(g.z))); w.w = cvt_pk_bf16(bf_lo(o.w) + v1[2] * sigmoidf_(bf_lo(g.w)), bf_hi(o.w) + v1[3] * sigmoidf_(bf_hi(g.w))); return w; }
struct EpiGate {
    static constexpr int PERM = 2;
    bf16_t* O; const bf16_t* Pg; LAS unsigned char* sh;
    __device__ __forceinline__ void operator()(const f32x4 (&acc)[2][2][4][2], const Unit& u, int wr, int wc, int fr, int fq) const {
        LAS unsigned char* my = sh + (wr * 4 + wc) * CSH_SLICE; const int lane = fq * 16 + fr, r8 = lane >> 3, c8 = lane & 7;
        LAS unsigned char* wp = my + fr * CSH_STR + fq * 16; const LAS unsigned char* rp = my + r8 * CSH_STR + c8 * 16;
        const int rowb = u.pm * BM + wr * 64 + r8, colb = u.pn * BM + wc * 64 + 8 * c8;
#pragma unroll
        for (int ai = 0; ai < 2; ++ai)
#pragma unroll
            for (int m = 0; m < 4; ++m) { const size_t row = (size_t)(rowb + ai * HALF + m * 16);
                u32x4 g[2], x[2];
#pragma unroll
                for (int hh = 0; hh < 2; ++hh) g[hh] = *(const u32x4*)(Pg + (row + 8 * hh) * NP + P_GATE + colb);
                const f32x4 a[2][2] = {{acc[ai][0][m][0], acc[ai][0][m][1]}, {acc[ai][1][m][0], acc[ai][1][m][1]}};
                relay16(a, wp, rp, x);
#pragma unroll
                for (int hh = 0; hh < 2; ++hh) *(u32x4*)(O + (row + 8 * hh) * 3072 + colb) = gate8x(x[hh], g[hh], (u32x4){0u, 0u, 0u, 0u}); }
    }
};
struct EpiMerge {
    static constexpr int PERM = 2;
    bf16_t* MG; const bf16_t* Pg; LAS unsigned char* sh;
    __device__ __forceinline__ void operator()(const f32x4 (&acc)[2][2][4][2], const Unit& u, int wr, int wc, int fr, int fq) const {
        LAS unsigned char* my = sh + (wr * 4 + wc) * CSH_SLICE; const int lane = fq * 16 + fr, r8 = lane >> 3, c8 = lane & 7;
        LAS unsigned char* wp = my + fr * CSH_STR + fq * 16; const LAS unsigned char* rp = my + r8 * CSH_STR + c8 * 16;
        const int rowb = u.pm * BM + wr * 64 + r8, colb = u.pn * BM + wc * 64 + 8 * c8; const int gcol = P_GATE + u.part * 1024 + colb;
#pragma unroll
        for (int ai = 0; ai < 2; ++ai)
#pragma unroll
            for (int m = 0; m < 4; ++m) { const size_t row = (size_t)(rowb + ai * HALF + m * 16);
                u32x4 g[2], o[2], x[2];
#pragma unroll
                for (int hh = 0; hh < 2; ++hh) { g[hh] = *(const u32x4*)(Pg + (row + 8 * hh) * NP + gcol); o[hh] = u.part ? *(const u32x4*)(MG + (row + 8 * hh) * D + colb) : (u32x4){0u, 0u, 0u, 0u}; }
                const f32x4 a[2][2] = {{acc[ai][0][m][0], acc[ai][0][m][1]}, {acc[ai][1][m][0], acc[ai][1][m][1]}};
                relay16(a, wp, rp, x);
#pragma unroll
                for (int hh = 0; hh < 2; ++hh) *(u32x4*)(MG + (row + 8 * hh) * D + colb) = gate8x(x[hh], g[hh], o[hh]); }
    }
};
struct EpiResid {
    static constexpr int PERM = 2;
    bf16_t* X; const float* modg; float* PART; const void* Xold; LAS unsigned char* sh; int oldf32; int pad_;
    __device__ __forceinline__ void operator()(const f32x4 (&acc)[2][2][4][2], const Unit& u, int wr, int wc, int fr, int fq) const {
        if (u.part >= 0) {
            LAS unsigned char* my = sh + (wr * 4 + wc) * CSH_SLICE; const int lane = fq * 16 + fr, r8 = lane >> 3, c8 = lane & 7;
            LAS unsigned char* wp = my + fr * CSH_STR + fq * 32; const LAS unsigned char* rp = my + r8 * CSH_STR + c8 * 16;
            float* pb = PART + ((size_t)u.part * TC + (u.pm * BM + wr * 64 + r8 - TL)) * D + u.pn * BM + wc * 64 + 4 * c8;
#pragma unroll
            for (int ai = 0; ai < 2; ++ai)
#pragma unroll
                for (int m = 0; m < 4; ++m) { float* rowp = pb + (size_t)(ai * HALF + m * 16) * D;
#pragma unroll
                    for (int bj = 0; bj < 2; ++bj) {
                        *(LAS f32x4*)wp = acc[ai][bj][m][0]; *(LAS f32x4*)(wp + 16) = acc[ai][bj][m][1];
                        asm volatile("" ::: "memory"); __builtin_amdgcn_wave_barrier();
                        const f32x4 x0 = *(const LAS f32x4*)rp, x1 = *(const LAS f32x4*)(rp + 8 * CSH_STR);
                        asm volatile("" ::: "memory"); __builtin_amdgcn_wave_barrier();
                        *(f32x4*)(rowp + bj * 32) = x0; *(f32x4*)(rowp + (size_t)8 * D + bj * 32) = x1; } }
            return;
        }
        const float* mg = modg + (size_t)mod_row(u.pm * BM) * 6144 + u.pn * BM + wc * 64 + 8 * fq;
        f32x4 gv[2][2];
#pragma unroll
        for (int bj = 0; bj < 2; ++bj)
#pragma unroll
            for (int n = 0; n < 2; ++n) gv[bj][n] = *(const f32x4*)(mg + bj * 32 + n * 4);
        LAS unsigned char* my = sh + (wr * 4 + wc) * CSH_SLICE; const int lane = fq * 16 + fr, r8 = lane >> 3, c8 = lane & 7;
        LAS unsigned char* wp = my + fr * CSH_STR + fq * 16; const LAS unsigned char* rp = my + r8 * CSH_STR + c8 * 16;
        const size_t ro0 = (size_t)(u.pm * BM + wr * 64 + r8) * D + u.pn * BM + wc * 64 + 8 * c8;
#pragma unroll
        for (int ai = 0; ai < 2; ++ai)
#pragma unroll
            for (int m = 0; m < 4; ++m) { const size_t ro = ro0 + (size_t)(ai * HALF + m * 16) * D;
                f32x4 oa[2][2];
#pragma unroll
                for (int hh = 0; hh < 2; ++hh) { const size_t rr = ro + (size_t)hh * 8 * D;
                    if (oldf32) { oa[hh][0] = *(const f32x4*)((const float*)Xold + rr); oa[hh][1] = *(const f32x4*)((const float*)Xold + rr + 4); }
                    else { const u32x4 w = *(const u32x4*)((const bf16_t*)Xold + rr); oa[hh][0] = (f32x4){__uint_as_float(w.x), __uint_as_float(w.y), __uint_as_float(w.z), __uint_as_float(w.w)}; oa[hh][1] = oa[hh][0]; } }
#pragma unroll
                for (int bj = 0; bj < 2; ++bj) { const f32x4 v0 = gv[bj][0] * acc[ai][bj][m][0], v1 = gv[bj][1] * acc[ai][bj][m][1];
                    u32x4 w; w.x = cvt_pk_bf16(v0[0], v0[1]); w.y = cvt_pk_bf16(v0[2], v0[3]); w.z = cvt_pk_bf16(v1[0], v1[1]); w.w = cvt_pk_bf16(v1[2], v1[3]);
                    *(LAS u32x4*)(wp + bj * 64) = w; }
                asm volatile("" ::: "memory"); __builtin_amdgcn_wave_barrier();
                u32x4 dx[2]; dx[0] = *(const LAS u32x4*)rp; dx[1] = *(const LAS u32x4*)(rp + 8 * CSH_STR);
                asm volatile("" ::: "memory"); __builtin_amdgcn_wave_barrier();
#pragma unroll
                for (int hh = 0; hh < 2; ++hh) { float o[8], dl[8]; unpack8(dx[hh], dl);
                    if (oldf32) { o[0] = oa[hh][0][0]; o[1] = oa[hh][0][1]; o[2] = oa[hh][0][2]; o[3] = oa[hh][0][3]; o[4] = oa[hh][1][0]; o[5] = oa[hh][1][1]; o[6] = oa[hh][1][2]; o[7] = oa[hh][1][3]; }
                    else { u32x4 w; w.x = __float_as_uint(oa[hh][0][0]); w.y = __float_as_uint(oa[hh][0][1]); w.z = __float_as_uint(oa[hh][0][2]); w.w = __float_as_uint(oa[hh][0][3]); unpack8(w, o); }
#pragma unroll
                    for (int e = 0; e < 8; ++e) o[e] += dl[e];
                    *(u32x4*)(X + ro + (size_t)hh * 8 * D) = pack8(o); } }
    }
};
struct EpiSwiglu {
    static constexpr bool PERM = true;
    bf16_t* O;
    __device__ __forceinline__ void operator()(const f32x4 (&acc)[2][2][4][2], const Unit& u, int wr, int wc, int fr, int fq) const {
        const int row0 = u.pm * BM + wr * 64 + fr; const int chunk = u.pn * 4 + wc;
#pragma unroll
        for (int ai = 0; ai < 2; ++ai)
#pragma unroll
            for (int m = 0; m < 4; ++m) { const int row = row0 + ai * HALF + m * 16; bf16_t* rowp = O + ((size_t)(row >> 1) * (DFF / 32) + chunk) * 64 + (row & 1) * 32 + 8 * fq;
                const f32x4 a0 = acc[ai][0][m][0], a1 = acc[ai][0][m][1], b0 = acc[ai][1][m][0], b1 = acc[ai][1][m][1];
                u32x4 w; w.x = cvt_pk_bf16(siluf_(a0[0]) * b0[0], siluf_(a0[1]) * b0[1]); w.y = cvt_pk_bf16(siluf_(a0[2]) * b0[2], siluf_(a0[3]) * b0[3]);
                w.z = cvt_pk_bf16(siluf_(a1[0]) * b1[0], siluf_(a1[1]) * b1[1]); w.w = cvt_pk_bf16(siluf_(a1[2]) * b1[2], siluf_(a1[3]) * b1[3]);
                *(u32x4*)rowp = w; }
    }
};
}

#define XB_TMO      128
#define XB_XCNT(j)  (256  + 64 * (j))
#define XB_XSUB(j)  (1280 + 64 * (j))
#define XB_XGEN(j)  (2304 + 64 * (j))
#define XB_TOP      3328
#define XB_TOPGEN   3392
#define XCD_BAR_WORDS 3456
#define XB_SPIN_CAP (1u << 18)
__device__ __forceinline__ unsigned xb_ld(unsigned* p)              { return __hip_atomic_load(p, __ATOMIC_RELAXED, __HIP_MEMORY_SCOPE_AGENT); }
__device__ __forceinline__ unsigned xb_add(unsigned* p, unsigned v) { return __hip_atomic_fetch_add(p, v, __ATOMIC_RELAXED, __HIP_MEMORY_SCOPE_AGENT); }
__device__ __forceinline__ unsigned xb_xcc_id() { return (unsigned)__builtin_amdgcn_s_getreg((3 << 11) | 20) & 0xFu; }
#define XB_SPIN(cond, bar) do { unsigned _sp = 0; while (cond) { __builtin_amdgcn_s_sleep(1); \
    if ((++_sp & 255u) == 0u) { if (xb_ld(&(bar)[XB_TMO])) break; if (_sp > XB_SPIN_CAP) { atomicAdd(&(bar)[XB_TMO], 1u); break; } } } } while (0)
struct XcdBarrier { unsigned* bar; unsigned x; volatile LAS unsigned* st; };
__device__ __forceinline__ XcdBarrier xcd_barrier_post(unsigned* bar, volatile LAS unsigned* st) {
    XcdBarrier b; b.bar = bar; b.x = (unsigned)__builtin_amdgcn_readfirstlane((int)xb_xcc_id()); b.st = st;
    if (threadIdx.x == 0) (void)xb_add(&bar[XB_XCNT(b.x)], 1u);
    return b;
}
__device__ __forceinline__ void xcd_barrier_complete(unsigned* bar, unsigned x, unsigned& nloc, unsigned& nx) {
    const unsigned G = gridDim.x * gridDim.y * gridDim.z;
    unsigned sum, cnt, mine, sp = 0u;
    for (;;) {
        sum = 0u; cnt = 0u; mine = 0u;
#pragma unroll
        for (unsigned j = 0; j < 16; ++j) { const unsigned c = xb_ld(&bar[XB_XCNT(j)]); sum += c; cnt += (c > 0u) ? 1u : 0u; mine = (j == x) ? c : mine; }
        if (sum == G) break;
        __builtin_amdgcn_s_sleep(1);
        if ((++sp & 255u) == 0u) { if (xb_ld(&bar[XB_TMO])) break; if (sp > XB_SPIN_CAP) { atomicAdd(&bar[XB_TMO], 1u); break; } }
    }
    nloc = mine > 0u ? mine : 1u; nx = cnt > 0u ? cnt : 1u;
}
template <bool FIRST> __device__ __forceinline__ void xcd_barrier_t(const XcdBarrier& b, const Ctx cx) {
    asm volatile("s_waitcnt vmcnt(0)" ::: "memory");
    __syncthreads();
    if (tidx(cx) == 0) {
        unsigned* bar = b.bar; unsigned bx = b.x; OPQ_S(bar); OPQ_S(bx);
        __builtin_amdgcn_s_waitcnt(0);
        unsigned nloc = b.st[0], nx = b.st[1];
        if (FIRST) { if (nloc == 0u) { xcd_barrier_complete(bar, bx, nloc, nx); b.st[0] = nloc; b.st[1] = nx; } }
        const unsigned old = xb_add(&bar[XB_XSUB(bx)], 1u);
        const unsigned gen = old / nloc;
        if (old + 1u == (gen + 1u) * nloc) {
            __builtin_amdgcn_fence(__ATOMIC_RELEASE, "agent");
            asm volatile("s_waitcnt vmcnt(0)" ::: "memory");
            const unsigned og = xb_add(&bar[XB_TOP], 1u);
            const unsigned tg = og / nx;
            if (og + 1u == (tg + 1u) * nx) xb_add(&bar[XB_TOPGEN], 1u);
            else XB_SPIN(xb_ld(&bar[XB_TOPGEN]) == tg, bar);
            __builtin_amdgcn_fence(__ATOMIC_ACQUIRE, "agent");
            xb_add(&bar[XB_XGEN(bx)], 1u);
            asm volatile("s_waitcnt vmcnt(0)" ::: "memory");
        } else {
            XB_SPIN(xb_ld(&bar[XB_XGEN(bx)]) == gen, bar);
            __builtin_amdgcn_fence(__ATOMIC_ACQUIRE, "agent");
            asm volatile("s_waitcnt vmcnt(0)" ::: "memory");
        }
    }
    __syncthreads();
}
__device__ __forceinline__ void xcd_barrier_first(const XcdBarrier& b, const Ctx cx) { xcd_barrier_t<true>(b, cx); }
__device__ __forceinline__ void xcd_barrier(const XcdBarrier& b, const Ctx cx) { xcd_barrier_t<false>(b, cx); }

constexpr int LDS_TEXP = 139264, LDS_BARW = LDS_TEXP + 1024, LDS_SBASE = LDS_BARW + 16, LDS_CSH = LDS_SBASE + 64 + 176 + 256, LDS_BYTES = LDS_CSH + 8 * pg8::CSH_SLICE;
constexpr int CW_BAR = 4096;

#define MMA16(acc, afrag, bfrag) acc = __builtin_amdgcn_mfma_f32_16x16x32_bf16(bfrag, afrag, acc, 0, 0, 0)
typedef short s16x4 __attribute__((ext_vector_type(4)));
constexpr int STR64 = 144, STR128 = 272;
__device__ __forceinline__ bf16x8 frag_row(const LAS unsigned char* img, int r, int k0, int stride) { return *(const LAS bf16x8*)(img + r * stride + k0 * 2); }
__device__ __forceinline__ bf16x8 frag_tr(const LAS unsigned char* img, int rowlo, int rowhi, int x0, int stride, int fr) {
    const int q = fr >> 2, p = fr & 3;
    const s16x4 lo = __builtin_amdgcn_ds_read_tr16_b64_v4i16((LAS s16x4*)(img + (rowlo + q) * stride + x0 * 2 + 8 * p));
    const s16x4 hi = __builtin_amdgcn_ds_read_tr16_b64_v4i16((LAS s16x4*)(img + (rowhi + q) * stride + x0 * 2 + 8 * p));
    return __builtin_shufflevector(lo, hi, 0, 1, 2, 3, 4, 5, 6, 7);
}

struct CvtJob { const float* s0; const float* s1; bf16_t* dst; int ldw, ldd, kd0, K, Nd, kind; };
__device__ __forceinline__ CvtJob mkjob(const float* s0, const float* s1, bf16_t* dst, int ldw, int ldd, int kd0, int K, int Nd, int kind) { CvtJob j; j.s0 = s0; j.s1 = s1; j.dst = dst; j.ldw = ldw; j.ldd = ldd; j.kd0 = kd0; j.K = K; j.Nd = Nd; j.kind = kind; return j; }
constexpr int CV_STR = 144;
__device__ __forceinline__ void cvt_src(const CvtJob& j, int n0, int n, const float*& src, int& col) {
    const int nh = n0 + (n & 32); src = j.s0; int sc = nh;
    if (j.kind == 1) { sc = nh < 3840 ? nh : (nh < 6912 ? nh + 32 : (nh < 6944 ? nh - 3072 : -1)); }
    else if (j.kind == 2) { const int tj = nh >> 8, r = nh & 255; if (r < 128) { sc = tj * 128 + r; } else { src = j.s1; sc = tj * 128 + r - 128; } }
    col = sc < 0 ? -1 : sc + (n & 31);
}
__device__ __forceinline__ void ph_convert(const CvtJob& j, LAS unsigned char* lds, const Ctx cx, int& rot) {
    const int tid = tidx(cx), c16 = tid & 15, kr = tid >> 4, lane = tid & 63, wid = tid >> 6, fr = lane & 15, fq = lane >> 4;
    const int kch = j.K / 256, nitems = (j.Nd / 64) * kch;
    int first = cx.bid - rot; if (first < 0) first += cx.nb;
    f32x4 v[8];
    auto issue = [&](int it) { const int nbk = it / kch, kc = it % kch, n0 = nbk * 64, k0 = kc * 256; const float* src; int col; cvt_src(j, n0, c16 * 4, src, col);
#pragma unroll
        for (int p = 0; p < 8; ++p) v[p] = col >= 0 ? *(const f32x4*)(src + (size_t)(k0 + p * 32 + kr) * j.ldw + col) : (f32x4){0.f, 0.f, 0.f, 0.f}; };
    if (first < nitems) issue(first);
    for (int it = first; it < nitems; it += cx.nb) {
        const int nbk = it / kch, kc = it % kch, n0 = nbk * 64, k0 = kc * 256;
        if (j.kind == 1 && n0 >= P_QA && n0 < P_VA) {
            const int e = (c16 * 4) & 31, blk = (c16 * 4) & 32;
#pragma unroll
            for (int p = 0; p < 8; ++p) { const unsigned w0 = cvt_pk_bf16(v[p][0], v[p][1]), w1 = cvt_pk_bf16(v[p][2], v[p][3]); LAS bf16_t* rowp = (LAS bf16_t*)(lds + (p * 32 + kr) * CV_STR) + blk;
#pragma unroll
                for (int q = 0; q < 4; ++q) { const int ee = e + q, pos = ee < 16 ? 2 * ee : 2 * (ee - 16) + 1; const unsigned w = q < 2 ? w0 : w1; rowp[pos] = (bf16_t)((q & 1) ? (w >> 16) : (w & 0xffffu)); } }
        } else {
#pragma unroll
        for (int p = 0; p < 8; ++p) { u32x2 w; w.x = cvt_pk_bf16(v[p][0], v[p][1]); w.y = cvt_pk_bf16(v[p][2], v[p][3]); *(LAS u32x2*)(lds + (p * 32 + kr) * CV_STR + c16 * 8) = w; }
        }
        __syncthreads();
        if (it + cx.nb < nitems) issue(it + cx.nb);
        { const int kq = wid & 3, nh = wid >> 2, r8 = lane >> 3, c8 = lane & 7;
          LAS unsigned char* my = lds + 256 * CV_STR + wid * (16 * CV_STR); LAS unsigned char* wp = my + fr * CV_STR + fq * 16; const LAS unsigned char* rp = my + (2 * r8 + (c8 >> 2)) * CV_STR + (c8 & 3) * 16;
#pragma unroll
          for (int q = 0; q < 2; ++q) { const int nb = nh * 2 + q;
              const bf16x8 oa = frag_tr(lds, (8 * kq + fq) * 8, (8 * kq + fq) * 8 + 4, nb * 16, CV_STR, fr), ob = frag_tr(lds, (8 * kq + 4 + fq) * 8, (8 * kq + 4 + fq) * 8 + 4, nb * 16, CV_STR, fr);
              *(LAS bf16x8*)wp = oa; *(LAS bf16x8*)(wp + 64) = ob;
              asm volatile("" ::: "memory"); __builtin_amdgcn_wave_barrier();
              const bf16x8 x0 = *(const LAS bf16x8*)rp, x1 = *(const LAS bf16x8*)(rp + 64);
              asm volatile("" ::: "memory"); __builtin_amdgcn_wave_barrier();
              bf16_t* dp = j.dst + ((size_t)(((n0 + nb * 16) >> 1) + r8) * (j.ldd >> 5) + ((j.kd0 + k0 + 64 * kq) >> 5)) * 64 + 8 * c8;
              *(bf16x8*)dp = x0; *(bf16x8*)(dp + 64) = x1; } }
        __syncthreads();
    }
    rot = (rot + nitems) % cx.nb;
}

__device__ __forceinline__ void ph_init(const float* x, const float* ctx, float* XS, f32x2* CS, const Ctx cx) {
    (void)x; (void)ctx; (void)XS;
    if (cx.bid == cx.nb - 1) for (int i = tidx(cx); i < 64 * 16; i += 512) { const int pos = i >> 4, f = i & 15; const float inv = powf(10000.0f, -(float)f / 16.0f); const float a = (float)pos * inv; CS[i] = (f32x2){cosf(a), sinf(a)}; }
}
__device__ __forceinline__ void ph_mod(const float* c, const float* c_ctx, const float* w_mod, const float* b_mod, float* MOD, LAS unsigned char* lds, const Ctx cx) {
    if (cx.bid >= DEPTH * 48) return;
    LAS float* sv = (LAS float*)lds; LAS float* red = sv + 9 * 1024;
    const int tid = tidx(cx);
    for (int i = tid; i < 9 * 1024; i += 512) { const float v = i < 8192 ? c[i] : c_ctx[i - 8192]; sv[i] = siluf_(v); }
    __syncthreads();
    const int c4 = (tid & 31) * 4, kg = tid >> 5;
    for (int it = cx.bid; it < DEPTH * 48; it += cx.nb) {
        const int l = it / 48, n0 = (it % 48) * 128;
        const float* w = w_mod + ((size_t)l * D + kg * 64) * 6144 + n0 + c4;
        f32x4 a[9];
#pragma unroll
        for (int r = 0; r < 9; ++r) a[r] = (f32x4){0.f, 0.f, 0.f, 0.f};
#pragma unroll 1
        for (int k0 = 0; k0 < 64; k0 += 8) { f32x4 wv[8];
#pragma unroll
            for (int u = 0; u < 8; ++u) wv[u] = *(const f32x4*)(w + (size_t)(k0 + u) * 6144);
#pragma unroll
            for (int u = 0; u < 8; ++u)
#pragma unroll
                for (int r = 0; r < 9; ++r) a[r] = a[r] + wv[u] * sv[r * 1024 + kg * 64 + k0 + u]; }
#pragma unroll
        for (int r = 0; r < 9; ++r) *(LAS f32x4*)(red + (kg * 9 + r) * 128 + c4) = a[r];
        __syncthreads();
        for (int i = tid; i < 9 * 128; i += 512) { const int r = i >> 7, cc = i & 127; float sacc = b_mod[(size_t)l * 6144 + n0 + cc];
#pragma unroll
            for (int g = 0; g < 16; ++g) sacc += red[(g * 9 + r) * 128 + cc];
            MOD[((size_t)l * 9 + r) * 6144 + n0 + cc] = sacc; }
        __syncthreads();
    }
}

struct NormArgs { bf16_t* XS; const void* Xl; const void* Xc; int lf32, cf32; bf16_t* H;
                  const float* g; const float* mod_shift; const float* mod_scale;
                  const bf16_t* Y; const int* POS; const float* TOPKp; const float* mod_g5prev;
                  const float* router; float* TOPK; unsigned* cnt; int nrows;
                  const float* PART; const float* mod_gpart; int npart; };
template <bool ROUTE> __device__ __forceinline__ void ph_norm(const NormArgs& a, bool combine, LAS unsigned char* lds, const Ctx cx) {
    const int lane = tidx(cx) & 63, wid = tidx(cx) >> 6;
    LAS unsigned* hist = (LAS unsigned*)(lds + LDS_SBASE);
    LAS float* rtab = (LAS float*)lds;
    if (ROUTE) { __syncthreads(); if (tidx(cx) < 8) hist[tidx(cx)] = 0u;
        for (int f = tidx(cx); f < 8192; f += 512) { const int e = f & 7, ln = (f >> 3) & 63, jq = f >> 9; rtab[f] = a.router[(size_t)(4 * (ln + 64 * (jq >> 2)) + (jq & 3)) * 8 + e]; }
        __syncthreads(); }
    f32x4 gq[4];
#pragma unroll
    for (int j = 0; j < 4; ++j) gq[j] = *(const f32x4*)(a.g + 4 * (lane + 64 * j));
    const int gw = cx.bid * 8 + wid, nk = a.nrows / (cx.nb * 8);
    auto rowof = [&](int k) { return k < 8 ? gw * 8 + k : TL + gw; };
    f32x4 xn[4];
    { const int r0 = rowof(0); if (nk > 0) { const bool f = r0 < TL ? a.lf32 : a.cf32; const void* rp = r0 < TL ? a.Xl : a.Xc;
#pragma unroll
        for (int j = 0; j < 4; ++j) xn[j] = ldx_raw(rp, f, (size_t)r0 * D + 4 * (lane + 64 * j)); } }
    int cs1 = 0, cs2 = 0; float cp1 = 0.f, cp2 = 0.f; u32x2 y1n[4], y2n[4];
    if (combine) { const int rk = rowof(lane);
        if (lane < nk) { cs1 = a.POS[2 * rk]; cs2 = a.POS[2 * rk + 1]; cp1 = a.TOPKp[4 * rk + 2]; cp2 = a.TOPKp[4 * rk + 3]; }
        if (nk > 0) { const int s1 = __builtin_amdgcn_readlane(cs1, 0), s2 = __builtin_amdgcn_readlane(cs2, 0);
#pragma unroll
            for (int j = 0; j < 4; ++j) { const int cc = 4 * (lane + 64 * j); y1n[j] = *(const u32x2*)(a.Y + (size_t)s1 * D + cc); y2n[j] = *(const u32x2*)(a.Y + (size_t)s2 * D + cc); } } }
    f32x4 shq[4], scq[4];
    for (int it = 0; it < nk; ++it) {
        const int row = rowof(it); const bool hasnext = it + 1 < nk;
        const int mr = mod_row(row);
        bf16_t* xr = a.XS + (size_t)row * D; const bool fcur = row < TL ? a.lf32 : a.cf32;
        f32x4 x[4];
        if (it == 0 || it == 8) {
#pragma unroll
            for (int j = 0; j < 4; ++j) { shq[j] = *(const f32x4*)(a.mod_shift + (size_t)mr * 6144 + 4 * (lane + 64 * j)); scq[j] = *(const f32x4*)(a.mod_scale + (size_t)mr * 6144 + 4 * (lane + 64 * j)); } }
#pragma unroll
        for (int j = 0; j < 4; ++j) x[j] = cvx(xn[j], fcur);
        if (hasnext) {
            const int rn = rowof(it + 1); const bool f = rn < TL ? a.lf32 : a.cf32; const void* rp = rn < TL ? a.Xl : a.Xc;
#pragma unroll
            for (int j = 0; j < 4; ++j) xn[j] = ldx_raw(rp, f, (size_t)rn * D + 4 * (lane + 64 * j)); }
        if (combine) {
            const float p1 = __int_as_float(__builtin_amdgcn_readlane(__float_as_int(cp1), it)), p2 = __int_as_float(__builtin_amdgcn_readlane(__float_as_int(cp2), it));
            u32x2 y1c[4], y2c[4];
#pragma unroll
            for (int j = 0; j < 4; ++j) { y1c[j] = y1n[j]; y2c[j] = y2n[j]; }
            if (hasnext) { const int s1 = __builtin_amdgcn_readlane(cs1, it + 1), s2 = __builtin_amdgcn_readlane(cs2, it + 1);
#pragma unroll
                for (int j = 0; j < 4; ++j) { const int cc = 4 * (lane + 64 * j); y1n[j] = *(const u32x2*)(a.Y + (size_t)s1 * D + cc); y2n[j] = *(const u32x2*)(a.Y + (size_t)s2 * D + cc); } }
#pragma unroll
            for (int j = 0; j < 4; ++j) { const int cc = 4 * (lane + 64 * j);
                const u32x2 y1 = y1c[j], y2 = y2c[j];
                const f32x4 mg = *(const f32x4*)(a.mod_g5prev + (size_t)mr * 6144 + cc);
                f32x4 e; e[0] = p1 * bf_lo(y1.x) + p2 * bf_lo(y2.x); e[1] = p1 * bf_hi(y1.x) + p2 * bf_hi(y2.x); e[2] = p1 * bf_lo(y1.y) + p2 * bf_lo(y2.y); e[3] = p1 * bf_hi(y1.y) + p2 * bf_hi(y2.y);
                x[j] = x[j] + mg * e; stx(xr + cc, x[j]); }
        }
        if (a.PART != nullptr && row >= TL) {
#pragma unroll
            for (int j = 0; j < 4; ++j) { const int cc = 4 * (lane + 64 * j); const float* pp = a.PART + (size_t)(row - TL) * D + cc;
                f32x4 e = (*(const f32x4*)pp + *(const f32x4*)(pp + (size_t)TC * D)) + (*(const f32x4*)(pp + (size_t)2 * TC * D) + *(const f32x4*)(pp + (size_t)3 * TC * D));
                e = e + (*(const f32x4*)(pp + (size_t)4 * TC * D) + *(const f32x4*)(pp + (size_t)5 * TC * D));
                if (a.npart == 7) e = e + *(const f32x4*)(pp + (size_t)6 * TC * D);
                const f32x4 mg = *(const f32x4*)(a.mod_gpart + (size_t)8 * 6144 + cc);
                x[j] = x[j] + mg * e; stx(xr + cc, x[j]); }
        }
        float ss = 0.f;
#pragma unroll
        for (int j = 0; j < 4; ++j) ss += x[j][0] * x[j][0] + x[j][1] * x[j][1] + x[j][2] * x[j][2] + x[j][3] * x[j][3];
        ss = wave_sum(ss, lane);
        const float rs = rsqrtf(ss * (1.0f / D) + EPS);
        f32x4 h[4];
#pragma unroll
        for (int j = 0; j < 4; ++j) { const int cc = 4 * (lane + 64 * j);
            h[j] = (x[j] * rs * gq[j]) * (scq[j] + 1.0f) + shq[j];
            u32x2 w; w.x = cvt_pk_bf16(h[j][0], h[j][1]); w.y = cvt_pk_bf16(h[j][2], h[j][3]);
            *(u32x2*)(a.H + (size_t)row * D + cc) = w; }
        if (ROUTE) {
            float lg[8];
#pragma unroll
            for (int e = 0; e < 8; ++e) lg[e] = 0.f;
#pragma unroll
            for (int j = 0; j < 4; ++j)
#pragma unroll
                for (int q = 0; q < 4; ++q) { const LAS float* rw = rtab + ((j * 4 + q) * 64 + lane) * 8; const f32x4 r0 = *(const LAS f32x4*)rw, r1 = *(const LAS f32x4*)(rw + 4); const float hv = h[j][q];
                    lg[0] += hv * r0[0]; lg[1] += hv * r0[1]; lg[2] += hv * r0[2]; lg[3] += hv * r0[3]; lg[4] += hv * r1[0]; lg[5] += hv * r1[1]; lg[6] += hv * r1[2]; lg[7] += hv * r1[3]; }
#pragma unroll
            for (int e = 0; e < 8; ++e) lg[e] = wave_sum(lg[e], lane);
            if (lane == 0) {
                int e1 = 0; float v1 = lg[0];
#pragma unroll
                for (int e = 1; e < 8; ++e) if (lg[e] > v1) { v1 = lg[e]; e1 = e; }
                int e2 = -1; float v2 = -3.0e38f;
#pragma unroll
                for (int e = 0; e < 8; ++e) if (e != e1 && lg[e] > v2) { v2 = lg[e]; e2 = e; }
                const float p2 = 1.0f / (1.0f + __expf(v1 - v2)), p1 = 1.0f - p2;
                float* tk = a.TOPK + 4 * (size_t)row; tk[0] = __int_as_float(e1); tk[1] = __int_as_float(e2); tk[2] = p1; tk[3] = p2;
                lds_add(hist + e1, 1u); lds_add(hist + e2, 1u);
            }
        }
    }
    if (ROUTE) { __syncthreads(); if (tidx(cx) < 8) { const unsigned v = hist[tidx(cx)]; if (v) atomicAdd(a.cnt + tidx(cx), v); } __syncthreads(); }
}

__device__ __forceinline__ void ph_route(const float* TOPK, const bf16_t* H, bf16_t* HS, int* POS, unsigned* ctl, int j, int nrows, LAS unsigned char* lds, const Ctx cx) {
    LAS unsigned* sbase = (LAS unsigned*)(lds + LDS_SBASE);
    const int lane = tidx(cx) & 63, wid = tidx(cx) >> 6;
    __syncthreads();
    if (tidx(cx) == 0) { unsigned b = 0; for (int e = 0; e < 8; ++e) { sbase[e] = b; b += (xb_ld(ctl + CW_CNT + j * 64 + e) + 255u) & ~255u; } sbase[8] = b; }
    __syncthreads();
    if (cx.bid == 0) {
        if (tidx(cx) < 256) { const unsigned r0 = tidx(cx) * 256u; int e = 0;
            for (int q = 1; q < 8; ++q) if (r0 >= sbase[q]) e = q;
            ctl[CW_TEXP + j * 256 + tidx(cx)] = (unsigned)e; }
        if (tidx(cx) == 0) ctl[CW_NT + j] = sbase[8] / 256u;
    }
    for (int i = cx.bid * 8 + wid; i < 8 * 256; i += cx.nb * 8) { const int e = i >> 8, r = i & 255; const unsigned s = sbase[e] + xb_ld(ctl + CW_CNT + j * 64 + e) + r;
        if (s < sbase[e + 1]) {
#pragma unroll
            for (int q = 0; q < 2; ++q) ((u32x4*)(HS + (size_t)s * D))[lane + 64 * q] = ((const u32x4*)H)[lane + 64 * q]; } }
    LAS unsigned* wcnt = sbase + 16; LAS unsigned* wbase = sbase + 24;
    if (tidx(cx) < 8) wcnt[tidx(cx)] = 0u;
    const int nk = nrows / (cx.nb * 8); const int myrow = cx.bid * 8 + wid + lane * (cx.nb * 8); const bool own = lane < nk;
    int e1 = 0, e2 = 0; if (own) { const f32x2 t = *(const f32x2*)(TOPK + 4 * (size_t)myrow); e1 = __float_as_int(t[0]); e2 = __float_as_int(t[1]); }
    __syncthreads();
    if (own) { lds_add(wcnt + e1, 1u); lds_add(wcnt + e2, 1u); }
    __syncthreads();
    if (tidx(cx) < 8) { const unsigned n = wcnt[tidx(cx)]; wbase[tidx(cx)] = sbase[tidx(cx)] + (n ? atomicAdd(ctl + CW_FILL + j * 64 + tidx(cx), n) : 0u); wcnt[tidx(cx)] = 0u; }
    __syncthreads();
    int s1 = 0, s2 = 0;
    if (own) { s1 = (int)(wbase[e1] + lds_add(wcnt + e1, 1u)); s2 = (int)(wbase[e2] + lds_add(wcnt + e2, 1u)); POS[2 * myrow] = s1; POS[2 * myrow + 1] = s2; }
    u32x4 v[9][2];
#pragma unroll
    for (int k = 0; k < 9; ++k) if (k < nk) { const u32x4* src = (const u32x4*)(H + (size_t)(cx.bid * 8 + wid + k * (cx.nb * 8)) * D); v[k][0] = src[lane]; v[k][1] = src[lane + 64]; }
#pragma unroll
    for (int k = 0; k < 9; ++k) if (k < nk) { const int d1 = __builtin_amdgcn_readlane(s1, k), d2 = __builtin_amdgcn_readlane(s2, k);
        u32x4* o1 = (u32x4*)(HS + (size_t)d1 * D); u32x4* o2 = (u32x4*)(HS + (size_t)d2 * D);
        o1[lane] = v[k][0]; o1[lane + 64] = v[k][1]; o2[lane] = v[k][0]; o2[lane + 64] = v[k][1]; }
    __syncthreads();
}

struct CvIn { u32x4 cc[3], cu[3], cb; };
__device__ __forceinline__ void ph_conv(const bf16_t* P, bf16_t* BR, const float* conv_w, int nrows, const Ctx cx) {
    const int tid = tidx(cx), lane = tid & 63, wid = tid >> 6; const int c0 = lane * 8;
    float cw[3][8];
#pragma unroll
    for (int d = 0; d < 3; ++d)
#pragma unroll
        for (int e = 0; e < 8; ++e) cw[d][e] = conv_w[d * 512 + c0 + e];
    auto seqpos = [&](int row, int& sp, int& slen) { const bool lat = row < TL; sp = lat ? (row & (SEQ - 1)) : ((row - TL) & (CTXL - 1)); slen = lat ? SEQ : CTXL; };
    auto load = [&](int row, CvIn& in) { const bf16_t* pr = P + (size_t)row * NP; int sp, slen; seqpos(row, sp, slen);
#pragma unroll
        for (int d = 0; d < 3; ++d) { const int sq = sp + d - 1; const bool ok = sq >= 0 && sq < slen; const bf16_t* q = pr + (ptrdiff_t)(ok ? d - 1 : 0) * NP;
            in.cc[d] = *(const u32x4*)(q + P_CC + c0); in.cu[d] = *(const u32x4*)(q + P_CU + c0); }
        in.cb = *(const u32x4*)(pr + P_CB + c0); };
    const int stride = cx.nb * 8; int row = cx.bid * 8 + wid; CvIn cur, nxt;
    if (row < nrows) load(row, cur);
    for (; row < nrows; row += stride) {
        const int rn = row + stride; const bool hn = rn < nrows;
        if (hn) load(rn, nxt);
        int sp, slen; seqpos(row, sp, slen);
        float y[8];
#pragma unroll
        for (int e = 0; e < 8; ++e) y[e] = 0.f;
#pragma unroll
        for (int d = 0; d < 3; ++d) { const int sq = sp + d - 1; const float m = (sq >= 0 && sq < slen) ? 1.0f : 0.0f; float cv[8], uv[8]; unpack8(cur.cc[d], cv); unpack8(cur.cu[d], uv);
#pragma unroll
            for (int e = 0; e < 8; ++e) y[e] += (cv[e] * uv[e]) * (cw[d][e] * m); }
        float bv[8]; unpack8(cur.cb, bv);
#pragma unroll
        for (int e = 0; e < 8; ++e) y[e] *= bv[e];
        *(u32x4*)(BR + (size_t)row * 1536 + c0) = pack8(y);
        if (hn) cur = nxt;
    }
}

__device__ __forceinline__ void ph_final(const bf16_t* XS, const bf16_t* Y, const int* POS, const float* TOPK, const float* mod_g5, const float* g, float* out, const Ctx cx) {
    const int lane = tidx(cx) & 63, wid = tidx(cx) >> 6;
    f32x4 gq[4];
#pragma unroll
    for (int j = 0; j < 4; ++j) gq[j] = *(const f32x4*)(g + 4 * (lane + 64 * j));
    const int stride = cx.nb * 8; int row = cx.bid * 8 + wid;
    f32x4 xn[4]; u32x2 y1n[4], y2n[4]; float p1n = 0.f, p2n = 0.f;
    int cs1 = 0, cs2 = 0; float cp1 = 0.f, cp2 = 0.f;
    { const int rk = cx.bid * 8 + wid + lane * stride; if (rk < TL) { cs1 = POS[2 * rk]; cs2 = POS[2 * rk + 1]; cp1 = TOPK[4 * rk + 2]; cp2 = TOPK[4 * rk + 3]; } }
    auto fetch = [&](int r, int k) { const int s1 = __builtin_amdgcn_readlane(cs1, k), s2 = __builtin_amdgcn_readlane(cs2, k);
        p1n = __int_as_float(__builtin_amdgcn_readlane(__float_as_int(cp1), k)); p2n = __int_as_float(__builtin_amdgcn_readlane(__float_as_int(cp2), k));
#pragma unroll
        for (int j = 0; j < 4; ++j) { const int cc = 4 * (lane + 64 * j); xn[j] = ldx_raw(XS, false, (size_t)r * D + cc); y1n[j] = *(const u32x2*)(Y + (size_t)s1 * D + cc); y2n[j] = *(const u32x2*)(Y + (size_t)s2 * D + cc); } };
    if (row < TL) fetch(row, 0);
    int it = 0;
    for (; row < TL; row += stride, ++it) {
        const int mr = mod_row(row);
        f32x4 x[4]; u32x2 y1[4], y2[4]; const float p1 = p1n, p2 = p2n;
#pragma unroll
        for (int j = 0; j < 4; ++j) { x[j] = cvx(xn[j], false); y1[j] = y1n[j]; y2[j] = y2n[j]; }
        if (row + stride < TL) fetch(row + stride, it + 1);
        float ss = 0.f;
#pragma unroll
        for (int j = 0; j < 4; ++j) { const int cc = 4 * (lane + 64 * j);
            const f32x4 mg = *(const f32x4*)(mod_g5 + (size_t)mr * 6144 + cc);
            f32x4 e; e[0] = p1 * bf_lo(y1[j].x) + p2 * bf_lo(y2[j].x); e[1] = p1 * bf_hi(y1[j].x) + p2 * bf_hi(y2[j].x); e[2] = p1 * bf_lo(y1[j].y) + p2 * bf_lo(y2[j].y); e[3] = p1 * bf_hi(y1[j].y) + p2 * bf_hi(y2[j].y);
            x[j] = x[j] + mg * e; ss += x[j][0] * x[j][0] + x[j][1] * x[j][1] + x[j][2] * x[j][2] + x[j][3] * x[j][3]; }
        ss = wave_sum(ss, lane); const float rs = rsqrtf(ss * (1.0f / D) + EPS);
#pragma unroll
        for (int j = 0; j < 4; ++j) { const int cc = 4 * (lane + 64 * j); *(f32x4*)(out + (size_t)row * D + cc) = x[j] * rs * gq[j]; }
    }
}

__device__ __forceinline__ float wave_incl_scan(float v) {
    v += __int_as_float(__builtin_amdgcn_update_dpp(0, __float_as_int(v), 0x111, 0xF, 0xF, true));
    v += __int_as_float(__builtin_amdgcn_update_dpp(0, __float_as_int(v), 0x112, 0xF, 0xF, true));
    v += __int_as_float(__builtin_amdgcn_update_dpp(0, __float_as_int(v), 0x114, 0xF, 0xF, true));
    v += __int_as_float(__builtin_amdgcn_update_dpp(0, __float_as_int(v), 0x118, 0xF, 0xF, true));
    v += __int_as_float(__builtin_amdgcn_update_dpp(0, __float_as_int(v), 0x142, 0xA, 0xF, false));
    v += __int_as_float(__builtin_amdgcn_update_dpp(0, __float_as_int(v), 0x143, 0xC, 0xF, false));
    return v;
}
__device__ __forceinline__ float lsig16(float z) { const float e = __builtin_amdgcn_exp2f(fmaxf(z, -80.0f) * -LOG2E); return __builtin_amdgcn_logf(1.0f + e) * (-0.6931471805599453f / 16.0f); }
__device__ __forceinline__ void gla_wave_decay(const bf16_t* P, int row0, int t, int h, int d, int ch0, const float* gla_w2, const float* gla_b, float (&b)[16]) {
    const u32x4* ap = (const u32x4*)(P + (size_t)(row0 + t) * NP + P_AG + d * 16);
    float a[16]; unpack8(ap[0], a); unpack8(ap[1], a + 8);
    const float* w2 = gla_w2 + (size_t)d * 16 * 256 + h * 64 + ch0; const float* bb = gla_b + d * 256 + h * 64 + ch0;
#pragma unroll
    for (int i = 0; i < 16; ++i) b[i] = bb[i];
#pragma unroll
    for (int r = 0; r < 16; ++r)
#pragma unroll
        for (int i = 0; i < 16; ++i) b[i] = __builtin_fmaf(a[r], w2[r * 256 + i], b[i]);
#pragma unroll
    for (int i = 0; i < 16; ++i) b[i] = wave_incl_scan(lsig16(b[i]));
}

constexpr int G_QD = 0, G_KI = G_QD + 2 * 64 * STR64, G_AT = G_KI + 2 * 64 * STR64, G_VI = G_AT + 2 * 64 * STR64, G_SE = G_VI + 64 * STR128, G_RED = G_SE + 2 * 64 * STR128, G_END = G_RED + 512;
constexpr int G1_KR = G_KI, G1_AR = G_KI + 64 * STR64, G1_ASTR = 80, G1_W2 = 73728;
struct G1In { u32x4 vv[2], kraw, araw; float bb[16]; };
__device__ __forceinline__ void g1_load(G1In& in, const bf16_t* P, const float* gla_b, int ci, int h, int tid) {
    const int row0 = ci * 64;
    { const int w = tid >> 6; const float* bb = gla_b + (w >> 2) * 256 + h * 64 + (w & 3) * 16;
#pragma unroll
      for (int i = 0; i < 16; ++i) in.bb[i] = bb[i]; }
#pragma unroll
    for (int q = 0; q < 2; ++q) { const int id = tid + 512 * q, r = id >> 4, c16 = id & 15; in.vv[q] = *(const u32x4*)(P + (size_t)(row0 + r) * NP + P_VG + h * 128 + c16 * 8); }
    in.kraw = *(const u32x4*)(P + (size_t)(row0 + (tid >> 3)) * NP + P_KG + h * 64 + (tid & 7) * 8);
    in.araw = (u32x4){0u, 0u, 0u, 0u}; if (tid < 256) in.araw = *(const u32x4*)(P + (size_t)(row0 + (tid >> 2)) * NP + P_AG + (tid & 3) * 8);
}
__device__ __forceinline__ void gla_state_unit(const G1In& in, G1In& nxt, int vnext  , const bf16_t* P, int ci, int h, const float* gla_b, float* DS, float* DEC, float* BC, LAS unsigned char* lds, const Ctx cx) {
    const int tid = tidx(cx), lane = tid & 63, wid = __builtin_amdgcn_readfirstlane(tid >> 6), fr = lane & 15, fq = lane >> 4;
    LAS unsigned char* Ke = lds + G_QD; LAS unsigned char* Vi = lds + G_VI; LAS unsigned char* Kr = lds + G1_KR; LAS unsigned char* Ar = lds + G1_AR; const LAS float* w2s = (const LAS float*)(lds + G1_W2);
    {
#pragma unroll
      for (int q = 0; q < 2; ++q) { const int id = tid + 512 * q, r = id >> 4, c16 = id & 15; *(LAS u32x4*)(Vi + r * STR128 + c16 * 16) = in.vv[q]; }
      *(LAS u32x4*)(Kr + (tid >> 3) * STR64 + (tid & 7) * 16) = in.kraw;
      if (tid < 256) *(LAS u32x4*)(Ar + (tid >> 2) * G1_ASTR + (tid & 3) * 16) = in.araw; }
    __syncthreads();
    const size_t ub = ((size_t)ci * 4 + h) * 2;
    { const int d = wid >> 2, ch0 = (wid & 3) * 16, t = d ? 63 - lane : lane; float b[16];
      const LAS u32x4* ap = (const LAS u32x4*)(Ar + t * G1_ASTR + d * 32); float a[16]; unpack8(ap[0], a); unpack8(ap[1], a + 8);
      const LAS u32x4* kp = (const LAS u32x4*)(Kr + t * STR64 + ch0 * 2); const u32x4 k0 = kp[0], k1 = kp[1];
      const LAS float* w2 = w2s + d * 16 * 256 + h * 64 + ch0;
#pragma unroll
      for (int i = 0; i < 16; ++i) b[i] = in.bb[i];
#pragma unroll
      for (int r = 0; r < 16; ++r)
#pragma unroll
          for (int i = 0; i < 16; ++i) b[i] = __builtin_fmaf(a[r], w2[r * 256 + i], b[i]);
#pragma unroll
      for (int i = 0; i < 16; ++i) b[i] = wave_incl_scan(lsig16(b[i]));
      { float* bp = BC + ((ub + d) * 64 + ch0) * 64 + t;
#pragma unroll
        for (int i = 0; i < 16; ++i) bp[i * 64] = b[i]; }
      float kf[16], o[16]; unpack8(k0, kf); unpack8(k1, kf + 8);
#pragma unroll
      for (int i = 0; i < 16; ++i) { const float bt = __int_as_float(__builtin_amdgcn_readlane(__float_as_int(b[i]), 63)); o[i] = kf[i] * __expf(bt - b[i]); b[i] = bt; }
      *(LAS u32x4*)(Ke + d * 64 * STR64 + t * STR64 + ch0 * 2) = pack8(o); *(LAS u32x4*)(Ke + d * 64 * STR64 + t * STR64 + ch0 * 2 + 16) = pack8(o + 8);
      if (lane < 16) { float dv = b[0];
#pragma unroll
          for (int i = 1; i < 16; ++i) dv = (lane == i) ? b[i] : dv;
          DEC[(ub + d) * 64 + ch0 + lane] = __expf(dv); } }
    __syncthreads();
    if (vnext >= 0) g1_load(nxt, P, gla_b, vnext >> 2, vnext & 3, tid);
    { const int d = wid >> 2, mt = wid & 3; f32x4 acc[8];
#pragma unroll
      for (int n = 0; n < 8; ++n) acc[n] = (f32x4){0.f, 0.f, 0.f, 0.f};
#pragma unroll
      for (int s = 0; s < 2; ++s) { const int r0 = 32 * s + 8 * fq; const bf16x8 af = frag_tr(Ke + d * 64 * STR64, r0, r0 + 4, mt * 16, STR64, fr);
#pragma unroll
          for (int n = 0; n < 8; ++n) { const bf16x8 bfr = frag_tr(Vi, r0, r0 + 4, n * 16, STR128, fr); MMA16(acc[n], af, bfr); } }
      LAS unsigned char* my = lds + G_AT + wid * (16 * STR64); const int r8 = lane >> 3, c8 = lane & 7;
      LAS unsigned char* wp = my + fr * STR64 + fq * 16; const LAS unsigned char* rp = my + r8 * STR64 + c8 * 16;
      float* dst = DS + ((ub + d) * 64 + mt * 16 + r8) * 128 + 4 * c8;
#pragma unroll
      for (int p = 0; p < 4; ++p) {
          *(LAS f32x4*)wp = acc[2 * p]; *(LAS f32x4*)(wp + 64) = acc[2 * p + 1];
          asm volatile("" ::: "memory"); __builtin_amdgcn_wave_barrier();
          const f32x4 x0 = *(const LAS f32x4*)rp, x1 = *(const LAS f32x4*)(rp + 8 * STR64);
          asm volatile("" ::: "memory"); __builtin_amdgcn_wave_barrier();
          *(f32x4*)(dst + p * 32) = x0; *(f32x4*)(dst + 8 * 128 + p * 32) = x1; } }
    __syncthreads();
}

__device__ __forceinline__ void ph_gla_scan2(const float* DS, const float* DEC, bf16_t* SE, const Ctx cx) {
    const int tid = tidx(cx);
    for (int vi = cx.bid * 512 + tid; vi < 64 * 2048; vi += cx.nb * 512) {
        const int sid = vi >> 11, dk = (vi >> 5) & 63, dvq = vi & 31; const int b = sid >> 3, h = (sid >> 1) & 3, d = sid & 1;
        f32x4 S = (f32x4){0.f, 0.f, 0.f, 0.f};
#pragma unroll 12
        for (int st = 0; st < 36; ++st) {
            const int ci = st < 4 ? (256 + 4 * b + (d ? 3 - st : st)) : (32 * b + (d ? 35 - st : st - 4));
            const size_t ub = ((size_t)ci * 4 + h) * 2 + d; const size_t eo = (ub * 64 + dk) * 128 + dvq * 4;
            u32x2 w; w.x = cvt_pk_bf16(S[0], S[1]); w.y = cvt_pk_bf16(S[2], S[3]); *(u32x2*)(SE + eo) = w;
            const float dec = DEC[ub * 64 + dk]; const f32x4 ds = *(const f32x4*)(DS + eo);
            S = S * dec + ds;
        }
    }
}

struct G3In { u32x4 vv[2], sv[4], qraw, kraw; float bb[16]; };
__device__ __forceinline__ void g3_load(G3In& in, const bf16_t* P, int ci, int h, const float* BC, const bf16_t* SE, int tid) {
    const int lane = tid & 63, wid = __builtin_amdgcn_readfirstlane(tid >> 6); const int row0 = ci * 64; const size_t ub = ((size_t)ci * 4 + h) * 2;
#pragma unroll
    for (int q = 0; q < 2; ++q) { const int id = tid + 512 * q, r = id >> 4, c16 = id & 15; in.vv[q] = *(const u32x4*)(P + (size_t)(row0 + r) * NP + P_VG + h * 128 + c16 * 8); }
#pragma unroll
    for (int q = 0; q < 4; ++q) { const int id = tid + 512 * q, r = id >> 4, c16 = id & 15; in.sv[q] = *(const u32x4*)(SE + (ub * 64 + r) * 128 + c16 * 8); }
    const int d = wid >> 2, ch0 = (wid & 3) * 16, t = d ? 63 - lane : lane;
    { const bf16_t* pr = P + (size_t)(row0 + (tid >> 3)) * NP + h * 64 + (tid & 7) * 8; in.qraw = *(const u32x4*)(pr + P_QG); in.kraw = *(const u32x4*)(pr + P_KG); }
    const float* bp = BC + ((ub + d) * 64 + ch0) * 64 + t;
#pragma unroll
    for (int i = 0; i < 16; ++i) in.bb[i] = bp[i * 64];
}
__device__ __forceinline__ void gla_out_unit(const G3In& in, const bf16_t* P, int ci, int h, const float* gng, bf16_t* BR, LAS unsigned char* lds, const Ctx cx) {
    const int tid = tidx(cx), lane = tid & 63, wid = __builtin_amdgcn_readfirstlane(tid >> 6), fr = lane & 15, fq = lane >> 4; const int row0 = ci * 64;
    LAS unsigned char* Qd = lds + G_QD; LAS unsigned char* Ki = lds + G_KI; LAS unsigned char* Vi = lds + G_VI; LAS unsigned char* Se = lds + G_SE; LAS unsigned char* At = lds + G_AT;
    { LAS unsigned char* Qr = At; LAS unsigned char* Kr = At + 64 * STR64;
      *(LAS u32x4*)(Qr + (tid >> 3) * STR64 + (tid & 7) * 16) = in.qraw; *(LAS u32x4*)(Kr + (tid >> 3) * STR64 + (tid & 7) * 16) = in.kraw; }
#pragma unroll
    for (int q = 0; q < 2; ++q) { const int id = tid + 512 * q, r = id >> 4, c16 = id & 15; *(LAS u32x4*)(Vi + r * STR128 + c16 * 16) = in.vv[q]; }
#pragma unroll
    for (int q = 0; q < 4; ++q) { const int id = tid + 512 * q, r = id >> 4, c16 = id & 15; *(LAS u32x4*)(Se + r * STR128 + c16 * 16) = in.sv[q]; }
    __syncthreads();
    { const int d = wid >> 2, ch0 = (wid & 3) * 16, t = d ? 63 - lane : lane; float b[16];
      const LAS u32x4* qp = (const LAS u32x4*)(At + t * STR64 + ch0 * 2); const LAS u32x4* kp = (const LAS u32x4*)(At + 64 * STR64 + t * STR64 + ch0 * 2);
      const u32x4 q0 = qp[0], q1 = qp[1], k0 = kp[0], k1 = kp[1];
#pragma unroll
      for (int i = 0; i < 16; ++i) b[i] = in.bb[i];
      float qf[16], kf[16]; unpack8(q0, qf); unpack8(q1, qf + 8); unpack8(k0, kf); unpack8(k1, kf + 8);
#pragma unroll
      for (int i = 0; i < 16; ++i) { const float e = __expf(b[i]); qf[i] = qf[i] * 0.125f * e; kf[i] = kf[i] * __builtin_amdgcn_rcpf(e); }
      LAS unsigned char* qd = Qd + d * 64 * STR64 + t * STR64 + ch0 * 2; LAS unsigned char* ki = Ki + d * 64 * STR64 + t * STR64 + ch0 * 2;
      *(LAS u32x4*)qd = pack8(qf); *(LAS u32x4*)(qd + 16) = pack8(qf + 8); *(LAS u32x4*)ki = pack8(kf); *(LAS u32x4*)(ki + 16) = pack8(kf + 8); }
    __syncthreads();
    { const int d = wid >> 2, mt = wid & 3; f32x4 acc[4];
#pragma unroll
      for (int n = 0; n < 4; ++n) acc[n] = (f32x4){0.f, 0.f, 0.f, 0.f};
#pragma unroll
      for (int s = 0; s < 2; ++s) { const bf16x8 af = frag_row(Qd + d * 64 * STR64, mt * 16 + fr, 32 * s + 8 * fq, STR64);
#pragma unroll
          for (int n = 0; n < 4; ++n) { const bf16x8 bfr = frag_row(Ki + d * 64 * STR64, n * 16 + fr, 32 * s + 8 * fq, STR64); MMA16(acc[n], af, bfr); } }
      const int l = mt * 16 + fr;
#pragma unroll
      for (int n = 0; n < 4; ++n) { float v[4];
#pragma unroll
          for (int j = 0; j < 4; ++j) { const int s = n * 16 + 4 * fq + j; const bool keep = d ? (s >= l) : (s <= l); v[j] = keep ? acc[n][j] : 0.f; }
          u32x2 w; w.x = cvt_pk_bf16(v[0], v[1]); w.y = cvt_pk_bf16(v[2], v[3]); *(LAS u32x2*)(At + d * 64 * STR64 + l * STR64 + (n * 16 + 4 * fq) * 2) = w; } }
    __syncthreads();
    { const int mt = wid & 3, nh = wid >> 2; f32x4 acc[4];
      const int l = mt * 16 + fr; const size_t row = (size_t)row0 + l;
      u32x2 rw[4]; f32x4 gg[4];
#pragma unroll
      for (int n = 0; n < 4; ++n) { const int v0 = (nh * 4 + n) * 16 + 4 * fq; rw[n] = *(const u32x2*)(P + row * NP + P_RG + h * 128 + v0); gg[n] = *(const f32x4*)(gng + h * 128 + v0); }
#pragma unroll
      for (int n = 0; n < 4; ++n) acc[n] = (f32x4){0.f, 0.f, 0.f, 0.f};
#pragma unroll
      for (int d = 0; d < 2; ++d)
#pragma unroll
          for (int s = 0; s < 2; ++s) { const int r0 = 32 * s + 8 * fq;
              const bf16x8 af = frag_row(At + d * 64 * STR64, mt * 16 + fr, r0, STR64), aq = frag_row(Qd + d * 64 * STR64, mt * 16 + fr, r0, STR64);
#pragma unroll
              for (int n = 0; n < 4; ++n) { const int x0 = (nh * 4 + n) * 16;
                  const bf16x8 bv = frag_tr(Vi, r0, r0 + 4, x0, STR128, fr); MMA16(acc[n], af, bv);
                  const bf16x8 bs = frag_tr(Se + d * 64 * STR128, r0, r0 + 4, x0, STR128, fr); MMA16(acc[n], aq, bs); } }
      float ss = 0.f;
#pragma unroll
      for (int n = 0; n < 4; ++n) ss += acc[n][0] * acc[n][0] + acc[n][1] * acc[n][1] + acc[n][2] * acc[n][2] + acc[n][3] * acc[n][3];
      ss = row4_sum(ss);
      LAS float* red = (LAS float*)(lds + G_RED);
      if (fq == 0) red[l * 2 + nh] = ss;
      __syncthreads();
      const float rs = rsqrtf((red[l * 2] + red[l * 2 + 1]) * (1.0f / 128.0f) + EPS);
#pragma unroll
      for (int n = 0; n < 4; ++n) { const int v0 = (nh * 4 + n) * 16 + 4 * fq;
          const float y0 = acc[n][0] * rs * gg[n][0] * siluf_(bf_lo(rw[n].x)), y1 = acc[n][1] * rs * gg[n][1] * siluf_(bf_hi(rw[n].x)), y2 = acc[n][2] * rs * gg[n][2] * siluf_(bf_lo(rw[n].y)), y3 = acc[n][3] * rs * gg[n][3] * siluf_(bf_hi(rw[n].y));
          u32x2 w; w.x = cvt_pk_bf16(y0, y1); w.y = cvt_pk_bf16(y2, y3); *(u32x2*)(BR + row * 1536 + 1024 + h * 128 + v0) = w; } }
    __syncthreads();
}

constexpr int A_KBUF = 0, A_VBUF = 64 * STR64, A_BUF = 2 * 64 * STR64;
__device__ __forceinline__ void attn_unit(const bf16_t* QR, const bf16_t* KV, bf16_t* BR, const float* sink, int b, int kh, int qrow0  , int qpos0  , LAS unsigned char* lds, const Ctx cx) {
    const int tid = tidx(cx), lane = tid & 63, wid = tid >> 6, fr = lane & 15, fq = lane >> 4; const int hq = wid >> 1, qh = wid & 1;
    const bool lat = qpos0 >= 0;
    int kt0 = 0, kt1 = 0; if (lat) { kt0 = (qpos0 >> 6) - 2; if (kt0 < 0) kt0 = 0; kt1 = (qpos0 >> 6) + 4; if (kt1 > 32) kt1 = 32; }
    const int ntile = (kt1 - kt0) + 4;
    bf16x8 qf[4][2];
#pragma unroll
    for (int mt = 0; mt < 4; ++mt)
#pragma unroll
        for (int ks = 0; ks < 2; ++ks) qf[mt][ks] = *(const bf16x8*)(QR + (size_t)(qrow0 + 64 * qh + 16 * mt + fr) * 512 + (4 * kh + hq) * 64 + 32 * ks + 8 * fq);
    const float sk = sink[4 * kh + hq] * LOG2E;
    f32x4 oacc[4][4]; float mrun[4], lrun[4];
#pragma unroll
    for (int mt = 0; mt < 4; ++mt) { mrun[mt] = sk; lrun[mt] = (fq == 0) ? 1.0f : 0.0f;
#pragma unroll
        for (int dt = 0; dt < 4; ++dt) oacc[mt][dt] = (f32x4){0.f, 0.f, 0.f, 0.f}; }
    const int sr = tid >> 3, sc = tid & 7;
    auto tile_row0 = [&](int t) -> int { return t < (kt1 - kt0) ? b * SEQ + (kt0 + t) * 64 : TL + b * CTXL + (t - (kt1 - kt0)) * 64; };
    u32x4 kreg, vreg;
    { const bf16_t* src = KV + (size_t)(tile_row0(0) + sr) * 256 + kh * 64 + sc * 8; kreg = *(const u32x4*)src; vreg = *(const u32x4*)(src + 128); }
    *(LAS u32x4*)(lds + A_KBUF + sr * STR64 + sc * 16) = kreg; *(LAS u32x4*)(lds + A_VBUF + sr * STR64 + sc * 16) = vreg;
    __syncthreads();
    for (int t = 0; t < ntile; ++t) {
        LAS unsigned char* Kb = lds + (t & 1) * A_BUF + A_KBUF; LAS unsigned char* Vb = lds + (t & 1) * A_BUF + A_VBUF;
        if (t + 1 < ntile) { const bf16_t* src = KV + (size_t)(tile_row0(t + 1) + sr) * 256 + kh * 64 + sc * 8; kreg = *(const u32x4*)src; vreg = *(const u32x4*)(src + 128); }
        const bool latt = t < (kt1 - kt0); const int kpos0 = (kt0 + t) * 64;
        const int qlo = qpos0 + 64 * qh;
        const bool active = !latt || (kpos0 + 63 >= qlo - 128 && kpos0 <= qlo + 63 + 128);
        const bool needmask = latt && (kpos0 > qlo + 65 || kpos0 < qlo - 65);
        if (active) {
            u32x4 pf[4][2];
            { bf16x8 kf[4][2];
#pragma unroll
              for (int nt = 0; nt < 4; ++nt)
#pragma unroll
                  for (int ks = 0; ks < 2; ++ks) kf[nt][ks] = frag_row(Kb, nt * 16 + fr, 32 * ks + 8 * fq, STR64);
#pragma unroll
              for (int mt = 0; mt < 4; ++mt) {
                f32x4 s[4];
#pragma unroll
                for (int nt = 0; nt < 4; ++nt) { s[nt] = (f32x4){0.f, 0.f, 0.f, 0.f}; MMA16(s[nt], qf[mt][0], kf[nt][0]); MMA16(s[nt], qf[mt][1], kf[nt][1]); }
                if (needmask) { const int qp = qlo + 16 * mt + fr;
#pragma unroll
                    for (int nt = 0; nt < 4; ++nt)
#pragma unroll
                        for (int j = 0; j < 4; ++j) { const int dlt = kpos0 + nt * 16 + 4 * fq + j - qp; if (dlt > 128 || dlt < -128) s[nt][j] = -3.0e38f; } }
                float mx = fmaxf(fmaxf(fmaxf(s[0][0], s[0][1]), fmaxf(s[0][2], s[0][3])), fmaxf(fmaxf(s[1][0], s[1][1]), fmaxf(s[1][2], s[1][3])));
                mx = fmaxf(mx, fmaxf(fmaxf(fmaxf(s[2][0], s[2][1]), fmaxf(s[2][2], s[2][3])), fmaxf(fmaxf(s[3][0], s[3][1]), fmaxf(s[3][2], s[3][3]))));
                mx = row4_max(mx);
                const float mnew = fmaxf(mrun[mt], mx), alpha = __builtin_amdgcn_exp2f(mrun[mt] - mnew); mrun[mt] = mnew;
                float ps = 0.f;
#pragma unroll
                for (int nt = 0; nt < 4; ++nt)
#pragma unroll
                    for (int j = 0; j < 4; ++j) { const float p = __builtin_amdgcn_exp2f(s[nt][j] - mnew); s[nt][j] = p; ps += p; }
                lrun[mt] = lrun[mt] * alpha + ps;
                pf[mt][0].x = cvt_pk_bf16(s[0][0], s[0][1]); pf[mt][0].y = cvt_pk_bf16(s[0][2], s[0][3]); pf[mt][0].z = cvt_pk_bf16(s[1][0], s[1][1]); pf[mt][0].w = cvt_pk_bf16(s[1][2], s[1][3]);
                pf[mt][1].x = cvt_pk_bf16(s[2][0], s[2][1]); pf[mt][1].y = cvt_pk_bf16(s[2][2], s[2][3]); pf[mt][1].z = cvt_pk_bf16(s[3][0], s[3][1]); pf[mt][1].w = cvt_pk_bf16(s[3][2], s[3][3]);
#pragma unroll
                for (int dt = 0; dt < 4; ++dt) oacc[mt][dt] = oacc[mt][dt] * alpha;
              } }
#pragma unroll
            for (int dt = 0; dt < 4; ++dt) {
                const bf16x8 v0 = frag_tr(Vb, 4 * fq, 16 + 4 * fq, dt * 16, STR64, fr), v1 = frag_tr(Vb, 32 + 4 * fq, 48 + 4 * fq, dt * 16, STR64, fr);
#pragma unroll
                for (int mt = 0; mt < 4; ++mt) { MMA16(oacc[mt][dt], __builtin_bit_cast(bf16x8, pf[mt][0]), v0); MMA16(oacc[mt][dt], __builtin_bit_cast(bf16x8, pf[mt][1]), v1); } }
        }
        if (t + 1 < ntile) { LAS unsigned char* nb_ = lds + ((t + 1) & 1) * A_BUF; *(LAS u32x4*)(nb_ + A_KBUF + sr * STR64 + sc * 16) = kreg; *(LAS u32x4*)(nb_ + A_VBUF + sr * STR64 + sc * 16) = vreg; }
        __syncthreads();
    }
#pragma unroll
    for (int mt = 0; mt < 4; ++mt) { const float l = row4_sum(lrun[mt]); const float inv = 1.0f / l;
        bf16_t* op = BR + (size_t)(qrow0 + 64 * qh + 16 * mt + fr) * 1536 + 512 + (4 * kh + hq) * 64 + 4 * fq;
#pragma unroll
        for (int dt = 0; dt < 4; ++dt) { u32x2 w; w.x = cvt_pk_bf16(oacc[mt][dt][0] * inv, oacc[mt][dt][1] * inv); w.y = cvt_pk_bf16(oacc[mt][dt][2] * inv, oacc[mt][dt][3] * inv); *(u32x2*)(op + dt * 16) = w; } }
}

__device__ __forceinline__ void ph_mixA(const bf16_t* P, const bf16_t* QR, const bf16_t* KV, bf16_t* BR, const float* sink, const float* gla_w2, const float* gla_b, float* DS, float* DEC, float* BC, bool ctxq, LAS unsigned char* lds, const Ctx cx) {
    { LAS float* w2s = (LAS float*)(lds + G1_W2); for (int i = tidx(cx); i < 2 * 16 * 256; i += 512) w2s[i] = gla_w2[i]; }
    for (int u = cx.bid; u < 256; u += cx.nb) { const int b = u >> 5, n = (u >> 1) & 15, kh = u & 1; attn_unit(QR, KV, BR, sink, b, kh, b * SEQ + n * 128, n * 128, lds, cx); }
    if (cx.nb == 256) {
        const int n = (cx.bid >> 1) & 15; const bool edge = (n == 0 || n == 15);
        if (ctxq && edge) { const int b = cx.bid >> 5, kh = cx.bid & 1; attn_unit(QR, KV, BR, sink, b, kh, TL + b * CTXL + (n == 15 ? 128 : 0), -1000000, lds, cx); }
        int rank; if (!ctxq) rank = cx.bid; else { const int blk = cx.bid >> 5, w = cx.bid & 31; rank = edge ? -1 : blk * 28 + (w - 2); }
        const int nv = (rank >= 0 && rank < 128) ? 5 : 4;
        G1In cur, nxt; g1_load(cur, P, gla_b, cx.bid >> 2, cx.bid & 3, tidx(cx));
#pragma unroll 1
        for (int k = 0; k < nv; ++k) { const int v = k < 4 ? cx.bid + 256 * k : 1024 + rank; const int vn = (k + 1 < nv) ? ((k + 1) < 4 ? cx.bid + 256 * (k + 1) : 1024 + rank) : -1;
            gla_state_unit(cur, nxt, vn, P, v >> 2, v & 3, gla_b, DS, DEC, BC, lds, cx);
            if (vn >= 0) cur = nxt; }
        return;
    }
    const int nsmall = (ctxq ? 32 : 0) + 1152;
    for (int u = cx.bid; u < nsmall; u += cx.nb) {
        int v = u;
        if (ctxq) { if (v < 32) { const int b = v >> 2, n = (v >> 1) & 1, kh = v & 1; attn_unit(QR, KV, BR, sink, b, kh, TL + b * CTXL + n * 128, -1000000, lds, cx); continue; } v -= 32; }
        { G1In cur, nxt; g1_load(cur, P, gla_b, v >> 2, v & 3, tidx(cx)); gla_state_unit(cur, nxt, -1, P, v >> 2, v & 3, gla_b, DS, DEC, BC, lds, cx); }
    }
}
__device__ __forceinline__ void ph_mixC(const bf16_t* P, const float* BC, const bf16_t* SE, const float* gng, bf16_t* BR, int nchunks, LAS unsigned char* lds, const Ctx cx) {
    const int n = nchunks * 4; int u = cx.bid; G3In cur, nxt;
    if (u < n) g3_load(cur, P, u >> 2, u & 3, BC, SE, tidx(cx));
    for (; u < n; u += cx.nb) { const int un = u + cx.nb; const bool hn = un < n;
        if (hn) g3_load(nxt, P, un >> 2, un & 3, BC, SE, tidx(cx));
        gla_out_unit(cur, P, u >> 2, u & 3, gng, BR, lds, cx);
        if (hn) cur = nxt; }
}

template <int MODE, class Epi, int ABLK = 0> __device__ __forceinline__ void ph_gemm(LAS unsigned char* lds, const bf16_t* A, const bf16_t* Bt, int lda, int ldb, int K, int nM, int nN, const Epi& E, unsigned* ctl, int moe_j, size_t bexp, const Ctx cx) {
    pg8::Prob<MODE> P; P.A = A; P.Bt = Bt; P.lda = lda; P.ldb = ldb; P.K = K; P.nM = nM; P.nN = nN; P.G = cx.nb; P.c = cx.bid; P.texp = (LAS int*)(lds + LDS_TEXP); P.bexp = bexp; P.nctx = (MODE == 3) ? moe_j : 0;
    if (MODE == 2) {
        __syncthreads();
        if (tidx(cx) < 256) ((LAS int*)(lds + LDS_TEXP))[tidx(cx)] = (int)xb_ld(ctl + CW_TEXP + moe_j * 256 + tidx(cx));
        P.nM = (int)xb_ld(ctl + CW_NT + moe_j);
        __syncthreads();
    }
    pg8::gemm_phase<Epi, pg8::Prob<MODE>, ABLK>(lds, P, E, cx);
}

__device__ __forceinline__ bool idle_ctx(unsigned* ctl, int j, int nN, Ctx& cx) {
    const int U = (int)xb_ld(ctl + CW_NT + j) * nN, rounds = (U + cx.nb - 1) / cx.nb, nidle = rounds * cx.nb - U;
    if (nidle < 64) return true;
    const int first = cx.nb - nidle; if (cx.bid < first) return false;
    cx.bid -= first; cx.nb = nidle; return true;
}

struct MKP { const float* in[24]; float* out; char* ws; };
typedef const MKP __attribute__((address_space(4)))* KPtr;
__device__ __forceinline__ KPtr kp() { KPtr q = (KPtr)__builtin_amdgcn_kernarg_segment_ptr(); OPQ_S(q); return q; }
#define IN_(i) ((const float*)q->in[i])
#define WSP(off) (ws + (off))

__global__ void __launch_bounds__(512, 2) mk_fwd(MKP p_unused) {
    extern __shared__ __attribute__((aligned(16))) unsigned char shm[];
    LAS unsigned char* lds = (LAS unsigned char*)shm;
    const int nb = gridDim.x; const int wv = __builtin_amdgcn_readfirstlane((int)(threadIdx.x >> 6));
    XcdBarrier bar;
    { KPtr q = kp(); char* ws = q->ws;
      if (threadIdx.x == 0) *(LAS u32x4*)(lds + LDS_BARW) = (u32x4){0u, 0u, 0u, 0u};
      __syncthreads();
      bar = xcd_barrier_post((unsigned*)WSP(WS_CTL) + CW_BAR, (volatile LAS unsigned*)(lds + LDS_BARW)); }

    { KPtr q = kp(); char* ws = q->ws; Ctx cx; cx.bid = blockIdx.x; cx.nb = nb; cx.wv = wv; OPQ_S(cx.bid); OPQ_S(cx.wv);
      ph_init(IN_(0), IN_(2), (float*)nullptr, (f32x2*)WSP(WS_CS), cx);
      ph_mod(IN_(1), IN_(3), IN_(4), IN_(5), (float*)WSP(WS_MOD), lds, cx);
      __syncthreads(); }
    { int rot = 0;
#pragma unroll 1
      for (int l = 0; l < DEPTH; ++l) {
          KPtr q = kp(); char* ws = q->ws; Ctx cx; cx.bid = blockIdx.x; cx.nb = nb; cx.wv = wv; OPQ_S(cx.bid); OPQ_S(cx.wv);
          ph_convert(mkjob(IN_(8) + (size_t)l * D * DIN, nullptr, (bf16_t*)WSP(WS_WIN) + (size_t)l * NP * D, DIN, D, 0, D, NP, 1), lds, cx, rot);
          ph_convert(mkjob(IN_(15) + (size_t)l * D * D, nullptr, (bf16_t*)WSP(WS_WO3) + (size_t)l * D * D, D, D, 0, D, D, 0), lds, cx, rot);
#pragma unroll 1
          for (int i = 0; i < 3; ++i) {
              ph_convert(mkjob(IN_(14) + ((size_t)l * 3 + i) * 512 * D, nullptr, (bf16_t*)WSP(WS_WBR) + (size_t)l * D * 1536, D, 1536, i * 512, 512, 1024, 0), lds, cx, rot);
          }
      }
#pragma unroll 1
      for (int j = 0; j < 2; ++j) {
          KPtr q = kp(); char* ws = q->ws; Ctx cx; cx.bid = blockIdx.x; cx.nb = nb; cx.wv = wv; OPQ_S(cx.bid); OPQ_S(cx.wv);
          ph_convert(mkjob(IN_(16) + (size_t)j * D * DFF, IN_(17) + (size_t)j * D * DFF, (bf16_t*)WSP(WS_WUPD) + (size_t)j * NUP * D, DFF, D, 0, D, NUP, 2), lds, cx, rot);
          ph_convert(mkjob(IN_(18) + (size_t)j * DFF * D, nullptr, (bf16_t*)WSP(WS_WDND) + (size_t)j * D * DFF, D, DFF, 0, DFF, D, 0), lds, cx, rot);
      }
    }
    { Ctx cx; cx.bid = 0; cx.nb = nb; cx.wv = wv; OPQ_S(cx.wv); xcd_barrier_first(bar, cx); }

#pragma unroll 1
    for (int l = 0; l < DEPTH; ++l) {
        const bool last = (l == DEPTH - 1), moe = (l & 1); const int j = l >> 1; const int nrows = last ? TL : T; const int nMr = nrows / 256;
        { KPtr q = kp(); char* ws = q->ws; Ctx cx; cx.bid = blockIdx.x; cx.nb = nb; cx.wv = wv; OPQ_S(cx.bid); OPQ_S(cx.wv); const float* modl = (const float*)WSP(WS_MOD) + (size_t)l * 9 * 6144;
          NormArgs a; a.XS = (bf16_t*)WSP(WS_XS); a.lf32 = a.cf32 = (l == 0); a.Xl = l ? (const void*)WSP(WS_XS) : (const void*)IN_(0); a.Xc = l ? (const void*)WSP(WS_XS) : (const void*)(IN_(2) - (size_t)TL * D); a.H = (bf16_t*)WSP(WS_H); a.g = IN_(6) + l * D; a.mod_shift = modl; a.mod_scale = modl + 1024; a.nrows = T;
          a.Y = (const bf16_t*)WSP(WS_YB); a.POS = (const int*)WSP(WS_POS); a.TOPKp = (const float*)WSP(WS_TOPK); a.mod_g5prev = (const float*)WSP(WS_MOD) + (size_t)(l > 0 ? l - 1 : 0) * 9 * 6144 + 5 * 1024; a.router = nullptr; a.TOPK = nullptr; a.cnt = nullptr;
          a.npart = 7; a.PART = (l == 1 || l == 3) ? (const float*)WSP(WS_PART) : nullptr; a.mod_gpart = (const float*)WSP(WS_MOD) + (size_t)(l > 0 ? l - 1 : 0) * 9 * 6144 + 5 * 1024;
          ph_norm<false>(a, l == 2, lds, cx); }
        { Ctx cx; cx.bid = 0; cx.nb = nb; cx.wv = wv; OPQ_S(cx.wv); xcd_barrier(bar, cx); }
        { KPtr q = kp(); char* ws = q->ws; Ctx cx; cx.bid = blockIdx.x; cx.nb = nb; cx.wv = wv; OPQ_S(cx.bid); OPQ_S(cx.wv);
          pg8::EpiWin E{(bf16_t*)WSP(WS_PH), (bf16_t*)WSP(WS_QR), (bf16_t*)WSP(WS_KV), (const f32x2*)WSP(WS_CS), lds + LDS_CSH}; ph_gemm<0>(lds, (const bf16_t*)WSP(WS_H), (const bf16_t*)WSP(WS_WIN) + (size_t)l * NP * D, D, D, D, T / 256, NP / 256, E, nullptr, 0, 0, cx); }
        { Ctx cx; cx.bid = 0; cx.nb = nb; cx.wv = wv; OPQ_S(cx.wv); xcd_barrier(bar, cx); }
        { KPtr q = kp(); char* ws = q->ws; Ctx cx; cx.bid = blockIdx.x; cx.nb = nb; cx.wv = wv; OPQ_S(cx.bid); OPQ_S(cx.wv);
          ph_mixA((const bf16_t*)WSP(WS_PH), (const bf16_t*)WSP(WS_QR), (const bf16_t*)WSP(WS_KV), (bf16_t*)WSP(WS_BR), IN_(10) + l * 8, IN_(11) + (size_t)l * 2 * 16 * 256, IN_(12) + (size_t)l * 2 * 256,
                  (float*)WSP(WS_R3), (float*)WSP(WS_DEC), (float*)WSP(WS_YB), !last, lds, cx); }
        { Ctx cx; cx.bid = 0; cx.nb = nb; cx.wv = wv; OPQ_S(cx.wv); xcd_barrier(bar, cx); }
        { KPtr q = kp(); char* ws = q->ws; Ctx cx; cx.bid = blockIdx.x; cx.nb = nb; cx.wv = wv; OPQ_S(cx.bid); OPQ_S(cx.wv);
          ph_gla_scan2((const float*)WSP(WS_R3), (const float*)WSP(WS_DEC), (bf16_t*)(WSP(WS_R3) + (size_t)2 * T * 512 * 4), cx); }
        { Ctx cx; cx.bid = 0; cx.nb = nb; cx.wv = wv; OPQ_S(cx.wv); xcd_barrier(bar, cx); }
        { KPtr q = kp(); char* ws = q->ws; Ctx cx; cx.bid = blockIdx.x; cx.nb = nb; cx.wv = wv; OPQ_S(cx.bid); OPQ_S(cx.wv);
          ph_conv((const bf16_t*)WSP(WS_PH), (bf16_t*)WSP(WS_BR), IN_(9) + (size_t)l * 3 * 512, nrows, cx);
          ph_mixC((const bf16_t*)WSP(WS_PH), (const float*)WSP(WS_YB), (const bf16_t*)(WSP(WS_R3) + (size_t)2 * T * 512 * 4), IN_(13) + l * 512, (bf16_t*)WSP(WS_BR), nrows / 64, lds, cx); }
        { Ctx cx; cx.bid = 0; cx.nb = nb; cx.wv = wv; OPQ_S(cx.wv); xcd_barrier(bar, cx); }
        { KPtr q = kp(); char* ws = q->ws; Ctx cx; cx.bid = blockIdx.x; cx.nb = nb; cx.wv = wv; OPQ_S(cx.bid); OPQ_S(cx.wv);
          constexpr size_t MG3C_OFF = (size_t)TL * D * 2;
          if (!last) { pg8::EpiGate E{(bf16_t*)(WSP(WS_R3) + MG3C_OFF), (const bf16_t*)WSP(WS_PH) + (size_t)TL * NP, lds + LDS_CSH}; ph_gemm<1>(lds, (const bf16_t*)WSP(WS_BR) + (size_t)TL * 1536, (const bf16_t*)WSP(WS_WBR) + (size_t)l * D * 1536, 1536, 1536, 512, 8, 12, E, nullptr, 0, 0, cx); }
          { pg8::EpiMerge E{(bf16_t*)WSP(WS_R3), (const bf16_t*)WSP(WS_PH), lds + LDS_CSH}; ph_gemm<4>(lds, (const bf16_t*)WSP(WS_BR), (const bf16_t*)WSP(WS_WBR) + (size_t)l * D * 1536, 1536, 1536, 1536, 64, 4, E, nullptr, 0, 0, cx); } }
        { Ctx cx; cx.bid = 0; cx.nb = nb; cx.wv = wv; OPQ_S(cx.wv); xcd_barrier(bar, cx); }
        { KPtr q = kp(); char* ws = q->ws; Ctx cx; cx.bid = blockIdx.x; cx.nb = nb; cx.wv = wv; OPQ_S(cx.bid); OPQ_S(cx.wv);
          constexpr size_t MG3C_OFF = (size_t)TL * D * 2;
          pg8::EpiResid E{(bf16_t*)WSP(WS_XS), (const float*)WSP(WS_MOD) + (size_t)l * 9 * 6144 + 2 * 1024, (float*)WSP(WS_PART), l ? (const void*)WSP(WS_XS) : (const void*)IN_(0), lds + LDS_CSH, l == 0, 0};
          if (!last) ph_gemm<5>(lds, (const bf16_t*)(WSP(WS_R3) + MG3C_OFF) - (size_t)TL * 3072, (const bf16_t*)WSP(WS_WO3) + (size_t)l * D * D, 3072, D, 512, 8, 4, E, nullptr, 0, 0, cx);
          ph_gemm<0>(lds, (const bf16_t*)WSP(WS_R3), (const bf16_t*)WSP(WS_WO3) + (size_t)l * D * D, D, D, D, 64, 4, E, nullptr, 0, 0, cx); }
        { Ctx cx; cx.bid = 0; cx.nb = nb; cx.wv = wv; OPQ_S(cx.wv); xcd_barrier(bar, cx); }
        { KPtr q = kp(); char* ws = q->ws; Ctx cx; cx.bid = blockIdx.x; cx.nb = nb; cx.wv = wv; OPQ_S(cx.bid); OPQ_S(cx.wv); const float* modl = (const float*)WSP(WS_MOD) + (size_t)l * 9 * 6144;
          NormArgs a; a.XS = (bf16_t*)WSP(WS_XS); a.lf32 = 0; a.cf32 = (l == 0); a.Xl = (const void*)WSP(WS_XS); a.Xc = l ? (const void*)WSP(WS_XS) : (const void*)(IN_(2) - (size_t)TL * D); a.H = (bf16_t*)WSP(WS_H); a.g = IN_(7) + l * D; a.mod_shift = modl + 3 * 1024; a.mod_scale = modl + 4 * 1024; a.nrows = nrows;
          a.Y = nullptr; a.POS = nullptr; a.TOPKp = nullptr; a.mod_g5prev = nullptr; a.router = IN_(19) + (size_t)j * D * 8; a.TOPK = (float*)WSP(WS_TOPK); a.cnt = (unsigned*)WSP(WS_CTL) + CW_CNT + j * 64;
          a.npart = 6; a.PART = last ? nullptr : (const float*)WSP(WS_PART); a.mod_gpart = modl + 2 * 1024;
          if (moe) ph_norm<true>(a, false, lds, cx); else ph_norm<false>(a, false, lds, cx); }
        if (moe && j == 0) {
            int rot = 0;
#pragma unroll 1
            for (int e = 0; e < NEXP; ++e) { KPtr q = kp(); char* ws = q->ws; Ctx cx; cx.bid = blockIdx.x; cx.nb = nb; cx.wv = wv; OPQ_S(cx.bid); OPQ_S(cx.wv); const size_t eo = ((size_t)j * NEXP + e) * D * DFF;
                ph_convert(mkjob(IN_(20) + eo, IN_(21) + eo, (bf16_t*)WSP(WS_WUPM) + (size_t)e * NUP * D, DFF, D, 0, D, NUP, 2), lds, cx, rot);
            }
        }
        { Ctx cx; cx.bid = 0; cx.nb = nb; cx.wv = wv; OPQ_S(cx.wv); xcd_barrier(bar, cx); }
        if (!moe) {
            { KPtr q = kp(); char* ws = q->ws; Ctx cx; cx.bid = blockIdx.x; cx.nb = nb; cx.wv = wv; OPQ_S(cx.bid); OPQ_S(cx.wv);
              pg8::EpiSwiglu E{(bf16_t*)WSP(WS_PH)}; ph_gemm<0>(lds, (const bf16_t*)WSP(WS_H), (const bf16_t*)WSP(WS_WUPD) + (size_t)j * NUP * D, D, D, D, nMr, NUP / 256, E, nullptr, 0, 0, cx); }
            { Ctx cx; cx.bid = 0; cx.nb = nb; cx.wv = wv; OPQ_S(cx.wv); xcd_barrier(bar, cx); }
            { KPtr q = kp(); char* ws = q->ws; Ctx cx; cx.bid = blockIdx.x; cx.nb = nb; cx.wv = wv; OPQ_S(cx.bid); OPQ_S(cx.wv);
              pg8::EpiResid E{(bf16_t*)WSP(WS_XS), (const float*)WSP(WS_MOD) + (size_t)l * 9 * 6144 + 5 * 1024, (float*)WSP(WS_PART), (const void*)WSP(WS_XS), lds + LDS_CSH, 0, 0}; ph_gemm<3, pg8::EpiResid, 1>(lds, (const bf16_t*)WSP(WS_PH), (const bf16_t*)WSP(WS_WDND) + (size_t)j * D * DFF, DFF, DFF, DFF, nMr, 4, E, nullptr, last ? 0 : 224, 0, cx); }
            { Ctx cx; cx.bid = 0; cx.nb = nb; cx.wv = wv; OPQ_S(cx.wv); xcd_barrier(bar, cx); }
        } else {
            { KPtr q = kp(); char* ws = q->ws; Ctx cx; cx.bid = blockIdx.x; cx.nb = nb; cx.wv = wv; OPQ_S(cx.bid); OPQ_S(cx.wv);
              ph_route((const float*)WSP(WS_TOPK), (const bf16_t*)WSP(WS_H), (bf16_t*)WSP(WS_R3), (int*)WSP(WS_POS), (unsigned*)WSP(WS_CTL), j, nrows, lds, cx); }
            { Ctx cx; cx.bid = 0; cx.nb = nb; cx.wv = wv; OPQ_S(cx.wv); xcd_barrier(bar, cx); }
            { KPtr q = kp(); char* ws = q->ws; Ctx cx; cx.bid = blockIdx.x; cx.nb = nb; cx.wv = wv; OPQ_S(cx.bid); OPQ_S(cx.wv);
              pg8::EpiSwiglu E{(bf16_t*)WSP(WS_PH)}; ph_gemm<2>(lds, (const bf16_t*)WSP(WS_R3), (const bf16_t*)WSP(WS_WUPM), D, D, D, 0, NUP / 256, E, (unsigned*)WSP(WS_CTL), j, (size_t)NUP * D, cx);
              { Ctx c2 = cx; if (idle_ctx((unsigned*)WSP(WS_CTL), j, NUP / 256, c2)) { int rot = 0;
#pragma unroll 1
                  for (int e = 0; e < NEXP; ++e) { const size_t eo = ((size_t)j * NEXP + e) * D * DFF; ph_convert(mkjob(IN_(22) + eo, nullptr, (bf16_t*)WSP(WS_WDNM) + (size_t)e * D * DFF, D, DFF, 0, DFF, D, 0), lds, c2, rot); } } } }
            { Ctx cx; cx.bid = 0; cx.nb = nb; cx.wv = wv; OPQ_S(cx.wv); xcd_barrier(bar, cx); }
            { KPtr q = kp(); char* ws = q->ws; Ctx cx; cx.bid = blockIdx.x; cx.nb = nb; cx.wv = wv; OPQ_S(cx.bid); OPQ_S(cx.wv);
              pg8::EpiBf16 E{(bf16_t*)WSP(WS_YB), lds + LDS_CSH, D, 0}; ph_gemm<2, pg8::EpiBf16, 1>(lds, (const bf16_t*)WSP(WS_PH), (const bf16_t*)WSP(WS_WDNM), DFF, DFF, DFF, 0, 4, E, (unsigned*)WSP(WS_CTL), j, (size_t)D * DFF, cx);
              if (j == 0) { Ctx c2 = cx; if (idle_ctx((unsigned*)WSP(WS_CTL), j, 4, c2)) { int rot = 0;
#pragma unroll 1
                  for (int e = 0; e < NEXP; ++e) { const size_t eo = ((size_t)NEXP + e) * D * DFF; ph_convert(mkjob(IN_(20) + eo, IN_(21) + eo, (bf16_t*)WSP(WS_WUPM) + (size_t)e * NUP * D, DFF, D, 0, D, NUP, 2), lds, c2, rot); } } } }
            { Ctx cx; cx.bid = 0; cx.nb = nb; cx.wv = wv; OPQ_S(cx.wv); xcd_barrier(bar, cx); }
        }
    }
    { KPtr q = kp(); char* ws = q->ws; Ctx cx; cx.bid = blockIdx.x; cx.nb = nb; cx.wv = wv; OPQ_S(cx.bid); OPQ_S(cx.wv);
      ph_final((const bf16_t*)WSP(WS_XS), (const bf16_t*)WSP(WS_YB), (const int*)WSP(WS_POS), (const float*)WSP(WS_TOPK), (const float*)WSP(WS_MOD) + (size_t)3 * 9 * 6144 + 5 * 1024, IN_(23), q->out, cx); }
}

extern "C" void kernel_launch(void* const* d_in, const int* in_sizes, int n_in, void* d_out, int out_size, void* d_ws, size_t ws_size, hipStream_t stream) {
    (void)in_sizes; (void)out_size;
    if (n_in != 24 || ws_size < WS_END) return;
    static int grid = 0;
    if (!grid) {
        int dev = 0, cus = 0, per_cu = 0;
        if (hipGetDevice(&dev) != hipSuccess || hipDeviceGetAttribute(&cus, hipDeviceAttributeMultiprocessorCount, dev) != hipSuccess) return;
        if (hipFuncSetAttribute((const void*)mk_fwd, hipFuncAttributeMaxDynamicSharedMemorySize, LDS_BYTES) != hipSuccess) return;
        if (hipOccupancyMaxActiveBlocksPerMultiprocessor(&per_cu, mk_fwd, 512, LDS_BYTES) != hipSuccess || per_cu < 1) return;
        if (cus != 256) return;
        grid = cus;
    }
    (void)hipMemsetAsync((char*)d_ws + WS_CTL, 0, CTL_BYTES, stream);
    MKP p;
    for (int i = 0; i < 24; ++i) p.in[i] = (const float*)d_in[i];
    p.out = (float*)d_out; p.ws = (char*)d_ws;
    hipLaunchKernelGGL(mk_fwd, dim3(grid), dim3(512), LDS_BYTES, stream, p);
}
```

```cpp
#include <hip/hip_runtime.h>
#include <stdint.h>
#include <stddef.h>

#define LAS __attribute__((address_space(3)))
typedef unsigned short bf16_t;
typedef short bf16x8 __attribute__((ext_vector_type(8)));
typedef float f32x4 __attribute__((ext_vector_type(4)));
typedef float f32x2 __attribute__((ext_vector_type(2)));
typedef unsigned u32x4 __attribute__((ext_vector_type(4)));
typedef unsigned u32x2 __attribute__((ext_vector_type(2)));

constexpr int D = 1024, NBATCH = 8, SEQ = 2048, CTXL = 256, DEPTH = 4;
constexpr int TL = NBATCH * SEQ, TC = NBATCH * CTXL, T = TL + TC;
constexpr int DIN = 6944, NP = 7168;
constexpr int DFF = 3584, NUP = 2 * DFF;
constexpr int NEXP = 8;
constexpr int MAXR = 2 * T + NEXP * 256;
constexpr int P_CB = 0, P_CC = 512, P_CU = 1024, P_QA = 1536, P_KA = 2048, P_VA = 2176, P_QG = 2304, P_KG = 2560, P_VG = 2816, P_RG = 3328, P_GATE = 3840, P_AG = 6912;
constexpr float EPS = 1e-6f;
constexpr float LOG2E = 1.4426950408889634f, QSCALE = 0.125f * LOG2E;

constexpr size_t al256(size_t x) { return (x + 255) & ~(size_t)255; }
constexpr size_t WS_CTL = 0;                                   constexpr size_t CTL_BYTES = 65536;
constexpr size_t WS_MOD = WS_CTL + CTL_BYTES;                  constexpr size_t MOD_BYTES = (size_t)DEPTH * 9 * 6 * D * 4;
constexpr size_t WS_CS = al256(WS_MOD + MOD_BYTES);            constexpr size_t CS_BYTES = 64 * 16 * 8;
constexpr size_t WS_XS = al256(WS_CS + CS_BYTES);              constexpr size_t XS_BYTES = (size_t)T * D * 4;
constexpr size_t WS_H = al256(WS_XS + XS_BYTES);               constexpr size_t H_BYTES = (size_t)T * D * 2;
constexpr size_t WS_PH = al256(WS_H + H_BYTES);                constexpr size_t PH_BYTES = (size_t)MAXR * DFF * 2;
constexpr size_t WS_BR = al256(WS_PH + PH_BYTES);              constexpr size_t BR_BYTES = (size_t)T * 1536 * 2;
constexpr size_t WS_R3 = al256(WS_BR + BR_BYTES);              constexpr size_t R3_BYTES = (size_t)T * 3072 * 2;
constexpr size_t WS_YB = al256(WS_R3 + R3_BYTES);              constexpr size_t YB_BYTES = (size_t)MAXR * D * 2;
constexpr size_t WS_QR = al256(WS_YB + YB_BYTES);              constexpr size_t QR_BYTES = (size_t)T * 512 * 2;
constexpr size_t WS_KV = al256(WS_QR + QR_BYTES);              constexpr size_t KV_BYTES = (size_t)T * 256 * 2;
constexpr size_t WS_TOPK = al256(WS_KV + KV_BYTES);            constexpr size_t TOPK_BYTES = (size_t)T * 16;
constexpr size_t WS_POS = al256(WS_TOPK + TOPK_BYTES);         constexpr size_t POS_BYTES = (size_t)T * 8;
constexpr size_t WS_IDX = al256(WS_POS + POS_BYTES);           constexpr size_t IDX_BYTES = (size_t)MAXR * 4;
constexpr size_t WS_DEC = al256(WS_IDX + IDX_BYTES);           constexpr size_t DEC_BYTES = (size_t)(T / 64) * 4 * 2 * 64 * 4;
constexpr size_t WS_PART = al256(WS_DEC + DEC_BYTES);         constexpr size_t PART_BYTES = (size_t)7 * TC * D * 4;
constexpr size_t WS_WIN = al256(WS_PART + PART_BYTES);           constexpr size_t WIN_BYTES = (size_t)DEPTH * NP * D * 2;
constexpr size_t WS_WBR = al256(WS_WIN + WIN_BYTES);           constexpr size_t WBR_BYTES = (size_t)DEPTH * D * 1536 * 2;
constexpr size_t WS_WO3 = al256(WS_WBR + WBR_BYTES);           constexpr size_t WO3_BYTES = (size_t)DEPTH * D * D * 2;
constexpr size_t WS_WUPD = al256(WS_WO3 + WO3_BYTES);          constexpr size_t WUPD_BYTES = (size_t)2 * NUP * D * 2;
constexpr size_t WS_WDND = al256(WS_WUPD + WUPD_BYTES);        constexpr size_t WDND_BYTES = (size_t)2 * D * DFF * 2;
constexpr size_t WS_WUPM = al256(WS_WDND + WDND_BYTES);        constexpr size_t WUPM_BYTES = (size_t)NEXP * NUP * D * 2;
constexpr size_t WS_WDNM = al256(WS_WUPM + WUPM_BYTES);        constexpr size_t WDNM_BYTES = (size_t)NEXP * D * DFF * 2;
constexpr size_t WS_END = al256(WS_WDNM + WDNM_BYTES);
constexpr int CW_CNT = 0;
constexpr int CW_FILL = 128;
constexpr int CW_TEXP = 1024;
constexpr int CW_NT = 1536;

typedef __bf16 bf16x2_t __attribute__((ext_vector_type(2)));
__device__ __forceinline__ unsigned cvt_pk_bf16(float lo, float hi) { const f32x2 v = {lo, hi}; return __builtin_bit_cast(unsigned, __builtin_convertvector(v, bf16x2_t)); }
__device__ __forceinline__ float bf_lo(unsigned w) { return __uint_as_float(w << 16); }
__device__ __forceinline__ float bf_hi(unsigned w) { return __uint_as_float(w & 0xffff0000u); }
__device__ __forceinline__ float bf2f(bf16_t b) { return __uint_as_float(((unsigned)b) << 16); }
__device__ __forceinline__ bf16_t f2bf(float f) { return (bf16_t)(cvt_pk_bf16(f, 0.f) & 0xffffu); }
__device__ __forceinline__ float sigmoidf_(float x) { return __builtin_amdgcn_rcpf(1.0f + __builtin_amdgcn_exp2f(x * -1.4426950408889634f)); }
__device__ __forceinline__ float siluf_(float x) { return x * __builtin_amdgcn_rcpf(1.0f + __builtin_amdgcn_exp2f(x * -1.4426950408889634f)); }
__device__ __forceinline__ float shx(float v, int mask, int lane) { return __int_as_float(__builtin_amdgcn_ds_bpermute((lane ^ mask) << 2, __float_as_int(v))); }
__device__ __forceinline__ float shl_(float v, int src) { return __int_as_float(__builtin_amdgcn_ds_bpermute(src << 2, __float_as_int(v))); }
__device__ __forceinline__ float wave_sum(float v, int lane) {
#pragma unroll
    for (int o = 32; o >= 1; o >>= 1) v += shx(v, o, lane);
    return v;
}
__device__ __forceinline__ float wave_max(float v, int lane) {
#pragma unroll
    for (int o = 32; o >= 1; o >>= 1) v = fmaxf(v, shx(v, o, lane));
    return v;
}
__device__ __forceinline__ unsigned lds_add(LAS unsigned* p, unsigned v) { return __hip_atomic_fetch_add(p, v, __ATOMIC_RELAXED, __HIP_MEMORY_SCOPE_WORKGROUP); }
__device__ __forceinline__ f32x4 ldx_raw(const void* base, bool f32src, size_t idx) { if (f32src) return *(const f32x4*)((const float*)base + idx); const u32x2 w = *(const u32x2*)((const bf16_t*)base + idx); return (f32x4){__uint_as_float(w.x), __uint_as_float(w.y), 0.f, 0.f}; }
__device__ __forceinline__ f32x4 cvx(const f32x4 raw, bool f32src) { if (f32src) return raw; const unsigned a = __float_as_uint(raw[0]), b = __float_as_uint(raw[1]); return (f32x4){__uint_as_float(a << 16), __uint_as_float(a & 0xffff0000u), __uint_as_float(b << 16), __uint_as_float(b & 0xffff0000u)}; }
__device__ __forceinline__ void stx(bf16_t* p, const f32x4 v) { u32x2 w; w.x = cvt_pk_bf16(v[0], v[1]); w.y = cvt_pk_bf16(v[2], v[3]); *(u32x2*)p = w; }
__device__ __forceinline__ int mod_row(int row) { return row < TL ? (row >> 11) : 8; }
struct Ctx { int bid, nb, wv; };
__device__ __forceinline__ int tidx(const Ctx& cx) { int z = cx.wv << 6; asm volatile("" : "+s"(z)); return (int)__builtin_amdgcn_mbcnt_hi(~0u, __builtin_amdgcn_mbcnt_lo(~0u, (unsigned)z)); }
#define OPQ_S(x) asm volatile("" : "+s"(x))
__device__ __forceinline__ float row4_max(float v) { auto a = __builtin_amdgcn_permlane16_swap(__float_as_uint(v), __float_as_uint(v), false, false); v = fmaxf(__uint_as_float(a[0]), __uint_as_float(a[1]));
    auto b = __builtin_amdgcn_permlane32_swap(__float_as_uint(v), __float_as_uint(v), false, false); return fmaxf(__uint_as_float(b[0]), __uint_as_float(b[1])); }
__device__ __forceinline__ float row4_sum(float v) { auto a = __builtin_amdgcn_permlane16_swap(__float_as_uint(v), __float_as_uint(v), false, false); v = __uint_as_float(a[0]) + __uint_as_float(a[1]);
    auto b = __builtin_amdgcn_permlane32_swap(__float_as_uint(v), __float_as_uint(v), false, false); return __uint_as_float(b[0]) + __uint_as_float(b[1]); }

__device__ __forceinline__ u32x4 pack8(const float* v) { u32x4 w; w.x = cvt_pk_bf16(v[0], v[1]); w.y = cvt_pk_bf16(v[2], v[3]); w.z = cvt_pk_bf16(v[4], v[5]); w.w = cvt_pk_bf16(v[6], v[7]); return w; }
__device__ __forceinline__ void unpack8(const u32x4 w, float* v) { v[0] = bf_lo(w.x); v[1] = bf_hi(w.x); v[2] = bf_lo(w.y); v[3] = bf_hi(w.y); v[4] = bf_lo(w.z); v[5] = bf_hi(w.z); v[6] = bf_lo(w.w); v[7] = bf_hi(w.w); }
namespace pg8 {
constexpr int BM = 256, BK = 64, HALF = 128, HTB = HALF * BK * 2, STAGE_BYTES = 8 * HTB, NXCD = 8, WGM = 8;
constexpr int CSH_STR = 144, CSH_SLICE = 16 * CSH_STR;
__host__ __device__ __forceinline__ int lds_byte(int r, int c) { const int st = (r >> 4) * 2 + (c >> 5), rr = r & 15, cc = c & 31, ob = rr * 64 + cc * 2; return st * 1024 + (ob ^ (((ob >> 9) & 1) << 5)); }
__host__ __device__ __forceinline__ void stage_rc(int b, int& R, int& C) { const int st = b / 1024, sb = b % 1024, swz = sb ^ (((sb >> 9) & 1) << 5); R = (st >> 1) * 16 + swz / 64; C = (st & 1) * 32 + (swz % 64) / 2; }
__host__ __device__ __forceinline__ int perm32(int rho) { const int n = rho >> 4, i = rho & 15; return 8 * (i >> 2) + 4 * n + (i & 3); }
struct Unit { int pm, pn, kofs, kofsB, nt, part; };

__device__ __forceinline__ bool static_next(int i, int G, int c, int nM, int nN, Unit& u) {
    const int nwg = nM * nN; const long L = (long)i * G + c; if (L >= nwg) return false;
    int wgid = (int)L; { const int q = nwg / NXCD, r = nwg % NXCD, xcd = wgid % NXCD, off = wgid / NXCD; wgid = (xcd < r ? xcd * (q + 1) : r * (q + 1) + (xcd - r) * q) + off; }
    const int nig = WGM * nN, gid = wgid / nig, fm = gid * WGM, gsz = (nM - fm) < WGM ? (nM - fm) : WGM;
    u.pm = fm + ((wgid % nig) % gsz); u.pn = (wgid % nig) / gsz; return true;
}

template <int MODE> struct Prob {
    const bf16_t* A; const bf16_t* Bt; int lda, ldb, K, nM, nN, G, c; const LAS int* texp; size_t bexp; int nctx;
    __device__ __forceinline__ bool next(int i, Unit& u) const {
        u.kofs = 0; u.kofsB = 0; u.nt = K / BK; u.part = -1;
        if (MODE == 3) {
            const int idx = i + (c < nctx ? 0 : 1);
            if (idx == 0) { const int ct = c / 7; u.pm = 64 + (ct >> 2); u.pn = ct & 3; u.part = c - ct * 7; u.nt = K / (7 * BK); u.kofs = u.part * (K / 7); u.kofsB = u.kofs; return true; }
            return static_next(idx - 1, G, c, 64, 4, u);
        }
        if (MODE == 4) { const int seg = i % 3; u.kofs = seg * 512; u.kofsB = u.kofs; u.nt = 8; u.part = seg; return static_next(i / 3, G, c, 64, 4, u); }
        if (MODE == 5) { const int L = i * G + c; if (L >= 192) return false; const int ct = L / 6, sub = L - ct * 6; u.pm = 64 + (ct >> 2); u.pn = ct & 3; u.part = sub; u.nt = 8; u.kofs = (sub >> 1) * 1024 + (sub & 1) * 512; u.kofsB = (sub & 1) * 512; return true; }
        const bool ok = static_next(i, G, c, nM, nN, u);
        if (MODE == 1) { u.kofs = (u.pn >> 2) * 512; u.kofsB = u.kofs; }
        return ok;
    }
    __device__ __forceinline__ const char* a_base(const Unit& u, bool ablk) const { return (const char*)(A + (size_t)u.pm * BM * lda + (ablk ? 2 * u.kofs : u.kofs)); }
    __device__ __forceinline__ const char* b_base(const Unit& u) const { const bf16_t* p = Bt + (size_t)(MODE == 1 ? (u.pn & 3) : u.pn) * BM * ldb + 2 * u.kofsB; if (MODE == 2) p += (size_t)texp[u.pm] * bexp; return (const char*)p; }
};

template <class Epi, class PB, int ABLK>
__device__ __forceinline__ void gemm_phase(LAS unsigned char* lds, const PB& P, const Epi& E, const Ctx cx) {
    const int tid = tidx(cx), wid = __builtin_amdgcn_readfirstlane(tid >> 6), lane = tid & 63, wr = wid >> 2, wc = wid & 3, fr = lane & 15, fq = lane >> 4;
    unsigned voffA[2], voffB[2];
#pragma unroll
    for (int i = 0; i < 2; ++i) { int R, C; stage_rc(tid * 16 + i * 8192, R, C); const int Rb = (int)Epi::PERM == 2 ? (2 * (R & ~31) + perm32(R & 31)) : Epi::PERM ? ((R & ~31) + perm32(R & 31)) : R;
        voffA[i] = ABLK ? (unsigned)((((R >> 1) * (P.lda >> 5) + (C >> 5)) * 64 + (R & 1) * 32 + (C & 31)) * 2) : (unsigned)(R * P.lda + C) * 2u;     voffB[i] = (unsigned)((((Rb >> 1) * (P.ldb >> 5) + (C >> 5)) * 64 + (Rb & 1) * 32 + (C & 31)) * 2);     }
    const size_t kstep = (size_t)(BK * 4), kstepA = ABLK ? (size_t)(BK * 4) : (size_t)(BK * 2);
    const size_t hstepA = (size_t)HALF * P.lda * 2, hstepB = (size_t)((int)Epi::PERM == 2 ? 32 : HALF) * P.ldb * 2;
    const unsigned ldsw = (unsigned)wid * 1024u;
    const int aoff = lds_byte(wr * 64 + fr, fq * 8), boff = lds_byte(wc * 32 + fr, fq * 8);
#define PG8_SA(b, h) (((b) * 2 + (h)) * HTB)
#define PG8_SB(b, h) ((4 + (b) * 2 + (h)) * HTB)
#define PG8_STAGE(bufoff, gbase, voff) do { _Pragma("unroll") for (int _i = 0; _i < 2; ++_i) \
        __builtin_amdgcn_global_load_lds((const unsigned*)((const char*)(gbase) + (voff)[_i]), (LAS unsigned*)(lds + (bufoff) + ldsw + _i * 8192), 16, 0, 0); } while (0)
#define PG8_LDA(dst, b, h) do { _Pragma("unroll") for (int m = 0; m < 4; ++m) _Pragma("unroll") for (int k = 0; k < 2; ++k) dst[m][k] = *(const LAS bf16x8*)(lds + PG8_SA(b, h) + aoff + m * 2048 + k * 1024); } while (0)
#define PG8_LDB(dst, b, h) do { _Pragma("unroll") for (int n = 0; n < 2; ++n) _Pragma("unroll") for (int k = 0; k < 2; ++k) dst[n][k] = *(const LAS bf16x8*)(lds + PG8_SB(b, h) + boff + n * 2048 + k * 1024); } while (0)
#define PG8_MMA(ai, bj, At, Bt) do { __builtin_amdgcn_s_setprio(1); _Pragma("unroll") for (int m = 0; m < 4; ++m) _Pragma("unroll") for (int n = 0; n < 2; ++n) _Pragma("unroll") for (int k = 0; k < 2; ++k) \
        acc[ai][bj][m][n] = __builtin_amdgcn_mfma_f32_16x16x32_bf16(Bt[n][k], At[m][k], acc[ai][bj][m][n], 0, 0, 0); __builtin_amdgcn_s_setprio(0); } while (0)
#define PG8_WAIT_V(n) asm volatile("s_waitcnt vmcnt(" #n ")" ::: "memory")
#define PG8_WAIT_L(n) asm volatile("s_waitcnt lgkmcnt(" #n ")" ::: "memory")
#define PG8_BAR __builtin_amdgcn_s_barrier()
#define PG8_SCHED __builtin_amdgcn_sched_barrier(0)
    Unit cur, nxt; int ui = 0;
    if (!P.next(0, cur)) return;
    f32x4 acc[2][2][4][2];
#pragma unroll
    for (int a = 0; a < 2; ++a)
#pragma unroll
        for (int b = 0; b < 2; ++b)
#pragma unroll
            for (int m = 0; m < 4; ++m)
#pragma unroll
                for (int n = 0; n < 2; ++n) acc[a][b][m][n] = (f32x4){0.f, 0.f, 0.f, 0.f};
    bf16x8 At[4][2], B0[2][2], B1[2][2];
    const char* cA = P.a_base(cur, ABLK != 0); const char* cB = P.b_base(cur);
    PG8_STAGE(PG8_SB(0, 0), cB, voffB); PG8_STAGE(PG8_SB(0, 1), cB + hstepB, voffB); PG8_STAGE(PG8_SA(0, 0), cA, voffA); PG8_STAGE(PG8_SA(0, 1), cA + hstepA, voffA);
    if (wr == 1) PG8_BAR;
    PG8_WAIT_V(2); PG8_BAR;
    PG8_STAGE(PG8_SB(1, 0), cB + kstep, voffB); PG8_STAGE(PG8_SA(1, 0), cA + kstepA, voffA); PG8_STAGE(PG8_SB(1, 1), cB + hstepB + kstep, voffB);
    PG8_WAIT_V(6); PG8_BAR;
    for (;;) {
        const bool has_next = P.next(ui + 1, nxt);
        const char* nA = has_next ? P.a_base(nxt, ABLK != 0) : cA; const char* nB = has_next ? P.b_base(nxt) : cB;
        const int nt = cur.nt;
        for (int t = 0; t < nt; t += 2) {
            const bool last = (t == nt - 2);
            const char* a1 = cA + (size_t)(t + 1) * kstepA;
            const char* a2 = last ? nA : cA + (size_t)(t + 2) * kstepA; const char* b2 = last ? nB : cB + (size_t)(t + 2) * kstep;
            const char* a3 = a2 + kstepA; const char* b3 = b2 + kstep;
            PG8_LDB(B0, 0, 0); PG8_LDB(B1, 0, 1); PG8_SCHED; PG8_LDA(At, 0, 0); PG8_STAGE(PG8_SA(1, 1), a1 + hstepA, voffA);
            PG8_WAIT_V(8); PG8_WAIT_L(0); PG8_BAR; PG8_MMA(0, 0, At, B0); PG8_MMA(0, 1, At, B1); PG8_BAR; PG8_SCHED;
            PG8_LDA(At, 0, 1); PG8_STAGE(PG8_SB(0, 0), b2, voffB); PG8_STAGE(PG8_SB(0, 1), b2 + hstepB, voffB); PG8_STAGE(PG8_SA(0, 0), a2, voffA);
            PG8_WAIT_V(8); PG8_WAIT_L(0); PG8_BAR; PG8_MMA(1, 0, At, B0); PG8_MMA(1, 1, At, B1); PG8_BAR; PG8_SCHED;
            PG8_LDB(B0, 1, 0); PG8_LDB(B1, 1, 1); PG8_SCHED; PG8_LDA(At, 1, 0); PG8_STAGE(PG8_SA(0, 1), a2 + hstepA, voffA);
            PG8_WAIT_V(8); PG8_WAIT_L(0); PG8_BAR; PG8_MMA(0, 0, At, B0); PG8_MMA(0, 1, At, B1); PG8_BAR; PG8_SCHED;
            PG8_LDA(At, 1, 1); PG8_STAGE(PG8_SB(1, 0), b3, voffB); PG8_STAGE(PG8_SB(1, 1), b3 + hstepB, voffB); PG8_STAGE(PG8_SA(1, 0), a3, voffA);
            PG8_WAIT_V(8); PG8_WAIT_L(0); PG8_BAR; PG8_MMA(1, 0, At, B0); PG8_MMA(1, 1, At, B1); PG8_BAR; PG8_SCHED;
        }
        if (wr == 0) PG8_BAR;
        E(acc, cur, wr, wc, fr, fq);
        if (!has_next) break;
#pragma unroll
        for (int a = 0; a < 2; ++a)
#pragma unroll
            for (int b = 0; b < 2; ++b)
#pragma unroll
                for (int m = 0; m < 4; ++m)
#pragma unroll
                    for (int n = 0; n < 2; ++n) acc[a][b][m][n] = (f32x4){0.f, 0.f, 0.f, 0.f};
        cur = nxt; cA = nA; cB = nB; ++ui;
        if (wr == 1) PG8_BAR;
    }
    PG8_WAIT_V(0);
    PG8_BAR;
#undef PG8_SA
#undef PG8_SB
#undef PG8_STAGE
#undef PG8_LDA
#undef PG8_LDB
#undef PG8_MMA
#undef PG8_WAIT_V
#undef PG8_WAIT_L
#undef PG8_BAR
#undef PG8_SCHED
}

__device__ __forceinline__ void relay16(const f32x4 (&a)[2][2], LAS unsigned char* wp, const LAS unsigned char* rp, u32x4 (&x)[2]) {
#pragma unroll
    for (int bj = 0; bj < 2; ++bj) { u32x4 w; w.x = cvt_pk_bf16(a[bj][0][0], a[bj][0][1]); w.y = cvt_pk_bf16(a[bj][0][2], a[bj][0][3]); w.z = cvt_pk_bf16(a[bj][1][0], a[bj][1][1]); w.w = cvt_pk_bf16(a[bj][1][2], a[bj][1][3]);
        *(LAS u32x4*)(wp + bj * 64) = w; }
    asm volatile("" ::: "memory"); __builtin_amdgcn_wave_barrier();
    x[0] = *(const LAS u32x4*)rp; x[1] = *(const LAS u32x4*)(rp + 8 * CSH_STR);
    asm volatile("" ::: "memory"); __builtin_amdgcn_wave_barrier();
}
__device__ __forceinline__ u32x4 gate8x(const u32x4& x, const u32x4& g, const u32x4& o) {
    float xv[8], gv[8], ov[8]; unpack8(x, xv); unpack8(g, gv); unpack8(o, ov);
#pragma unroll
    for (int e = 0; e < 8; ++e) ov[e] += xv[e] * sigmoidf_(gv[e]);
    return pack8(ov);
}
struct EpiBf16 {
    static constexpr int PERM = 2;
    bf16_t* O; LAS unsigned char* sh; int ldc; int pad_;
    __device__ __forceinline__ void operator()(const f32x4 (&acc)[2][2][4][2], const Unit& u, int wr, int wc, int fr, int fq) const {
        LAS unsigned char* my = sh + (wr * 4 + wc) * CSH_SLICE; const int lane = fq * 16 + fr, r8 = lane >> 3, c8 = lane & 7;
        LAS unsigned char* wp = my + fr * CSH_STR + fq * 16; const LAS unsigned char* rp = my + r8 * CSH_STR + c8 * 16;
        bf16_t* ob = O + (size_t)(u.pm * BM + wr * 64 + r8) * ldc + u.pn * BM + wc * 64 + 8 * c8;
#pragma unroll
        for (int ai = 0; ai < 2; ++ai)
#pragma unroll
            for (int m = 0; m < 4; ++m) { u32x4 x[2];
                const f32x4 a[2][2] = {{acc[ai][0][m][0], acc[ai][0][m][1]}, {acc[ai][1][m][0], acc[ai][1][m][1]}};
                relay16(a, wp, rp, x);
                bf16_t* rowp = ob + (size_t)(ai * HALF + m * 16) * ldc;
                *(u32x4*)rowp = x[0]; *(u32x4*)(rowp + (size_t)8 * ldc) = x[1]; }
    }
};
struct EpiWin {
    static constexpr int PERM = 2;
    bf16_t* O; bf16_t* QR; bf16_t* KV; const f32x2* CS; LAS unsigned char* sh;
    __device__ __forceinline__ void operator()(const f32x4 (&acc)[2][2][4][2], const Unit& u, int wr, int wc, int fr, int fq) const {
        const int row0 = u.pm * BM + wr * 64 + fr;
        if (u.pn < 6 || u.pn > 8) {
            LAS unsigned char* my = sh + (wr * 4 + wc) * CSH_SLICE; const int lane = fq * 16 + fr, r8 = lane >> 3, c8 = lane & 7;
            LAS unsigned char* wp = my + fr * CSH_STR + fq * 16; const LAS unsigned char* rp = my + r8 * CSH_STR + c8 * 16;
            bf16_t* ob = O + (size_t)(u.pm * BM + wr * 64 + r8) * NP + u.pn * BM + wc * 64 + 8 * c8;
#pragma unroll
            for (int ai = 0; ai < 2; ++ai)
#pragma unroll
                for (int m = 0; m < 4; ++m) {
#pragma unroll
                    for (int bj = 0; bj < 2; ++bj) { const f32x4 v0 = acc[ai][bj][m][0], v1 = acc[ai][bj][m][1];
                        u32x4 w; w.x = cvt_pk_bf16(v0[0], v0[1]); w.y = cvt_pk_bf16(v0[2], v0[3]); w.z = cvt_pk_bf16(v1[0], v1[1]); w.w = cvt_pk_bf16(v1[2], v1[3]);
                        *(LAS u32x4*)(wp + bj * 64) = w; }
                    asm volatile("" ::: "memory"); __builtin_amdgcn_wave_barrier();
                    const u32x4 x0 = *(const LAS u32x4*)rp, x1 = *(const LAS u32x4*)(rp + 8 * CSH_STR);
                    asm volatile("" ::: "memory"); __builtin_amdgcn_wave_barrier();
                    bf16_t* rowp = ob + (size_t)(ai * HALF + m * 16) * NP;
                    *(u32x4*)rowp = x0; *(u32x4*)(rowp + (size_t)8 * NP) = x1; }
            return;
        }
        const bool lat = u.pm < 64; const bool isq = u.pn < 8; const bool rot = isq || wc < 2;
#pragma unroll
        for (int ai = 0; ai < 2; ++ai)
#pragma unroll
            for (int m = 0; m < 4; ++m) { const int row = row0 + ai * HALF + m * 16; const int sp = row & (SEQ - 1);
#pragma unroll
                for (int bj = 0; bj < 2; ++bj) { const f32x4 v0 = acc[ai][bj][m][0], v1 = acc[ai][bj][m][1]; float o[8];
                    const int ps = bj ? (sp & 63) : (sp >> 6);
                    f32x4 c01 = (f32x4){1.f, 0.f, 1.f, 0.f}, c23 = c01;
                    if (lat && rot) { const f32x4* cp = (const f32x4*)(CS + ps * 16 + 4 * fq); c01 = cp[0]; c23 = cp[1]; }
                    if (rot) {
                        o[0] = v0[0] * c01[0] - v0[1] * c01[1]; o[1] = v0[1] * c01[0] + v0[0] * c01[1]; o[2] = v0[2] * c01[2] - v0[3] * c01[3]; o[3] = v0[3] * c01[2] + v0[2] * c01[3];
                        o[4] = v1[0] * c23[0] - v1[1] * c23[1]; o[5] = v1[1] * c23[0] + v1[0] * c23[1]; o[6] = v1[2] * c23[2] - v1[3] * c23[3]; o[7] = v1[3] * c23[2] + v1[2] * c23[3];
                    } else { o[0] = v0[0]; o[1] = v0[1]; o[2] = v0[2]; o[3] = v0[3]; o[4] = v1[0]; o[5] = v1[1]; o[6] = v1[2]; o[7] = v1[3]; }
                    u32x4 w;
                    if (isq) { w.x = cvt_pk_bf16(o[0] * QSCALE, o[1] * QSCALE); w.y = cvt_pk_bf16(o[2] * QSCALE, o[3] * QSCALE); w.z = cvt_pk_bf16(o[4] * QSCALE, o[5] * QSCALE); w.w = cvt_pk_bf16(o[6] * QSCALE, o[7] * QSCALE);
                        *(u32x4*)(QR + (size_t)row * 512 + (u.pn - 6) * 256 + wc * 64 + bj * 32 + 8 * fq) = w; }
                    else { w.x = cvt_pk_bf16(o[0], o[1]); w.y = cvt_pk_bf16(o[2], o[3]); w.z = cvt_pk_bf16(o[4], o[5]); w.w = cvt_pk_bf16(o[6], o[7]);
                        *(u32x4*)(KV + (size_t)row * 256 + wc * 64 + bj * 32 + 8 * fq) = w; } } }
    }
};
__device__ __forceinline__ u32x4 gate8(const f32x4& v0, const f32x4& v1, const u32x4& g) {
    u32x4 w;
    w.x = cvt_pk_bf16(v0[0] * sigmoidf_(bf_lo(g.x)), v0[1] * sigmoidf_(bf_hi(g.x))); w.y = cvt_pk_bf16(v0[2] * sigmoidf_(bf_lo(g.y)), v0[3] * sigmoidf_(bf_hi(g.y)));
    w.z = cvt_pk_bf16(v1[0] * sigmoidf_(bf_lo(g.z)), v1[1] * sigmoidf_(bf_hi(g.z))); w.w = cvt_pk_bf16(v1[2] * sigmoidf_(bf_lo(g.w)), v1[3] * sigmoidf_(bf_hi(g.w))); return w; }
__device__ __forceinline__ u32x4 gate8acc(const f32x4& v0, const f32x4& v1, const u32x4& g, const u32x4& o) {
    u32x4 w;
    w.x = cvt_pk_bf16(bf_lo(o.x) + v0[0] * sigmoidf_(bf_lo(g.x)), bf_hi(o.x) + v0[1] * sigmoidf_(bf_hi(g.x))); w.y = cvt_pk_bf16(bf_lo(o.y) + v0[2] * sigmoidf_(bf_lo(g.y)), bf_hi(o.y) + v0[3] * sigmoidf_(bf_hi(g.y)));
    w.z = cvt_pk_bf16(bf_lo(o.z) + v1[0] * sigmoidf_(bf_lo(g.z)), bf_hi(o.z) + v1[1] * sigmoidf_(bf_hi(g.z))); w.w = cvt_pk_bf16(bf_lo(o.w) + v1[2] * sigmoidf_(bf_lo(g.w)), bf_hi(o.w) + v1[3] * sigmoidf_(bf_hi(g.w))); return w; }
struct EpiGate {
    static constexpr int PERM = 2;
    bf16_t* O; const bf16_t* Pg; LAS unsigned char* sh;
    __device__ __forceinline__ void operator()(const f32x4 (&acc)[2][2][4][2], const Unit& u, int wr, int wc, int fr, int fq) const {
        LAS unsigned char* my = sh + (wr * 4 + wc) * CSH_SLICE; const int lane = fq * 16 + fr, r8 = lane >> 3, c8 = lane & 7;
        LAS unsigned char* wp = my + fr * CSH_STR + fq * 16; const LAS unsigned char* rp = my + r8 * CSH_STR + c8 * 16;
        const int rowb = u.pm * BM + wr * 64 + r8, colb = u.pn * BM + wc * 64 + 8 * c8;
#pragma unroll
        for (int ai = 0; ai < 2; ++ai)
#pragma unroll
            for (int m = 0; m < 4; ++m) { const size_t row = (size_t)(rowb + ai * HALF + m * 16);
                u32x4 g[2], x[2];
#pragma unroll
                for (int hh = 0; hh < 2; ++hh) g[hh] = *(const u32x4*)(Pg + (row + 8 * hh) * NP + P_GATE + colb);
                const f32x4 a[2][2] = {{acc[ai][0][m][0], acc[ai][0][m][1]}, {acc[ai][1][m][0], acc[ai][1][m][1]}};
                relay16(a, wp, rp, x);
#pragma unroll
                for (int hh = 0; hh < 2; ++hh) *(u32x4*)(O + (row + 8 * hh) * 3072 + colb) = gate8x(x[hh], g[hh], (u32x4){0u, 0u, 0u, 0u}); }
    }
};
struct EpiMerge {
    static constexpr int PERM = 2;
    bf16_t* MG; const bf16_t* Pg; LAS unsigned char* sh;
    __device__ __forceinline__ void operator()(const f32x4 (&acc)[2][2][4][2], const Unit& u, int wr, int wc, int fr, int fq) const {
        LAS unsigned char* my = sh + (wr * 4 + wc) * CSH_SLICE; const int lane = fq * 16 + fr, r8 = lane >> 3, c8 = lane & 7;
        LAS unsigned char* wp = my + fr * CSH_STR + fq * 16; const LAS unsigned char* rp = my + r8 * CSH_STR + c8 * 16;
        const int rowb = u.pm * BM + wr * 64 + r8, colb = u.pn * BM + wc * 64 + 8 * c8; const int gcol = P_GATE + u.part * 1024 + colb;
#pragma unroll
        for (int ai = 0; ai < 2; ++ai)
#pragma unroll
            for (int m = 0; m < 4; ++m) { const size_t row = (size_t)(rowb + ai * HALF + m * 16);
                u32x4 g[2], o[2], x[2];
#pragma unroll
                for (int hh = 0; hh < 2; ++hh) { g[hh] = *(const u32x4*)(Pg + (row + 8 * hh) * NP + gcol); o[hh] = u.part ? *(const u32x4*)(MG + (row + 8 * hh) * D + colb) : (u32x4){0u, 0u, 0u, 0u}; }
                const f32x4 a[2][2] = {{acc[ai][0][m][0], acc[ai][0][m][1]}, {acc[ai][1][m][0], acc[ai][1][m][1]}};
                relay16(a, wp, rp, x);
#pragma unroll
                for (int hh = 0; hh < 2; ++hh) *(u32x4*)(MG + (row + 8 * hh) * D + colb) = gate8x(x[hh], g[hh], o[hh]); }
    }
};
struct EpiResid {
    static constexpr int PERM = 2;
    bf16_t* X; const float* modg; float* PART; const void* Xold; LAS unsigned char* sh; int oldf32; int pad_;
    __device__ __forceinline__ void operator()(const f32x4 (&acc)[2][2][4][2], const Unit& u, int wr, int wc, int fr, int fq) const {
        if (u.part >= 0) {
            LAS unsigned char* my = sh + (wr * 4 + wc) * CSH_SLICE; const int lane = fq * 16 + fr, r8 = lane >> 3, c8 = lane & 7;
            LAS unsigned char* wp = my + fr * CSH_STR + fq * 32; const LAS unsigned char* rp = my + r8 * CSH_STR + c8 * 16;
            float* pb = PART + ((size_t)u.part * TC + (u.pm * BM + wr * 64 + r8 - TL)) * D + u.pn * BM + wc * 64 + 4 * c8;
#pragma unroll
            for (int ai = 0; ai < 2; ++ai)
#pragma unroll
                for (int m = 0; m < 4; ++m) { float* rowp = pb + (size_t)(ai * HALF + m * 16) * D;
#pragma unroll
                    for (int bj = 0; bj < 2; ++bj) {
                        *(LAS f32x4*)wp = acc[ai][bj][m][0]; *(LAS f32x4*)(wp + 16) = acc[ai][bj][m][1];
                        asm volatile("" ::: "memory"); __builtin_amdgcn_wave_barrier();
                        const f32x4 x0 = *(const LAS f32x4*)rp, x1 = *(const LAS f32x4*)(rp + 8 * CSH_STR);
                        asm volatile("" ::: "memory"); __builtin_amdgcn_wave_barrier();
                        *(f32x4*)(rowp + bj * 32) = x0; *(f32x4*)(rowp + (size_t)8 * D + bj * 32) = x1; } }
            return;
        }
        const float* mg = modg + (size_t)mod_row(u.pm * BM) * 6144 + u.pn * BM + wc * 64 + 8 * fq;
        f32x4 gv[2][2];
#pragma unroll
        for (int bj = 0; bj < 2; ++bj)
#pragma unroll
            for (int n = 0; n < 2; ++n) gv[bj][n] = *(const f32x4*)(mg + bj * 32 + n * 4);
        LAS unsigned char* my = sh + (wr * 4 + wc) * CSH_SLICE; const int lane = fq * 16 + fr, r8 = lane >> 3, c8 = lane & 7;
        LAS unsigned char* wp = my + fr * CSH_STR + fq * 16; const LAS unsigned char* rp = my + r8 * CSH_STR + c8 * 16;
        const size_t ro0 = (size_t)(u.pm * BM + wr * 64 + r8) * D + u.pn * BM + wc * 64 + 8 * c8;
#pragma unroll
        for (int ai = 0; ai < 2; ++ai)
#pragma unroll
            for (int m = 0; m < 4; ++m) { const size_t ro = ro0 + (size_t)(ai * HALF + m * 16) * D;
                f32x4 oa[2][2];
#pragma unroll
                for (int hh = 0; hh < 2; ++hh) { const size_t rr = ro + (size_t)hh * 8 * D;
                    if (oldf32) { oa[hh][0] = *(const f32x4*)((const float*)Xold + rr); oa[hh][1] = *(const f32x4*)((const float*)Xold + rr + 4); }
                    else { const u32x4 w = *(const u32x4*)((const bf16_t*)Xold + rr); oa[hh][0] = (f32x4){__uint_as_float(w.x), __uint_as_float(w.y), __uint_as_float(w.z), __uint_as_float(w.w)}; oa[hh][1] = oa[hh][0]; } }
#pragma unroll
                for (int bj = 0; bj < 2; ++bj) { const f32x4 v0 = gv[bj][0] * acc[ai][bj][m][0], v1 = gv[bj][1] * acc[ai][bj][m][1];
                    u32x4 w; w.x = cvt_pk_bf16(v0[0], v0[1]); w.y = cvt_pk_bf16(v0[2], v0[3]); w.z = cvt_pk_bf16(v1[0], v1[1]); w.w = cvt_pk_bf16(v1[2], v1[3]);
                    *(LAS u32x4*)(wp + bj * 64) = w; }
                asm volatile("" ::: "memory"); __builtin_amdgcn_wave_barrier();
                u32x4 dx[2]; dx[0] = *(const LAS u32x4*)rp; dx[1] = *(const LAS u32x4*)(rp + 8 * CSH_STR);
                asm volatile("" ::: "memory"); __builtin_amdgcn_wave_barrier();
#pragma unroll
                for (int hh = 0; hh < 2; ++hh) { float o[8], dl[8]; unpack8(dx[hh], dl);
                    if (oldf32) { o[0] = oa[hh][0][0]; o[1] = oa[hh][0][1]; o[2] = oa[hh][0][2]; o[3] = oa[hh][0][3]; o[4] = oa[hh][1][0]; o[5] = oa[hh][1][1]; o[6] = oa[hh][1][2]; o[7] = oa[hh][1][3]; }
                    else { u32x4 w; w.x = __float_as_uint(oa[hh][0][0]); w.y = __float_as_uint(oa[hh][0][1]); w.z = __float_as_uint(oa[hh][0][2]); w.w = __float_as_uint(oa[hh][0][3]); unpack8(w, o); }
#pragma unroll
                    for (int e = 0; e < 8; ++e) o[e] += dl[e];
                    *(u32x4*)(X + ro + (size_t)hh * 8 * D) = pack8(o); } }
    }
};
struct EpiSwiglu {
    static constexpr bool PERM = true;
    bf16_t* O;
    __device__ __forceinline__ void operator()(const f32x4 (&acc)[2][2][4][2], const Unit& u, int wr, int wc, int fr, int fq) const {
        const int row0 = u.pm * BM + wr * 64 + fr; const int chunk = u.pn * 4 + wc;
#pragma unroll
        for (int ai = 0; ai < 2; ++ai)
#pragma unroll
            for (int m = 0; m < 4; ++m) { const int row = row0 + ai * HALF + m * 16; bf16_t* rowp = O + ((size_t)(row >> 1) * (DFF / 32) + chunk) * 64 + (row & 1) * 32 + 8 * fq;
                const f32x4 a0 = acc[ai][0][m][0], a1 = acc[ai][0][m][1], b0 = acc[ai][1][m][0], b1 = acc[ai][1][m][1];
                u32x4 w; w.x = cvt_pk_bf16(siluf_(a0[0]) * b0[0], siluf_(a0[1]) * b0[1]); w.y = cvt_pk_bf16(siluf_(a0[2]) * b0[2], siluf_(a0[3]) * b0[3]);
                w.z = cvt_pk_bf16(siluf_(a1[0]) * b1[0], siluf_(a1[1]) * b1[1]); w.w = cvt_pk_bf16(siluf_(a1[2]) * b1[2], siluf_(a1[3]) * b1[3]);
                *(u32x4*)rowp = w; }
    }
};
}

#define XB_TMO      128
#define XB_XCNT(j)  (256  + 64 * (j))
#define XB_XSUB(j)  (1280 + 64 * (j))
#define XB_XGEN(j)  (2304 + 64 * (j))
#define XB_TOP      3328
#define XB_TOPGEN   3392
#define XCD_BAR_WORDS 3456
#define XB_SPIN_CAP (1u << 18)
__device__ __forceinline__ unsigned xb_ld(unsigned* p)              { return __hip_atomic_load(p, __ATOMIC_RELAXED, __HIP_MEMORY_SCOPE_AGENT); }
__device__ __forceinline__ unsigned xb_add(unsigned* p, unsigned v) { return __hip_atomic_fetch_add(p, v, __ATOMIC_RELAXED, __HIP_MEMORY_SCOPE_AGENT); }
__device__ __forceinline__ unsigned xb_xcc_id() { return (unsigned)__builtin_amdgcn_s_getreg((3 << 11) | 20) & 0xFu; }
#define XB_SPIN(cond, bar) do { unsigned _sp = 0; while (cond) { __builtin_amdgcn_s_sleep(1); \
    if ((++_sp & 255u) == 0u) { if (xb_ld(&(bar)[XB_TMO])) break; if (_sp > XB_SPIN_CAP) { atomicAdd(&(bar)[XB_TMO], 1u); break; } } } } while (0)
struct XcdBarrier { unsigned* bar; unsigned x; volatile LAS unsigned* st; };
__device__ __forceinline__ XcdBarrier xcd_barrier_post(unsigned* bar, volatile LAS unsigned* st) {
    XcdBarrier b; b.bar = bar; b.x = (unsigned)__builtin_amdgcn_readfirstlane((int)xb_xcc_id()); b.st = st;
    if (threadIdx.x == 0) (void)xb_add(&bar[XB_XCNT(b.x)], 1u);
    return b;
}
__device__ __forceinline__ void xcd_barrier_complete(unsigned* bar, unsigned x, unsigned& nloc, unsigned& nx) {
    const unsigned G = gridDim.x * gridDim.y * gridDim.z;
    unsigned sum, cnt, mine, sp = 0u;
    for (;;) {
        sum = 0u; cnt = 0u; mine = 0u;
#pragma unroll
        for (unsigned j = 0; j < 16; ++j) { const unsigned c = xb_ld(&bar[XB_XCNT(j)]); sum += c; cnt += (c > 0u) ? 1u : 0u; mine = (j == x) ? c : mine; }
        if (sum == G) break;
        __builtin_amdgcn_s_sleep(1);
        if ((++sp & 255u) == 0u) { if (xb_ld(&bar[XB_TMO])) break; if (sp > XB_SPIN_CAP) { atomicAdd(&bar[XB_TMO], 1u); break; } }
    }
    nloc = mine > 0u ? mine : 1u; nx = cnt > 0u ? cnt : 1u;
}
template <bool FIRST> __device__ __forceinline__ void xcd_barrier_t(const XcdBarrier& b, const Ctx cx) {
    asm volatile("s_waitcnt vmcnt(0)" ::: "memory");
    __syncthreads();
    if (tidx(cx) == 0) {
        unsigned* bar = b.bar; unsigned bx = b.x; OPQ_S(bar); OPQ_S(bx);
        __builtin_amdgcn_s_waitcnt(0);
        unsigned nloc = b.st[0], nx = b.st[1];
        if (FIRST) { if (nloc == 0u) { xcd_barrier_complete(bar, bx, nloc, nx); b.st[0] = nloc; b.st[1] = nx; } }
        const unsigned old = xb_add(&bar[XB_XSUB(bx)], 1u);
        const unsigned gen = old / nloc;
        if (old + 1u == (gen + 1u) * nloc) {
            __builtin_amdgcn_fence(__ATOMIC_RELEASE, "agent");
            asm volatile("s_waitcnt vmcnt(0)" ::: "memory");
            const unsigned og = xb_add(&bar[XB_TOP], 1u);
            const unsigned tg = og / nx;
            if (og + 1u == (tg + 1u) * nx) xb_add(&bar[XB_TOPGEN], 1u);
            else XB_SPIN(xb_ld(&bar[XB_TOPGEN]) == tg, bar);
            __builtin_amdgcn_fence(__ATOMIC_ACQUIRE, "agent");
            xb_add(&bar[XB_XGEN(bx)], 1u);
            asm volatile("s_waitcnt vmcnt(0)" ::: "memory");
        } else {
            XB_SPIN(xb_ld(&bar[XB_XGEN(bx)]) == gen, bar);
            __builtin_amdgcn_fence(__ATOMIC_ACQUIRE, "agent");
            asm volatile("s_waitcnt vmcnt(0)" ::: "memory");
        }
    }
    __syncthreads();
}
__device__ __forceinline__ void xcd_barrier_first(const XcdBarrier& b, const Ctx cx) { xcd_barrier_t<true>(b, cx); }
__device__ __forceinline__ void xcd_barrier(const XcdBarrier& b, const Ctx cx) { xcd_barrier_t<false>(b, cx); }

constexpr int LDS_TEXP = 139264, LDS_BARW = LDS_TEXP + 1024, LDS_SBASE = LDS_BARW + 16, LDS_CSH = LDS_SBASE + 64 + 176 + 256, LDS_BYTES = LDS_CSH + 8 * pg8::CSH_SLICE;
constexpr int CW_BAR = 4096;

#define MMA16(acc, afrag, bfrag) acc = __builtin_amdgcn_mfma_f32_16x16x32_bf16(bfrag, afrag, acc, 0, 0, 0)
typedef short s16x4 __attribute__((ext_vector_type(4)));
constexpr int STR64 = 144, STR128 = 272;
__device__ __forceinline__ bf16x8 frag_row(const LAS unsigned char* img, int r, int k0, int stride) { return *(const LAS bf16x8*)(img + r * stride + k0 * 2); }
__device__ __forceinline__ bf16x8 frag_tr(const LAS unsigned char* img, int rowlo, int rowhi, int x0, int stride, int fr) {
    const int q = fr >> 2, p = fr & 3;
    const s16x4 lo = __builtin_amdgcn_ds_read_tr16_b64_v4i16((LAS s16x4*)(img + (rowlo + q) * stride + x0 * 2 + 8 * p));
    const s16x4 hi = __builtin_amdgcn_ds_read_tr16_b64_v4i16((LAS s16x4*)(img + (rowhi + q) * stride + x0 * 2 + 8 * p));
    return __builtin_shufflevector(lo, hi, 0, 1, 2, 3, 4, 5, 6, 7);
}

struct CvtJob { const float* s0; const float* s1; bf16_t* dst; int ldw, ldd, kd0, K, Nd, kind; };
__device__ __forceinline__ CvtJob mkjob(const float* s0, const float* s1, bf16_t* dst, int ldw, int ldd, int kd0, int K, int Nd, int kind) { CvtJob j; j.s0 = s0; j.s1 = s1; j.dst = dst; j.ldw = ldw; j.ldd = ldd; j.kd0 = kd0; j.K = K; j.Nd = Nd; j.kind = kind; return j; }
constexpr int CV_STR = 144;
__device__ __forceinline__ void cvt_src(const CvtJob& j, int n0, int n, const float*& src, int& col) {
    const int nh = n0 + (n & 32); src = j.s0; int sc = nh;
    if (j.kind == 1) { sc = nh < 3840 ? nh : (nh < 6912 ? nh + 32 : (nh < 6944 ? nh - 3072 : -1)); }
    else if (j.kind == 2) { const int tj = nh >> 8, r = nh & 255; if (r < 128) { sc = tj * 128 + r; } else { src = j.s1; sc = tj * 128 + r - 128; } }
    col = sc < 0 ? -1 : sc + (n & 31);
}
__device__ __forceinline__ void ph_convert(const CvtJob& j, LAS unsigned char* lds, const Ctx cx, int& rot) {
    const int tid = tidx(cx), c16 = tid & 15, kr = tid >> 4, lane = tid & 63, wid = tid >> 6, fr = lane & 15, fq = lane >> 4;
    const int kch = j.K / 256, nitems = (j.Nd / 64) * kch;
    int first = cx.bid - rot; if (first < 0) first += cx.nb;
    f32x4 v[8];
    auto issue = [&](int it) { const int nbk = it / kch, kc = it % kch, n0 = nbk * 64, k0 = kc * 256; const float* src; int col; cvt_src(j, n0, c16 * 4, src, col);
#pragma unroll
        for (int p = 0; p < 8; ++p) v[p] = col >= 0 ? *(const f32x4*)(src + (size_t)(k0 + p * 32 + kr) * j.ldw + col) : (f32x4){0.f, 0.f, 0.f, 0.f}; };
    if (first < nitems) issue(first);
    for (int it = first; it < nitems; it += cx.nb) {
        const int nbk = it / kch, kc = it % kch, n0 = nbk * 64, k0 = kc * 256;
        if (j.kind == 1 && n0 >= P_QA && n0 < P_VA) {
            const int e = (c16 * 4) & 31, blk = (c16 * 4) & 32;
#pragma unroll
            for (int p = 0; p < 8; ++p) { const unsigned w0 = cvt_pk_bf16(v[p][0], v[p][1]), w1 = cvt_pk_bf16(v[p][2], v[p][3]); LAS bf16_t* rowp = (LAS bf16_t*)(lds + (p * 32 + kr) * CV_STR) + blk;
#pragma unroll
                for (int q = 0; q < 4; ++q) { const int ee = e + q, pos = ee < 16 ? 2 * ee : 2 * (ee - 16) + 1; const unsigned w = q < 2 ? w0 : w1; rowp[pos] = (bf16_t)((q & 1) ? (w >> 16) : (w & 0xffffu)); } }
        } else {
#pragma unroll
        for (int p = 0; p < 8; ++p) { u32x2 w; w.x = cvt_pk_bf16(v[p][0], v[p][1]); w.y = cvt_pk_bf16(v[p][2], v[p][3]); *(LAS u32x2*)(lds + (p * 32 + kr) * CV_STR + c16 * 8) = w; }
        }
        __syncthreads();
        if (it + cx.nb < nitems) issue(it + cx.nb);
        { const int kq = wid & 3, nh = wid >> 2, r8 = lane >> 3, c8 = lane & 7;
          LAS unsigned char* my = lds + 256 * CV_STR + wid * (16 * CV_STR); LAS unsigned char* wp = my + fr * CV_STR + fq * 16; const LAS unsigned char* rp = my + (2 * r8 + (c8 >> 2)) * CV_STR + (c8 & 3) * 16;
#pragma unroll
          for (int q = 0; q < 2; ++q) { const int nb = nh * 2 + q;
              const bf16x8 oa = frag_tr(lds, (8 * kq + fq) * 8, (8 * kq + fq) * 8 + 4, nb * 16, CV_STR, fr), ob = frag_tr(lds, (8 * kq + 4 + fq) * 8, (8 * kq + 4 + fq) * 8 + 4, nb * 16, CV_STR, fr);
              *(LAS bf16x8*)wp = oa; *(LAS bf16x8*)(wp + 64) = ob;
              asm volatile("" ::: "memory"); __builtin_amdgcn_wave_barrier();
              const bf16x8 x0 = *(const LAS bf16x8*)rp, x1 = *(const LAS bf16x8*)(rp + 64);
              asm volatile("" ::: "memory"); __builtin_amdgcn_wave_barrier();
              bf16_t* dp = j.dst + ((size_t)(((n0 + nb * 16) >> 1) + r8) * (j.ldd >> 5) + ((j.kd0 + k0 + 64 * kq) >> 5)) * 64 + 8 * c8;
              *(bf16x8*)dp = x0; *(bf16x8*)(dp + 64) = x1; } }
        __syncthreads();
    }
    rot = (rot + nitems) % cx.nb;
}

__device__ __forceinline__ void ph_init(const float* x, const float* ctx, float* XS, f32x2* CS, const Ctx cx) {
    (void)x; (void)ctx; (void)XS;
    if (cx.bid == cx.nb - 1) for (int i = tidx(cx); i < 64 * 16; i += 512) { const int pos = i >> 4, f = i & 15; const float inv = powf(10000.0f, -(float)f / 16.0f); const float a = (float)pos * inv; CS[i] = (f32x2){cosf(a), sinf(a)}; }
}
__device__ __forceinline__ void ph_mod(const float* c, const float* c_ctx, const float* w_mod, const float* b_mod, float* MOD, LAS unsigned char* lds, const Ctx cx) {
    if (cx.bid >= DEPTH * 48) return;
    LAS float* sv = (LAS float*)lds; LAS float* red = sv + 9 * 1024;
    const int tid = tidx(cx);
    for (int i = tid; i < 9 * 1024; i += 512) { const float v = i < 8192 ? c[i] : c_ctx[i - 8192]; sv[i] = siluf_(v); }
    __syncthreads();
    const int c4 = (tid & 31) * 4, kg = tid >> 5;
    for (int it = cx.bid; it < DEPTH * 48; it += cx.nb) {
        const int l = it / 48, n0 = (it % 48) * 128;
        const float* w = w_mod + ((size_t)l * D + kg * 64) * 6144 + n0 + c4;
        f32x4 a[9];
#pragma unroll
        for (int r = 0; r < 9; ++r) a[r] = (f32x4){0.f, 0.f, 0.f, 0.f};
#pragma unroll 1
        for (int k0 = 0; k0 < 64; k0 += 8) { f32x4 wv[8];
#pragma unroll
            for (int u = 0; u < 8; ++u) wv[u] = *(const f32x4*)(w + (size_t)(k0 + u) * 6144);
#pragma unroll
            for (int u = 0; u < 8; ++u)
#pragma unroll
                for (int r = 0; r < 9; ++r) a[r] = a[r] + wv[u] * sv[r * 1024 + kg * 64 + k0 + u]; }
#pragma unroll
        for (int r = 0; r < 9; ++r) *(LAS f32x4*)(red + (kg * 9 + r) * 128 + c4) = a[r];
        __syncthreads();
        for (int i = tid; i < 9 * 128; i += 512) { const int r = i >> 7, cc = i & 127; float sacc = b_mod[(size_t)l * 6144 + n0 + cc];
#pragma unroll
            for (int g = 0; g < 16; ++g) sacc += red[(g * 9 + r) * 128 + cc];
            MOD[((size_t)l * 9 + r) * 6144 + n0 + cc] = sacc; }
        __syncthreads();
    }
}

struct NormArgs { bf16_t* XS; const void* Xl; const void* Xc; int lf32, cf32; bf16_t* H;
                  const float* g; const float* mod_shift; const float* mod_scale;
                  const bf16_t* Y; const int* POS; const float* TOPKp; const float* mod_g5prev;
                  const float* router; float* TOPK; unsigned* cnt; int nrows;
                  const float* PART; const float* mod_gpart; int npart; };
template <bool ROUTE> __device__ __forceinline__ void ph_norm(const NormArgs& a, bool combine, LAS unsigned char* lds, const Ctx cx) {
    const int lane = tidx(cx) & 63, wid = tidx(cx) >> 6;
    LAS unsigned* hist = (LAS unsigned*)(lds + LDS_SBASE);
    LAS float* rtab = (LAS float*)lds;
    if (ROUTE) { __syncthreads(); if (tidx(cx) < 8) hist[tidx(cx)] = 0u;
        for (int f = tidx(cx); f < 8192; f += 512) { const int e = f & 7, ln = (f >> 3) & 63, jq = f >> 9; rtab[f] = a.router[(size_t)(4 * (ln + 64 * (jq >> 2)) + (jq & 3)) * 8 + e]; }
        __syncthreads(); }
    f32x4 gq[4];
#pragma unroll
    for (int j = 0; j < 4; ++j) gq[j] = *(const f32x4*)(a.g + 4 * (lane + 64 * j));
    f32x4 xn[4], xnn[4];
    { const int r0 = cx.bid * 8 + wid; if (r0 < a.nrows) { const bool f = r0 < TL ? a.lf32 : a.cf32; const void* rp = r0 < TL ? a.Xl : a.Xc;
#pragma unroll
        for (int j = 0; j < 4; ++j) xn[j] = ldx_raw(rp, f, (size_t)r0 * D + 4 * (lane + 64 * j)); }
      const int r1 = r0 + cx.nb * 8; if (r1 < a.nrows) { const bool f = r1 < TL ? a.lf32 : a.cf32; const void* rp = r1 < TL ? a.Xl : a.Xc;
#pragma unroll
        for (int j = 0; j < 4; ++j) xnn[j] = ldx_raw(rp, f, (size_t)r1 * D + 4 * (lane + 64 * j)); } }
    int cs1 = 0, cs2 = 0; float cp1 = 0.f, cp2 = 0.f; u32x2 y1n[4], y2n[4];
    if (combine) { const int rk = cx.bid * 8 + wid + lane * (cx.nb * 8);
        if (rk < a.nrows) { cs1 = a.POS[2 * rk]; cs2 = a.POS[2 * rk + 1]; cp1 = a.TOPKp[4 * rk + 2]; cp2 = a.TOPKp[4 * rk + 3]; }
        if (cx.bid * 8 + wid < a.nrows) { const int s1 = __builtin_amdgcn_readlane(cs1, 0), s2 = __builtin_amdgcn_readlane(cs2, 0);
#pragma unroll
            for (int j = 0; j < 4; ++j) { const int cc = 4 * (lane + 64 * j); y1n[j] = *(const u32x2*)(a.Y + (size_t)s1 * D + cc); y2n[j] = *(const u32x2*)(a.Y + (size_t)s2 * D + cc); } } }
    int it = 0;
    for (int row = cx.bid * 8 + wid; row < a.nrows; row += cx.nb * 8, ++it) {
        const int mr = mod_row(row);
        bf16_t* xr = a.XS + (size_t)row * D; const bool fcur = row < TL ? a.lf32 : a.cf32;
        f32x4 x[4], shq[4], scq[4];
#pragma unroll
        for (int j = 0; j < 4; ++j) { x[j] = cvx(xn[j], fcur); shq[j] = *(const f32x4*)(a.mod_shift + (size_t)mr * 6144 + 4 * (lane + 64 * j)); scq[j] = *(const f32x4*)(a.mod_scale + (size_t)mr * 6144 + 4 * (lane + 64 * j)); }
#pragma unroll
        for (int j = 0; j < 4; ++j) xn[j] = xnn[j];
        if (row + 2 * cx.nb * 8 < a.nrows) {
            const int rn = row + 2 * cx.nb * 8; const bool f = rn < TL ? a.lf32 : a.cf32; const void* rp = rn < TL ? a.Xl : a.Xc;
#pragma unroll
            for (int j = 0; j < 4; ++j) xnn[j] = ldx_raw(rp, f, (size_t)rn * D + 4 * (lane + 64 * j)); }
        if (combine) {
            const float p1 = __int_as_float(__builtin_amdgcn_readlane(__float_as_int(cp1), it)), p2 = __int_as_float(__builtin_amdgcn_readlane(__float_as_int(cp2), it));
            u32x2 y1c[4], y2c[4];
#pragma unroll
            for (int j = 0; j < 4; ++j) { y1c[j] = y1n[j]; y2c[j] = y2n[j]; }
            if (row + cx.nb * 8 < a.nrows) { const int s1 = __builtin_amdgcn_readlane(cs1, it + 1), s2 = __builtin_amdgcn_readlane(cs2, it + 1);
#pragma unroll
                for (int j = 0; j < 4; ++j) { const int cc = 4 * (lane + 64 * j); y1n[j] = *(const u32x2*)(a.Y + (size_t)s1 * D + cc); y2n[j] = *(const u32x2*)(a.Y + (size_t)s2 * D + cc); } }
#pragma unroll
            for (int j = 0; j < 4; ++j) { const int cc = 4 * (lane + 64 * j);
                const u32x2 y1 = y1c[j], y2 = y2c[j];
                const f32x4 mg = *(const f32x4*)(a.mod_g5prev + (size_t)mr * 6144 + cc);
                f32x4 e; e[0] = p1 * bf_lo(y1.x) + p2 * bf_lo(y2.x); e[1] = p1 * bf_hi(y1.x) + p2 * bf_hi(y2.x); e[2] = p1 * bf_lo(y1.y) + p2 * bf_lo(y2.y); e[3] = p1 * bf_hi(y1.y) + p2 * bf_hi(y2.y);
                x[j] = x[j] + mg * e; stx(xr + cc, x[j]); }
        }
        if (a.PART != nullptr && row >= TL) {
#pragma unroll
            for (int j = 0; j < 4; ++j) { const int cc = 4 * (lane + 64 * j); const float* pp = a.PART + (size_t)(row - TL) * D + cc;
                f32x4 e = (*(const f32x4*)pp + *(const f32x4*)(pp + (size_t)TC * D)) + (*(const f32x4*)(pp + (size_t)2 * TC * D) + *(const f32x4*)(pp + (size_t)3 * TC * D));
                e = e + (*(const f32x4*)(pp + (size_t)4 * TC * D) + *(const f32x4*)(pp + (size_t)5 * TC * D));
                if (a.npart == 7) e = e + *(const f32x4*)(pp + (size_t)6 * TC * D);
                const f32x4 mg = *(const f32x4*)(a.mod_gpart + (size_t)8 * 6144 + cc);
                x[j] = x[j] + mg * e; stx(xr + cc, x[j]); }
        }
        float ss = 0.f;
#pragma unroll
        for (int j = 0; j < 4; ++j) ss += x[j][0] * x[j][0] + x[j][1] * x[j][1] + x[j][2] * x[j][2] + x[j][3] * x[j][3];
        ss = wave_sum(ss, lane);
        const float rs = rsqrtf(ss * (1.0f / D) + EPS);
        f32x4 h[4];
#pragma unroll
        for (int j = 0; j < 4; ++j) { const int cc = 4 * (lane + 64 * j);
            h[j] = (x[j] * rs * gq[j]) * (scq[j] + 1.0f) + shq[j];
            u32x2 w; w.x = cvt_pk_bf16(h[j][0], h[j][1]); w.y = cvt_pk_bf16(h[j][2], h[j][3]);
            *(u32x2*)(a.H + (size_t)row * D + cc) = w; }
        if (ROUTE) {
            float lg[8];
#pragma unroll
            for (int e = 0; e < 8; ++e) lg[e] = 0.f;
#pragma unroll
            for (int j = 0; j < 4; ++j)
#pragma unroll
                for (int q = 0; q < 4; ++q) { const LAS float* rw = rtab + ((j * 4 + q) * 64 + lane) * 8; const f32x4 r0 = *(const LAS f32x4*)rw, r1 = *(const LAS f32x4*)(rw + 4); const float hv = h[j][q];
                    lg[0] += hv * r0[0]; lg[1] += hv * r0[1]; lg[2] += hv * r0[2]; lg[3] += hv * r0[3]; lg[4] += hv * r1[0]; lg[5] += hv * r1[1]; lg[6] += hv * r1[2]; lg[7] += hv * r1[3]; }
#pragma unroll
            for (int e = 0; e < 8; ++e) lg[e] = wave_sum(lg[e], lane);
            if (lane == 0) {
                int e1 = 0; float v1 = lg[0];
#pragma unroll
                for (int e = 1; e < 8; ++e) if (lg[e] > v1) { v1 = lg[e]; e1 = e; }
                int e2 = -1; float v2 = -3.0e38f;
#pragma unroll
                for (int e = 0; e < 8; ++e) if (e != e1 && lg[e] > v2) { v2 = lg[e]; e2 = e; }
                const float p2 = 1.0f / (1.0f + __expf(v1 - v2)), p1 = 1.0f - p2;
                float* tk = a.TOPK + 4 * (size_t)row; tk[0] = __int_as_float(e1); tk[1] = __int_as_float(e2); tk[2] = p1; tk[3] = p2;
                lds_add(hist + e1, 1u); lds_add(hist + e2, 1u);
            }
        }
    }
    if (ROUTE) { __syncthreads(); if (tidx(cx) < 8) { const unsigned v = hist[tidx(cx)]; if (v) atomicAdd(a.cnt + tidx(cx), v); } __syncthreads(); }
}

__device__ __forceinline__ void ph_route(const float* TOPK, const bf16_t* H, bf16_t* HS, int* POS, unsigned* ctl, int j, int nrows, LAS unsigned char* lds, const Ctx cx) {
    LAS unsigned* sbase = (LAS unsigned*)(lds + LDS_SBASE);
    const int lane = tidx(cx) & 63, wid = tidx(cx) >> 6;
    __syncthreads();
    if (tidx(cx) == 0) { unsigned b = 0; for (int e = 0; e < 8; ++e) { sbase[e] = b; b += (xb_ld(ctl + CW_CNT + j * 64 + e) + 255u) & ~255u; } sbase[8] = b; }
    __syncthreads();
    if (cx.bid == 0) {
        if (tidx(cx) < 256) { const unsigned r0 = tidx(cx) * 256u; int e = 0;
            for (int q = 1; q < 8; ++q) if (r0 >= sbase[q]) e = q;
            ctl[CW_TEXP + j * 256 + tidx(cx)] = (unsigned)e; }
        if (tidx(cx) == 0) ctl[CW_NT + j] = sbase[8] / 256u;
    }
    for (int i = cx.bid * 8 + wid; i < 8 * 256; i += cx.nb * 8) { const int e = i >> 8, r = i & 255; const unsigned s = sbase[e] + xb_ld(ctl + CW_CNT + j * 64 + e) + r;
        if (s < sbase[e + 1]) {
#pragma unroll
            for (int q = 0; q < 2; ++q) ((u32x4*)(HS + (size_t)s * D))[lane + 64 * q] = ((const u32x4*)H)[lane + 64 * q]; } }
    LAS unsigned* wcnt = sbase + 16; LAS unsigned* wbase = sbase + 24;
    if (tidx(cx) < 8) wcnt[tidx(cx)] = 0u;
    const int nk = nrows / (cx.nb * 8); const int myrow = cx.bid * 8 + wid + lane * (cx.nb * 8); const bool own = lane < nk;
    int e1 = 0, e2 = 0; if (own) { const f32x2 t = *(const f32x2*)(TOPK + 4 * (size_t)myrow); e1 = __float_as_int(t[0]); e2 = __float_as_int(t[1]); }
    __syncthreads();
    if (own) { lds_add(wcnt + e1, 1u); lds_add(wcnt + e2, 1u); }
    __syncthreads();
    if (tidx(cx) < 8) { const unsigned n = wcnt[tidx(cx)]; wbase[tidx(cx)] = sbase[tidx(cx)] + (n ? atomicAdd(ctl + CW_FILL + j * 64 + tidx(cx), n) : 0u); wcnt[tidx(cx)] = 0u; }
    __syncthreads();
    int s1 = 0, s2 = 0;
    if (own) { s1 = (int)(wbase[e1] + lds_add(wcnt + e1, 1u)); s2 = (int)(wbase[e2] + lds_add(wcnt + e2, 1u)); POS[2 * myrow] = s1; POS[2 * myrow + 1] = s2; }
    u32x4 v[9][2];
#pragma unroll
    for (int k = 0; k < 9; ++k) if (k < nk) { const u32x4* src = (const u32x4*)(H + (size_t)(cx.bid * 8 + wid + k * (cx.nb * 8)) * D); v[k][0] = src[lane]; v[k][1] = src[lane + 64]; }
#pragma unroll
    for (int k = 0; k < 9; ++k) if (k < nk) { const int d1 = __builtin_amdgcn_readlane(s1, k), d2 = __builtin_amdgcn_readlane(s2, k);
        u32x4* o1 = (u32x4*)(HS + (size_t)d1 * D); u32x4* o2 = (u32x4*)(HS + (size_t)d2 * D);
        o1[lane] = v[k][0]; o1[lane + 64] = v[k][1]; o2[lane] = v[k][0]; o2[lane + 64] = v[k][1]; }
    __syncthreads();
}

struct CvIn { u32x4 cc[3], cu[3], cb; };
__device__ __forceinline__ void ph_conv(const bf16_t* P, bf16_t* BR, const float* conv_w, int nrows, const Ctx cx) {
    const int tid = tidx(cx), lane = tid & 63, wid = tid >> 6; const int c0 = lane * 8;
    float cw[3][8];
#pragma unroll
    for (int d = 0; d < 3; ++d)
#pragma unroll
        for (int e = 0; e < 8; ++e) cw[d][e] = conv_w[d * 512 + c0 + e];
    auto seqpos = [&](int row, int& sp, int& slen) { const bool lat = row < TL; sp = lat ? (row & (SEQ - 1)) : ((row - TL) & (CTXL - 1)); slen = lat ? SEQ : CTXL; };
    auto load = [&](int row, CvIn& in) { const bf16_t* pr = P + (size_t)row * NP; int sp, slen; seqpos(row, sp, slen);
#pragma unroll
        for (int d = 0; d < 3; ++d) { const int sq = sp + d - 1; const bool ok = sq >= 0 && sq < slen; const bf16_t* q = pr + (ptrdiff_t)(ok ? d - 1 : 0) * NP;
            in.cc[d] = *(const u32x4*)(q + P_CC + c0); in.cu[d] = *(const u32x4*)(q + P_CU + c0); }
        in.cb = *(const u32x4*)(pr + P_CB + c0); };
    const int stride = cx.nb * 8; int row = cx.bid * 8 + wid; CvIn cur, nxt;
    if (row < nrows) load(row, cur);
    for (; row < nrows; row += stride) {
        const int rn = row + stride; const bool hn = rn < nrows;
        if (hn) load(rn, nxt);
        int sp, slen; seqpos(row, sp, slen);
        float y[8];
#pragma unroll
        for (int e = 0; e < 8; ++e) y[e] = 0.f;
#pragma unroll
        for (int d = 0; d < 3; ++d) { const int sq = sp + d - 1; const float m = (sq >= 0 && sq < slen) ? 1.0f : 0.0f; float cv[8], uv[8]; unpack8(cur.cc[d], cv); unpack8(cur.cu[d], uv);
#pragma unroll
            for (int e = 0; e < 8; ++e) y[e] += (cv[e] * uv[e]) * (cw[d][e] * m); }
        float bv[8]; unpack8(cur.cb, bv);
#pragma unroll
        for (int e = 0; e < 8; ++e) y[e] *= bv[e];
        *(u32x4*)(BR + (size_t)row * 1536 + c0) = pack8(y);
        if (hn) cur = nxt;
    }
}

__device__ __forceinline__ void ph_final(const bf16_t* XS, const bf16_t* Y, const int* POS, const float* TOPK, const float* mod_g5, const float* g, float* out, const Ctx cx) {
    const int lane = tidx(cx) & 63, wid = tidx(cx) >> 6;
    f32x4 gq[4];
#pragma unroll
    for (int j = 0; j < 4; ++j) gq[j] = *(const f32x4*)(g + 4 * (lane + 64 * j));
    const int stride = cx.nb * 8; int row = cx.bid * 8 + wid;
    f32x4 xn[4]; u32x2 y1n[4], y2n[4]; float p1n = 0.f, p2n = 0.f;
    int cs1 = 0, cs2 = 0; float cp1 = 0.f, cp2 = 0.f;
    { const int rk = cx.bid * 8 + wid + lane * stride; if (rk < TL) { cs1 = POS[2 * rk]; cs2 = POS[2 * rk + 1]; cp1 = TOPK[4 * rk + 2]; cp2 = TOPK[4 * rk + 3]; } }
    auto fetch = [&](int r, int k) { const int s1 = __builtin_amdgcn_readlane(cs1, k), s2 = __builtin_amdgcn_readlane(cs2, k);
        p1n = __int_as_float(__builtin_amdgcn_readlane(__float_as_int(cp1), k)); p2n = __int_as_float(__builtin_amdgcn_readlane(__float_as_int(cp2), k));
#pragma unroll
        for (int j = 0; j < 4; ++j) { const int cc = 4 * (lane + 64 * j); xn[j] = ldx_raw(XS, false, (size_t)r * D + cc); y1n[j] = *(const u32x2*)(Y + (size_t)s1 * D + cc); y2n[j] = *(const u32x2*)(Y + (size_t)s2 * D + cc); } };
    if (row < TL) fetch(row, 0);
    int it = 0;
    for (; row < TL; row += stride, ++it) {
        const int mr = mod_row(row);
        f32x4 x[4]; u32x2 y1[4], y2[4]; const float p1 = p1n, p2 = p2n;
#pragma unroll
        for (int j = 0; j < 4; ++j) { x[j] = cvx(xn[j], false); y1[j] = y1n[j]; y2[j] = y2n[j]; }
        if (row + stride < TL) fetch(row + stride, it + 1);
        float ss = 0.f;
#pragma unroll
        for (int j = 0; j < 4; ++j) { const int cc = 4 * (lane + 64 * j);
            const f32x4 mg = *(const f32x4*)(mod_g5 + (size_t)mr * 6144 + cc);
            f32x4 e; e[0] = p1 * bf_lo(y1[j].x) + p2 * bf_lo(y2[j].x); e[1] = p1 * bf_hi(y1[j].x) + p2 * bf_hi(y2[j].x); e[2] = p1 * bf_lo(y1[j].y) + p2 * bf_lo(y2[j].y); e[3] = p1 * bf_hi(y1[j].y) + p2 * bf_hi(y2[j].y);
            x[j] = x[j] + mg * e; ss += x[j][0] * x[j][0] + x[j][1] * x[j][1] + x[j][2] * x[j][2] + x[j][3] * x[j][3]; }
        ss = wave_sum(ss, lane); const float rs = rsqrtf(ss * (1.0f / D) + EPS);
#pragma unroll
        for (int j = 0; j < 4; ++j) { const int cc = 4 * (lane + 64 * j); *(f32x4*)(out + (size_t)row * D + cc) = x[j] * rs * gq[j]; }
    }
}

__device__ __forceinline__ float wave_incl_scan(float v) {
    v += __int_as_float(__builtin_amdgcn_update_dpp(0, __float_as_int(v), 0x111, 0xF, 0xF, true));
    v += __int_as_float(__builtin_amdgcn_update_dpp(0, __float_as_int(v), 0x112, 0xF, 0xF, true));
    v += __int_as_float(__builtin_amdgcn_update_dpp(0, __float_as_int(v), 0x114, 0xF, 0xF, true));
    v += __int_as_float(__builtin_amdgcn_update_dpp(0, __float_as_int(v), 0x118, 0xF, 0xF, true));
    v += __int_as_float(__builtin_amdgcn_update_dpp(0, __float_as_int(v), 0x142, 0xA, 0xF, false));
    v += __int_as_float(__builtin_amdgcn_update_dpp(0, __float_as_int(v), 0x143, 0xC, 0xF, false));
    return v;
}
__device__ __forceinline__ float lsig16(float z) { const float e = __builtin_amdgcn_exp2f(fmaxf(z, -80.0f) * -LOG2E); return __builtin_amdgcn_logf(1.0f + e) * (-0.6931471805599453f / 16.0f); }
__device__ __forceinline__ void gla_wave_decay(const bf16_t* P, int row0, int t, int h, int d, int ch0, const float* gla_w2, const float* gla_b, float (&b)[16]) {
    const u32x4* ap = (const u32x4*)(P + (size_t)(row0 + t) * NP + P_AG + d * 16);
    float a[16]; unpack8(ap[0], a); unpack8(ap[1], a + 8);
    const float* w2 = gla_w2 + (size_t)d * 16 * 256 + h * 64 + ch0; const float* bb = gla_b + d * 256 + h * 64 + ch0;
#pragma unroll
    for (int i = 0; i < 16; ++i) b[i] = bb[i];
#pragma unroll
    for (int r = 0; r < 16; ++r)
#pragma unroll
        for (int i = 0; i < 16; ++i) b[i] = __builtin_fmaf(a[r], w2[r * 256 + i], b[i]);
#pragma unroll
    for (int i = 0; i < 16; ++i) b[i] = wave_incl_scan(lsig16(b[i]));
}

constexpr int G_QD = 0, G_KI = G_QD + 2 * 64 * STR64, G_AT = G_KI + 2 * 64 * STR64, G_VI = G_AT + 2 * 64 * STR64, G_SE = G_VI + 64 * STR128, G_RED = G_SE + 2 * 64 * STR128, G_END = G_RED + 512;
constexpr int G1_KR = G_KI, G1_AR = G_KI + 64 * STR64, G1_ASTR = 80, G1_W2 = 73728;
struct G1In { u32x4 vv[2], kraw, araw; float bb[16]; };
__device__ __forceinline__ void g1_load(G1In& in, const bf16_t* P, const float* gla_b, int ci, int h, int tid) {
    const int row0 = ci * 64;
    { const int w = tid >> 6; const float* bb = gla_b + (w >> 2) * 256 + h * 64 + (w & 3) * 16;
#pragma unroll
      for (int i = 0; i < 16; ++i) in.bb[i] = bb[i]; }
#pragma unroll
    for (int q = 0; q < 2; ++q) { const int id = tid + 512 * q, r = id >> 4, c16 = id & 15; in.vv[q] = *(const u32x4*)(P + (size_t)(row0 + r) * NP + P_VG + h * 128 + c16 * 8); }
    in.kraw = *(const u32x4*)(P + (size_t)(row0 + (tid >> 3)) * NP + P_KG + h * 64 + (tid & 7) * 8);
    in.araw = (u32x4){0u, 0u, 0u, 0u}; if (tid < 256) in.araw = *(const u32x4*)(P + (size_t)(row0 + (tid >> 2)) * NP + P_AG + (tid & 3) * 8);
}
__device__ __forceinline__ void gla_state_unit(const G1In& in, G1In& nxt, int vnext  , const bf16_t* P, int ci, int h, const float* gla_b, float* DS, float* DEC, float* BC, LAS unsigned char* lds, const Ctx cx) {
    const int tid = tidx(cx), lane = tid & 63, wid = __builtin_amdgcn_readfirstlane(tid >> 6), fr = lane & 15, fq = lane >> 4;
    LAS unsigned char* Ke = lds + G_QD; LAS unsigned char* Vi = lds + G_VI; LAS unsigned char* Kr = lds + G1_KR; LAS unsigned char* Ar = lds + G1_AR; const LAS float* w2s = (const LAS float*)(lds + G1_W2);
    {
#pragma unroll
      for (int q = 0; q < 2; ++q) { const int id = tid + 512 * q, r = id >> 4, c16 = id & 15; *(LAS u32x4*)(Vi + r * STR128 + c16 * 16) = in.vv[q]; }
      *(LAS u32x4*)(Kr + (tid >> 3) * STR64 + (tid & 7) * 16) = in.kraw;
      if (tid < 256) *(LAS u32x4*)(Ar + (tid >> 2) * G1_ASTR + (tid & 3) * 16) = in.araw; }
    __syncthreads();
    const size_t ub = ((size_t)ci * 4 + h) * 2;
    { const int d = wid >> 2, ch0 = (wid & 3) * 16, t = d ? 63 - lane : lane; float b[16];
      const LAS u32x4* ap = (const LAS u32x4*)(Ar + t * G1_ASTR + d * 32); float a[16]; unpack8(ap[0], a); unpack8(ap[1], a + 8);
      const LAS u32x4* kp = (const LAS u32x4*)(Kr + t * STR64 + ch0 * 2); const u32x4 k0 = kp[0], k1 = kp[1];
      const LAS float* w2 = w2s + d * 16 * 256 + h * 64 + ch0;
#pragma unroll
      for (int i = 0; i < 16; ++i) b[i] = in.bb[i];
#pragma unroll
      for (int r = 0; r < 16; ++r)
#pragma unroll
          for (int i = 0; i < 16; ++i) b[i] = __builtin_fmaf(a[r], w2[r * 256 + i], b[i]);
#pragma unroll
      for (int i = 0; i < 16; ++i) b[i] = wave_incl_scan(lsig16(b[i]));
      { float* bp = BC + ((ub + d) * 64 + ch0) * 64 + t;
#pragma unroll
        for (int i = 0; i < 16; ++i) bp[i * 64] = b[i]; }
      float kf[16], o[16]; unpack8(k0, kf); unpack8(k1, kf + 8);
#pragma unroll
      for (int i = 0; i < 16; ++i) { const float bt = __int_as_float(__builtin_amdgcn_readlane(__float_as_int(b[i]), 63)); o[i] = kf[i] * __expf(bt - b[i]); b[i] = bt; }
      *(LAS u32x4*)(Ke + d * 64 * STR64 + t * STR64 + ch0 * 2) = pack8(o); *(LAS u32x4*)(Ke + d * 64 * STR64 + t * STR64 + ch0 * 2 + 16) = pack8(o + 8);
      if (lane < 16) { float dv = b[0];
#pragma unroll
          for (int i = 1; i < 16; ++i) dv = (lane == i) ? b[i] : dv;
          DEC[(ub + d) * 64 + ch0 + lane] = __expf(dv); } }
    __syncthreads();
    if (vnext >= 0) g1_load(nxt, P, gla_b, vnext >> 2, vnext & 3, tid);
    { const int d = wid >> 2, mt = wid & 3; f32x4 acc[8];
#pragma unroll
      for (int n = 0; n < 8; ++n) acc[n] = (f32x4){0.f, 0.f, 0.f, 0.f};
#pragma unroll
      for (int s = 0; s < 2; ++s) { const int r0 = 32 * s + 8 * fq; const bf16x8 af = frag_tr(Ke + d * 64 * STR64, r0, r0 + 4, mt * 16, STR64, fr);
#pragma unroll
          for (int n = 0; n < 8; ++n) { const bf16x8 bfr = frag_tr(Vi, r0, r0 + 4, n * 16, STR128, fr); MMA16(acc[n], af, bfr); } }
      LAS unsigned char* my = lds + G_AT + wid * (16 * STR64); const int r8 = lane >> 3, c8 = lane & 7;
      LAS unsigned char* wp = my + fr * STR64 + fq * 16; const LAS unsigned char* rp = my + r8 * STR64 + c8 * 16;
      float* dst = DS + ((ub + d) * 64 + mt * 16 + r8) * 128 + 4 * c8;
#pragma unroll
      for (int p = 0; p < 4; ++p) {
          *(LAS f32x4*)wp = acc[2 * p]; *(LAS f32x4*)(wp + 64) = acc[2 * p + 1];
          asm volatile("" ::: "memory"); __builtin_amdgcn_wave_barrier();
          const f32x4 x0 = *(const LAS f32x4*)rp, x1 = *(const LAS f32x4*)(rp + 8 * STR64);
          asm volatile("" ::: "memory"); __builtin_amdgcn_wave_barrier();
          *(f32x4*)(dst + p * 32) = x0; *(f32x4*)(dst + 8 * 128 + p * 32) = x1; } }
    __syncthreads();
}

__device__ __forceinline__ void ph_gla_scan2(const float* DS, const float* DEC, bf16_t* SE, const Ctx cx) {
    const int tid = tidx(cx);
    for (int vi = cx.bid * 512 + tid; vi < 64 * 2048; vi += cx.nb * 512) {
        const int sid = vi >> 11, dk = (vi >> 5) & 63, dvq = vi & 31; const int b = sid >> 3, h = (sid >> 1) & 3, d = sid & 1;
        f32x4 S = (f32x4){0.f, 0.f, 0.f, 0.f};
#pragma unroll 12
        for (int st = 0; st < 36; ++st) {
            const int ci = st < 4 ? (256 + 4 * b + (d ? 3 - st : st)) : (32 * b + (d ? 35 - st : st - 4));
            const size_t ub = ((size_t)ci * 4 + h) * 2 + d; const size_t eo = (ub * 64 + dk) * 128 + dvq * 4;
            u32x2 w; w.x = cvt_pk_bf16(S[0], S[1]); w.y = cvt_pk_bf16(S[2], S[3]); *(u32x2*)(SE + eo) = w;
            const float dec = DEC[ub * 64 + dk]; const f32x4 ds = *(const f32x4*)(DS + eo);
            S = S * dec + ds;
        }
    }
}

struct G3In { u32x4 vv[2], sv[4], qraw, kraw; float bb[16]; };
__device__ __forceinline__ void g3_load(G3In& in, const bf16_t* P, int ci, int h, const float* BC, const bf16_t* SE, int tid) {
    const int lane = tid & 63, wid = __builtin_amdgcn_readfirstlane(tid >> 6); const int row0 = ci * 64; const size_t ub = ((size_t)ci * 4 + h) * 2;
#pragma unroll
    for (int q = 0; q < 2; ++q) { const int id = tid + 512 * q, r = id >> 4, c16 = id & 15; in.vv[q] = *(const u32x4*)(P + (size_t)(row0 + r) * NP + P_VG + h * 128 + c16 * 8); }
#pragma unroll
    for (int q = 0; q < 4; ++q) { const int id = tid + 512 * q, r = id >> 4, c16 = id & 15; in.sv[q] = *(const u32x4*)(SE + (ub * 64 + r) * 128 + c16 * 8); }
    const int d = wid >> 2, ch0 = (wid & 3) * 16, t = d ? 63 - lane : lane;
    { const bf16_t* pr = P + (size_t)(row0 + (tid >> 3)) * NP + h * 64 + (tid & 7) * 8; in.qraw = *(const u32x4*)(pr + P_QG); in.kraw = *(const u32x4*)(pr + P_KG); }
    const float* bp = BC + ((ub + d) * 64 + ch0) * 64 + t;
#pragma unroll
    for (int i = 0; i < 16; ++i) in.bb[i] = bp[i * 64];
}
__device__ __forceinline__ void gla_out_unit(const G3In& in, const bf16_t* P, int ci, int h, const float* gng, bf16_t* BR, LAS unsigned char* lds, const Ctx cx) {
    const int tid = tidx(cx), lane = tid & 63, wid = __builtin_amdgcn_readfirstlane(tid >> 6), fr = lane & 15, fq = lane >> 4; const int row0 = ci * 64;
    LAS unsigned char* Qd = lds + G_QD; LAS unsigned char* Ki = lds + G_KI; LAS unsigned char* Vi = lds + G_VI; LAS unsigned char* Se = lds + G_SE; LAS unsigned char* At = lds + G_AT;
    { LAS unsigned char* Qr = At; LAS unsigned char* Kr = At + 64 * STR64;
      *(LAS u32x4*)(Qr + (tid >> 3) * STR64 + (tid & 7) * 16) = in.qraw; *(LAS u32x4*)(Kr + (tid >> 3) * STR64 + (tid & 7) * 16) = in.kraw; }
#pragma unroll
    for (int q = 0; q < 2; ++q) { const int id = tid + 512 * q, r = id >> 4, c16 = id & 15; *(LAS u32x4*)(Vi + r * STR128 + c16 * 16) = in.vv[q]; }
#pragma unroll
    for (int q = 0; q < 4; ++q) { const int id = tid + 512 * q, r = id >> 4, c16 = id & 15; *(LAS u32x4*)(Se + r * STR128 + c16 * 16) = in.sv[q]; }
    __syncthreads();
    { const int d = wid >> 2, ch0 = (wid & 3) * 16, t = d ? 63 - lane : lane; float b[16];
      const LAS u32x4* qp = (const LAS u32x4*)(At + t * STR64 + ch0 * 2); const LAS u32x4* kp = (const LAS u32x4*)(At + 64 * STR64 + t * STR64 + ch0 * 2);
      const u32x4 q0 = qp[0], q1 = qp[1], k0 = kp[0], k1 = kp[1];
#pragma unroll
      for (int i = 0; i < 16; ++i) b[i] = in.bb[i];
      float qf[16], kf[16]; unpack8(q0, qf); unpack8(q1, qf + 8); unpack8(k0, kf); unpack8(k1, kf + 8);
#pragma unroll
      for (int i = 0; i < 16; ++i) { const float e = __expf(b[i]); qf[i] = qf[i] * 0.125f * e; kf[i] = kf[i] * __builtin_amdgcn_rcpf(e); }
      LAS unsigned char* qd = Qd + d * 64 * STR64 + t * STR64 + ch0 * 2; LAS unsigned char* ki = Ki + d * 64 * STR64 + t * STR64 + ch0 * 2;
      *(LAS u32x4*)qd = pack8(qf); *(LAS u32x4*)(qd + 16) = pack8(qf + 8); *(LAS u32x4*)ki = pack8(kf); *(LAS u32x4*)(ki + 16) = pack8(kf + 8); }
    __syncthreads();
    { const int d = wid >> 2, mt = wid & 3; f32x4 acc[4];
#pragma unroll
      for (int n = 0; n < 4; ++n) acc[n] = (f32x4){0.f, 0.f, 0.f, 0.f};
#pragma unroll
      for (int s = 0; s < 2; ++s) { const bf16x8 af = frag_row(Qd + d * 64 * STR64, mt * 16 + fr, 32 * s + 8 * fq, STR64);
#pragma unroll
          for (int n = 0; n < 4; ++n) { const bf16x8 bfr = frag_row(Ki + d * 64 * STR64, n * 16 + fr, 32 * s + 8 * fq, STR64); MMA16(acc[n], af, bfr); } }
      const int l = mt * 16 + fr;
#pragma unroll
      for (int n = 0; n < 4; ++n) { float v[4];
#pragma unroll
          for (int j = 0; j < 4; ++j) { const int s = n * 16 + 4 * fq + j; const bool keep = d ? (s >= l) : (s <= l); v[j] = keep ? acc[n][j] : 0.f; }
          u32x2 w; w.x = cvt_pk_bf16(v[0], v[1]); w.y = cvt_pk_bf16(v[2], v[3]); *(LAS u32x2*)(At + d * 64 * STR64 + l * STR64 + (n * 16 + 4 * fq) * 2) = w; } }
    __syncthreads();
    { const int mt = wid & 3, nh = wid >> 2; f32x4 acc[4];
      const int l = mt * 16 + fr; const size_t row = (size_t)row0 + l;
      u32x2 rw[4]; f32x4 gg[4];
#pragma unroll
      for (int n = 0; n < 4; ++n) { const int v0 = (nh * 4 + n) * 16 + 4 * fq; rw[n] = *(const u32x2*)(P + row * NP + P_RG + h * 128 + v0); gg[n] = *(const f32x4*)(gng + h * 128 + v0); }
#pragma unroll
      for (int n = 0; n < 4; ++n) acc[n] = (f32x4){0.f, 0.f, 0.f, 0.f};
#pragma unroll
      for (int d = 0; d < 2; ++d)
#pragma unroll
          for (int s = 0; s < 2; ++s) { const int r0 = 32 * s + 8 * fq;
              const bf16x8 af = frag_row(At + d * 64 * STR64, mt * 16 + fr, r0, STR64), aq = frag_row(Qd + d * 64 * STR64, mt * 16 + fr, r0, STR64);
#pragma unroll
              for (int n = 0; n < 4; ++n) { const int x0 = (nh * 4 + n) * 16;
                  const bf16x8 bv = frag_tr(Vi, r0, r0 + 4, x0, STR128, fr); MMA16(acc[n], af, bv);
                  const bf16x8 bs = frag_tr(Se + d * 64 * STR128, r0, r0 + 4, x0, STR128, fr); MMA16(acc[n], aq, bs); } }
      float ss = 0.f;
#pragma unroll
      for (int n = 0; n < 4; ++n) ss += acc[n][0] * acc[n][0] + acc[n][1] * acc[n][1] + acc[n][2] * acc[n][2] + acc[n][3] * acc[n][3];
      ss = row4_sum(ss);
      LAS float* red = (LAS float*)(lds + G_RED);
      if (fq == 0) red[l * 2 + nh] = ss;
      __syncthreads();
      const float rs = rsqrtf((red[l * 2] + red[l * 2 + 1]) * (1.0f / 128.0f) + EPS);
#pragma unroll
      for (int n = 0; n < 4; ++n) { const int v0 = (nh * 4 + n) * 16 + 4 * fq;
          const float y0 = acc[n][0] * rs * gg[n][0] * siluf_(bf_lo(rw[n].x)), y1 = acc[n][1] * rs * gg[n][1] * siluf_(bf_hi(rw[n].x)), y2 = acc[n][2] * rs * gg[n][2] * siluf_(bf_lo(rw[n].y)), y3 = acc[n][3] * rs * gg[n][3] * siluf_(bf_hi(rw[n].y));
          u32x2 w; w.x = cvt_pk_bf16(y0, y1); w.y = cvt_pk_bf16(y2, y3); *(u32x2*)(BR + row * 1536 + 1024 + h * 128 + v0) = w; } }
    __syncthreads();
}

constexpr int A_KBUF = 0, A_VBUF = 64 * STR64, A_BUF = 2 * 64 * STR64;
__device__ __forceinline__ void attn_unit(const bf16_t* QR, const bf16_t* KV, bf16_t* BR, const float* sink, int b, int kh, int qrow0  , int qpos0  , LAS unsigned char* lds, const Ctx cx) {
    const int tid = tidx(cx), lane = tid & 63, wid = tid >> 6, fr = lane & 15, fq = lane >> 4; const int hq = wid >> 1, qh = wid & 1;
    const bool lat = qpos0 >= 0;
    int kt0 = 0, kt1 = 0; if (lat) { kt0 = (qpos0 >> 6) - 2; if (kt0 < 0) kt0 = 0; kt1 = (qpos0 >> 6) + 4; if (kt1 > 32) kt1 = 32; }
    const int ntile = (kt1 - kt0) + 4;
    bf16x8 qf[4][2];
#pragma unroll
    for (int mt = 0; mt < 4; ++mt)
#pragma unroll
        for (int ks = 0; ks < 2; ++ks) qf[mt][ks] = *(const bf16x8*)(QR + (size_t)(qrow0 + 64 * qh + 16 * mt + fr) * 512 + (4 * kh + hq) * 64 + 32 * ks + 8 * fq);
    const float sk = sink[4 * kh + hq] * LOG2E;
    f32x4 oacc[4][4]; float mrun[4], lrun[4];
#pragma unroll
    for (int mt = 0; mt < 4; ++mt) { mrun[mt] = sk; lrun[mt] = (fq == 0) ? 1.0f : 0.0f;
#pragma unroll
        for (int dt = 0; dt < 4; ++dt) oacc[mt][dt] = (f32x4){0.f, 0.f, 0.f, 0.f}; }
    const int sr = tid >> 3, sc = tid & 7;
    auto tile_row0 = [&](int t) -> int { return t < (kt1 - kt0) ? b * SEQ + (kt0 + t) * 64 : TL + b * CTXL + (t - (kt1 - kt0)) * 64; };
    u32x4 kreg, vreg;
    { const bf16_t* src = KV + (size_t)(tile_row0(0) + sr) * 256 + kh * 64 + sc * 8; kreg = *(const u32x4*)src; vreg = *(const u32x4*)(src + 128); }
    *(LAS u32x4*)(lds + A_KBUF + sr * STR64 + sc * 16) = kreg; *(LAS u32x4*)(lds + A_VBUF + sr * STR64 + sc * 16) = vreg;
    __syncthreads();
    for (int t = 0; t < ntile; ++t) {
        LAS unsigned char* Kb = lds + (t & 1) * A_BUF + A_KBUF; LAS unsigned char* Vb = lds + (t & 1) * A_BUF + A_VBUF;
        if (t + 1 < ntile) { const bf16_t* src = KV + (size_t)(tile_row0(t + 1) + sr) * 256 + kh * 64 + sc * 8; kreg = *(const u32x4*)src; vreg = *(const u32x4*)(src + 128); }
        const bool latt = t < (kt1 - kt0); const int kpos0 = (kt0 + t) * 64;
        const int qlo = qpos0 + 64 * qh;
        const bool active = !latt || (kpos0 + 63 >= qlo - 128 && kpos0 <= qlo + 63 + 128);
        const bool needmask = latt && (kpos0 > qlo + 65 || kpos0 < qlo - 65);
        if (active) {
            u32x4 pf[4][2];
            { bf16x8 kf[4][2];
#pragma unroll
              for (int nt = 0; nt < 4; ++nt)
#pragma unroll
                  for (int ks = 0; ks < 2; ++ks) kf[nt][ks] = frag_row(Kb, nt * 16 + fr, 32 * ks + 8 * fq, STR64);
#pragma unroll
              for (int mt = 0; mt < 4; ++mt) {
                f32x4 s[4];
#pragma unroll
                for (int nt = 0; nt < 4; ++nt) { s[nt] = (f32x4){0.f, 0.f, 0.f, 0.f}; MMA16(s[nt], qf[mt][0], kf[nt][0]); MMA16(s[nt], qf[mt][1], kf[nt][1]); }
                if (needmask) { const int qp = qlo + 16 * mt + fr;
#pragma unroll
                    for (int nt = 0; nt < 4; ++nt)
#pragma unroll
                        for (int j = 0; j < 4; ++j) { const int dlt = kpos0 + nt * 16 + 4 * fq + j - qp; if (dlt > 128 || dlt < -128) s[nt][j] = -3.0e38f; } }
                float mx = fmaxf(fmaxf(fmaxf(s[0][0], s[0][1]), fmaxf(s[0][2], s[0][3])), fmaxf(fmaxf(s[1][0], s[1][1]), fmaxf(s[1][2], s[1][3])));
                mx = fmaxf(mx, fmaxf(fmaxf(fmaxf(s[2][0], s[2][1]), fmaxf(s[2][2], s[2][3])), fmaxf(fmaxf(s[3][0], s[3][1]), fmaxf(s[3][2], s[3][3]))));
                mx = row4_max(mx);
                const float mnew = fmaxf(mrun[mt], mx), alpha = __builtin_amdgcn_exp2f(mrun[mt] - mnew); mrun[mt] = mnew;
                float ps = 0.f;
#pragma unroll
                for (int nt = 0; nt < 4; ++nt)
#pragma unroll
                    for (int j = 0; j < 4; ++j) { const float p = __builtin_amdgcn_exp2f(s[nt][j] - mnew); s[nt][j] = p; ps += p; }
                lrun[mt] = lrun[mt] * alpha + ps;
                pf[mt][0].x = cvt_pk_bf16(s[0][0], s[0][1]); pf[mt][0].y = cvt_pk_bf16(s[0][2], s[0][3]); pf[mt][0].z = cvt_pk_bf16(s[1][0], s[1][1]); pf[mt][0].w = cvt_pk_bf16(s[1][2], s[1][3]);
                pf[mt][1].x = cvt_pk_bf16(s[2][0], s[2][1]); pf[mt][1].y = cvt_pk_bf16(s[2][2], s[2][3]); pf[mt][1].z = cvt_pk_bf16(s[3][0], s[3][1]); pf[mt][1].w = cvt_pk_bf16(s[3][2], s[3][3]);
#pragma unroll
                for (int dt = 0; dt < 4; ++dt) oacc[mt][dt] = oacc[mt][dt] * alpha;
              } }
#pragma unroll
            for (int dt = 0; dt < 4; ++dt) {
                const bf16x8 v0 = frag_tr(Vb, 4 * fq, 16 + 4 * fq, dt * 16, STR64, fr), v1 = frag_tr(Vb, 32 + 4 * fq, 48 + 4 * fq, dt * 16, STR64, fr);
#pragma unroll
                for (int mt = 0; mt < 4; ++mt) { MMA16(oacc[mt][dt], __builtin_bit_cast(bf16x8, pf[mt][0]), v0); MMA16(oacc[mt][dt], __builtin_bit_cast(bf16x8, pf[mt][1]), v1); } }
        }
        if (t + 1 < ntile) { LAS unsigned char* nb_ = lds + ((t + 1) & 1) * A_BUF; *(LAS u32x4*)(nb_ + A_KBUF + sr * STR64 + sc * 16) = kreg; *(LAS u32x4*)(nb_ + A_VBUF + sr * STR64 + sc * 16) = vreg; }
        __syncthreads();
    }
#pragma unroll
    for (int mt = 0; mt < 4; ++mt) { const float l = row4_sum(lrun[mt]); const float inv = 1.0f / l;
        bf16_t* op = BR + (size_t)(qrow0 + 64 * qh + 16 * mt + fr) * 1536 + 512 + (4 * kh + hq) * 64 + 4 * fq;
#pragma unroll
        for (int dt = 0; dt < 4; ++dt) { u32x2 w; w.x = cvt_pk_bf16(oacc[mt][dt][0] * inv, oacc[mt][dt][1] * inv); w.y = cvt_pk_bf16(oacc[mt][dt][2] * inv, oacc[mt][dt][3] * inv); *(u32x2*)(op + dt * 16) = w; } }
}

__device__ __forceinline__ void ph_mixA(const bf16_t* P, const bf16_t* QR, const bf16_t* KV, bf16_t* BR, const float* sink, const float* gla_w2, const float* gla_b, float* DS, float* DEC, float* BC, bool ctxq, LAS unsigned char* lds, const Ctx cx) {
    { LAS float* w2s = (LAS float*)(lds + G1_W2); for (int i = tidx(cx); i < 2 * 16 * 256; i += 512) w2s[i] = gla_w2[i]; }
    for (int u = cx.bid; u < 256; u += cx.nb) { const int b = u >> 5, n = (u >> 1) & 15, kh = u & 1; attn_unit(QR, KV, BR, sink, b, kh, b * SEQ + n * 128, n * 128, lds, cx); }
    if (cx.nb == 256) {
        const int n = (cx.bid >> 1) & 15; const bool edge = (n == 0 || n == 15);
        if (ctxq && edge) { const int b = cx.bid >> 5, kh = cx.bid & 1; attn_unit(QR, KV, BR, sink, b, kh, TL + b * CTXL + (n == 15 ? 128 : 0), -1000000, lds, cx); }
        int rank; if (!ctxq) rank = cx.bid; else { const int blk = cx.bid >> 5, w = cx.bid & 31; rank = edge ? -1 : blk * 28 + (w - 2); }
        const int nv = (rank >= 0 && rank < 128) ? 5 : 4;
        G1In cur, nxt; g1_load(cur, P, gla_b, cx.bid >> 2, cx.bid & 3, tidx(cx));
#pragma unroll 1
        for (int k = 0; k < nv; ++k) { const int v = k < 4 ? cx.bid + 256 * k : 1024 + rank; const int vn = (k + 1 < nv) ? ((k + 1) < 4 ? cx.bid + 256 * (k + 1) : 1024 + rank) : -1;
            gla_state_unit(cur, nxt, vn, P, v >> 2, v & 3, gla_b, DS, DEC, BC, lds, cx);
            if (vn >= 0) cur = nxt; }
        return;
    }
    const int nsmall = (ctxq ? 32 : 0) + 1152;
    for (int u = cx.bid; u < nsmall; u += cx.nb) {
        int v = u;
        if (ctxq) { if (v < 32) { const int b = v >> 2, n = (v >> 1) & 1, kh = v & 1; attn_unit(QR, KV, BR, sink, b, kh, TL + b * CTXL + n * 128, -1000000, lds, cx); continue; } v -= 32; }
        { G1In cur, nxt; g1_load(cur, P, gla_b, v >> 2, v & 3, tidx(cx)); gla_state_unit(cur, nxt, -1, P, v >> 2, v & 3, gla_b, DS, DEC, BC, lds, cx); }
    }
}
__device__ __forceinline__ void ph_mixC(const bf16_t* P, const float* BC, const bf16_t* SE, const float* gng, bf16_t* BR, int nchunks, LAS unsigned char* lds, const Ctx cx) {
    const int n = nchunks * 4; int u = cx.bid; G3In cur, nxt;
    if (u < n) g3_load(cur, P, u >> 2, u & 3, BC, SE, tidx(cx));
    for (; u < n; u += cx.nb) { const int un = u + cx.nb; const bool hn = un < n;
        if (hn) g3_load(nxt, P, un >> 2, un & 3, BC, SE, tidx(cx));
        gla_out_unit(cur, P, u >> 2, u & 3, gng, BR, lds, cx);
        if (hn) cur = nxt; }
}

template <int MODE, class Epi, int ABLK = 0> __device__ __forceinline__ void ph_gemm(LAS unsigned char* lds, const bf16_t* A, const bf16_t* Bt, int lda, int ldb, int K, int nM, int nN, const Epi& E, unsigned* ctl, int moe_j, size_t bexp, const Ctx cx) {
    pg8::Prob<MODE> P; P.A = A; P.Bt = Bt; P.lda = lda; P.ldb = ldb; P.K = K; P.nM = nM; P.nN = nN; P.G = cx.nb; P.c = cx.bid; P.texp = (LAS int*)(lds + LDS_TEXP); P.bexp = bexp; P.nctx = (MODE == 3) ? moe_j : 0;
    if (MODE == 2) {
        __syncthreads();
        if (tidx(cx) < 256) ((LAS int*)(lds + LDS_TEXP))[tidx(cx)] = (int)xb_ld(ctl + CW_TEXP + moe_j * 256 + tidx(cx));
        P.nM = (int)xb_ld(ctl + CW_NT + moe_j);
        __syncthreads();
    }
    pg8::gemm_phase<Epi, pg8::Prob<MODE>, ABLK>(lds, P, E, cx);
}

__device__ __forceinline__ bool idle_ctx(unsigned* ctl, int j, int nN, Ctx& cx) {
    const int U = (int)xb_ld(ctl + CW_NT + j) * nN, rounds = (U + cx.nb - 1) / cx.nb, nidle = rounds * cx.nb - U;
    if (nidle < 64) return true;
    const int first = cx.nb - nidle; if (cx.bid < first) return false;
    cx.bid -= first; cx.nb = nidle; return true;
}

struct MKP { const float* in[24]; float* out; char* ws; };
typedef const MKP __attribute__((address_space(4)))* KPtr;
__device__ __forceinline__ KPtr kp() { KPtr q = (KPtr)__builtin_amdgcn_kernarg_segment_ptr(); OPQ_S(q); return q; }
#define IN_(i) ((const float*)q->in[i])
#define WSP(off) (ws + (off))

__global__ void __launch_bounds__(512, 2) mk_fwd(MKP p_unused) {
    extern __shared__ __attribute__((aligned(16))) unsigned char shm[];
    LAS unsigned char* lds = (LAS unsigned char*)shm;
    const int nb = gridDim.x; const int wv = __builtin_amdgcn_readfirstlane((int)(threadIdx.x >> 6));
    XcdBarrier bar;
    { KPtr q = kp(); char* ws = q->ws;
      if (threadIdx.x == 0) *(LAS u32x4*)(lds + LDS_BARW) = (u32x4){0u, 0u, 0u, 0u};
      __syncthreads();
      bar = xcd_barrier_post((unsigned*)WSP(WS_CTL) + CW_BAR, (volatile LAS unsigned*)(lds + LDS_BARW)); }

    { KPtr q = kp(); char* ws = q->ws; Ctx cx; cx.bid = blockIdx.x; cx.nb = nb; cx.wv = wv; OPQ_S(cx.bid); OPQ_S(cx.wv);
      ph_init(IN_(0), IN_(2), (float*)nullptr, (f32x2*)WSP(WS_CS), cx);
      ph_mod(IN_(1), IN_(3), IN_(4), IN_(5), (float*)WSP(WS_MOD), lds, cx);
      __syncthreads(); }
    { int rot = 0;
#pragma unroll 1
      for (int l = 0; l < DEPTH; ++l) {
          KPtr q = kp(); char* ws = q->ws; Ctx cx; cx.bid = blockIdx.x; cx.nb = nb; cx.wv = wv; OPQ_S(cx.bid); OPQ_S(cx.wv);
          ph_convert(mkjob(IN_(8) + (size_t)l * D * DIN, nullptr, (bf16_t*)WSP(WS_WIN) + (size_t)l * NP * D, DIN, D, 0, D, NP, 1), lds, cx, rot);
          ph_convert(mkjob(IN_(15) + (size_t)l * D * D, nullptr, (bf16_t*)WSP(WS_WO3) + (size_t)l * D * D, D, D, 0, D, D, 0), lds, cx, rot);
#pragma unroll 1
          for (int i = 0; i < 3; ++i) {
              ph_convert(mkjob(IN_(14) + ((size_t)l * 3 + i) * 512 * D, nullptr, (bf16_t*)WSP(WS_WBR) + (size_t)l * D * 1536, D, 1536, i * 512, 512, 1024, 0), lds, cx, rot);
          }
      }
#pragma unroll 1
      for (int j = 0; j < 2; ++j) {
          KPtr q = kp(); char* ws = q->ws; Ctx cx; cx.bid = blockIdx.x; cx.nb = nb; cx.wv = wv; OPQ_S(cx.bid); OPQ_S(cx.wv);
          ph_convert(mkjob(IN_(16) + (size_t)j * D * DFF, IN_(17) + (size_t)j * D * DFF, (bf16_t*)WSP(WS_WUPD) + (size_t)j * NUP * D, DFF, D, 0, D, NUP, 2), lds, cx, rot);
          ph_convert(mkjob(IN_(18) + (size_t)j * DFF * D, nullptr, (bf16_t*)WSP(WS_WDND) + (size_t)j * D * DFF, D, DFF, 0, DFF, D, 0), lds, cx, rot);
      }
    }
    { Ctx cx; cx.bid = 0; cx.nb = nb; cx.wv = wv; OPQ_S(cx.wv); xcd_barrier_first(bar, cx); }

#pragma unroll 1
    for (int l = 0; l < DEPTH; ++l) {
        const bool last = (l == DEPTH - 1), moe = (l & 1); const int j = l >> 1; const int nrows = last ? TL : T; const int nMr = nrows / 256;
        { KPtr q = kp(); char* ws = q->ws; Ctx cx; cx.bid = blockIdx.x; cx.nb = nb; cx.wv = wv; OPQ_S(cx.bid); OPQ_S(cx.wv); const float* modl = (const float*)WSP(WS_MOD) + (size_t)l * 9 * 6144;
          NormArgs a; a.XS = (bf16_t*)WSP(WS_XS); a.lf32 = a.cf32 = (l == 0); a.Xl = l ? (const void*)WSP(WS_XS) : (const void*)IN_(0); a.Xc = l ? (const void*)WSP(WS_XS) : (const void*)(IN_(2) - (size_t)TL * D); a.H = (bf16_t*)WSP(WS_H); a.g = IN_(6) + l * D; a.mod_shift = modl; a.mod_scale = modl + 1024; a.nrows = T;
          a.Y = (const bf16_t*)WSP(WS_YB); a.POS = (const int*)WSP(WS_POS); a.TOPKp = (const float*)WSP(WS_TOPK); a.mod_g5prev = (const float*)WSP(WS_MOD) + (size_t)(l > 0 ? l - 1 : 0) * 9 * 6144 + 5 * 1024; a.router = nullptr; a.TOPK = nullptr; a.cnt = nullptr;
          a.npart = 7; a.PART = (l == 1 || l == 3) ? (const float*)WSP(WS_PART) : nullptr; a.mod_gpart = (const float*)WSP(WS_MOD) + (size_t)(l > 0 ? l - 1 : 0) * 9 * 6144 + 5 * 1024;
          ph_norm<false>(a, l == 2, lds, cx); }
        { Ctx cx; cx.bid = 0; cx.nb = nb; cx.wv = wv; OPQ_S(cx.wv); xcd_barrier(bar, cx); }
        { KPtr q = kp(); char* ws = q->ws; Ctx cx; cx.bid = blockIdx.x; cx.nb = nb; cx.wv = wv; OPQ_S(cx.bid); OPQ_S(cx.wv);
          pg8::EpiWin E{(bf16_t*)WSP(WS_PH), (bf16_t*)WSP(WS_QR), (bf16_t*)WSP(WS_KV), (const f32x2*)WSP(WS_CS), lds + LDS_CSH}; ph_gemm<0>(lds, (const bf16_t*)WSP(WS_H), (const bf16_t*)WSP(WS_WIN) + (size_t)l * NP * D, D, D, D, T / 256, NP / 256, E, nullptr, 0, 0, cx); }
        { Ctx cx; cx.bid = 0; cx.nb = nb; cx.wv = wv; OPQ_S(cx.wv); xcd_barrier(bar, cx); }
        { KPtr q = kp(); char* ws = q->ws; Ctx cx; cx.bid = blockIdx.x; cx.nb = nb; cx.wv = wv; OPQ_S(cx.bid); OPQ_S(cx.wv);
          ph_mixA((const bf16_t*)WSP(WS_PH), (const bf16_t*)WSP(WS_QR), (const bf16_t*)WSP(WS_KV), (bf16_t*)WSP(WS_BR), IN_(10) + l * 8, IN_(11) + (size_t)l * 2 * 16 * 256, IN_(12) + (size_t)l * 2 * 256,
                  (float*)WSP(WS_R3), (float*)WSP(WS_DEC), (float*)WSP(WS_YB), !last, lds, cx); }
        { Ctx cx; cx.bid = 0; cx.nb = nb; cx.wv = wv; OPQ_S(cx.wv); xcd_barrier(bar, cx); }
        { KPtr q = kp(); char* ws = q->ws; Ctx cx; cx.bid = blockIdx.x; cx.nb = nb; cx.wv = wv; OPQ_S(cx.bid); OPQ_S(cx.wv);
          ph_gla_scan2((const float*)WSP(WS_R3), (const float*)WSP(WS_DEC), (bf16_t*)(WSP(WS_R3) + (size_t)2 * T * 512 * 4), cx); }
        { Ctx cx; cx.bid = 0; cx.nb = nb; cx.wv = wv; OPQ_S(cx.wv); xcd_barrier(bar, cx); }
        { KPtr q = kp(); char* ws = q->ws; Ctx cx; cx.bid = blockIdx.x; cx.nb = nb; cx.wv = wv; OPQ_S(cx.bid); OPQ_S(cx.wv);
          ph_conv((const bf16_t*)WSP(WS_PH), (bf16_t*)WSP(WS_BR), IN_(9) + (size_t)l * 3 * 512, nrows, cx);
          ph_mixC((const bf16_t*)WSP(WS_PH), (const float*)WSP(WS_YB), (const bf16_t*)(WSP(WS_R3) + (size_t)2 * T * 512 * 4), IN_(13) + l * 512, (bf16_t*)WSP(WS_BR), nrows / 64, lds, cx); }
        { Ctx cx; cx.bid = 0; cx.nb = nb; cx.wv = wv; OPQ_S(cx.wv); xcd_barrier(bar, cx); }
        { KPtr q = kp(); char* ws = q->ws; Ctx cx; cx.bid = blockIdx.x; cx.nb = nb; cx.wv = wv; OPQ_S(cx.bid); OPQ_S(cx.wv);
          constexpr size_t MG3C_OFF = (size_t)TL * D * 2;
          if (!last) { pg8::EpiGate E{(bf16_t*)(WSP(WS_R3) + MG3C_OFF), (const bf16_t*)WSP(WS_PH) + (size_t)TL * NP, lds + LDS_CSH}; ph_gemm<1>(lds, (const bf16_t*)WSP(WS_BR) + (size_t)TL * 1536, (const bf16_t*)WSP(WS_WBR) + (size_t)l * D * 1536, 1536, 1536, 512, 8, 12, E, nullptr, 0, 0, cx); }
          { pg8::EpiMerge E{(bf16_t*)WSP(WS_R3), (const bf16_t*)WSP(WS_PH), lds + LDS_CSH}; ph_gemm<4>(lds, (const bf16_t*)WSP(WS_BR), (const bf16_t*)WSP(WS_WBR) + (size_t)l * D * 1536, 1536, 1536, 1536, 64, 4, E, nullptr, 0, 0, cx); } }
        { Ctx cx; cx.bid = 0; cx.nb = nb; cx.wv = wv; OPQ_S(cx.wv); xcd_barrier(bar, cx); }
        { KPtr q = kp(); char* ws = q->ws; Ctx cx; cx.bid = blockIdx.x; cx.nb = nb; cx.wv = wv; OPQ_S(cx.bid); OPQ_S(cx.wv);
          constexpr size_t MG3C_OFF = (size_t)TL * D * 2;
          pg8::EpiResid E{(bf16_t*)WSP(WS_XS), (const float*)WSP(WS_MOD) + (size_t)l * 9 * 6144 + 2 * 1024, (float*)WSP(WS_PART), l ? (const void*)WSP(WS_XS) : (const void*)IN_(0), lds + LDS_CSH, l == 0, 0};
          if (!last) ph_gemm<5>(lds, (const bf16_t*)(WSP(WS_R3) + MG3C_OFF) - (size_t)TL * 3072, (const bf16_t*)WSP(WS_WO3) + (size_t)l * D * D, 3072, D, 512, 8, 4, E, nullptr, 0, 0, cx);
          ph_gemm<0>(lds, (const bf16_t*)WSP(WS_R3), (const bf16_t*)WSP(WS_WO3) + (size_t)l * D * D, D, D, D, 64, 4, E, nullptr, 0, 0, cx); }
        { Ctx cx; cx.bid = 0; cx.nb = nb; cx.wv = wv; OPQ_S(cx.wv); xcd_barrier(bar, cx); }
        { KPtr q = kp(); char* ws = q->ws; Ctx cx; cx.bid = blockIdx.x; cx.nb = nb; cx.wv = wv; OPQ_S(cx.bid); OPQ_S(cx.wv); const float* modl = (const float*)WSP(WS_MOD) + (size_t)l * 9 * 6144;
          NormArgs a; a.XS = (bf16_t*)WSP(WS_XS); a.lf32 = 0; a.cf32 = (l == 0); a.Xl = (const void*)WSP(WS_XS); a.Xc = l ? (const void*)WSP(WS_XS) : (const void*)(IN_(2) - (size_t)TL * D); a.H = (bf16_t*)WSP(WS_H); a.g = IN_(7) + l * D; a.mod_shift = modl + 3 * 1024; a.mod_scale = modl + 4 * 1024; a.nrows = nrows;
          a.Y = nullptr; a.POS = nullptr; a.TOPKp = nullptr; a.mod_g5prev = nullptr; a.router = IN_(19) + (size_t)j * D * 8; a.TOPK = (float*)WSP(WS_TOPK); a.cnt = (unsigned*)WSP(WS_CTL) + CW_CNT + j * 64;
          a.npart = 6; a.PART = last ? nullptr : (const float*)WSP(WS_PART); a.mod_gpart = modl + 2 * 1024;
          if (moe) ph_norm<true>(a, false, lds, cx); else ph_norm<false>(a, false, lds, cx); }
        if (moe && j == 0) {
            int rot = 0;
#pragma unroll 1
            for (int e = 0; e < NEXP; ++e) { KPtr q = kp(); char* ws = q->ws; Ctx cx; cx.bid = blockIdx.x; cx.nb = nb; cx.wv = wv; OPQ_S(cx.bid); OPQ_S(cx.wv); const size_t eo = ((size_t)j * NEXP + e) * D * DFF;
                ph_convert(mkjob(IN_(20) + eo, IN_(21) + eo, (bf16_t*)WSP(WS_WUPM) + (size_t)e * NUP * D, DFF, D, 0, D, NUP, 2), lds, cx, rot);
            }
        }
        { Ctx cx; cx.bid = 0; cx.nb = nb; cx.wv = wv; OPQ_S(cx.wv); xcd_barrier(bar, cx); }
        if (!moe) {
            { KPtr q = kp(); char* ws = q->ws; Ctx cx; cx.bid = blockIdx.x; cx.nb = nb; cx.wv = wv; OPQ_S(cx.bid); OPQ_S(cx.wv);
              pg8::EpiSwiglu E{(bf16_t*)WSP(WS_PH)}; ph_gemm<0>(lds, (const bf16_t*)WSP(WS_H), (const bf16_t*)WSP(WS_WUPD) + (size_t)j * NUP * D, D, D, D, nMr, NUP / 256, E, nullptr, 0, 0, cx); }
            { Ctx cx; cx.bid = 0; cx.nb = nb; cx.wv = wv; OPQ_S(cx.wv); xcd_barrier(bar, cx); }
            { KPtr q = kp(); char* ws = q->ws; Ctx cx; cx.bid = blockIdx.x; cx.nb = nb; cx.wv = wv; OPQ_S(cx.bid); OPQ_S(cx.wv);
              pg8::EpiResid E{(bf16_t*)WSP(WS_XS), (const float*)WSP(WS_MOD) + (size_t)l * 9 * 6144 + 5 * 1024, (float*)WSP(WS_PART), (const void*)WSP(WS_XS), lds + LDS_CSH, 0, 0}; ph_gemm<3, pg8::EpiResid, 1>(lds, (const bf16_t*)WSP(WS_PH), (const bf16_t*)WSP(WS_WDND) + (size_t)j * D * DFF, DFF, DFF, DFF, nMr, 4, E, nullptr, last ? 0 : 224, 0, cx); }
            { Ctx cx; cx.bid = 0; cx.nb = nb; cx.wv = wv; OPQ_S(cx.wv); xcd_barrier(bar, cx); }
        } else {
            { KPtr q = kp(); char* ws = q->ws; Ctx cx; cx.bid = blockIdx.x; cx.nb = nb; cx.wv = wv; OPQ_S(cx.bid); OPQ_S(cx.wv);
              ph_route((const float*)WSP(WS_TOPK), (const bf16_t*)WSP(WS_H), (bf16_t*)WSP(WS_R3), (int*)WSP(WS_POS), (unsigned*)WSP(WS_CTL), j, nrows, lds, cx); }
            { Ctx cx; cx.bid = 0; cx.nb = nb; cx.wv = wv; OPQ_S(cx.wv); xcd_barrier(bar, cx); }
            { KPtr q = kp(); char* ws = q->ws; Ctx cx; cx.bid = blockIdx.x; cx.nb = nb; cx.wv = wv; OPQ_S(cx.bid); OPQ_S(cx.wv);
              pg8::EpiSwiglu E{(bf16_t*)WSP(WS_PH)}; ph_gemm<2>(lds, (const bf16_t*)WSP(WS_R3), (const bf16_t*)WSP(WS_WUPM), D, D, D, 0, NUP / 256, E, (unsigned*)WSP(WS_CTL), j, (size_t)NUP * D, cx);
              { Ctx c2 = cx; if (idle_ctx((unsigned*)WSP(WS_CTL), j, NUP / 256, c2)) { int rot = 0;
#pragma unroll 1
                  for (int e = 0; e < NEXP; ++e) { const size_t eo = ((size_t)j * NEXP + e) * D * DFF; ph_convert(mkjob(IN_(22) + eo, nullptr, (bf16_t*)WSP(WS_WDNM) + (size_t)e * D * DFF, D, DFF, 0, DFF, D, 0), lds, c2, rot); } } } }
            { Ctx cx; cx.bid = 0; cx.nb = nb; cx.wv = wv; OPQ_S(cx.wv); xcd_barrier(bar, cx); }
            { KPtr q = kp(); char* ws = q->ws; Ctx cx; cx.bid = blockIdx.x; cx.nb = nb; cx.wv = wv; OPQ_S(cx.bid); OPQ_S(cx.wv);
              pg8::EpiBf16 E{(bf16_t*)WSP(WS_YB), lds + LDS_CSH, D, 0}; ph_gemm<2, pg8::EpiBf16, 1>(lds, (const bf16_t*)WSP(WS_PH), (const bf16_t*)WSP(WS_WDNM), DFF, DFF, DFF, 0, 4, E, (unsigned*)WSP(WS_CTL), j, (size_t)D * DFF, cx);
              if (j == 0) { Ctx c2 = cx; if (idle_ctx((unsigned*)WSP(WS_CTL), j, 4, c2)) { int rot = 0;
#pragma unroll 1
                  for (int e = 0; e < NEXP; ++e) { const size_t eo = ((size_t)NEXP + e) * D * DFF; ph_convert(mkjob(IN_(20) + eo, IN_(21) + eo, (bf16_t*)WSP(WS_WUPM) + (size_t)e * NUP * D, DFF, D, 0, D, NUP, 2), lds, c2, rot); } } } }
            { Ctx cx; cx.bid = 0; cx.nb = nb; cx.wv = wv; OPQ_S(cx.wv); xcd_barrier(bar, cx); }
        }
    }
    { KPtr q = kp(); char* ws = q->ws; Ctx cx; cx.bid = blockIdx.x; cx.nb = nb; cx.wv = wv; OPQ_S(cx.bid); OPQ_S(cx.wv);
      ph_final((const bf16_t*)WSP(WS_XS), (const bf16_t*)WSP(WS_YB), (const int*)WSP(WS_POS), (const float*)WSP(WS_TOPK), (const float*)WSP(WS_MOD) + (size_t)3 * 9 * 6144 + 5 * 1024, IN_(23), q->out, cx); }
}

extern "C" void kernel_launch(void* const* d_in, const int* in_sizes, int n_in, void* d_out, int out_size, void* d_ws, size_t ws_size, hipStream_t stream) {
    (void)in_sizes; (void)out_size;
    if (n_in != 24 || ws_size < WS_END) return;
    static int grid = 0;
    if (!grid) {
        int dev = 0, cus = 0, per_cu = 0;
        if (hipGetDevice(&dev) != hipSuccess || hipDeviceGetAttribute(&cus, hipDeviceAttributeMultiprocessorCount, dev) != hipSuccess) return;
        if (hipFuncSetAttribute((const void*)mk_fwd, hipFuncAttributeMaxDynamicSharedMemorySize, LDS_BYTES) != hipSuccess) return;
        if (hipOccupancyMaxActiveBlocksPerMultiprocessor(&per_cu, mk_fwd, 512, LDS_BYTES) != hipSuccess || per_cu < 1) return;
        if (cus != 256) return;
        grid = cus;
    }
    (void)hipMemsetAsync((char*)d_ws + WS_CTL, 0, CTL_BYTES, stream);
    MKP p;
    for (int i = 0; i < 24; ++i) p.in[i] = (const float*)d_in[i];
    p.out = (float*)d_out; p.ws = (char*)d_ws;
    hipLaunchKernelGGL(mk_fwd, dim3(grid), dim3(512), LDS_BYTES, stream, p);
}
```

```cpp
#include <hip/hip_runtime.h>
#include <stdint.h>
#include <stddef.h>

#define LAS __attribute__((address_space(3)))
typedef unsigned short bf16_t;
typedef short bf16x8 __attribute__((ext_vector_type(8)));
typedef float f32x4 __attribute__((ext_vector_type(4)));
typedef float f32x2 __attribute__((ext_vector_type(2)));
typedef unsigned u32x4 __attribute__((ext_vector_type(4)));
typedef unsigned u32x2 __attribute__((ext_vector_type(2)));

constexpr int D = 1024, NBATCH = 8, SEQ = 2048, CTXL = 256, DEPTH = 4;
constexpr int TL = NBATCH * SEQ, TC = NBATCH * CTXL, T = TL + TC;
constexpr int DIN = 6944, NP = 7168;
constexpr int DFF = 3584, NUP = 2 * DFF;
constexpr int NEXP = 8;
constexpr int MAXR = 2 * T + NEXP * 256;
constexpr int P_CB = 0, P_CC = 512, P_CU = 1024, P_QA = 1536, P_KA = 2048, P_VA = 2176, P_QG = 2304, P_KG = 2560, P_VG = 2816, P_RG = 3328, P_GATE = 3840, P_AG = 6912;
constexpr float EPS = 1e-6f;
constexpr float LOG2E = 1.4426950408889634f, QSCALE = 0.125f * LOG2E;

constexpr size_t al256(size_t x) { return (x + 255) & ~(size_t)255; }
constexpr size_t WS_CTL = 0;                                   constexpr size_t CTL_BYTES = 65536;
constexpr size_t WS_MOD = WS_CTL + CTL_BYTES;                  constexpr size_t MOD_BYTES = (size_t)DEPTH * 9 * 6 * D * 4;
constexpr size_t WS_CS = al256(WS_MOD + MOD_BYTES);            constexpr size_t CS_BYTES = 64 * 16 * 8;
constexpr size_t WS_XS = al256(WS_CS + CS_BYTES);              constexpr size_t XS_BYTES = (size_t)T * D * 4;
constexpr size_t WS_H = al256(WS_XS + XS_BYTES);               constexpr size_t H_BYTES = (size_t)T * D * 2;
constexpr size_t WS_PH = al256(WS_H + H_BYTES);                constexpr size_t PH_BYTES = (size_t)MAXR * DFF * 2;
constexpr size_t WS_BR = al256(WS_PH + PH_BYTES);              constexpr size_t BR_BYTES = (size_t)T * 1536 * 2;
constexpr size_t WS_R3 = al256(WS_BR + BR_BYTES);              constexpr size_t R3_BYTES = (size_t)T * 3072 * 2;
constexpr size_t WS_YB = al256(WS_R3 + R3_BYTES);              constexpr size_t YB_BYTES = (size_t)MAXR * D * 2;
constexpr size_t WS_QR = al256(WS_YB + YB_BYTES);              constexpr size_t QR_BYTES = (size_t)T * 512 * 2;
constexpr size_t WS_KV = al256(WS_QR + QR_BYTES);              constexpr size_t KV_BYTES = (size_t)T * 256 * 2;
constexpr size_t WS_TOPK = al256(WS_KV + KV_BYTES);            constexpr size_t TOPK_BYTES = (size_t)T * 16;
constexpr size_t WS_POS = al256(WS_TOPK + TOPK_BYTES);         constexpr size_t POS_BYTES = (size_t)T * 8;
constexpr size_t WS_IDX = al256(WS_POS + POS_BYTES);           constexpr size_t IDX_BYTES = (size_t)MAXR * 4;
constexpr size_t WS_DEC = al256(WS_IDX + IDX_BYTES);           constexpr size_t DEC_BYTES = (size_t)(T / 64) * 4 * 2 * 64 * 4;
constexpr size_t WS_PART = al256(WS_DEC + DEC_BYTES);         constexpr size_t PART_BYTES = (size_t)7 * TC * D * 4;
constexpr size_t WS_WIN = al256(WS_PART + PART_BYTES);           constexpr size_t WIN_BYTES = (size_t)DEPTH * NP * D * 2;
constexpr size_t WS_WBR = al256(WS_WIN + WIN_BYTES);           constexpr size_t WBR_BYTES = (size_t)DEPTH * D * 1536 * 2;
constexpr size_t WS_WO3 = al256(WS_WBR + WBR_BYTES);           constexpr size_t WO3_BYTES = (size_t)DEPTH * D * D * 2;
constexpr size_t WS_WUPD = al256(WS_WO3 + WO3_BYTES);          constexpr size_t WUPD_BYTES = (size_t)2 * NUP * D * 2;
constexpr size_t WS_WDND = al256(WS_WUPD + WUPD_BYTES);        constexpr size_t WDND_BYTES = (size_t)2 * D * DFF * 2;
constexpr size_t WS_WUPM = al256(WS_WDND + WDND_BYTES);        constexpr size_t WUPM_BYTES = (size_t)NEXP * NUP * D * 2;
constexpr size_t WS_WDNM = al256(WS_WUPM + WUPM_BYTES);        constexpr size_t WDNM_BYTES = (size_t)NEXP * D * DFF * 2;
constexpr size_t WS_END = al256(WS_WDNM + WDNM_BYTES);
constexpr int CW_CNT = 0;
constexpr int CW_FILL = 128;
constexpr int CW_TEXP = 1024;
constexpr int CW_NT = 1536;

typedef __bf16 bf16x2_t __attribute__((ext_vector_type(2)));
__device__ __forceinline__ unsigned cvt_pk_bf16(float lo, float hi) { const f32x2 v = {lo, hi}; return __builtin_bit_cast(unsigned, __builtin_convertvector(v, bf16x2_t)); }
__device__ __forceinline__ float bf_lo(unsigned w) { return __uint_as_float(w << 16); }
__device__ __forceinline__ float bf_hi(unsigned w) { return __uint_as_float(w & 0xffff0000u); }
__device__ __forceinline__ float bf2f(bf16_t b) { return __uint_as_float(((unsigned)b) << 16); }
__device__ __forceinline__ bf16_t f2bf(float f) { return (bf16_t)(cvt_pk_bf16(f, 0.f) & 0xffffu); }
__device__ __forceinline__ float sigmoidf_(float x) { return __builtin_amdgcn_rcpf(1.0f + __builtin_amdgcn_exp2f(x * -1.4426950408889634f)); }
__device__ __forceinline__ float siluf_(float x) { return x * __builtin_amdgcn_rcpf(1.0f + __builtin_amdgcn_exp2f(x * -1.4426950408889634f)); }
__device__ __forceinline__ float shx(float v, int mask, int lane) { return __int_as_float(__builtin_amdgcn_ds_bpermute((lane ^ mask) << 2, __float_as_int(v))); }
__device__ __forceinline__ float shl_(float v, int src) { return __int_as_float(__builtin_amdgcn_ds_bpermute(src << 2, __float_as_int(v))); }
__device__ __forceinline__ float wave_total(float v) {
    v += __int_as_float(__builtin_amdgcn_update_dpp(0, __float_as_int(v), 0x111, 0xF, 0xF, true));
    v += __int_as_float(__builtin_amdgcn_update_dpp(0, __float_as_int(v), 0x112, 0xF, 0xF, true));
    v += __int_as_float(__builtin_amdgcn_update_dpp(0, __float_as_int(v), 0x114, 0xF, 0xF, true));
    v += __int_as_float(__builtin_amdgcn_update_dpp(0, __float_as_int(v), 0x118, 0xF, 0xF, true));
    v += __int_as_float(__builtin_amdgcn_update_dpp(0, __float_as_int(v), 0x142, 0xA, 0xF, false));
    v += __int_as_float(__builtin_amdgcn_update_dpp(0, __float_as_int(v), 0x143, 0xC, 0xF, false));
    return __int_as_float(__builtin_amdgcn_readlane(__float_as_int(v), 63));
}
__device__ __forceinline__ float wave_sum(float v, int lane) {
#pragma unroll
    for (int o = 32; o >= 1; o >>= 1) v += shx(v, o, lane);
    return v;
}
__device__ __forceinline__ float wave_max(float v, int lane) {
#pragma unroll
    for (int o = 32; o >= 1; o >>= 1) v = fmaxf(v, shx(v, o, lane));
    return v;
}
__device__ __forceinline__ unsigned lds_add(LAS unsigned* p, unsigned v) { return __hip_atomic_fetch_add(p, v, __ATOMIC_RELAXED, __HIP_MEMORY_SCOPE_WORKGROUP); }
__device__ __forceinline__ f32x4 ldx_raw(const void* base, bool f32src, size_t idx) { if (f32src) return *(const f32x4*)((const float*)base + idx); const u32x2 w = *(const u32x2*)((const bf16_t*)base + idx); return (f32x4){__uint_as_float(w.x), __uint_as_float(w.y), 0.f, 0.f}; }
__device__ __forceinline__ f32x4 cvx(const f32x4 raw, bool f32src) { if (f32src) return raw; const unsigned a = __float_as_uint(raw[0]), b = __float_as_uint(raw[1]); return (f32x4){__uint_as_float(a << 16), __uint_as_float(a & 0xffff0000u), __uint_as_float(b << 16), __uint_as_float(b & 0xffff0000u)}; }
__device__ __forceinline__ void stx(bf16_t* p, const f32x4 v) { u32x2 w; w.x = cvt_pk_bf16(v[0], v[1]); w.y = cvt_pk_bf16(v[2], v[3]); *(u32x2*)p = w; }
__device__ __forceinline__ int mod_row(int row) { return row < TL ? (row >> 11) : 8; }
struct Ctx { int bid, nb, wv; };
__device__ __forceinline__ int tidx(const Ctx& cx) { int z = cx.wv << 6; asm volatile("" : "+s"(z)); return (int)__builtin_amdgcn_mbcnt_hi(~0u, __builtin_amdgcn_mbcnt_lo(~0u, (unsigned)z)); }
#define OPQ_S(x) asm volatile("" : "+s"(x))
__device__ __forceinline__ float row4_max(float v) { auto a = __builtin_amdgcn_permlane16_swap(__float_as_uint(v), __float_as_uint(v), false, false); v = fmaxf(__uint_as_float(a[0]), __uint_as_float(a[1]));
    auto b = __builtin_amdgcn_permlane32_swap(__float_as_uint(v), __float_as_uint(v), false, false); return fmaxf(__uint_as_float(b[0]), __uint_as_float(b[1])); }
__device__ __forceinline__ float row4_sum(float v) { auto a = __builtin_amdgcn_permlane16_swap(__float_as_uint(v), __float_as_uint(v), false, false); v = __uint_as_float(a[0]) + __uint_as_float(a[1]);
    auto b = __builtin_amdgcn_permlane32_swap(__float_as_uint(v), __float_as_uint(v), false, false); return __uint_as_float(b[0]) + __uint_as_float(b[1]); }

__device__ __forceinline__ u32x4 pack8(const float* v) { u32x4 w; w.x = cvt_pk_bf16(v[0], v[1]); w.y = cvt_pk_bf16(v[2], v[3]); w.z = cvt_pk_bf16(v[4], v[5]); w.w = cvt_pk_bf16(v[6], v[7]); return w; }
__device__ __forceinline__ void unpack8(const u32x4 w, float* v) { v[0] = bf_lo(w.x); v[1] = bf_hi(w.x); v[2] = bf_lo(w.y); v[3] = bf_hi(w.y); v[4] = bf_lo(w.z); v[5] = bf_hi(w.z); v[6] = bf_lo(w.w); v[7] = bf_hi(w.w); }
namespace pg8 {
constexpr int BM = 256, BK = 64, HALF = 128, HTB = HALF * BK * 2, STAGE_BYTES = 8 * HTB, NXCD = 8, WGM = 8;
constexpr int CSH_STR = 144, CSH_SLICE = 16 * CSH_STR;
__host__ __device__ __forceinline__ int lds_byte(int r, int c) { const int st = (r >> 4) * 2 + (c >> 5), rr = r & 15, cc = c & 31, ob = rr * 64 + cc * 2; return st * 1024 + (ob ^ (((ob >> 9) & 1) << 5)); }
__host__ __device__ __forceinline__ void stage_rc(int b, int& R, int& C) { const int st = b / 1024, sb = b % 1024, swz = sb ^ (((sb >> 9) & 1) << 5); R = (st >> 1) * 16 + swz / 64; C = (st & 1) * 32 + (swz % 64) / 2; }
__host__ __device__ __forceinline__ int perm32(int rho) { const int n = rho >> 4, i = rho & 15; return 8 * (i >> 2) + 4 * n + (i & 3); }
struct Unit { int pm, pn, kofs, kofsB, nt, part; };

__device__ __forceinline__ bool static_next(int i, int G, int c, int nM, int nN, Unit& u) {
    const int nwg = nM * nN; const long L = (long)i * G + c; if (L >= nwg) return false;
    int wgid = (int)L; { const int q = nwg / NXCD, r = nwg % NXCD, xcd = wgid % NXCD, off = wgid / NXCD; wgid = (xcd < r ? xcd * (q + 1) : r * (q + 1) + (xcd - r) * q) + off; }
    const int nig = WGM * nN, gid = wgid / nig, fm = gid * WGM, gsz = (nM - fm) < WGM ? (nM - fm) : WGM;
    u.pm = fm + ((wgid % nig) % gsz); u.pn = (wgid % nig) / gsz; return true;
}

template <int MODE> struct Prob {
    const bf16_t* A; const bf16_t* Bt; int lda, ldb, K, nM, nN, G, c; const LAS int* texp; size_t bexp; int nctx;
    __device__ __forceinline__ bool next(int i, Unit& u) const {
        u.kofs = 0; u.kofsB = 0; u.nt = K / BK; u.part = -1;
        if (MODE == 3) {
            const int idx = i + (c < nctx ? 0 : 1);
            if (idx == 0) { const int ct = c / 7; u.pm = 64 + (ct >> 2); u.pn = ct & 3; u.part = c - ct * 7; u.nt = K / (7 * BK); u.kofs = u.part * (K / 7); u.kofsB = u.kofs; return true; }
            return static_next(idx - 1, G, c, 64, 4, u);
        }
        if (MODE == 4) { const int seg = i % 3; u.kofs = seg * 512; u.kofsB = u.kofs; u.nt = 8; u.part = seg; return static_next(i / 3, G, c, 64, 4, u); }
        if (MODE == 5) { const int L = i * G + c; if (L >= 192) return false; const int ct = L / 6, sub = L - ct * 6; u.pm = 64 + (ct >> 2); u.pn = ct & 3; u.part = sub; u.nt = 8; u.kofs = (sub >> 1) * 1024 + (sub & 1) * 512; u.kofsB = (sub & 1) * 512; return true; }
        const bool ok = static_next(i, G, c, nM, nN, u);
        if (MODE == 1) { u.kofs = (u.pn >> 2) * 512; u.kofsB = u.kofs; }
        return ok;
    }
    __device__ __forceinline__ const char* a_base(const Unit& u, bool ablk) const { return (const char*)(A + (size_t)u.pm * BM * lda + (ablk ? 2 * u.kofs : u.kofs)); }
    __device__ __forceinline__ const char* b_base(const Unit& u) const { const bf16_t* p = Bt + (size_t)(MODE == 1 ? (u.pn & 3) : u.pn) * BM * ldb + 2 * u.kofsB; if (MODE == 2) p += (size_t)texp[u.pm] * bexp; return (const char*)p; }
};

template <class Epi, class PB, int ABLK>
__device__ __forceinline__ void gemm_phase(LAS unsigned char* lds, const PB& P, const Epi& E, const Ctx cx) {
    const int tid = tidx(cx), wid = __builtin_amdgcn_readfirstlane(tid >> 6), lane = tid & 63, wr = wid >> 2, wc = wid & 3, fr = lane & 15, fq = lane >> 4;
    unsigned voffA[2], voffB[2];
#pragma unroll
    for (int i = 0; i < 2; ++i) { int R, C; stage_rc(tid * 16 + i * 8192, R, C); const int Rb = (int)Epi::PERM == 2 ? (2 * (R & ~31) + perm32(R & 31)) : Epi::PERM ? ((R & ~31) + perm32(R & 31)) : R;
        voffA[i] = ABLK ? (unsigned)((((R >> 1) * (P.lda >> 5) + (C >> 5)) * 64 + (R & 1) * 32 + (C & 31)) * 2) : (unsigned)(R * P.lda + C) * 2u;     voffB[i] = (unsigned)((((Rb >> 1) * (P.ldb >> 5) + (C >> 5)) * 64 + (Rb & 1) * 32 + (C & 31)) * 2);     }
    const size_t kstep = (size_t)(BK * 4), kstepA = ABLK ? (size_t)(BK * 4) : (size_t)(BK * 2);
    const size_t hstepA = (size_t)HALF * P.lda * 2, hstepB = (size_t)((int)Epi::PERM == 2 ? 32 : HALF) * P.ldb * 2;
    const unsigned ldsw = (unsigned)wid * 1024u;
    const int aoff = lds_byte(wr * 64 + fr, fq * 8), boff = lds_byte(wc * 32 + fr, fq * 8);
#define PG8_SA(b, h) (((b) * 2 + (h)) * HTB)
#define PG8_SB(b, h) ((4 + (b) * 2 + (h)) * HTB)
#define PG8_STAGE(bufoff, gbase, voff) do { _Pragma("unroll") for (int _i = 0; _i < 2; ++_i) \
        __builtin_amdgcn_global_load_lds((const unsigned*)((const char*)(gbase) + (voff)[_i]), (LAS unsigned*)(lds + (bufoff) + ldsw + _i * 8192), 16, 0, 0); } while (0)
#define PG8_LDA(dst, b, h) do { _Pragma("unroll") for (int m = 0; m < 4; ++m) _Pragma("unroll") for (int k = 0; k < 2; ++k) dst[m][k] = *(const LAS bf16x8*)(lds + PG8_SA(b, h) + aoff + m * 2048 + k * 1024); } while (0)
#define PG8_LDB(dst, b, h) do { _Pragma("unroll") for (int n = 0; n < 2; ++n) _Pragma("unroll") for (int k = 0; k < 2; ++k) dst[n][k] = *(const LAS bf16x8*)(lds + PG8_SB(b, h) + boff + n * 2048 + k * 1024); } while (0)
#define PG8_MMA(ai, bj, At, Bt) do { __builtin_amdgcn_s_setprio(1); _Pragma("unroll") for (int m = 0; m < 4; ++m) _Pragma("unroll") for (int n = 0; n < 2; ++n) _Pragma("unroll") for (int k = 0; k < 2; ++k) \
        acc[ai][bj][m][n] = __builtin_amdgcn_mfma_f32_16x16x32_bf16(Bt[n][k], At[m][k], acc[ai][bj][m][n], 0, 0, 0); __builtin_amdgcn_s_setprio(0); } while (0)
#define PG8_WAIT_V(n) asm volatile("s_waitcnt vmcnt(" #n ")" ::: "memory")
#define PG8_WAIT_L(n) asm volatile("s_waitcnt lgkmcnt(" #n ")" ::: "memory")
#define PG8_BAR __builtin_amdgcn_s_barrier()
#define PG8_SCHED __builtin_amdgcn_sched_barrier(0)
    Unit cur, nxt; int ui = 0;
    if (!P.next(0, cur)) return;
    f32x4 acc[2][2][4][2];
#pragma unroll
    for (int a = 0; a < 2; ++a)
#pragma unroll
        for (int b = 0; b < 2; ++b)
#pragma unroll
            for (int m = 0; m < 4; ++m)
#pragma unroll
                for (int n = 0; n < 2; ++n) acc[a][b][m][n] = (f32x4){0.f, 0.f, 0.f, 0.f};
    bf16x8 At[4][2], B0[2][2], B1[2][2];
    const char* cA = P.a_base(cur, ABLK != 0); const char* cB = P.b_base(cur);
    PG8_STAGE(PG8_SB(0, 0), cB, voffB); PG8_STAGE(PG8_SB(0, 1), cB + hstepB, voffB); PG8_STAGE(PG8_SA(0, 0), cA, voffA); PG8_STAGE(PG8_SA(0, 1), cA + hstepA, voffA);
    if (wr == 1) PG8_BAR;
    PG8_WAIT_V(2); PG8_BAR;
    PG8_STAGE(PG8_SB(1, 0), cB + kstep, voffB); PG8_STAGE(PG8_SA(1, 0), cA + kstepA, voffA); PG8_STAGE(PG8_SB(1, 1), cB + hstepB + kstep, voffB);
    PG8_WAIT_V(6); PG8_BAR;
    for (;;) {
        const bool has_next = P.next(ui + 1, nxt);
        const char* nA = has_next ? P.a_base(nxt, ABLK != 0) : cA; const char* nB = has_next ? P.b_base(nxt) : cB;
        const int nt = cur.nt;
        for (int t = 0; t < nt; t += 2) {
            const bool last = (t == nt - 2);
            const char* a1 = cA + (size_t)(t + 1) * kstepA;
            const char* a2 = last ? nA : cA + (size_t)(t + 2) * kstepA; const char* b2 = last ? nB : cB + (size_t)(t + 2) * kstep;
            const char* a3 = a2 + kstepA; const char* b3 = b2 + kstep;
            PG8_LDB(B0, 0, 0); PG8_LDB(B1, 0, 1); PG8_SCHED; PG8_LDA(At, 0, 0); PG8_STAGE(PG8_SA(1, 1), a1 + hstepA, voffA);
            PG8_WAIT_V(8); PG8_WAIT_L(0); PG8_BAR; PG8_MMA(0, 0, At, B0); PG8_MMA(0, 1, At, B1); PG8_BAR; PG8_SCHED;
            PG8_LDA(At, 0, 1); PG8_STAGE(PG8_SB(0, 0), b2, voffB); PG8_STAGE(PG8_SB(0, 1), b2 + hstepB, voffB); PG8_STAGE(PG8_SA(0, 0), a2, voffA);
            PG8_WAIT_V(8); PG8_WAIT_L(0); PG8_BAR; PG8_MMA(1, 0, At, B0); PG8_MMA(1, 1, At, B1); PG8_BAR; PG8_SCHED;
            PG8_LDB(B0, 1, 0); PG8_LDB(B1, 1, 1); PG8_SCHED; PG8_LDA(At, 1, 0); PG8_STAGE(PG8_SA(0, 1), a2 + hstepA, voffA);
            PG8_WAIT_V(8); PG8_WAIT_L(0); PG8_BAR; PG8_MMA(0, 0, At, B0); PG8_MMA(0, 1, At, B1); PG8_BAR; PG8_SCHED;
            PG8_LDA(At, 1, 1); PG8_STAGE(PG8_SB(1, 0), b3, voffB); PG8_STAGE(PG8_SB(1, 1), b3 + hstepB, voffB); PG8_STAGE(PG8_SA(1, 0), a3, voffA);
            PG8_WAIT_V(8); PG8_WAIT_L(0); PG8_BAR; PG8_MMA(1, 0, At, B0); PG8_MMA(1, 1, At, B1); PG8_BAR; PG8_SCHED;
        }
        if (wr == 0) PG8_BAR;
        E(acc, cur, wr, wc, fr, fq);
        if (!has_next) break;
#pragma unroll
        for (int a = 0; a < 2; ++a)
#pragma unroll
            for (int b = 0; b < 2; ++b)
#pragma unroll
                for (int m = 0; m < 4; ++m)
#pragma unroll
                    for (int n = 0; n < 2; ++n) acc[a][b][m][n] = (f32x4){0.f, 0.f, 0.f, 0.f};
        cur = nxt; cA = nA; cB = nB; ++ui;
        if (wr == 1) PG8_BAR;
    }
    PG8_WAIT_V(0);
    PG8_BAR;
#undef PG8_SA
#undef PG8_SB
#undef PG8_STAGE
#undef PG8_LDA
#undef PG8_LDB
#undef PG8_MMA
#undef PG8_WAIT_V
#undef PG8_WAIT_L
#undef PG8_BAR
#undef PG8_SCHED
}

__device__ __forceinline__ void relay16(const f32x4 (&a)[2][2], LAS unsigned char* wp, const LAS unsigned char* rp, u32x4 (&x)[2]) {
#pragma unroll
    for (int bj = 0; bj < 2; ++bj) { u32x4 w; w.x = cvt_pk_bf16(a[bj][0][0], a[bj][0][1]); w.y = cvt_pk_bf16(a[bj][0][2], a[bj][0][3]); w.z = cvt_pk_bf16(a[bj][1][0], a[bj][1][1]); w.w = cvt_pk_bf16(a[bj][1][2], a[bj][1][3]);
        *(LAS u32x4*)(wp + bj * 64) = w; }
    asm volatile("" ::: "memory"); __builtin_amdgcn_wave_barrier();
    x[0] = *(const LAS u32x4*)rp; x[1] = *(const LAS u32x4*)(rp + 8 * CSH_STR);
    asm volatile("" ::: "memory"); __builtin_amdgcn_wave_barrier();
}
__device__ __forceinline__ u32x4 gate8x(const u32x4& x, const u32x4& g, const u32x4& o) {
    float xv[8], gv[8], ov[8]; unpack8(x, xv); unpack8(g, gv); unpack8(o, ov);
#pragma unroll
    for (int e = 0; e < 8; ++e) ov[e] += xv[e] * sigmoidf_(gv[e]);
    return pack8(ov);
}
struct EpiBf16 {
    static constexpr int PERM = 2;
    bf16_t* O; LAS unsigned char* sh; int ldc; int pad_;
    __device__ __forceinline__ void operator()(const f32x4 (&acc)[2][2][4][2], const Unit& u, int wr, int wc, int fr, int fq) const {
        LAS unsigned char* my = sh + (wr * 4 + wc) * CSH_SLICE; const int lane = fq * 16 + fr, r8 = lane >> 3, c8 = lane & 7;
        LAS unsigned char* wp = my + fr * CSH_STR + fq * 16; const LAS unsigned char* rp = my + r8 * CSH_STR + c8 * 16;
        bf16_t* ob = O + (size_t)(u.pm * BM + wr * 64 + r8) * ldc + u.pn * BM + wc * 64 + 8 * c8;
#pragma unroll
        for (int ai = 0; ai < 2; ++ai)
#pragma unroll
            for (int m = 0; m < 4; ++m) { u32x4 x[2];
                const f32x4 a[2][2] = {{acc[ai][0][m][0], acc[ai][0][m][1]}, {acc[ai][1][m][0], acc[ai][1][m][1]}};
                relay16(a, wp, rp, x);
                bf16_t* rowp = ob + (size_t)(ai * HALF + m * 16) * ldc;
                *(u32x4*)rowp = x[0]; *(u32x4*)(rowp + (size_t)8 * ldc) = x[1]; }
    }
};
struct EpiWin {
    static constexpr int PERM = 2;
    bf16_t* O; bf16_t* QR; bf16_t* KV; const f32x2* CS; LAS unsigned char* sh;
    __device__ __forceinline__ void operator()(const f32x4 (&acc)[2][2][4][2], const Unit& u, int wr, int wc, int fr, int fq) const {
        const int row0 = u.pm * BM + wr * 64 + fr;
        if (u.pn < 6 || u.pn > 8) {
            LAS unsigned char* my = sh + (wr * 4 + wc) * CSH_SLICE; const int lane = fq * 16 + fr, r8 = lane >> 3, c8 = lane & 7;
            LAS unsigned char* wp = my + fr * CSH_STR + fq * 16; const LAS unsigned char* rp = my + r8 * CSH_STR + c8 * 16;
            bf16_t* ob = O + (size_t)(u.pm * BM + wr * 64 + r8) * NP + u.pn * BM + wc * 64 + 8 * c8;
#pragma unroll
            for (int ai = 0; ai < 2; ++ai)
#pragma unroll
                for (int m = 0; m < 4; ++m) {
#pragma unroll
                    for (int bj = 0; bj < 2; ++bj) { const f32x4 v0 = acc[ai][bj][m][0], v1 = acc[ai][bj][m][1];
                        u32x4 w; w.x = cvt_pk_bf16(v0[0], v0[1]); w.y = cvt_pk_bf16(v0[2], v0[3]); w.z = cvt_pk_bf16(v1[0], v1[1]); w.w = cvt_pk_bf16(v1[2], v1[3]);
                        *(LAS u32x4*)(wp + bj * 64) = w; }
                    asm volatile("" ::: "memory"); __builtin_amdgcn_wave_barrier();
                    const u32x4 x0 = *(const LAS u32x4*)rp, x1 = *(const LAS u32x4*)(rp + 8 * CSH_STR);
                    asm volatile("" ::: "memory"); __builtin_amdgcn_wave_barrier();
                    bf16_t* rowp = ob + (size_t)(ai * HALF + m * 16) * NP;
                    *(u32x4*)rowp = x0; *(u32x4*)(rowp + (size_t)8 * NP) = x1; }
            return;
        }
        const bool lat = u.pm < 64; const bool isq = u.pn < 8; const bool rot = isq || wc < 2;
#pragma unroll
        for (int ai = 0; ai < 2; ++ai)
#pragma unroll
            for (int m = 0; m < 4; ++m) { const int row = row0 + ai * HALF + m * 16; const int sp = row & (SEQ - 1);
#pragma unroll
                for (int bj = 0; bj < 2; ++bj) { const f32x4 v0 = acc[ai][bj][m][0], v1 = acc[ai][bj][m][1]; float o[8];
                    const int ps = bj ? (sp & 63) : (sp >> 6);
                    f32x4 c01 = (f32x4){1.f, 0.f, 1.f, 0.f}, c23 = c01;
                    if (lat && rot) { const f32x4* cp = (const f32x4*)(CS + ps * 16 + 4 * fq); c01 = cp[0]; c23 = cp[1]; }
                    if (rot) {
                        o[0] = v0[0] * c01[0] - v0[1] * c01[1]; o[1] = v0[1] * c01[0] + v0[0] * c01[1]; o[2] = v0[2] * c01[2] - v0[3] * c01[3]; o[3] = v0[3] * c01[2] + v0[2] * c01[3];
                        o[4] = v1[0] * c23[0] - v1[1] * c23[1]; o[5] = v1[1] * c23[0] + v1[0] * c23[1]; o[6] = v1[2] * c23[2] - v1[3] * c23[3]; o[7] = v1[3] * c23[2] + v1[2] * c23[3];
                    } else { o[0] = v0[0]; o[1] = v0[1]; o[2] = v0[2]; o[3] = v0[3]; o[4] = v1[0]; o[5] = v1[1]; o[6] = v1[2]; o[7] = v1[3]; }
                    u32x4 w;
                    if (isq) { w.x = cvt_pk_bf16(o[0] * QSCALE, o[1] * QSCALE); w.y = cvt_pk_bf16(o[2] * QSCALE, o[3] * QSCALE); w.z = cvt_pk_bf16(o[4] * QSCALE, o[5] * QSCALE); w.w = cvt_pk_bf16(o[6] * QSCALE, o[7] * QSCALE);
                        *(u32x4*)(QR + (size_t)row * 512 + (u.pn - 6) * 256 + wc * 64 + bj * 32 + 8 * fq) = w; }
                    else { w.x = cvt_pk_bf16(o[0], o[1]); w.y = cvt_pk_bf16(o[2], o[3]); w.z = cvt_pk_bf16(o[4], o[5]); w.w = cvt_pk_bf16(o[6], o[7]);
                        *(u32x4*)(KV + (size_t)row * 256 + wc * 64 + bj * 32 + 8 * fq) = w; } } }
    }
};
__device__ __forceinline__ u32x4 gate8(const f32x4& v0, const f32x4& v1, const u32x4& g) {
    u32x4 w;
    w.x = cvt_pk_bf16(v0[0] * sigmoidf_(bf_lo(g.x)), v0[1] * sigmoidf_(bf_hi(g.x))); w.y = cvt_pk_bf16(v0[2] * sigmoidf_(bf_lo(g.y)), v0[3] * sigmoidf_(bf_hi(g.y)));
    w.z = cvt_pk_bf16(v1[0] * sigmoidf_(bf_lo(g.z)), v1[1] * sigmoidf_(bf_hi(g.z))); w.w = cvt_pk_bf16(v1[2] * sigmoidf_(bf_lo(g.w)), v1[3] * sigmoidf_(bf_hi(g.w))); return w; }
__device__ __forceinline__ u32x4 gate8acc(const f32x4& v0, const f32x4& v1, const u32x4& g, const u32x4& o) {
    u32x4 w;
    w.x = cvt_pk_bf16(bf_lo(o.x) + v0[0] * sigmoidf_(bf_lo(g.x)), bf_hi(o.x) + v0[1] * sigmoidf_(bf_hi(g.x))); w.y = cvt_pk_bf16(bf_lo(o.y) + v0[2] * sigmoidf_(bf_lo(g.y)), bf_hi(o.y) + v0[3] * sigmoidf_(bf_hi(g.y)));
    w.z = cvt_pk_bf16(bf_lo(o.z) + v1[0] * sigmoidf_(bf_lo(g.z)), bf_hi(o.z) + v1[1] * sigmoidf_(bf_hi(g.z))); w.w = cvt_pk_bf16(bf_lo(o.w) + v1[2] * sigmoidf_(bf_lo(g.w)), bf_hi(o.w) + v1[3] * sigmoidf_(bf_hi(g.w))); return w; }
struct EpiGate {
    static constexpr int PERM = 2;
    bf16_t* O; const bf16_t* Pg; LAS unsigned char* sh;
    __device__ __forceinline__ void operator()(const f32x4 (&acc)[2][2][4][2], const Unit& u, int wr, int wc, int fr, int fq) const {
        LAS unsigned char* my = sh + (wr * 4 + wc) * CSH_SLICE; const int lane = fq * 16 + fr, r8 = lane >> 3, c8 = lane & 7;
        LAS unsigned char* wp = my + fr * CSH_STR + fq * 16; const LAS unsigned char* rp = my + r8 * CSH_STR + c8 * 16;
        const int rowb = u.pm * BM + wr * 64 + r8, colb = u.pn * BM + wc * 64 + 8 * c8;
#pragma unroll
        for (int ai = 0; ai < 2; ++ai)
#pragma unroll
            for (int m = 0; m < 4; ++m) { const size_t row = (size_t)(rowb + ai * HALF + m * 16);
                u32x4 g[2], x[2];
#pragma unroll
                for (int hh = 0; hh < 2; ++hh) g[hh] = *(const u32x4*)(Pg + (row + 8 * hh) * NP + P_GATE + colb);
                const f32x4 a[2][2] = {{acc[ai][0][m][0], acc[ai][0][m][1]}, {acc[ai][1][m][0], acc[ai][1][m][1]}};
                relay16(a, wp, rp, x);
#pragma unroll
                for (int hh = 0; hh < 2; ++hh) *(u32x4*)(O + (row + 8 * hh) * 3072 + colb) = gate8x(x[hh], g[hh], (u32x4){0u, 0u, 0u, 0u}); }
    }
};
struct EpiMerge {
    static constexpr int PERM = 2;
    bf16_t* MG; const bf16_t* Pg; LAS unsigned char* sh;
    __device__ __forceinline__ void operator()(const f32x4 (&acc)[2][2][4][2], const Unit& u, int wr, int wc, int fr, int fq) const {
        LAS unsigned char* my = sh + (wr * 4 + wc) * CSH_SLICE; const int lane = fq * 16 + fr, r8 = lane >> 3, c8 = lane & 7;
        LAS unsigned char* wp = my + fr * CSH_STR + fq * 16; const LAS unsigned char* rp = my + r8 * CSH_STR + c8 * 16;
        const int rowb = u.pm * BM + wr * 64 + r8, colb = u.pn * BM + wc * 64 + 8 * c8; const int gcol = P_GATE + u.part * 1024 + colb;
#pragma unroll
        for (int ai = 0; ai < 2; ++ai)
#pragma unroll
            for (int m = 0; m < 4; ++m) { const size_t row = (size_t)(rowb + ai * HALF + m * 16);
                u32x4 g[2], o[2], x[2];
#pragma unroll
                for (int hh = 0; hh < 2; ++hh) { g[hh] = *(const u32x4*)(Pg + (row + 8 * hh) * NP + gcol); o[hh] = u.part ? *(const u32x4*)(MG + (row + 8 * hh) * D + colb) : (u32x4){0u, 0u, 0u, 0u}; }
                const f32x4 a[2][2] = {{acc[ai][0][m][0], acc[ai][0][m][1]}, {acc[ai][1][m][0], acc[ai][1][m][1]}};
                relay16(a, wp, rp, x);
#pragma unroll
                for (int hh = 0; hh < 2; ++hh) *(u32x4*)(MG + (row + 8 * hh) * D + colb) = gate8x(x[hh], g[hh], o[hh]); }
    }
};
struct EpiResid {
    static constexpr int PERM = 2;
    bf16_t* X; const float* modg; float* PART; const void* Xold; LAS unsigned char* sh; int oldf32; int pad_;
    __device__ __forceinline__ void operator()(const f32x4 (&acc)[2][2][4][2], const Unit& u, int wr, int wc, int fr, int fq) const {
        if (u.part >= 0) {
            LAS unsigned char* my = sh + (wr * 4 + wc) * CSH_SLICE; const int lane = fq * 16 + fr, r8 = lane >> 3, c8 = lane & 7;
            LAS unsigned char* wp = my + fr * CSH_STR + fq * 32; const LAS unsigned char* rp = my + r8 * CSH_STR + c8 * 16;
            float* pb = PART + ((size_t)u.part * TC + (u.pm * BM + wr * 64 + r8 - TL)) * D + u.pn * BM + wc * 64 + 4 * c8;
#pragma unroll
            for (int ai = 0; ai < 2; ++ai)
#pragma unroll
                for (int m = 0; m < 4; ++m) { float* rowp = pb + (size_t)(ai * HALF + m * 16) * D;
#pragma unroll
                    for (int bj = 0; bj < 2; ++bj) {
                        *(LAS f32x4*)wp = acc[ai][bj][m][0]; *(LAS f32x4*)(wp + 16) = acc[ai][bj][m][1];
                        asm volatile("" ::: "memory"); __builtin_amdgcn_wave_barrier();
                        const f32x4 x0 = *(const LAS f32x4*)rp, x1 = *(const LAS f32x4*)(rp + 8 * CSH_STR);
                        asm volatile("" ::: "memory"); __builtin_amdgcn_wave_barrier();
                        *(f32x4*)(rowp + bj * 32) = x0; *(f32x4*)(rowp + (size_t)8 * D + bj * 32) = x1; } }
            return;
        }
        const float* mg = modg + (size_t)mod_row(u.pm * BM) * 6144 + u.pn * BM + wc * 64 + 8 * fq;
        f32x4 gv[2][2];
#pragma unroll
        for (int bj = 0; bj < 2; ++bj)
#pragma unroll
            for (int n = 0; n < 2; ++n) gv[bj][n] = *(const f32x4*)(mg + bj * 32 + n * 4);
        LAS unsigned char* my = sh + (wr * 4 + wc) * CSH_SLICE; const int lane = fq * 16 + fr, r8 = lane >> 3, c8 = lane & 7;
        LAS unsigned char* wp = my + fr * CSH_STR + fq * 16; const LAS unsigned char* rp = my + r8 * CSH_STR + c8 * 16;
        const size_t ro0 = (size_t)(u.pm * BM + wr * 64 + r8) * D + u.pn * BM + wc * 64 + 8 * c8;
#pragma unroll
        for (int ai = 0; ai < 2; ++ai)
#pragma unroll
            for (int m = 0; m < 4; ++m) { const size_t ro = ro0 + (size_t)(ai * HALF + m * 16) * D;
                f32x4 oa[2][2];
#pragma unroll
                for (int hh = 0; hh < 2; ++hh) { const size_t rr = ro + (size_t)hh * 8 * D;
                    if (oldf32) { oa[hh][0] = *(const f32x4*)((const float*)Xold + rr); oa[hh][1] = *(const f32x4*)((const float*)Xold + rr + 4); }
                    else { const u32x4 w = *(const u32x4*)((const bf16_t*)Xold + rr); oa[hh][0] = (f32x4){__uint_as_float(w.x), __uint_as_float(w.y), __uint_as_float(w.z), __uint_as_float(w.w)}; oa[hh][1] = oa[hh][0]; } }
#pragma unroll
                for (int bj = 0; bj < 2; ++bj) { const f32x4 v0 = gv[bj][0] * acc[ai][bj][m][0], v1 = gv[bj][1] * acc[ai][bj][m][1];
                    u32x4 w; w.x = cvt_pk_bf16(v0[0], v0[1]); w.y = cvt_pk_bf16(v0[2], v0[3]); w.z = cvt_pk_bf16(v1[0], v1[1]); w.w = cvt_pk_bf16(v1[2], v1[3]);
                    *(LAS u32x4*)(wp + bj * 64) = w; }
                asm volatile("" ::: "memory"); __builtin_amdgcn_wave_barrier();
                u32x4 dx[2]; dx[0] = *(const LAS u32x4*)rp; dx[1] = *(const LAS u32x4*)(rp + 8 * CSH_STR);
                asm volatile("" ::: "memory"); __builtin_amdgcn_wave_barrier();
#pragma unroll
                for (int hh = 0; hh < 2; ++hh) { float o[8], dl[8]; unpack8(dx[hh], dl);
                    if (oldf32) { o[0] = oa[hh][0][0]; o[1] = oa[hh][0][1]; o[2] = oa[hh][0][2]; o[3] = oa[hh][0][3]; o[4] = oa[hh][1][0]; o[5] = oa[hh][1][1]; o[6] = oa[hh][1][2]; o[7] = oa[hh][1][3]; }
                    else { u32x4 w; w.x = __float_as_uint(oa[hh][0][0]); w.y = __float_as_uint(oa[hh][0][1]); w.z = __float_as_uint(oa[hh][0][2]); w.w = __float_as_uint(oa[hh][0][3]); unpack8(w, o); }
#pragma unroll
                    for (int e = 0; e < 8; ++e) o[e] += dl[e];
                    *(u32x4*)(X + ro + (size_t)hh * 8 * D) = pack8(o); } }
    }
};
struct EpiSwiglu {
    static constexpr bool PERM = true;
    bf16_t* O;
    __device__ __forceinline__ void operator()(const f32x4 (&acc)[2][2][4][2], const Unit& u, int wr, int wc, int fr, int fq) const {
        const int row0 = u.pm * BM + wr * 64 + fr; const int chunk = u.pn * 4 + wc;
#pragma unroll
        for (int ai = 0; ai < 2; ++ai)
#pragma unroll
            for (int m = 0; m < 4; ++m) { const int row = row0 + ai * HALF + m * 16; bf16_t* rowp = O + ((size_t)(row >> 1) * (DFF / 32) + chunk) * 64 + (row & 1) * 32 + 8 * fq;
                const f32x4 a0 = acc[ai][0][m][0], a1 = acc[ai][0][m][1], b0 = acc[ai][1][m][0], b1 = acc[ai][1][m][1];
                u32x4 w; w.x = cvt_pk_bf16(siluf_(a0[0]) * b0[0], siluf_(a0[1]) * b0[1]); w.y = cvt_pk_bf16(siluf_(a0[2]) * b0[2], siluf_(a0[3]) * b0[3]);
                w.z = cvt_pk_bf16(siluf_(a1[0]) * b1[0], siluf_(a1[1]) * b1[1]); w.w = cvt_pk_bf16(siluf_(a1[2]) * b1[2], siluf_(a1[3]) * b1[3]);
                *(u32x4*)rowp = w; }
    }
};
}

#define XB_TMO      128
#define XB_XCNT(j)  (256  + 64 * (j))
#define XB_XSUB(j)  (1280 + 64 * (j))
#define XB_XGEN(j)  (2304 + 64 * (j))
#define XB_TOP      3328
#define XB_TOPGEN   3392
#define XCD_BAR_WORDS 3456
#define XB_SPIN_CAP (1u << 18)
__device__ __forceinline__ unsigned xb_ld(unsigned* p)              { return __hip_atomic_load(p, __ATOMIC_RELAXED, __HIP_MEMORY_SCOPE_AGENT); }
__device__ __forceinline__ unsigned xb_add(unsigned* p, unsigned v) { return __hip_atomic_fetch_add(p, v, __ATOMIC_RELAXED, __HIP_MEMORY_SCOPE_AGENT); }
__device__ __forceinline__ unsigned xb_xcc_id() { return (unsigned)__builtin_amdgcn_s_getreg((3 << 11) | 20) & 0xFu; }
#define XB_SPIN(cond, bar) do { unsigned _sp = 0; while (cond) { __builtin_amdgcn_s_sleep(1); \
    if ((++_sp & 255u) == 0u) { if (xb_ld(&(bar)[XB_TMO])) break; if (_sp > XB_SPIN_CAP) { atomicAdd(&(bar)[XB_TMO], 1u); break; } } } } while (0)
struct XcdBarrier { unsigned* bar; unsigned x; volatile LAS unsigned* st; };
__device__ __forceinline__ XcdBarrier xcd_barrier_post(unsigned* bar, volatile LAS unsigned* st) {
    XcdBarrier b; b.bar = bar; b.x = (unsigned)__builtin_amdgcn_readfirstlane((int)xb_xcc_id()); b.st = st;
    if (threadIdx.x == 0) (void)xb_add(&bar[XB_XCNT(b.x)], 1u);
    return b;
}
__device__ __forceinline__ void xcd_barrier_complete(unsigned* bar, unsigned x, unsigned& nloc, unsigned& nx) {
    const unsigned G = gridDim.x * gridDim.y * gridDim.z;
    unsigned sum, cnt, mine, sp = 0u;
    for (;;) {
        sum = 0u; cnt = 0u; mine = 0u;
#pragma unroll
        for (unsigned j = 0; j < 16; ++j) { const unsigned c = xb_ld(&bar[XB_XCNT(j)]); sum += c; cnt += (c > 0u) ? 1u : 0u; mine = (j == x) ? c : mine; }
        if (sum == G) break;
        __builtin_amdgcn_s_sleep(1);
        if ((++sp & 255u) == 0u) { if (xb_ld(&bar[XB_TMO])) break; if (sp > XB_SPIN_CAP) { atomicAdd(&bar[XB_TMO], 1u); break; } }
    }
    nloc = mine > 0u ? mine : 1u; nx = cnt > 0u ? cnt : 1u;
}
template <bool FIRST> __device__ __forceinline__ void xcd_barrier_t(const XcdBarrier& b, const Ctx cx) {
    asm volatile("s_waitcnt vmcnt(0)" ::: "memory");
    __syncthreads();
    if (tidx(cx) == 0) {
        unsigned* bar = b.bar; unsigned bx = b.x; OPQ_S(bar); OPQ_S(bx);
        __builtin_amdgcn_s_waitcnt(0);
        unsigned nloc = b.st[0], nx = b.st[1];
        if (FIRST) { if (nloc == 0u) { xcd_barrier_complete(bar, bx, nloc, nx); b.st[0] = nloc; b.st[1] = nx; } }
        const unsigned old = xb_add(&bar[XB_XSUB(bx)], 1u);
        const unsigned gen = old / nloc;
        if (old + 1u == (gen + 1u) * nloc) {
            __builtin_amdgcn_fence(__ATOMIC_RELEASE, "agent");
            asm volatile("s_waitcnt vmcnt(0)" ::: "memory");
            const unsigned og = xb_add(&bar[XB_TOP], 1u);
            const unsigned tg = og / nx;
            if (og + 1u == (tg + 1u) * nx) xb_add(&bar[XB_TOPGEN], 1u);
            else XB_SPIN(xb_ld(&bar[XB_TOPGEN]) == tg, bar);
            __builtin_amdgcn_fence(__ATOMIC_ACQUIRE, "agent");
            xb_add(&bar[XB_XGEN(bx)], 1u);
            asm volatile("s_waitcnt vmcnt(0)" ::: "memory");
        } else {
            XB_SPIN(xb_ld(&bar[XB_XGEN(bx)]) == gen, bar);
            __builtin_amdgcn_fence(__ATOMIC_ACQUIRE, "agent");
            asm volatile("s_waitcnt vmcnt(0)" ::: "memory");
        }
    }
    __syncthreads();
}
__device__ __forceinline__ void xcd_barrier_first(const XcdBarrier& b, const Ctx cx) { xcd_barrier_t<true>(b, cx); }
__device__ __forceinline__ void xcd_barrier(const XcdBarrier& b, const Ctx cx) { xcd_barrier_t<false>(b, cx); }

constexpr int LDS_TEXP = 139264, LDS_BARW = LDS_TEXP + 1024, LDS_SBASE = LDS_BARW + 16, LDS_CSH = LDS_SBASE + 64 + 176 + 256, LDS_BYTES = LDS_CSH + 8 * pg8::CSH_SLICE;
constexpr int CW_BAR = 4096;

#define MMA16(acc, afrag, bfrag) acc = __builtin_amdgcn_mfma_f32_16x16x32_bf16(bfrag, afrag, acc, 0, 0, 0)
typedef short s16x4 __attribute__((ext_vector_type(4)));
constexpr int STR64 = 144, STR128 = 272;
__device__ __forceinline__ bf16x8 frag_row(const LAS unsigned char* img, int r, int k0, int stride) { return *(const LAS bf16x8*)(img + r * stride + k0 * 2); }
__device__ __forceinline__ bf16x8 frag_tr(const LAS unsigned char* img, int rowlo, int rowhi, int x0, int stride, int fr) {
    const int q = fr >> 2, p = fr & 3;
    const s16x4 lo = __builtin_amdgcn_ds_read_tr16_b64_v4i16((LAS s16x4*)(img + (rowlo + q) * stride + x0 * 2 + 8 * p));
    const s16x4 hi = __builtin_amdgcn_ds_read_tr16_b64_v4i16((LAS s16x4*)(img + (rowhi + q) * stride + x0 * 2 + 8 * p));
    return __builtin_shufflevector(lo, hi, 0, 1, 2, 3, 4, 5, 6, 7);
}

struct CvtJob { const float* s0; const float* s1; bf16_t* dst; int ldw, ldd, kd0, K, Nd, kind; };
__device__ __forceinline__ CvtJob mkjob(const float* s0, const float* s1, bf16_t* dst, int ldw, int ldd, int kd0, int K, int Nd, int kind) { CvtJob j; j.s0 = s0; j.s1 = s1; j.dst = dst; j.ldw = ldw; j.ldd = ldd; j.kd0 = kd0; j.K = K; j.Nd = Nd; j.kind = kind; return j; }
constexpr int CV_STR = 144;
__device__ __forceinline__ void cvt_src(const CvtJob& j, int n0, int n, const float*& src, int& col) {
    const int nh = n0 + (n & 32); src = j.s0; int sc = nh;
    if (j.kind == 1) { sc = nh < 3840 ? nh : (nh < 6912 ? nh + 32 : (nh < 6944 ? nh - 3072 : -1)); }
    else if (j.kind == 2) { const int tj = nh >> 8, r = nh & 255; if (r < 128) { sc = tj * 128 + r; } else { src = j.s1; sc = tj * 128 + r - 128; } }
    col = sc < 0 ? -1 : sc + (n & 31);
}
__device__ __forceinline__ void ph_convert(const CvtJob& j, LAS unsigned char* lds, const Ctx cx, int& rot) {
    const int tid = tidx(cx), c16 = tid & 15, kr = tid >> 4, lane = tid & 63, wid = tid >> 6, fr = lane & 15, fq = lane >> 4;
    const int kch = j.K / 256, nitems = (j.Nd / 64) * kch;
    int first = cx.bid - rot; if (first < 0) first += cx.nb;
    f32x4 v[8];
    auto issue = [&](int it) { const int nbk = it / kch, kc = it % kch, n0 = nbk * 64, k0 = kc * 256; const float* src; int col; cvt_src(j, n0, c16 * 4, src, col);
#pragma unroll
        for (int p = 0; p < 8; ++p) v[p] = col >= 0 ? *(const f32x4*)(src + (size_t)(k0 + p * 32 + kr) * j.ldw + col) : (f32x4){0.f, 0.f, 0.f, 0.f}; };
    if (first < nitems) issue(first);
    for (int it = first; it < nitems; it += cx.nb) {
        const int nbk = it / kch, kc = it % kch, n0 = nbk * 64, k0 = kc * 256;
        if (j.kind == 1 && n0 >= P_QA && n0 < P_VA) {
            const int e = (c16 * 4) & 31, blk = (c16 * 4) & 32;
#pragma unroll
            for (int p = 0; p < 8; ++p) { const unsigned w0 = cvt_pk_bf16(v[p][0], v[p][1]), w1 = cvt_pk_bf16(v[p][2], v[p][3]); LAS bf16_t* rowp = (LAS bf16_t*)(lds + (p * 32 + kr) * CV_STR) + blk;
#pragma unroll
                for (int q = 0; q < 4; ++q) { const int ee = e + q, pos = ee < 16 ? 2 * ee : 2 * (ee - 16) + 1; const unsigned w = q < 2 ? w0 : w1; rowp[pos] = (bf16_t)((q & 1) ? (w >> 16) : (w & 0xffffu)); } }
        } else {
#pragma unroll
        for (int p = 0; p < 8; ++p) { u32x2 w; w.x = cvt_pk_bf16(v[p][0], v[p][1]); w.y = cvt_pk_bf16(v[p][2], v[p][3]); *(LAS u32x2*)(lds + (p * 32 + kr) * CV_STR + c16 * 8) = w; }
        }
        __syncthreads();
        if (it + cx.nb < nitems) issue(it + cx.nb);
        { const int kq = wid & 3, nh = wid >> 2, r8 = lane >> 3, c8 = lane & 7;
          LAS unsigned char* my = lds + 256 * CV_STR + wid * (16 * CV_STR); LAS unsigned char* wp = my + fr * CV_STR + fq * 16; const LAS unsigned char* rp = my + (2 * r8 + (c8 >> 2)) * CV_STR + (c8 & 3) * 16;
#pragma unroll
          for (int q = 0; q < 2; ++q) { const int nb = nh * 2 + q;
              const bf16x8 oa = frag_tr(lds, (8 * kq + fq) * 8, (8 * kq + fq) * 8 + 4, nb * 16, CV_STR, fr), ob = frag_tr(lds, (8 * kq + 4 + fq) * 8, (8 * kq + 4 + fq) * 8 + 4, nb * 16, CV_STR, fr);
              *(LAS bf16x8*)wp = oa; *(LAS bf16x8*)(wp + 64) = ob;
              asm volatile("" ::: "memory"); __builtin_amdgcn_wave_barrier();
              const bf16x8 x0 = *(const LAS bf16x8*)rp, x1 = *(const LAS bf16x8*)(rp + 64);
              asm volatile("" ::: "memory"); __builtin_amdgcn_wave_barrier();
              bf16_t* dp = j.dst + ((size_t)(((n0 + nb * 16) >> 1) + r8) * (j.ldd >> 5) + ((j.kd0 + k0 + 64 * kq) >> 5)) * 64 + 8 * c8;
              *(bf16x8*)dp = x0; *(bf16x8*)(dp + 64) = x1; } }
        __syncthreads();
    }
    rot = (rot + nitems) % cx.nb;
}

__device__ __forceinline__ void ph_init(const float* x, const float* ctx, float* XS, f32x2* CS, const Ctx cx) {
    (void)x; (void)ctx; (void)XS;
    if (cx.bid == cx.nb - 1) for (int i = tidx(cx); i < 64 * 16; i += 512) { const int pos = i >> 4, f = i & 15; const float inv = powf(10000.0f, -(float)f / 16.0f); const float a = (float)pos * inv; CS[i] = (f32x2){cosf(a), sinf(a)}; }
}
__device__ __forceinline__ void ph_mod(const float* c, const float* c_ctx, const float* w_mod, const float* b_mod, float* MOD, LAS unsigned char* lds, const Ctx cx) {
    if (cx.bid >= DEPTH * 48) return;
    LAS float* sv = (LAS float*)lds; LAS float* red = sv + 9 * 1024;
    const int tid = tidx(cx);
    for (int i = tid; i < 9 * 1024; i += 512) { const float v = i < 8192 ? c[i] : c_ctx[i - 8192]; sv[i] = siluf_(v); }
    __syncthreads();
    const int c4 = (tid & 31) * 4, kg = tid >> 5;
    for (int it = cx.bid; it < DEPTH * 48; it += cx.nb) {
        const int l = it / 48, n0 = (it % 48) * 128;
        const float* w = w_mod + ((size_t)l * D + kg * 64) * 6144 + n0 + c4;
        f32x4 a[9];
#pragma unroll
        for (int r = 0; r < 9; ++r) a[r] = (f32x4){0.f, 0.f, 0.f, 0.f};
#pragma unroll 1
        for (int k0 = 0; k0 < 64; k0 += 8) { f32x4 wv[8];
#pragma unroll
            for (int u = 0; u < 8; ++u) wv[u] = *(const f32x4*)(w + (size_t)(k0 + u) * 6144);
#pragma unroll
            for (int u = 0; u < 8; ++u)
#pragma unroll
                for (int r = 0; r < 9; ++r) a[r] = a[r] + wv[u] * sv[r * 1024 + kg * 64 + k0 + u]; }
#pragma unroll
        for (int r = 0; r < 9; ++r) *(LAS f32x4*)(red + (kg * 9 + r) * 128 + c4) = a[r];
        __syncthreads();
        for (int i = tid; i < 9 * 128; i += 512) { const int r = i >> 7, cc = i & 127; float sacc = b_mod[(size_t)l * 6144 + n0 + cc];
#pragma unroll
            for (int g = 0; g < 16; ++g) sacc += red[(g * 9 + r) * 128 + cc];
            MOD[((size_t)l * 9 + r) * 6144 + n0 + cc] = sacc; }
        __syncthreads();
    }
}

struct NormArgs { bf16_t* XS; const void* Xl; const void* Xc; int lf32, cf32; bf16_t* H;
                  const float* g; const float* mod_shift; const float* mod_scale;
                  const bf16_t* Y; const int* POS; const float* TOPKp; const float* mod_g5prev;
                  const float* router; float* TOPK; unsigned* cnt; int nrows;
                  const float* PART; const float* mod_gpart; int npart; };
template <bool ROUTE> __device__ __forceinline__ void ph_norm(const NormArgs& a, bool combine, LAS unsigned char* lds, const Ctx cx) {
    const int lane = tidx(cx) & 63, wid = tidx(cx) >> 6;
    LAS unsigned* hist = (LAS unsigned*)(lds + LDS_SBASE);
    LAS float* rtab = (LAS float*)lds;
    if (ROUTE) { __syncthreads(); if (tidx(cx) < 8) hist[tidx(cx)] = 0u;
        for (int f = tidx(cx); f < 8192; f += 512) { const int e = f & 7, ln = (f >> 3) & 63, jq = f >> 9; rtab[f] = a.router[(size_t)(4 * (ln + 64 * (jq >> 2)) + (jq & 3)) * 8 + e]; }
        __syncthreads(); }
    f32x4 gq[4];
#pragma unroll
    for (int j = 0; j < 4; ++j) gq[j] = *(const f32x4*)(a.g + 4 * (lane + 64 * j));
    f32x4 xn[4];
    { const int r0 = cx.bid * 8 + wid; if (r0 < a.nrows) { const bool f = r0 < TL ? a.lf32 : a.cf32; const void* rp = r0 < TL ? a.Xl : a.Xc;
#pragma unroll
        for (int j = 0; j < 4; ++j) xn[j] = ldx_raw(rp, f, (size_t)r0 * D + 4 * (lane + 64 * j)); } }
    int cs1 = 0, cs2 = 0; float cp1 = 0.f, cp2 = 0.f; u32x2 y1n[4], y2n[4];
    if (combine) { const int rk = cx.bid * 8 + wid + lane * (cx.nb * 8);
        if (rk < a.nrows) { cs1 = a.POS[2 * rk]; cs2 = a.POS[2 * rk + 1]; cp1 = a.TOPKp[4 * rk + 2]; cp2 = a.TOPKp[4 * rk + 3]; }
        if (cx.bid * 8 + wid < a.nrows) { const int s1 = __builtin_amdgcn_readlane(cs1, 0), s2 = __builtin_amdgcn_readlane(cs2, 0);
#pragma unroll
            for (int j = 0; j < 4; ++j) { const int cc = 4 * (lane + 64 * j); y1n[j] = *(const u32x2*)(a.Y + (size_t)s1 * D + cc); y2n[j] = *(const u32x2*)(a.Y + (size_t)s2 * D + cc); } } }
    int it = 0;
    for (int row = cx.bid * 8 + wid; row < a.nrows; row += cx.nb * 8, ++it) {
        const int mr = mod_row(row);
        bf16_t* xr = a.XS + (size_t)row * D; const bool fcur = row < TL ? a.lf32 : a.cf32;
        f32x4 x[4], shq[4], scq[4];
#pragma unroll
        for (int j = 0; j < 4; ++j) { x[j] = cvx(xn[j], fcur); shq[j] = *(const f32x4*)(a.mod_shift + (size_t)mr * 6144 + 4 * (lane + 64 * j)); scq[j] = *(const f32x4*)(a.mod_scale + (size_t)mr * 6144 + 4 * (lane + 64 * j)); }
        if (row + cx.nb * 8 < a.nrows) {
            const int rn = row + cx.nb * 8; const bool f = rn < TL ? a.lf32 : a.cf32; const void* rp = rn < TL ? a.Xl : a.Xc;
#pragma unroll
            for (int j = 0; j < 4; ++j) xn[j] = ldx_raw(rp, f, (size_t)rn * D + 4 * (lane + 64 * j)); }
        if (combine) {
            const float p1 = __int_as_float(__builtin_amdgcn_readlane(__float_as_int(cp1), it)), p2 = __int_as_float(__builtin_amdgcn_readlane(__float_as_int(cp2), it));
            u32x2 y1c[4], y2c[4];
#pragma unroll
            for (int j = 0; j < 4; ++j) { y1c[j] = y1n[j]; y2c[j] = y2n[j]; }
            if (row + cx.nb * 8 < a.nrows) { const int s1 = __builtin_amdgcn_readlane(cs1, it + 1), s2 = __builtin_amdgcn_readlane(cs2, it + 1);
#pragma unroll
                for (int j = 0; j < 4; ++j) { const int cc = 4 * (lane + 64 * j); y1n[j] = *(const u32x2*)(a.Y + (size_t)s1 * D + cc); y2n[j] = *(const u32x2*)(a.Y + (size_t)s2 * D + cc); } }
#pragma unroll
            for (int j = 0; j < 4; ++j) { const int cc = 4 * (lane + 64 * j);
                const u32x2 y1 = y1c[j], y2 = y2c[j];
                const f32x4 mg = *(const f32x4*)(a.mod_g5prev + (size_t)mr * 6144 + cc);
                f32x4 e; e[0] = p1 * bf_lo(y1.x) + p2 * bf_lo(y2.x); e[1] = p1 * bf_hi(y1.x) + p2 * bf_hi(y2.x); e[2] = p1 * bf_lo(y1.y) + p2 * bf_lo(y2.y); e[3] = p1 * bf_hi(y1.y) + p2 * bf_hi(y2.y);
                x[j] = x[j] + mg * e; stx(xr + cc, x[j]); }
        }
        if (a.PART != nullptr && row >= TL) {
#pragma unroll
            for (int j = 0; j < 4; ++j) { const int cc = 4 * (lane + 64 * j); const float* pp = a.PART + (size_t)(row - TL) * D + cc;
                f32x4 e = (*(const f32x4*)pp + *(const f32x4*)(pp + (size_t)TC * D)) + (*(const f32x4*)(pp + (size_t)2 * TC * D) + *(const f32x4*)(pp + (size_t)3 * TC * D));
                e = e + (*(const f32x4*)(pp + (size_t)4 * TC * D) + *(const f32x4*)(pp + (size_t)5 * TC * D));
                if (a.npart == 7) e = e + *(const f32x4*)(pp + (size_t)6 * TC * D);
                const f32x4 mg = *(const f32x4*)(a.mod_gpart + (size_t)8 * 6144 + cc);
                x[j] = x[j] + mg * e; stx(xr + cc, x[j]); }
        }
        float ss = 0.f;
#pragma unroll
        for (int j = 0; j < 4; ++j) ss += x[j][0] * x[j][0] + x[j][1] * x[j][1] + x[j][2] * x[j][2] + x[j][3] * x[j][3];
        ss = wave_total(ss);
        const float rs = rsqrtf(ss * (1.0f / D) + EPS);
        f32x4 h[4];
#pragma unroll
        for (int j = 0; j < 4; ++j) { const int cc = 4 * (lane + 64 * j);
            h[j] = (x[j] * rs * gq[j]) * (scq[j] + 1.0f) + shq[j];
            u32x2 w; w.x = cvt_pk_bf16(h[j][0], h[j][1]); w.y = cvt_pk_bf16(h[j][2], h[j][3]);
            *(u32x2*)(a.H + (size_t)row * D + cc) = w; }
        if (ROUTE) {
            float lg[8];
#pragma unroll
            for (int e = 0; e < 8; ++e) lg[e] = 0.f;
#pragma unroll
            for (int j = 0; j < 4; ++j)
#pragma unroll
                for (int q = 0; q < 4; ++q) { const LAS float* rw = rtab + ((j * 4 + q) * 64 + lane) * 8; const f32x4 r0 = *(const LAS f32x4*)rw, r1 = *(const LAS f32x4*)(rw + 4); const float hv = h[j][q];
                    lg[0] += hv * r0[0]; lg[1] += hv * r0[1]; lg[2] += hv * r0[2]; lg[3] += hv * r0[3]; lg[4] += hv * r1[0]; lg[5] += hv * r1[1]; lg[6] += hv * r1[2]; lg[7] += hv * r1[3]; }
#pragma unroll
            for (int e = 0; e < 8; ++e) lg[e] = wave_total(lg[e]);
            if (lane == 0) {
                int e1 = 0; float v1 = lg[0];
#pragma unroll
                for (int e = 1; e < 8; ++e) if (lg[e] > v1) { v1 = lg[e]; e1 = e; }
                int e2 = -1; float v2 = -3.0e38f;
#pragma unroll
                for (int e = 0; e < 8; ++e) if (e != e1 && lg[e] > v2) { v2 = lg[e]; e2 = e; }
                const float p2 = 1.0f / (1.0f + __expf(v1 - v2)), p1 = 1.0f - p2;
                float* tk = a.TOPK + 4 * (size_t)row; tk[0] = __int_as_float(e1); tk[1] = __int_as_float(e2); tk[2] = p1; tk[3] = p2;
                lds_add(hist + e1, 1u); lds_add(hist + e2, 1u);
            }
        }
    }
    if (ROUTE) { __syncthreads(); if (tidx(cx) < 8) { const unsigned v = hist[tidx(cx)]; if (v) atomicAdd(a.cnt + tidx(cx), v); } __syncthreads(); }
}

__device__ __forceinline__ void ph_route(const float* TOPK, const bf16_t* H, bf16_t* HS, int* POS, unsigned* ctl, int j, int nrows, LAS unsigned char* lds, const Ctx cx) {
    LAS unsigned* sbase = (LAS unsigned*)(lds + LDS_SBASE);
    const int lane = tidx(cx) & 63, wid = tidx(cx) >> 6;
    __syncthreads();
    if (tidx(cx) == 0) { unsigned b = 0; for (int e = 0; e < 8; ++e) { sbase[e] = b; b += (xb_ld(ctl + CW_CNT + j * 64 + e) + 255u) & ~255u; } sbase[8] = b; }
    __syncthreads();
    if (cx.bid == 0) {
        if (tidx(cx) < 256) { const unsigned r0 = tidx(cx) * 256u; int e = 0;
            for (int q = 1; q < 8; ++q) if (r0 >= sbase[q]) e = q;
            ctl[CW_TEXP + j * 256 + tidx(cx)] = (unsigned)e; }
        if (tidx(cx) == 0) ctl[CW_NT + j] = sbase[8] / 256u;
    }
    for (int i = cx.bid * 8 + wid; i < 8 * 256; i += cx.nb * 8) { const int e = i >> 8, r = i & 255; const unsigned s = sbase[e] + xb_ld(ctl + CW_CNT + j * 64 + e) + r;
        if (s < sbase[e + 1]) {
#pragma unroll
            for (int q = 0; q < 2; ++q) ((u32x4*)(HS + (size_t)s * D))[lane + 64 * q] = ((const u32x4*)H)[lane + 64 * q]; } }
    LAS unsigned* wcnt = sbase + 16; LAS unsigned* wbase = sbase + 24;
    if (tidx(cx) < 8) wcnt[tidx(cx)] = 0u;
    const int nk = nrows / (cx.nb * 8); const int myrow = cx.bid * 8 + wid + lane * (cx.nb * 8); const bool own = lane < nk;
    int e1 = 0, e2 = 0; if (own) { const f32x2 t = *(const f32x2*)(TOPK + 4 * (size_t)myrow); e1 = __float_as_int(t[0]); e2 = __float_as_int(t[1]); }
    __syncthreads();
    if (own) { lds_add(wcnt + e1, 1u); lds_add(wcnt + e2, 1u); }
    __syncthreads();
    if (tidx(cx) < 8) { const unsigned n = wcnt[tidx(cx)]; wbase[tidx(cx)] = sbase[tidx(cx)] + (n ? atomicAdd(ctl + CW_FILL + j * 64 + tidx(cx), n) : 0u); wcnt[tidx(cx)] = 0u; }
    __syncthreads();
    int s1 = 0, s2 = 0;
    if (own) { s1 = (int)(wbase[e1] + lds_add(wcnt + e1, 1u)); s2 = (int)(wbase[e2] + lds_add(wcnt + e2, 1u)); POS[2 * myrow] = s1; POS[2 * myrow + 1] = s2; }
    u32x4 v[9][2];
#pragma unroll
    for (int k = 0; k < 9; ++k) if (k < nk) { const u32x4* src = (const u32x4*)(H + (size_t)(cx.bid * 8 + wid + k * (cx.nb * 8)) * D); v[k][0] = src[lane]; v[k][1] = src[lane + 64]; }
#pragma unroll
    for (int k = 0; k < 9; ++k) if (k < nk) { const int d1 = __builtin_amdgcn_readlane(s1, k), d2 = __builtin_amdgcn_readlane(s2, k);
        u32x4* o1 = (u32x4*)(HS + (size_t)d1 * D); u32x4* o2 = (u32x4*)(HS + (size_t)d2 * D);
        o1[lane] = v[k][0]; o1[lane + 64] = v[k][1]; o2[lane] = v[k][0]; o2[lane + 64] = v[k][1]; }
    __syncthreads();
}

struct CvIn { u32x4 cc[3], cu[3], cb; };
__device__ __forceinline__ void ph_conv(const bf16_t* P, bf16_t* BR, const float* conv_w, int nrows, const Ctx cx) {
    const int tid = tidx(cx), lane = tid & 63, wid = tid >> 6; const int c0 = lane * 8;
    float cw[3][8];
#pragma unroll
    for (int d = 0; d < 3; ++d)
#pragma unroll
        for (int e = 0; e < 8; ++e) cw[d][e] = conv_w[d * 512 + c0 + e];
    auto seqpos = [&](int row, int& sp, int& slen) { const bool lat = row < TL; sp = lat ? (row & (SEQ - 1)) : ((row - TL) & (CTXL - 1)); slen = lat ? SEQ : CTXL; };
    auto load = [&](int row, CvIn& in) { const bf16_t* pr = P + (size_t)row * NP; int sp, slen; seqpos(row, sp, slen);
#pragma unroll
        for (int d = 0; d < 3; ++d) { const int sq = sp + d - 1; const bool ok = sq >= 0 && sq < slen; const bf16_t* q = pr + (ptrdiff_t)(ok ? d - 1 : 0) * NP;
            in.cc[d] = *(const u32x4*)(q + P_CC + c0); in.cu[d] = *(const u32x4*)(q + P_CU + c0); }
        in.cb = *(const u32x4*)(pr + P_CB + c0); };
    const int stride = cx.nb * 8; int row = cx.bid * 8 + wid; CvIn cur, nxt;
    if (row < nrows) load(row, cur);
    for (; row < nrows; row += stride) {
        const int rn = row + stride; const bool hn = rn < nrows;
        if (hn) load(rn, nxt);
        int sp, slen; seqpos(row, sp, slen);
        float y[8];
#pragma unroll
        for (int e = 0; e < 8; ++e) y[e] = 0.f;
#pragma unroll
        for (int d = 0; d < 3; ++d) { const int sq = sp + d - 1; const float m = (sq >= 0 && sq < slen) ? 1.0f : 0.0f; float cv[8], uv[8]; unpack8(cur.cc[d], cv); unpack8(cur.cu[d], uv);
#pragma unroll
            for (int e = 0; e < 8; ++e) y[e] += (cv[e] * uv[e]) * (cw[d][e] * m); }
        float bv[8]; unpack8(cur.cb, bv);
#pragma unroll
        for (int e = 0; e < 8; ++e) y[e] *= bv[e];
        *(u32x4*)(BR + (size_t)row * 1536 + c0) = pack8(y);
        if (hn) cur = nxt;
    }
}

__device__ __forceinline__ void ph_final(const bf16_t* XS, const bf16_t* Y, const int* POS, const float* TOPK, const float* mod_g5, const float* g, float* out, const Ctx cx) {
    const int lane = tidx(cx) & 63, wid = tidx(cx) >> 6;
    f32x4 gq[4];
#pragma unroll
    for (int j = 0; j < 4; ++j) gq[j] = *(const f32x4*)(g + 4 * (lane + 64 * j));
    const int stride = cx.nb * 8; int row = cx.bid * 8 + wid;
    f32x4 xn[4]; u32x2 y1n[4], y2n[4]; float p1n = 0.f, p2n = 0.f;
    int cs1 = 0, cs2 = 0; float cp1 = 0.f, cp2 = 0.f;
    { const int rk = cx.bid * 8 + wid + lane * stride; if (rk < TL) { cs1 = POS[2 * rk]; cs2 = POS[2 * rk + 1]; cp1 = TOPK[4 * rk + 2]; cp2 = TOPK[4 * rk + 3]; } }
    auto fetch = [&](int r, int k) { const int s1 = __builtin_amdgcn_readlane(cs1, k), s2 = __builtin_amdgcn_readlane(cs2, k);
        p1n = __int_as_float(__builtin_amdgcn_readlane(__float_as_int(cp1), k)); p2n = __int_as_float(__builtin_amdgcn_readlane(__float_as_int(cp2), k));
#pragma unroll
        for (int j = 0; j < 4; ++j) { const int cc = 4 * (lane + 64 * j); xn[j] = ldx_raw(XS, false, (size_t)r * D + cc); y1n[j] = *(const u32x2*)(Y + (size_t)s1 * D + cc); y2n[j] = *(const u32x2*)(Y + (size_t)s2 * D + cc); } };
    if (row < TL) fetch(row, 0);
    int it = 0;
    for (; row < TL; row += stride, ++it) {
        const int mr = mod_row(row);
        f32x4 x[4]; u32x2 y1[4], y2[4]; const float p1 = p1n, p2 = p2n;
#pragma unroll
        for (int j = 0; j < 4; ++j) { x[j] = cvx(xn[j], false); y1[j] = y1n[j]; y2[j] = y2n[j]; }
        if (row + stride < TL) fetch(row + stride, it + 1);
        float ss = 0.f;
#pragma unroll
        for (int j = 0; j < 4; ++j) { const int cc = 4 * (lane + 64 * j);
            const f32x4 mg = *(const f32x4*)(mod_g5 + (size_t)mr * 6144 + cc);
            f32x4 e; e[0] = p1 * bf_lo(y1[j].x) + p2 * bf_lo(y2[j].x); e[1] = p1 * bf_hi(y1[j].x) + p2 * bf_hi(y2[j].x); e[2] = p1 * bf_lo(y1[j].y) + p2 * bf_lo(y2[j].y); e[3] = p1 * bf_hi(y1[j].y) + p2 * bf_hi(y2[j].y);
            x[j] = x[j] + mg * e; ss += x[j][0] * x[j][0] + x[j][1] * x[j][1] + x[j][2] * x[j][2] + x[j][3] * x[j][3]; }
        ss = wave_total(ss); const float rs = rsqrtf(ss * (1.0f / D) + EPS);
#pragma unroll
        for (int j = 0; j < 4; ++j) { const int cc = 4 * (lane + 64 * j); *(f32x4*)(out + (size_t)row * D + cc) = x[j] * rs * gq[j]; }
    }
}

__device__ __forceinline__ float wave_incl_scan(float v) {
    v += __int_as_float(__builtin_amdgcn_update_dpp(0, __float_as_int(v), 0x111, 0xF, 0xF, true));
    v += __int_as_float(__builtin_amdgcn_update_dpp(0, __float_as_int(v), 0x112, 0xF, 0xF, true));
    v += __int_as_float(__builtin_amdgcn_update_dpp(0, __float_as_int(v), 0x114, 0xF, 0xF, true));
    v += __int_as_float(__builtin_amdgcn_update_dpp(0, __float_as_int(v), 0x118, 0xF, 0xF, true));
    v += __int_as_float(__builtin_amdgcn_update_dpp(0, __float_as_int(v), 0x142, 0xA, 0xF, false));
    v += __int_as_float(__builtin_amdgcn_update_dpp(0, __float_as_int(v), 0x143, 0xC, 0xF, false));
    return v;
}
__device__ __forceinline__ float lsig16(float z) { const float e = __builtin_amdgcn_exp2f(fmaxf(z, -80.0f) * -LOG2E); return __builtin_amdgcn_logf(1.0f + e) * (-0.6931471805599453f / 16.0f); }
__device__ __forceinline__ void gla_wave_decay(const bf16_t* P, int row0, int t, int h, int d, int ch0, const float* gla_w2, const float* gla_b, float (&b)[16]) {
    const u32x4* ap = (const u32x4*)(P + (size_t)(row0 + t) * NP + P_AG + d * 16);
    float a[16]; unpack8(ap[0], a); unpack8(ap[1], a + 8);
    const float* w2 = gla_w2 + (size_t)d * 16 * 256 + h * 64 + ch0; const float* bb = gla_b + d * 256 + h * 64 + ch0;
#pragma unroll
    for (int i = 0; i < 16; ++i) b[i] = bb[i];
#pragma unroll
    for (int r = 0; r < 16; ++r)
#pragma unroll
        for (int i = 0; i < 16; ++i) b[i] = __builtin_fmaf(a[r], w2[r * 256 + i], b[i]);
#pragma unroll
    for (int i = 0; i < 16; ++i) b[i] = wave_incl_scan(lsig16(b[i]));
}

constexpr int G_QD = 0, G_KI = G_QD + 2 * 64 * STR64, G_AT = G_KI + 2 * 64 * STR64, G_VI = G_AT + 2 * 64 * STR64, G_SE = G_VI + 64 * STR128, G_RED = G_SE + 2 * 64 * STR128, G_END = G_RED + 512;
constexpr int G1_KR = G_KI, G1_AR = G_KI + 64 * STR64, G1_ASTR = 80, G1_W2 = 73728;
struct G1In { u32x4 vv[2], kraw, araw; float bb[16]; };
__device__ __forceinline__ void g1_load(G1In& in, const bf16_t* P, const float* gla_b, int ci, int h, int tid) {
    const int row0 = ci * 64;
    { const int w = tid >> 6; const float* bb = gla_b + (w >> 2) * 256 + h * 64 + (w & 3) * 16;
#pragma unroll
      for (int i = 0; i < 16; ++i) in.bb[i] = bb[i]; }
#pragma unroll
    for (int q = 0; q < 2; ++q) { const int id = tid + 512 * q, r = id >> 4, c16 = id & 15; in.vv[q] = *(const u32x4*)(P + (size_t)(row0 + r) * NP + P_VG + h * 128 + c16 * 8); }
    in.kraw = *(const u32x4*)(P + (size_t)(row0 + (tid >> 3)) * NP + P_KG + h * 64 + (tid & 7) * 8);
    in.araw = (u32x4){0u, 0u, 0u, 0u}; if (tid < 256) in.araw = *(const u32x4*)(P + (size_t)(row0 + (tid >> 2)) * NP + P_AG + (tid & 3) * 8);
}
__device__ __forceinline__ void gla_state_unit(const G1In& in, G1In& nxt, int vnext  , const bf16_t* P, int ci, int h, const float* gla_b, float* DS, float* DEC, float* BC, LAS unsigned char* lds, const Ctx cx) {
    const int tid = tidx(cx), lane = tid & 63, wid = __builtin_amdgcn_readfirstlane(tid >> 6), fr = lane & 15, fq = lane >> 4;
    LAS unsigned char* Ke = lds + G_QD; LAS unsigned char* Vi = lds + G_VI; LAS unsigned char* Kr = lds + G1_KR; LAS unsigned char* Ar = lds + G1_AR; const LAS float* w2s = (const LAS float*)(lds + G1_W2);
    {
#pragma unroll
      for (int q = 0; q < 2; ++q) { const int id = tid + 512 * q, r = id >> 4, c16 = id & 15; *(LAS u32x4*)(Vi + r * STR128 + c16 * 16) = in.vv[q]; }
      *(LAS u32x4*)(Kr + (tid >> 3) * STR64 + (tid & 7) * 16) = in.kraw;
      if (tid < 256) *(LAS u32x4*)(Ar + (tid >> 2) * G1_ASTR + (tid & 3) * 16) = in.araw; }
    __syncthreads();
    const size_t ub = ((size_t)ci * 4 + h) * 2;
    { const int d = wid >> 2, ch0 = (wid & 3) * 16, t = d ? 63 - lane : lane; float b[16];
      const LAS u32x4* ap = (const LAS u32x4*)(Ar + t * G1_ASTR + d * 32); float a[16]; unpack8(ap[0], a); unpack8(ap[1], a + 8);
      const LAS u32x4* kp = (const LAS u32x4*)(Kr + t * STR64 + ch0 * 2); const u32x4 k0 = kp[0], k1 = kp[1];
      const LAS float* w2 = w2s + d * 16 * 256 + h * 64 + ch0;
#pragma unroll
      for (int i = 0; i < 16; ++i) b[i] = in.bb[i];
#pragma unroll
      for (int r = 0; r < 16; ++r)
#pragma unroll
          for (int i = 0; i < 16; ++i) b[i] = __builtin_fmaf(a[r], w2[r * 256 + i], b[i]);
#pragma unroll
      for (int i = 0; i < 16; ++i) b[i] = wave_incl_scan(lsig16(b[i]));
      { float* bp = BC + ((ub + d) * 64 + ch0) * 64 + t;
#pragma unroll
        for (int i = 0; i < 16; ++i) bp[i * 64] = b[i]; }
      float kf[16], o[16]; unpack8(k0, kf); unpack8(k1, kf + 8);
#pragma unroll
      for (int i = 0; i < 16; ++i) { const float bt = __int_as_float(__builtin_amdgcn_readlane(__float_as_int(b[i]), 63)); o[i] = kf[i] * __expf(bt - b[i]); b[i] = bt; }
      *(LAS u32x4*)(Ke + d * 64 * STR64 + t * STR64 + ch0 * 2) = pack8(o); *(LAS u32x4*)(Ke + d * 64 * STR64 + t * STR64 + ch0 * 2 + 16) = pack8(o + 8);
      if (lane < 16) { float dv = b[0];
#pragma unroll
          for (int i = 1; i < 16; ++i) dv = (lane == i) ? b[i] : dv;
          DEC[(ub + d) * 64 + ch0 + lane] = __expf(dv); } }
    __syncthreads();
    if (vnext >= 0) g1_load(nxt, P, gla_b, vnext >> 2, vnext & 3, tid);
    { const int d = wid >> 2, mt = wid & 3; f32x4 acc[8];
#pragma unroll
      for (int n = 0; n < 8; ++n) acc[n] = (f32x4){0.f, 0.f, 0.f, 0.f};
#pragma unroll
      for (int s = 0; s < 2; ++s) { const int r0 = 32 * s + 8 * fq; const bf16x8 af = frag_tr(Ke + d * 64 * STR64, r0, r0 + 4, mt * 16, STR64, fr);
#pragma unroll
          for (int n = 0; n < 8; ++n) { const bf16x8 bfr = frag_tr(Vi, r0, r0 + 4, n * 16, STR128, fr); MMA16(acc[n], af, bfr); } }
      LAS unsigned char* my = lds + G_AT + wid * (16 * STR64); const int r8 = lane >> 3, c8 = lane & 7;
      LAS unsigned char* wp = my + fr * STR64 + fq * 16; const LAS unsigned char* rp = my + r8 * STR64 + c8 * 16;
      float* dst = DS + ((ub + d) * 64 + mt * 16 + r8) * 128 + 4 * c8;
#pragma unroll
      for (int p = 0; p < 4; ++p) {
          *(LAS f32x4*)wp = acc[2 * p]; *(LAS f32x4*)(wp + 64) = acc[2 * p + 1];
          asm volatile("" ::: "memory"); __builtin_amdgcn_wave_barrier();
          const f32x4 x0 = *(const LAS f32x4*)rp, x1 = *(const LAS f32x4*)(rp + 8 * STR64);
          asm volatile("" ::: "memory"); __builtin_amdgcn_wave_barrier();
          *(f32x4*)(dst + p * 32) = x0; *(f32x4*)(dst + 8 * 128 + p * 32) = x1; } }
    __syncthreads();
}

__device__ __forceinline__ void ph_gla_scan2(const float* DS, const float* DEC, bf16_t* SE, const Ctx cx) {
    const int tid = tidx(cx);
    for (int vi = cx.bid * 512 + tid; vi < 64 * 2048; vi += cx.nb * 512) {
        const int sid = vi >> 11, dk = (vi >> 5) & 63, dvq = vi & 31; const int b = sid >> 3, h = (sid >> 1) & 3, d = sid & 1;
        f32x4 S = (f32x4){0.f, 0.f, 0.f, 0.f};
#pragma unroll 12
        for (int st = 0; st < 36; ++st) {
            const int ci = st < 4 ? (256 + 4 * b + (d ? 3 - st : st)) : (32 * b + (d ? 35 - st : st - 4));
            const size_t ub = ((size_t)ci * 4 + h) * 2 + d; const size_t eo = (ub * 64 + dk) * 128 + dvq * 4;
            u32x2 w; w.x = cvt_pk_bf16(S[0], S[1]); w.y = cvt_pk_bf16(S[2], S[3]); *(u32x2*)(SE + eo) = w;
            const float dec = DEC[ub * 64 + dk]; const f32x4 ds = *(const f32x4*)(DS + eo);
            S = S * dec + ds;
        }
    }
}

struct G3In { u32x4 vv[2], sv[4], qraw, kraw; float bb[16]; };
__device__ __forceinline__ void g3_load(G3In& in, const bf16_t* P, int ci, int h, const float* BC, const bf16_t* SE, int tid) {
    const int lane = tid & 63, wid = __builtin_amdgcn_readfirstlane(tid >> 6); const int row0 = ci * 64; const size_t ub = ((size_t)ci * 4 + h) * 2;
#pragma unroll
    for (int q = 0; q < 2; ++q) { const int id = tid + 512 * q, r = id >> 4, c16 = id & 15; in.vv[q] = *(const u32x4*)(P + (size_t)(row0 + r) * NP + P_VG + h * 128 + c16 * 8); }
#pragma unroll
    for (int q = 0; q < 4; ++q) { const int id = tid + 512 * q, r = id >> 4, c16 = id & 15; in.sv[q] = *(const u32x4*)(SE + (ub * 64 + r) * 128 + c16 * 8); }
    const int d = wid >> 2, ch0 = (wid & 3) * 16, t = d ? 63 - lane : lane;
    { const bf16_t* pr = P + (size_t)(row0 + (tid >> 3)) * NP + h * 64 + (tid & 7) * 8; in.qraw = *(const u32x4*)(pr + P_QG); in.kraw = *(const u32x4*)(pr + P_KG); }
    const float* bp = BC + ((ub + d) * 64 + ch0) * 64 + t;
#pragma unroll
    for (int i = 0; i < 16; ++i) in.bb[i] = bp[i * 64];
}
__device__ __forceinline__ void gla_out_unit(const G3In& in, const bf16_t* P, int ci, int h, const float* gng, bf16_t* BR, LAS unsigned char* lds, const Ctx cx) {
    const int tid = tidx(cx), lane = tid & 63, wid = __builtin_amdgcn_readfirstlane(tid >> 6), fr = lane & 15, fq = lane >> 4; const int row0 = ci * 64;
    LAS unsigned char* Qd = lds + G_QD; LAS unsigned char* Ki = lds + G_KI; LAS unsigned char* Vi = lds + G_VI; LAS unsigned char* Se = lds + G_SE; LAS unsigned char* At = lds + G_AT;
    { LAS unsigned char* Qr = At; LAS unsigned char* Kr = At + 64 * STR64;
      *(LAS u32x4*)(Qr + (tid >> 3) * STR64 + (tid & 7) * 16) = in.qraw; *(LAS u32x4*)(Kr + (tid >> 3) * STR64 + (tid & 7) * 16) = in.kraw; }
#pragma unroll
    for (int q = 0; q < 2; ++q) { const int id = tid + 512 * q, r = id >> 4, c16 = id & 15; *(LAS u32x4*)(Vi + r * STR128 + c16 * 16) = in.vv[q]; }
#pragma unroll
    for (int q = 0; q < 4; ++q) { const int id = tid + 512 * q, r = id >> 4, c16 = id & 15; *(LAS u32x4*)(Se + r * STR128 + c16 * 16) = in.sv[q]; }
    __syncthreads();
    { const int d = wid >> 2, ch0 = (wid & 3) * 16, t = d ? 63 - lane : lane; float b[16];
      const LAS u32x4* qp = (const LAS u32x4*)(At + t * STR64 + ch0 * 2); const LAS u32x4* kp = (const LAS u32x4*)(At + 64 * STR64 + t * STR64 + ch0 * 2);
      const u32x4 q0 = qp[0], q1 = qp[1], k0 = kp[0], k1 = kp[1];
#pragma unroll
      for (int i = 0; i < 16; ++i) b[i] = in.bb[i];
      float qf[16], kf[16]; unpack8(q0, qf); unpack8(q1, qf + 8); unpack8(k0, kf); unpack8(k1, kf + 8);
#pragma unroll
      for (int i = 0; i < 16; ++i) { const float e = __expf(b[i]); qf[i] = qf[i] * 0.125f * e; kf[i] = kf[i] * __builtin_amdgcn_rcpf(e); }
      LAS unsigned char* qd = Qd + d * 64 * STR64 + t * STR64 + ch0 * 2; LAS unsigned char* ki = Ki + d * 64 * STR64 + t * STR64 + ch0 * 2;
      *(LAS u32x4*)qd = pack8(qf); *(LAS u32x4*)(qd + 16) = pack8(qf + 8); *(LAS u32x4*)ki = pack8(kf); *(LAS u32x4*)(ki + 16) = pack8(kf + 8); }
    __syncthreads();
    { const int d = wid >> 2, mt = wid & 3; f32x4 acc[4];
#pragma unroll
      for (int n = 0; n < 4; ++n) acc[n] = (f32x4){0.f, 0.f, 0.f, 0.f};
#pragma unroll
      for (int s = 0; s < 2; ++s) { const bf16x8 af = frag_row(Qd + d * 64 * STR64, mt * 16 + fr, 32 * s + 8 * fq, STR64);
#pragma unroll
          for (int n = 0; n < 4; ++n) { const bf16x8 bfr = frag_row(Ki + d * 64 * STR64, n * 16 + fr, 32 * s + 8 * fq, STR64); MMA16(acc[n], af, bfr); } }
      const int l = mt * 16 + fr;
#pragma unroll
      for (int n = 0; n < 4; ++n) { float v[4];
#pragma unroll
          for (int j = 0; j < 4; ++j) { const int s = n * 16 + 4 * fq + j; const bool keep = d ? (s >= l) : (s <= l); v[j] = keep ? acc[n][j] : 0.f; }
          u32x2 w; w.x = cvt_pk_bf16(v[0], v[1]); w.y = cvt_pk_bf16(v[2], v[3]); *(LAS u32x2*)(At + d * 64 * STR64 + l * STR64 + (n * 16 + 4 * fq) * 2) = w; } }
    __syncthreads();
    { const int mt = wid & 3, nh = wid >> 2; f32x4 acc[4];
      const int l = mt * 16 + fr; const size_t row = (size_t)row0 + l;
      u32x2 rw[4]; f32x4 gg[4];
#pragma unroll
      for (int n = 0; n < 4; ++n) { const int v0 = (nh * 4 + n) * 16 + 4 * fq; rw[n] = *(const u32x2*)(P + row * NP + P_RG + h * 128 + v0); gg[n] = *(const f32x4*)(gng + h * 128 + v0); }
#pragma unroll
      for (int n = 0; n < 4; ++n) acc[n] = (f32x4){0.f, 0.f, 0.f, 0.f};
#pragma unroll
      for (int d = 0; d < 2; ++d)
#pragma unroll
          for (int s = 0; s < 2; ++s) { const int r0 = 32 * s + 8 * fq;
              const bf16x8 af = frag_row(At + d * 64 * STR64, mt * 16 + fr, r0, STR64), aq = frag_row(Qd + d * 64 * STR64, mt * 16 + fr, r0, STR64);
#pragma unroll
              for (int n = 0; n < 4; ++n) { const int x0 = (nh * 4 + n) * 16;
                  const bf16x8 bv = frag_tr(Vi, r0, r0 + 4, x0, STR128, fr); MMA16(acc[n], af, bv);
                  const bf16x8 bs = frag_tr(Se + d * 64 * STR128, r0, r0 + 4, x0, STR128, fr); MMA16(acc[n], aq, bs); } }
      float ss = 0.f;
#pragma unroll
      for (int n = 0; n < 4; ++n) ss += acc[n][0] * acc[n][0] + acc[n][1] * acc[n][1] + acc[n][2] * acc[n][2] + acc[n][3] * acc[n][3];
      ss = row4_sum(ss);
      LAS float* red = (LAS float*)(lds + G_RED);
      if (fq == 0) red[l * 2 + nh] = ss;
      __syncthreads();
      const float rs = rsqrtf((red[l * 2] + red[l * 2 + 1]) * (1.0f / 128.0f) + EPS);
#pragma unroll
      for (int n = 0; n < 4; ++n) { const int v0 = (nh * 4 + n) * 16 + 4 * fq;
          const float y0 = acc[n][0] * rs * gg[n][0] * siluf_(bf_lo(rw[n].x)), y1 = acc[n][1] * rs * gg[n][1] * siluf_(bf_hi(rw[n].x)), y2 = acc[n][2] * rs * gg[n][2] * siluf_(bf_lo(rw[n].y)), y3 = acc[n][3] * rs * gg[n][3] * siluf_(bf_hi(rw[n].y));
          u32x2 w; w.x = cvt_pk_bf16(y0, y1); w.y = cvt_pk_bf16(y2, y3); *(u32x2*)(BR + row * 1536 + 1024 + h * 128 + v0) = w; } }
    __syncthreads();
}

constexpr int A_KBUF = 0, A_VBUF = 64 * STR64, A_BUF = 2 * 64 * STR64;
__device__ __forceinline__ void attn_unit(const bf16_t* QR, const bf16_t* KV, bf16_t* BR, const float* sink, int b, int kh, int qrow0  , int qpos0  , LAS unsigned char* lds, const Ctx cx) {
    const int tid = tidx(cx), lane = tid & 63, wid = tid >> 6, fr = lane & 15, fq = lane >> 4; const int hq = wid >> 1, qh = wid & 1;
    const bool lat = qpos0 >= 0;
    int kt0 = 0, kt1 = 0; if (lat) { kt0 = (qpos0 >> 6) - 2; if (kt0 < 0) kt0 = 0; kt1 = (qpos0 >> 6) + 4; if (kt1 > 32) kt1 = 32; }
    const int ntile = (kt1 - kt0) + 4;
    bf16x8 qf[4][2];
#pragma unroll
    for (int mt = 0; mt < 4; ++mt)
#pragma unroll
        for (int ks = 0; ks < 2; ++ks) qf[mt][ks] = *(const bf16x8*)(QR + (size_t)(qrow0 + 64 * qh + 16 * mt + fr) * 512 + (4 * kh + hq) * 64 + 32 * ks + 8 * fq);
    const float sk = sink[4 * kh + hq] * LOG2E;
    f32x4 oacc[4][4]; float mrun[4], lrun[4];
#pragma unroll
    for (int mt = 0; mt < 4; ++mt) { mrun[mt] = sk; lrun[mt] = (fq == 0) ? 1.0f : 0.0f;
#pragma unroll
        for (int dt = 0; dt < 4; ++dt) oacc[mt][dt] = (f32x4){0.f, 0.f, 0.f, 0.f}; }
    const int sr = tid >> 3, sc = tid & 7;
    auto tile_row0 = [&](int t) -> int { return t < (kt1 - kt0) ? b * SEQ + (kt0 + t) * 64 : TL + b * CTXL + (t - (kt1 - kt0)) * 64; };
    u32x4 kreg, vreg;
    { const bf16_t* src = KV + (size_t)(tile_row0(0) + sr) * 256 + kh * 64 + sc * 8; kreg = *(const u32x4*)src; vreg = *(const u32x4*)(src + 128); }
    *(LAS u32x4*)(lds + A_KBUF + sr * STR64 + sc * 16) = kreg; *(LAS u32x4*)(lds + A_VBUF + sr * STR64 + sc * 16) = vreg;
    __syncthreads();
    for (int t = 0; t < ntile; ++t) {
        LAS unsigned char* Kb = lds + (t & 1) * A_BUF + A_KBUF; LAS unsigned char* Vb = lds + (t & 1) * A_BUF + A_VBUF;
        if (t + 1 < ntile) { const bf16_t* src = KV + (size_t)(tile_row0(t + 1) + sr) * 256 + kh * 64 + sc * 8; kreg = *(const u32x4*)src; vreg = *(const u32x4*)(src + 128); }
        const bool latt = t < (kt1 - kt0); const int kpos0 = (kt0 + t) * 64;
        const int qlo = qpos0 + 64 * qh;
        const bool active = !latt || (kpos0 + 63 >= qlo - 128 && kpos0 <= qlo + 63 + 128);
        const bool needmask = latt && (kpos0 > qlo + 65 || kpos0 < qlo - 65);
        if (active) {
            u32x4 pf[4][2];
            { bf16x8 kf[4][2];
#pragma unroll
              for (int nt = 0; nt < 4; ++nt)
#pragma unroll
                  for (int ks = 0; ks < 2; ++ks) kf[nt][ks] = frag_row(Kb, nt * 16 + fr, 32 * ks + 8 * fq, STR64);
#pragma unroll
              for (int mt = 0; mt < 4; ++mt) {
                f32x4 s[4];
#pragma unroll
                for (int nt = 0; nt < 4; ++nt) { s[nt] = (f32x4){0.f, 0.f, 0.f, 0.f}; MMA16(s[nt], qf[mt][0], kf[nt][0]); MMA16(s[nt], qf[mt][1], kf[nt][1]); }
                if (needmask) { const int qp = qlo + 16 * mt + fr;
#pragma unroll
                    for (int nt = 0; nt < 4; ++nt)
#pragma unroll
                        for (int j = 0; j < 4; ++j) { const int dlt = kpos0 + nt * 16 + 4 * fq + j - qp; if (dlt > 128 || dlt < -128) s[nt][j] = -3.0e38f; } }
                float mx = fmaxf(fmaxf(fmaxf(s[0][0], s[0][1]), fmaxf(s[0][2], s[0][3])), fmaxf(fmaxf(s[1][0], s[1][1]), fmaxf(s[1][2], s[1][3])));
                mx = fmaxf(mx, fmaxf(fmaxf(fmaxf(s[2][0], s[2][1]), fmaxf(s[2][2], s[2][3])), fmaxf(fmaxf(s[3][0], s[3][1]), fmaxf(s[3][2], s[3][3]))));
                mx = row4_max(mx);
                const float mnew = fmaxf(mrun[mt], mx), alpha = __builtin_amdgcn_exp2f(mrun[mt] - mnew); mrun[mt] = mnew;
                float ps = 0.f;
#pragma unroll
                for (int nt = 0; nt < 4; ++nt)
#pragma unroll
                    for (int j = 0; j < 4; ++j) { const float p = __builtin_amdgcn_exp2f(s[nt][j] - mnew); s[nt][j] = p; ps += p; }
                lrun[mt] = lrun[mt] * alpha + ps;
                pf[mt][0].x = cvt_pk_bf16(s[0][0], s[0][1]); pf[mt][0].y = cvt_pk_bf16(s[0][2], s[0][3]); pf[mt][0].z = cvt_pk_bf16(s[1][0], s[1][1]); pf[mt][0].w = cvt_pk_bf16(s[1][2], s[1][3]);
                pf[mt][1].x = cvt_pk_bf16(s[2][0], s[2][1]); pf[mt][1].y = cvt_pk_bf16(s[2][2], s[2][3]); pf[mt][1].z = cvt_pk_bf16(s[3][0], s[3][1]); pf[mt][1].w = cvt_pk_bf16(s[3][2], s[3][3]);
#pragma unroll
                for (int dt = 0; dt < 4; ++dt) oacc[mt][dt] = oacc[mt][dt] * alpha;
              } }
#pragma unroll
            for (int dt = 0; dt < 4; ++dt) {
                const bf16x8 v0 = frag_tr(Vb, 4 * fq, 16 + 4 * fq, dt * 16, STR64, fr), v1 = frag_tr(Vb, 32 + 4 * fq, 48 + 4 * fq, dt * 16, STR64, fr);
#pragma unroll
                for (int mt = 0; mt < 4; ++mt) { MMA16(oacc[mt][dt], __builtin_bit_cast(bf16x8, pf[mt][0]), v0); MMA16(oacc[mt][dt], __builtin_bit_cast(bf16x8, pf[mt][1]), v1); } }
        }
        if (t + 1 < ntile) { LAS unsigned char* nb_ = lds + ((t + 1) & 1) * A_BUF; *(LAS u32x4*)(nb_ + A_KBUF + sr * STR64 + sc * 16) = kreg; *(LAS u32x4*)(nb_ + A_VBUF + sr * STR64 + sc * 16) = vreg; }
        __syncthreads();
    }
#pragma unroll
    for (int mt = 0; mt < 4; ++mt) { const float l = row4_sum(lrun[mt]); const float inv = 1.0f / l;
        bf16_t* op = BR + (size_t)(qrow0 + 64 * qh + 16 * mt + fr) * 1536 + 512 + (4 * kh + hq) * 64 + 4 * fq;
#pragma unroll
        for (int dt = 0; dt < 4; ++dt) { u32x2 w; w.x = cvt_pk_bf16(oacc[mt][dt][0] * inv, oacc[mt][dt][1] * inv); w.y = cvt_pk_bf16(oacc[mt][dt][2] * inv, oacc[mt][dt][3] * inv); *(u32x2*)(op + dt * 16) = w; } }
}

__device__ __forceinline__ void ph_mixA(const bf16_t* P, const bf16_t* QR, const bf16_t* KV, bf16_t* BR, const float* sink, const float* gla_w2, const float* gla_b, float* DS, float* DEC, float* BC, bool ctxq, LAS unsigned char* lds, const Ctx cx) {
    { LAS float* w2s = (LAS float*)(lds + G1_W2); for (int i = tidx(cx); i < 2 * 16 * 256; i += 512) w2s[i] = gla_w2[i]; }
    for (int u = cx.bid; u < 256; u += cx.nb) { const int b = u >> 5, n = (u >> 1) & 15, kh = u & 1; attn_unit(QR, KV, BR, sink, b, kh, b * SEQ + n * 128, n * 128, lds, cx); }
    if (cx.nb == 256) {
        const int n = (cx.bid >> 1) & 15; const bool edge = (n == 0 || n == 15);
        if (ctxq && edge) { const int b = cx.bid >> 5, kh = cx.bid & 1; attn_unit(QR, KV, BR, sink, b, kh, TL + b * CTXL + (n == 15 ? 128 : 0), -1000000, lds, cx); }
        int rank; if (!ctxq) rank = cx.bid; else { const int blk = cx.bid >> 5, w = cx.bid & 31; rank = edge ? -1 : blk * 28 + (w - 2); }
        const int nv = (rank >= 0 && rank < 128) ? 5 : 4;
        G1In cur, nxt; g1_load(cur, P, gla_b, cx.bid >> 2, cx.bid & 3, tidx(cx));
#pragma unroll 1
        for (int k = 0; k < nv; ++k) { const int v = k < 4 ? cx.bid + 256 * k : 1024 + rank; const int vn = (k + 1 < nv) ? ((k + 1) < 4 ? cx.bid + 256 * (k + 1) : 1024 + rank) : -1;
            gla_state_unit(cur, nxt, vn, P, v >> 2, v & 3, gla_b, DS, DEC, BC, lds, cx);
            if (vn >= 0) cur = nxt; }
        return;
    }
    const int nsmall = (ctxq ? 32 : 0) + 1152;
    for (int u = cx.bid; u < nsmall; u += cx.nb) {
        int v = u;
        if (ctxq) { if (v < 32) { const int b = v >> 2, n = (v >> 1) & 1, kh = v & 1; attn_unit(QR, KV, BR, sink, b, kh, TL + b * CTXL + n * 128, -1000000, lds, cx); continue; } v -= 32; }
        { G1In cur, nxt; g1_load(cur, P, gla_b, v >> 2, v & 3, tidx(cx)); gla_state_unit(cur, nxt, -1, P, v >> 2, v & 3, gla_b, DS, DEC, BC, lds, cx); }
    }
}
__device__ __forceinline__ void ph_mixC(const bf16_t* P, const float* BC, const bf16_t* SE, const float* gng, bf16_t* BR, int nchunks, LAS unsigned char* lds, const Ctx cx) {
    const int n = nchunks * 4; int u = cx.bid; G3In cur, nxt;
    if (u < n) g3_load(cur, P, u >> 2, u & 3, BC, SE, tidx(cx));
    for (; u < n; u += cx.nb) { const int un = u + cx.nb; const bool hn = un < n;
        if (hn) g3_load(nxt, P, un >> 2, un & 3, BC, SE, tidx(cx));
        gla_out_unit(cur, P, u >> 2, u & 3, gng, BR, lds, cx);
        if (hn) cur = nxt; }
}

template <int MODE, class Epi, int ABLK = 0> __device__ __forceinline__ void ph_gemm(LAS unsigned char* lds, const bf16_t* A, const bf16_t* Bt, int lda, int ldb, int K, int nM, int nN, const Epi& E, unsigned* ctl, int moe_j, size_t bexp, const Ctx cx) {
    pg8::Prob<MODE> P; P.A = A; P.Bt = Bt; P.lda = lda; P.ldb = ldb; P.K = K; P.nM = nM; P.nN = nN; P.G = cx.nb; P.c = cx.bid; P.texp = (LAS int*)(lds + LDS_TEXP); P.bexp = bexp; P.nctx = (MODE == 3) ? moe_j : 0;
    if (MODE == 2) {
        __syncthreads();
        if (tidx(cx) < 256) ((LAS int*)(lds + LDS_TEXP))[tidx(cx)] = (int)xb_ld(ctl + CW_TEXP + moe_j * 256 + tidx(cx));
        P.nM = (int)xb_ld(ctl + CW_NT + moe_j);
        __syncthreads();
    }
    pg8::gemm_phase<Epi, pg8::Prob<MODE>, ABLK>(lds, P, E, cx);
}

__device__ __forceinline__ bool idle_ctx(unsigned* ctl, int j, int nN, Ctx& cx) {
    const int U = (int)xb_ld(ctl + CW_NT + j) * nN, rounds = (U + cx.nb - 1) / cx.nb, nidle = rounds * cx.nb - U;
    if (nidle < 64) return true;
    const int first = cx.nb - nidle; if (cx.bid < first) return false;
    cx.bid -= first; cx.nb = nidle; return true;
}

struct MKP { const float* in[24]; float* out; char* ws; };
typedef const MKP __attribute__((address_space(4)))* KPtr;
__device__ __forceinline__ KPtr kp() { KPtr q = (KPtr)__builtin_amdgcn_kernarg_segment_ptr(); OPQ_S(q); return q; }
#define IN_(i) ((const float*)q->in[i])
#define WSP(off) (ws + (off))

__global__ void __launch_bounds__(512, 2) mk_fwd(MKP p_unused) {
    extern __shared__ __attribute__((aligned(16))) unsigned char shm[];
    LAS unsigned char* lds = (LAS unsigned char*)shm;
    const int nb = gridDim.x; const int wv = __builtin_amdgcn_readfirstlane((int)(threadIdx.x >> 6));
    XcdBarrier bar;
    { KPtr q = kp(); char* ws = q->ws;
      if (threadIdx.x == 0) *(LAS u32x4*)(lds + LDS_BARW) = (u32x4){0u, 0u, 0u, 0u};
      __syncthreads();
      bar = xcd_barrier_post((unsigned*)WSP(WS_CTL) + CW_BAR, (volatile LAS unsigned*)(lds + LDS_BARW)); }

    { KPtr q = kp(); char* ws = q->ws; Ctx cx; cx.bid = blockIdx.x; cx.nb = nb; cx.wv = wv; OPQ_S(cx.bid); OPQ_S(cx.wv);
      ph_init(IN_(0), IN_(2), (float*)nullptr, (f32x2*)WSP(WS_CS), cx);
      ph_mod(IN_(1), IN_(3), IN_(4), IN_(5), (float*)WSP(WS_MOD), lds, cx);
      __syncthreads(); }
    { int rot = 0;
#pragma unroll 1
      for (int l = 0; l < DEPTH; ++l) {
          KPtr q = kp(); char* ws = q->ws; Ctx cx; cx.bid = blockIdx.x; cx.nb = nb; cx.wv = wv; OPQ_S(cx.bid); OPQ_S(cx.wv);
          ph_convert(mkjob(IN_(8) + (size_t)l * D * DIN, nullptr, (bf16_t*)WSP(WS_WIN) + (size_t)l * NP * D, DIN, D, 0, D, NP, 1), lds, cx, rot);
          ph_convert(mkjob(IN_(15) + (size_t)l * D * D, nullptr, (bf16_t*)WSP(WS_WO3) + (size_t)l * D * D, D, D, 0, D, D, 0), lds, cx, rot);
#pragma unroll 1
          for (int i = 0; i < 3; ++i) {
              ph_convert(mkjob(IN_(14) + ((size_t)l * 3 + i) * 512 * D, nullptr, (bf16_t*)WSP(WS_WBR) + (size_t)l * D * 1536, D, 1536, i * 512, 512, 1024, 0), lds, cx, rot);
          }
      }
#pragma unroll 1
      for (int j = 0; j < 2; ++j) {
          KPtr q = kp(); char* ws = q->ws; Ctx cx; cx.bid = blockIdx.x; cx.nb = nb; cx.wv = wv; OPQ_S(cx.bid); OPQ_S(cx.wv);
          ph_convert(mkjob(IN_(16) + (size_t)j * D * DFF, IN_(17) + (size_t)j * D * DFF, (bf16_t*)WSP(WS_WUPD) + (size_t)j * NUP * D, DFF, D, 0, D, NUP, 2), lds, cx, rot);
          ph_convert(mkjob(IN_(18) + (size_t)j * DFF * D, nullptr, (bf16_t*)WSP(WS_WDND) + (size_t)j * D * DFF, D, DFF, 0, DFF, D, 0), lds, cx, rot);
      }
    }
    { Ctx cx; cx.bid = 0; cx.nb = nb; cx.wv = wv; OPQ_S(cx.wv); xcd_barrier_first(bar, cx); }

#pragma unroll 1
    for (int l = 0; l < DEPTH; ++l) {
        const bool last = (l == DEPTH - 1), moe = (l & 1); const int j = l >> 1; const int nrows = last ? TL : T; const int nMr = nrows / 256;
        { KPtr q = kp(); char* ws = q->ws; Ctx cx; cx.bid = blockIdx.x; cx.nb = nb; cx.wv = wv; OPQ_S(cx.bid); OPQ_S(cx.wv); const float* modl = (const float*)WSP(WS_MOD) + (size_t)l * 9 * 6144;
          NormArgs a; a.XS = (bf16_t*)WSP(WS_XS); a.lf32 = a.cf32 = (l == 0); a.Xl = l ? (const void*)WSP(WS_XS) : (const void*)IN_(0); a.Xc = l ? (const void*)WSP(WS_XS) : (const void*)(IN_(2) - (size_t)TL * D); a.H = (bf16_t*)WSP(WS_H); a.g = IN_(6) + l * D; a.mod_shift = modl; a.mod_scale = modl + 1024; a.nrows = T;
          a.Y = (const bf16_t*)WSP(WS_YB); a.POS = (const int*)WSP(WS_POS); a.TOPKp = (const float*)WSP(WS_TOPK); a.mod_g5prev = (const float*)WSP(WS_MOD) + (size_t)(l > 0 ? l - 1 : 0) * 9 * 6144 + 5 * 1024; a.router = nullptr; a.TOPK = nullptr; a.cnt = nullptr;
          a.npart = 7; a.PART = (l == 1 || l == 3) ? (const float*)WSP(WS_PART) : nullptr; a.mod_gpart = (const float*)WSP(WS_MOD) + (size_t)(l > 0 ? l - 1 : 0) * 9 * 6144 + 5 * 1024;
          ph_norm<false>(a, l == 2, lds, cx); }
        { Ctx cx; cx.bid = 0; cx.nb = nb; cx.wv = wv; OPQ_S(cx.wv); xcd_barrier(bar, cx); }
        { KPtr q = kp(); char* ws = q->ws; Ctx cx; cx.bid = blockIdx.x; cx.nb = nb; cx.wv = wv; OPQ_S(cx.bid); OPQ_S(cx.wv);
          pg8::EpiWin E{(bf16_t*)WSP(WS_PH), (bf16_t*)WSP(WS_QR), (bf16_t*)WSP(WS_KV), (const f32x2*)WSP(WS_CS), lds + LDS_CSH}; ph_gemm<0>(lds, (const bf16_t*)WSP(WS_H), (const bf16_t*)WSP(WS_WIN) + (size_t)l * NP * D, D, D, D, T / 256, NP / 256, E, nullptr, 0, 0, cx); }
        { Ctx cx; cx.bid = 0; cx.nb = nb; cx.wv = wv; OPQ_S(cx.wv); xcd_barrier(bar, cx); }
        { KPtr q = kp(); char* ws = q->ws; Ctx cx; cx.bid = blockIdx.x; cx.nb = nb; cx.wv = wv; OPQ_S(cx.bid); OPQ_S(cx.wv);
          ph_mixA((const bf16_t*)WSP(WS_PH), (const bf16_t*)WSP(WS_QR), (const bf16_t*)WSP(WS_KV), (bf16_t*)WSP(WS_BR), IN_(10) + l * 8, IN_(11) + (size_t)l * 2 * 16 * 256, IN_(12) + (size_t)l * 2 * 256,
                  (float*)WSP(WS_R3), (float*)WSP(WS_DEC), (float*)WSP(WS_YB), !last, lds, cx); }
        { Ctx cx; cx.bid = 0; cx.nb = nb; cx.wv = wv; OPQ_S(cx.wv); xcd_barrier(bar, cx); }
        { KPtr q = kp(); char* ws = q->ws; Ctx cx; cx.bid = blockIdx.x; cx.nb = nb; cx.wv = wv; OPQ_S(cx.bid); OPQ_S(cx.wv);
          ph_gla_scan2((const float*)WSP(WS_R3), (const float*)WSP(WS_DEC), (bf16_t*)(WSP(WS_R3) + (size_t)2 * T * 512 * 4), cx); }
        { Ctx cx; cx.bid = 0; cx.nb = nb; cx.wv = wv; OPQ_S(cx.wv); xcd_barrier(bar, cx); }
        { KPtr q = kp(); char* ws = q->ws; Ctx cx; cx.bid = blockIdx.x; cx.nb = nb; cx.wv = wv; OPQ_S(cx.bid); OPQ_S(cx.wv);
          ph_conv((const bf16_t*)WSP(WS_PH), (bf16_t*)WSP(WS_BR), IN_(9) + (size_t)l * 3 * 512, nrows, cx);
          ph_mixC((const bf16_t*)WSP(WS_PH), (const float*)WSP(WS_YB), (const bf16_t*)(WSP(WS_R3) + (size_t)2 * T * 512 * 4), IN_(13) + l * 512, (bf16_t*)WSP(WS_BR), nrows / 64, lds, cx); }
        { Ctx cx; cx.bid = 0; cx.nb = nb; cx.wv = wv; OPQ_S(cx.wv); xcd_barrier(bar, cx); }
        { KPtr q = kp(); char* ws = q->ws; Ctx cx; cx.bid = blockIdx.x; cx.nb = nb; cx.wv = wv; OPQ_S(cx.bid); OPQ_S(cx.wv);
          constexpr size_t MG3C_OFF = (size_t)TL * D * 2;
          if (!last) { pg8::EpiGate E{(bf16_t*)(WSP(WS_R3) + MG3C_OFF), (const bf16_t*)WSP(WS_PH) + (size_t)TL * NP, lds + LDS_CSH}; ph_gemm<1>(lds, (const bf16_t*)WSP(WS_BR) + (size_t)TL * 1536, (const bf16_t*)WSP(WS_WBR) + (size_t)l * D * 1536, 1536, 1536, 512, 8, 12, E, nullptr, 0, 0, cx); }
          { pg8::EpiMerge E{(bf16_t*)WSP(WS_R3), (const bf16_t*)WSP(WS_PH), lds + LDS_CSH}; ph_gemm<4>(lds, (const bf16_t*)WSP(WS_BR), (const bf16_t*)WSP(WS_WBR) + (size_t)l * D * 1536, 1536, 1536, 1536, 64, 4, E, nullptr, 0, 0, cx); } }
        { Ctx cx; cx.bid = 0; cx.nb = nb; cx.wv = wv; OPQ_S(cx.wv); xcd_barrier(bar, cx); }
        { KPtr q = kp(); char* ws = q->ws; Ctx cx; cx.bid = blockIdx.x; cx.nb = nb; cx.wv = wv; OPQ_S(cx.bid); OPQ_S(cx.wv);
          constexpr size_t MG3C_OFF = (size_t)TL * D * 2;
          pg8::EpiResid E{(bf16_t*)WSP(WS_XS), (const float*)WSP(WS_MOD) + (size_t)l * 9 * 6144 + 2 * 1024, (float*)WSP(WS_PART), l ? (const void*)WSP(WS_XS) : (const void*)IN_(0), lds + LDS_CSH, l == 0, 0};
          if (!last) ph_gemm<5>(lds, (const bf16_t*)(WSP(WS_R3) + MG3C_OFF) - (size_t)TL * 3072, (const bf16_t*)WSP(WS_WO3) + (size_t)l * D * D, 3072, D, 512, 8, 4, E, nullptr, 0, 0, cx);
          ph_gemm<0>(lds, (const bf16_t*)WSP(WS_R3), (const bf16_t*)WSP(WS_WO3) + (size_t)l * D * D, D, D, D, 64, 4, E, nullptr, 0, 0, cx); }
        { Ctx cx; cx.bid = 0; cx.nb = nb; cx.wv = wv; OPQ_S(cx.wv); xcd_barrier(bar, cx); }
        { KPtr q = kp(); char* ws = q->ws; Ctx cx; cx.bid = blockIdx.x; cx.nb = nb; cx.wv = wv; OPQ_S(cx.bid); OPQ_S(cx.wv); const float* modl = (const float*)WSP(WS_MOD) + (size_t)l * 9 * 6144;
          NormArgs a; a.XS = (bf16_t*)WSP(WS_XS); a.lf32 = 0; a.cf32 = (l == 0); a.Xl = (const void*)WSP(WS_XS); a.Xc = l ? (const void*)WSP(WS_XS) : (const void*)(IN_(2) - (size_t)TL * D); a.H = (bf16_t*)WSP(WS_H); a.g = IN_(7) + l * D; a.mod_shift = modl + 3 * 1024; a.mod_scale = modl + 4 * 1024; a.nrows = nrows;
          a.Y = nullptr; a.POS = nullptr; a.TOPKp = nullptr; a.mod_g5prev = nullptr; a.router = IN_(19) + (size_t)j * D * 8; a.TOPK = (float*)WSP(WS_TOPK); a.cnt = (unsigned*)WSP(WS_CTL) + CW_CNT + j * 64;
          a.npart = 6; a.PART = last ? nullptr : (const float*)WSP(WS_PART); a.mod_gpart = modl + 2 * 1024;
          if (moe) ph_norm<true>(a, false, lds, cx); else ph_norm<false>(a, false, lds, cx); }
        if (moe && j == 0) {
            int rot = 0;
#pragma unroll 1
            for (int e = 0; e < NEXP; ++e) { KPtr q = kp(); char* ws = q->ws; Ctx cx; cx.bid = blockIdx.x; cx.nb = nb; cx.wv = wv; OPQ_S(cx.bid); OPQ_S(cx.wv); const size_t eo = ((size_t)j * NEXP + e) * D * DFF;
                ph_convert(mkjob(IN_(20) + eo, IN_(21) + eo, (bf16_t*)WSP(WS_WUPM) + (size_t)e * NUP * D, DFF, D, 0, D, NUP, 2), lds, cx, rot);
            }
        }
        { Ctx cx; cx.bid = 0; cx.nb = nb; cx.wv = wv; OPQ_S(cx.wv); xcd_barrier(bar, cx); }
        if (!moe) {
            { KPtr q = kp(); char* ws = q->ws; Ctx cx; cx.bid = blockIdx.x; cx.nb = nb; cx.wv = wv; OPQ_S(cx.bid); OPQ_S(cx.wv);
              pg8::EpiSwiglu E{(bf16_t*)WSP(WS_PH)}; ph_gemm<0>(lds, (const bf16_t*)WSP(WS_H), (const bf16_t*)WSP(WS_WUPD) + (size_t)j * NUP * D, D, D, D, nMr, NUP / 256, E, nullptr, 0, 0, cx); }
            { Ctx cx; cx.bid = 0; cx.nb = nb; cx.wv = wv; OPQ_S(cx.wv); xcd_barrier(bar, cx); }
            { KPtr q = kp(); char* ws = q->ws; Ctx cx; cx.bid = blockIdx.x; cx.nb = nb; cx.wv = wv; OPQ_S(cx.bid); OPQ_S(cx.wv);
              pg8::EpiResid E{(bf16_t*)WSP(WS_XS), (const float*)WSP(WS_MOD) + (size_t)l * 9 * 6144 + 5 * 1024, (float*)WSP(WS_PART), (const void*)WSP(WS_XS), lds + LDS_CSH, 0, 0}; ph_gemm<3, pg8::EpiResid, 1>(lds, (const bf16_t*)WSP(WS_PH), (const bf16_t*)WSP(WS_WDND) + (size_t)j * D * DFF, DFF, DFF, DFF, nMr, 4, E, nullptr, last ? 0 : 224, 0, cx); }
            { Ctx cx; cx.bid = 0; cx.nb = nb; cx.wv = wv; OPQ_S(cx.wv); xcd_barrier(bar, cx); }
        } else {
            { KPtr q = kp(); char* ws = q->ws; Ctx cx; cx.bid = blockIdx.x; cx.nb = nb; cx.wv = wv; OPQ_S(cx.bid); OPQ_S(cx.wv);
              ph_route((const float*)WSP(WS_TOPK), (const bf16_t*)WSP(WS_H), (bf16_t*)WSP(WS_R3), (int*)WSP(WS_POS), (unsigned*)WSP(WS_CTL), j, nrows, lds, cx); }
            { Ctx cx; cx.bid = 0; cx.nb = nb; cx.wv = wv; OPQ_S(cx.wv); xcd_barrier(bar, cx); }
            { KPtr q = kp(); char* ws = q->ws; Ctx cx; cx.bid = blockIdx.x; cx.nb = nb; cx.wv = wv; OPQ_S(cx.bid); OPQ_S(cx.wv);
              pg8::EpiSwiglu E{(bf16_t*)WSP(WS_PH)}; ph_gemm<2>(lds, (const bf16_t*)WSP(WS_R3), (const bf16_t*)WSP(WS_WUPM), D, D, D, 0, NUP / 256, E, (unsigned*)WSP(WS_CTL), j, (size_t)NUP * D, cx);
              { Ctx c2 = cx; if (idle_ctx((unsigned*)WSP(WS_CTL), j, NUP / 256, c2)) { int rot = 0;
#pragma unroll 1
                  for (int e = 0; e < NEXP; ++e) { const size_t eo = ((size_t)j * NEXP + e) * D * DFF; ph_convert(mkjob(IN_(22) + eo, nullptr, (bf16_t*)WSP(WS_WDNM) + (size_t)e * D * DFF, D, DFF, 0, DFF, D, 0), lds, c2, rot); } } } }
            { Ctx cx; cx.bid = 0; cx.nb = nb; cx.wv = wv; OPQ_S(cx.wv); xcd_barrier(bar, cx); }
            { KPtr q = kp(); char* ws = q->ws; Ctx cx; cx.bid = blockIdx.x; cx.nb = nb; cx.wv = wv; OPQ_S(cx.bid); OPQ_S(cx.wv);
              pg8::EpiBf16 E{(bf16_t*)WSP(WS_YB), lds + LDS_CSH, D, 0}; ph_gemm<2, pg8::EpiBf16, 1>(lds, (const bf16_t*)WSP(WS_PH), (const bf16_t*)WSP(WS_WDNM), DFF, DFF, DFF, 0, 4, E, (unsigned*)WSP(WS_CTL), j, (size_t)D * DFF, cx);
              if (j == 0) { Ctx c2 = cx; if (idle_ctx((unsigned*)WSP(WS_CTL), j, 4, c2)) { int rot = 0;
#pragma unroll 1
                  for (int e = 0; e < NEXP; ++e) { const size_t eo = ((size_t)NEXP + e) * D * DFF; ph_convert(mkjob(IN_(20) + eo, IN_(21) + eo, (bf16_t*)WSP(WS_WUPM) + (size_t)e * NUP * D, DFF, D, 0, D, NUP, 2), lds, c2, rot); } } } }
            { Ctx cx; cx.bid = 0; cx.nb = nb; cx.wv = wv; OPQ_S(cx.wv); xcd_barrier(bar, cx); }
        }
    }
    { KPtr q = kp(); char* ws = q->ws; Ctx cx; cx.bid = blockIdx.x; cx.nb = nb; cx.wv = wv; OPQ_S(cx.bid); OPQ_S(cx.wv);
      ph_final((const bf16_t*)WSP(WS_XS), (const bf16_t*)WSP(WS_YB), (const int*)WSP(WS_POS), (const float*)WSP(WS_TOPK), (const float*)WSP(WS_MOD) + (size_t)3 * 9 * 6144 + 5 * 1024, IN_(23), q->out, cx); }
}

extern "C" void kernel_launch(void* const* d_in, const int* in_sizes, int n_in, void* d_out, int out_size, void* d_ws, size_t ws_size, hipStream_t stream) {
    (void)in_sizes; (void)out_size;
    if (n_in != 24 || ws_size < WS_END) return;
    static int grid = 0;
    if (!grid) {
        int dev = 0, cus = 0, per_cu = 0;
        if (hipGetDevice(&dev) != hipSuccess || hipDeviceGetAttribute(&cus, hipDeviceAttributeMultiprocessorCount, dev) != hipSuccess) return;
        if (hipFuncSetAttribute((const void*)mk_fwd, hipFuncAttributeMaxDynamicSharedMemorySize, LDS_BYTES) != hipSuccess) return;
        if (hipOccupancyMaxActiveBlocksPerMultiprocessor(&per_cu, mk_fwd, 512, LDS_BYTES) != hipSuccess || per_cu < 1) return;
        if (cus != 256) return;
        grid = cus;
    }
    (void)hipMemsetAsync((char*)d_ws + WS_CTL, 0, CTL_BYTES, stream);
    MKP p;
    for (int i = 0; i < 24; ++i) p.in[i] = (const float*)d_in[i];
    p.out = (float*)d_out; p.ws = (char*)d_ws;
    hipLaunchKernelGGL(mk_fwd, dim3(grid), dim3(512), LDS_BYTES, stream, p);
}
```

```cpp
#include <hip/hip_runtime.h>
#include <stdint.h>
#include <stddef.h>

#define LAS __attribute__((address_space(3)))
typedef unsigned short bf16_t;
typedef short bf16x8 __attribute__((ext_vector_type(8)));
typedef float f32x4 __attribute__((ext_vector_type(4)));
typedef float f32x2 __attribute__((ext_vector_type(2)));
typedef unsigned u32x4 __attribute__((ext_vector_type(4)));
typedef unsigned u32x2 __attribute__((ext_vector_type(2)));

constexpr int D = 1024, NBATCH = 8, SEQ = 2048, CTXL = 256, DEPTH = 4;
constexpr int TL = NBATCH * SEQ, TC = NBATCH * CTXL, T = TL + TC;
constexpr int DIN = 6944, NP = 7168;
constexpr int DFF = 3584, NUP = 2 * DFF;
constexpr int NEXP = 8;
constexpr int MAXR = 2 * T + NEXP * 256;
constexpr int P_CB = 0, P_CC = 512, P_CU = 1024, P_QA = 1536, P_KA = 2048, P_VA = 2176, P_QG = 2304, P_KG = 2560, P_VG = 2816, P_RG = 3328, P_GATE = 3840, P_AG = 6912;
constexpr float EPS = 1e-6f;
constexpr float LOG2E = 1.4426950408889634f, QSCALE = 0.125f * LOG2E;

constexpr size_t al256(size_t x) { return (x + 255) & ~(size_t)255; }
constexpr size_t WS_CTL = 0;                                   constexpr size_t CTL_BYTES = 65536;
constexpr size_t WS_MOD = WS_CTL + CTL_BYTES;                  constexpr size_t MOD_BYTES = (size_t)DEPTH * 9 * 6 * D * 4;
constexpr size_t WS_CS = al256(WS_MOD + MOD_BYTES);            constexpr size_t CS_BYTES = 64 * 16 * 8;
constexpr size_t WS_XS = al256(WS_CS + CS_BYTES);              constexpr size_t XS_BYTES = (size_t)T * D * 4;
constexpr size_t WS_H = al256(WS_XS + XS_BYTES);               constexpr size_t H_BYTES = (size_t)T * D * 2;
constexpr size_t WS_PH = al256(WS_H + H_BYTES);                constexpr size_t PH_BYTES = (size_t)MAXR * DFF * 2;
constexpr size_t WS_BR = al256(WS_PH + PH_BYTES);              constexpr size_t BR_BYTES = (size_t)T * 1536 * 2;
constexpr size_t WS_R3 = al256(WS_BR + BR_BYTES);              constexpr size_t R3_BYTES = (size_t)T * 3072 * 2;
constexpr size_t WS_YB = al256(WS_R3 + R3_BYTES);              constexpr size_t YB_BYTES = (size_t)MAXR * D * 2;
constexpr size_t WS_QR = al256(WS_YB + YB_BYTES);              constexpr size_t QR_BYTES = (size_t)T * 512 * 2;
constexpr size_t WS_KV = al256(WS_QR + QR_BYTES);              constexpr size_t KV_BYTES = (size_t)T * 256 * 2;
constexpr size_t WS_TOPK = al256(WS_KV + KV_BYTES);            constexpr size_t TOPK_BYTES = (size_t)T * 16;
constexpr size_t WS_POS = al256(WS_TOPK + TOPK_BYTES);         constexpr size_t POS_BYTES = (size_t)T * 8;
constexpr size_t WS_IDX = al256(WS_POS + POS_BYTES);           constexpr size_t IDX_BYTES = (size_t)MAXR * 4;
constexpr size_t WS_DEC = al256(WS_IDX + IDX_BYTES);           constexpr size_t DEC_BYTES = (size_t)(T / 64) * 4 * 2 * 64 * 4;
constexpr size_t WS_PART = al256(WS_DEC + DEC_BYTES);         constexpr size_t PART_BYTES = (size_t)7 * TC * D * 4;
constexpr size_t WS_WIN = al256(WS_PART + PART_BYTES);           constexpr size_t WIN_BYTES = (size_t)DEPTH * NP * D * 2;
constexpr size_t WS_WBR = al256(WS_WIN + WIN_BYTES);           constexpr size_t WBR_BYTES = (size_t)DEPTH * D * 1536 * 2;
constexpr size_t WS_WO3 = al256(WS_WBR + WBR_BYTES);           constexpr size_t WO3_BYTES = (size_t)DEPTH * D * D * 2;
constexpr size_t WS_WUPD = al256(WS_WO3 + WO3_BYTES);          constexpr size_t WUPD_BYTES = (size_t)2 * NUP * D * 2;
constexpr size_t WS_WDND = al256(WS_WUPD + WUPD_BYTES);        constexpr size_t WDND_BYTES = (size_t)2 * D * DFF * 2;
constexpr size_t WS_WUPM = al256(WS_WDND + WDND_BYTES);        constexpr size_t WUPM_BYTES = (size_t)NEXP * NUP * D * 2;
constexpr size_t WS_WDNM = al256(WS_WUPM + WUPM_BYTES);        constexpr size_t WDNM_BYTES = (size_t)NEXP * D * DFF * 2;
constexpr size_t WS_END = al256(WS_WDNM + WDNM_BYTES);
constexpr int CW_CNT = 0;
constexpr int CW_FILL = 128;
constexpr int CW_TEXP = 1024;
constexpr int CW_NT = 1536;

typedef __bf16 bf16x2_t __attribute__((ext_vector_type(2)));
__device__ __forceinline__ unsigned cvt_pk_bf16(float lo, float hi) { const f32x2 v = {lo, hi}; return __builtin_bit_cast(unsigned, __builtin_convertvector(v, bf16x2_t)); }
__device__ __forceinline__ float bf_lo(unsigned w) { return __uint_as_float(w << 16); }
__device__ __forceinline__ float bf_hi(unsigned w) { return __uint_as_float(w & 0xffff0000u); }
__device__ __forceinline__ float bf2f(bf16_t b) { return __uint_as_float(((unsigned)b) << 16); }
__device__ __forceinline__ bf16_t f2bf(float f) { return (bf16_t)(cvt_pk_bf16(f, 0.f) & 0xffffu); }
__device__ __forceinline__ float sigmoidf_(float x) { return __builtin_amdgcn_rcpf(1.0f + __builtin_amdgcn_exp2f(x * -1.4426950408889634f)); }
__device__ __forceinline__ float siluf_(float x) { return x * __builtin_amdgcn_rcpf(1.0f + __builtin_amdgcn_exp2f(x * -1.4426950408889634f)); }
__device__ __forceinline__ float shx(float v, int mask, int lane) { return __int_as_float(__builtin_amdgcn_ds_bpermute((lane ^ mask) << 2, __float_as_int(v))); }
__device__ __forceinline__ float shl_(float v, int src) { return __int_as_float(__builtin_amdgcn_ds_bpermute(src << 2, __float_as_int(v))); }
__device__ __forceinline__ float wave_total(float v) {
    v += __int_as_float(__builtin_amdgcn_update_dpp(0, __float_as_int(v), 0x111, 0xF, 0xF, true));
    v += __int_as_float(__builtin_amdgcn_update_dpp(0, __float_as_int(v), 0x112, 0xF, 0xF, true));
    v += __int_as_float(__builtin_amdgcn_update_dpp(0, __float_as_int(v), 0x114, 0xF, 0xF, true));
    v += __int_as_float(__builtin_amdgcn_update_dpp(0, __float_as_int(v), 0x118, 0xF, 0xF, true));
    v += __int_as_float(__builtin_amdgcn_update_dpp(0, __float_as_int(v), 0x142, 0xA, 0xF, false));
    v += __int_as_float(__builtin_amdgcn_update_dpp(0, __float_as_int(v), 0x143, 0xC, 0xF, false));
    return __int_as_float(__builtin_amdgcn_readlane(__float_as_int(v), 63));
}
__device__ __forceinline__ float wave_sum(float v, int lane) {
#pragma unroll
    for (int o = 32; o >= 1; o >>= 1) v += shx(v, o, lane);
    return v;
}
__device__ __forceinline__ float wave_max(float v, int lane) {
#pragma unroll
    for (int o = 32; o >= 1; o >>= 1) v = fmaxf(v, shx(v, o, lane));
    return v;
}
__device__ __forceinline__ unsigned lds_add(LAS unsigned* p, unsigned v) { return __hip_atomic_fetch_add(p, v, __ATOMIC_RELAXED, __HIP_MEMORY_SCOPE_WORKGROUP); }
__device__ __forceinline__ f32x4 ldx_raw(const void* base, bool f32src, size_t idx) { if (f32src) return *(const f32x4*)((const float*)base + idx); const u32x2 w = *(const u32x2*)((const bf16_t*)base + idx); return (f32x4){__uint_as_float(w.x), __uint_as_float(w.y), 0.f, 0.f}; }
__device__ __forceinline__ f32x4 cvx(const f32x4 raw, bool f32src) { if (f32src) return raw; const unsigned a = __float_as_uint(raw[0]), b = __float_as_uint(raw[1]); return (f32x4){__uint_as_float(a << 16), __uint_as_float(a & 0xffff0000u), __uint_as_float(b << 16), __uint_as_float(b & 0xffff0000u)}; }
__device__ __forceinline__ void stx(bf16_t* p, const f32x4 v) { u32x2 w; w.x = cvt_pk_bf16(v[0], v[1]); w.y = cvt_pk_bf16(v[2], v[3]); *(u32x2*)p = w; }
__device__ __forceinline__ int mod_row(int row) { return row < TL ? (row >> 11) : 8; }
struct Ctx { int bid, nb, wv; };
__device__ __forceinline__ int tidx(const Ctx& cx) { int z = cx.wv << 6; asm volatile("" : "+s"(z)); return (int)__builtin_amdgcn_mbcnt_hi(~0u, __builtin_amdgcn_mbcnt_lo(~0u, (unsigned)z)); }
#define OPQ_S(x) asm volatile("" : "+s"(x))
__device__ __forceinline__ float vmax2(float a, float b) { return __builtin_elementwise_maximum(a, b); }
__device__ __forceinline__ float row4_max(float v) { auto a = __builtin_amdgcn_permlane16_swap(__float_as_uint(v), __float_as_uint(v), false, false); v = vmax2(__uint_as_float(a[0]), __uint_as_float(a[1]));
    auto b = __builtin_amdgcn_permlane32_swap(__float_as_uint(v), __float_as_uint(v), false, false); return vmax2(__uint_as_float(b[0]), __uint_as_float(b[1])); }
__device__ __forceinline__ float row4_sum(float v) { auto a = __builtin_amdgcn_permlane16_swap(__float_as_uint(v), __float_as_uint(v), false, false); v = __uint_as_float(a[0]) + __uint_as_float(a[1]);
    auto b = __builtin_amdgcn_permlane32_swap(__float_as_uint(v), __float_as_uint(v), false, false); return __uint_as_float(b[0]) + __uint_as_float(b[1]); }

__device__ __forceinline__ u32x4 pack8(const float* v) { u32x4 w; w.x = cvt_pk_bf16(v[0], v[1]); w.y = cvt_pk_bf16(v[2], v[3]); w.z = cvt_pk_bf16(v[4], v[5]); w.w = cvt_pk_bf16(v[6], v[7]); return w; }
__device__ __forceinline__ void unpack8(const u32x4 w, float* v) { v[0] = bf_lo(w.x); v[1] = bf_hi(w.x); v[2] = bf_lo(w.y); v[3] = bf_hi(w.y); v[4] = bf_lo(w.z); v[5] = bf_hi(w.z); v[6] = bf_lo(w.w); v[7] = bf_hi(w.w); }
namespace pg8 {
constexpr int BM = 256, BK = 64, HALF = 128, HTB = HALF * BK * 2, STAGE_BYTES = 8 * HTB, NXCD = 8, WGM = 8;
constexpr int CSH_STR = 144, CSH_SLICE = 16 * CSH_STR;
__host__ __device__ __forceinline__ int lds_byte(int r, int c) { const int st = (r >> 4) * 2 + (c >> 5), rr = r & 15, cc = c & 31, ob = rr * 64 + cc * 2; return st * 1024 + (ob ^ (((ob >> 9) & 1) << 5)); }
__host__ __device__ __forceinline__ void stage_rc(int b, int& R, int& C) { const int st = b / 1024, sb = b % 1024, swz = sb ^ (((sb >> 9) & 1) << 5); R = (st >> 1) * 16 + swz / 64; C = (st & 1) * 32 + (swz % 64) / 2; }
__host__ __device__ __forceinline__ int perm32(int rho) { const int n = rho >> 4, i = rho & 15; return 8 * (i >> 2) + 4 * n + (i & 3); }
struct Unit { int pm, pn, kofs, kofsB, nt, part; };

__device__ __forceinline__ bool static_next(int i, int G, int c, int nM, int nN, Unit& u) {
    const int nwg = nM * nN; const long L = (long)i * G + c; if (L >= nwg) return false;
    int wgid = (int)L; { const int q = nwg / NXCD, r = nwg % NXCD, xcd = wgid % NXCD, off = wgid / NXCD; wgid = (xcd < r ? xcd * (q + 1) : r * (q + 1) + (xcd - r) * q) + off; }
    const int nig = WGM * nN, gid = wgid / nig, fm = gid * WGM, gsz = (nM - fm) < WGM ? (nM - fm) : WGM;
    u.pm = fm + ((wgid % nig) % gsz); u.pn = (wgid % nig) / gsz; return true;
}

template <int MODE> struct Prob {
    const bf16_t* A; const bf16_t* Bt; int lda, ldb, K, nM, nN, G, c; const LAS int* texp; size_t bexp; int nctx;
    __device__ __forceinline__ bool next(int i, Unit& u) const {
        u.kofs = 0; u.kofsB = 0; u.nt = K / BK; u.part = -1;
        if (MODE == 3) {
            const int idx = i + (c < nctx ? 0 : 1);
            if (idx == 0) { const int ct = c / 7; u.pm = 64 + (ct >> 2); u.pn = ct & 3; u.part = c - ct * 7; u.nt = K / (7 * BK); u.kofs = u.part * (K / 7); u.kofsB = u.kofs; return true; }
            return static_next(idx - 1, G, c, 64, 4, u);
        }
        if (MODE == 4) { const int seg = i % 3; u.kofs = seg * 512; u.kofsB = u.kofs; u.nt = 8; u.part = seg; return static_next(i / 3, G, c, 64, 4, u); }
        if (MODE == 5) { const int L = i * G + c; if (L >= 192) return false; const int ct = L / 6, sub = L - ct * 6; u.pm = 64 + (ct >> 2); u.pn = ct & 3; u.part = sub; u.nt = 8; u.kofs = (sub >> 1) * 1024 + (sub & 1) * 512; u.kofsB = (sub & 1) * 512; return true; }
        const bool ok = static_next(i, G, c, nM, nN, u);
        if (MODE == 1) { u.kofs = (u.pn >> 2) * 512; u.kofsB = u.kofs; }
        return ok;
    }
    __device__ __forceinline__ const char* a_base(const Unit& u, bool ablk) const { return (const char*)(A + (size_t)u.pm * BM * lda + (ablk ? 2 * u.kofs : u.kofs)); }
    __device__ __forceinline__ const char* b_base(const Unit& u) const { const bf16_t* p = Bt + (size_t)(MODE == 1 ? (u.pn & 3) : u.pn) * BM * ldb + 2 * u.kofsB; if (MODE == 2) p += (size_t)texp[u.pm] * bexp; return (const char*)p; }
};

template <class Epi, class PB, int ABLK>
__device__ __forceinline__ void gemm_phase(LAS unsigned char* lds, const PB& P, const Epi& E, const Ctx cx) {
    const int tid = tidx(cx), wid = __builtin_amdgcn_readfirstlane(tid >> 6), lane = tid & 63, wr = wid >> 2, wc = wid & 3, fr = lane & 15, fq = lane >> 4;
    unsigned voffA[2], voffB[2];
#pragma unroll
    for (int i = 0; i < 2; ++i) { int R, C; stage_rc(tid * 16 + i * 8192, R, C); const int Rb = (int)Epi::PERM == 2 ? (2 * (R & ~31) + perm32(R & 31)) : Epi::PERM ? ((R & ~31) + perm32(R & 31)) : R;
        voffA[i] = ABLK ? (unsigned)((((R >> 1) * (P.lda >> 5) + (C >> 5)) * 64 + (R & 1) * 32 + (C & 31)) * 2) : (unsigned)(R * P.lda + C) * 2u;     voffB[i] = (unsigned)((((Rb >> 1) * (P.ldb >> 5) + (C >> 5)) * 64 + (Rb & 1) * 32 + (C & 31)) * 2);     }
    const size_t kstep = (size_t)(BK * 4), kstepA = ABLK ? (size_t)(BK * 4) : (size_t)(BK * 2);
    const size_t hstepA = (size_t)HALF * P.lda * 2, hstepB = (size_t)((int)Epi::PERM == 2 ? 32 : HALF) * P.ldb * 2;
    const unsigned ldsw = (unsigned)wid * 1024u;
    const int aoff = lds_byte(wr * 64 + fr, fq * 8), boff = lds_byte(wc * 32 + fr, fq * 8);
#define PG8_SA(b, h) (((b) * 2 + (h)) * HTB)
#define PG8_SB(b, h) ((4 + (b) * 2 + (h)) * HTB)
#define PG8_STAGE(bufoff, gbase, voff) do { _Pragma("unroll") for (int _i = 0; _i < 2; ++_i) \
        __builtin_amdgcn_global_load_lds((const unsigned*)((const char*)(gbase) + (voff)[_i]), (LAS unsigned*)(lds + (bufoff) + ldsw + _i * 8192), 16, 0, 0); } while (0)
#define PG8_LDA(dst, b, h) do { _Pragma("unroll") for (int m = 0; m < 4; ++m) _Pragma("unroll") for (int k = 0; k < 2; ++k) dst[m][k] = *(const LAS bf16x8*)(lds + PG8_SA(b, h) + aoff + m * 2048 + k * 1024); } while (0)
#define PG8_LDB(dst, b, h) do { _Pragma("unroll") for (int n = 0; n < 2; ++n) _Pragma("unroll") for (int k = 0; k < 2; ++k) dst[n][k] = *(const LAS bf16x8*)(lds + PG8_SB(b, h) + boff + n * 2048 + k * 1024); } while (0)
#define PG8_MMA(ai, bj, At, Bt) do { __builtin_amdgcn_s_setprio(1); _Pragma("unroll") for (int m = 0; m < 4; ++m) _Pragma("unroll") for (int n = 0; n < 2; ++n) _Pragma("unroll") for (int k = 0; k < 2; ++k) \
        acc[ai][bj][m][n] = __builtin_amdgcn_mfma_f32_16x16x32_bf16(Bt[n][k], At[m][k], acc[ai][bj][m][n], 0, 0, 0); __builtin_amdgcn_s_setprio(0); } while (0)
#define PG8_WAIT_V(n) asm volatile("s_waitcnt vmcnt(" #n ")" ::: "memory")
#define PG8_WAIT_L(n) asm volatile("s_waitcnt lgkmcnt(" #n ")" ::: "memory")
#define PG8_BAR __builtin_amdgcn_s_barrier()
#define PG8_SCHED __builtin_amdgcn_sched_barrier(0)
    Unit cur, nxt; int ui = 0;
    if (!P.next(0, cur)) return;
    f32x4 acc[2][2][4][2];
#pragma unroll
    for (int a = 0; a < 2; ++a)
#pragma unroll
        for (int b = 0; b < 2; ++b)
#pragma unroll
            for (int m = 0; m < 4; ++m)
#pragma unroll
                for (int n = 0; n < 2; ++n) acc[a][b][m][n] = (f32x4){0.f, 0.f, 0.f, 0.f};
    bf16x8 At[4][2], B0[2][2], B1[2][2];
    const char* cA = P.a_base(cur, ABLK != 0); const char* cB = P.b_base(cur);
    PG8_STAGE(PG8_SB(0, 0), cB, voffB); PG8_STAGE(PG8_SB(0, 1), cB + hstepB, voffB); PG8_STAGE(PG8_SA(0, 0), cA, voffA); PG8_STAGE(PG8_SA(0, 1), cA + hstepA, voffA);
    if (wr == 1) PG8_BAR;
    PG8_WAIT_V(2); PG8_BAR;
    PG8_STAGE(PG8_SB(1, 0), cB + kstep, voffB); PG8_STAGE(PG8_SA(1, 0), cA + kstepA, voffA); PG8_STAGE(PG8_SB(1, 1), cB + hstepB + kstep, voffB);
    PG8_WAIT_V(6); PG8_BAR;
    for (;;) {
        const bool has_next = P.next(ui + 1, nxt);
        const char* nA = has_next ? P.a_base(nxt, ABLK != 0) : cA; const char* nB = has_next ? P.b_base(nxt) : cB;
        const int nt = cur.nt;
        for (int t = 0; t < nt; t += 2) {
            const bool last = (t == nt - 2);
            const char* a1 = cA + (size_t)(t + 1) * kstepA;
            const char* a2 = last ? nA : cA + (size_t)(t + 2) * kstepA; const char* b2 = last ? nB : cB + (size_t)(t + 2) * kstep;
            const char* a3 = a2 + kstepA; const char* b3 = b2 + kstep;
            PG8_LDB(B0, 0, 0); PG8_LDB(B1, 0, 1); PG8_SCHED; PG8_LDA(At, 0, 0); PG8_STAGE(PG8_SA(1, 1), a1 + hstepA, voffA);
            PG8_WAIT_V(8); PG8_WAIT_L(0); PG8_BAR; PG8_MMA(0, 0, At, B0); PG8_MMA(0, 1, At, B1); PG8_BAR; PG8_SCHED;
            PG8_LDA(At, 0, 1); PG8_STAGE(PG8_SB(0, 0), b2, voffB); PG8_STAGE(PG8_SB(0, 1), b2 + hstepB, voffB); PG8_STAGE(PG8_SA(0, 0), a2, voffA);
            PG8_WAIT_V(8); PG8_WAIT_L(0); PG8_BAR; PG8_MMA(1, 0, At, B0); PG8_MMA(1, 1, At, B1); PG8_BAR; PG8_SCHED;
            PG8_LDB(B0, 1, 0); PG8_LDB(B1, 1, 1); PG8_SCHED; PG8_LDA(At, 1, 0); PG8_STAGE(PG8_SA(0, 1), a2 + hstepA, voffA);
            PG8_WAIT_V(8); PG8_WAIT_L(0); PG8_BAR; PG8_MMA(0, 0, At, B0); PG8_MMA(0, 1, At, B1); PG8_BAR; PG8_SCHED;
            PG8_LDA(At, 1, 1); PG8_STAGE(PG8_SB(1, 0), b3, voffB); PG8_STAGE(PG8_SB(1, 1), b3 + hstepB, voffB); PG8_STAGE(PG8_SA(1, 0), a3, voffA);
            PG8_WAIT_V(8); PG8_WAIT_L(0); PG8_BAR; PG8_MMA(1, 0, At, B0); PG8_MMA(1, 1, At, B1); PG8_BAR; PG8_SCHED;
        }
        if (wr == 0) PG8_BAR;
        E(acc, cur, wr, wc, fr, fq);
        if (!has_next) break;
#pragma unroll
        for (int a = 0; a < 2; ++a)
#pragma unroll
            for (int b = 0; b < 2; ++b)
#pragma unroll
                for (int m = 0; m < 4; ++m)
#pragma unroll
                    for (int n = 0; n < 2; ++n) acc[a][b][m][n] = (f32x4){0.f, 0.f, 0.f, 0.f};
        cur = nxt; cA = nA; cB = nB; ++ui;
        if (wr == 1) PG8_BAR;
    }
    PG8_WAIT_V(0);
    PG8_BAR;
#undef PG8_SA
#undef PG8_SB
#undef PG8_STAGE
#undef PG8_LDA
#undef PG8_LDB
#undef PG8_MMA
#undef PG8_WAIT_V
#undef PG8_WAIT_L
#undef PG8_BAR
#undef PG8_SCHED
}

__device__ __forceinline__ void relay16(const f32x4 (&a)[2][2], LAS unsigned char* wp, const LAS unsigned char* rp, u32x4 (&x)[2]) {
#pragma unroll
    for (int bj = 0; bj < 2; ++bj) { u32x4 w; w.x = cvt_pk_bf16(a[bj][0][0], a[bj][0][1]); w.y = cvt_pk_bf16(a[bj][0][2], a[bj][0][3]); w.z = cvt_pk_bf16(a[bj][1][0], a[bj][1][1]); w.w = cvt_pk_bf16(a[bj][1][2], a[bj][1][3]);
        *(LAS u32x4*)(wp + bj * 64) = w; }
    asm volatile("" ::: "memory"); __builtin_amdgcn_wave_barrier();
    x[0] = *(const LAS u32x4*)rp; x[1] = *(const LAS u32x4*)(rp + 8 * CSH_STR);
    asm volatile("" ::: "memory"); __builtin_amdgcn_wave_barrier();
}
__device__ __forceinline__ u32x4 gate8x(const u32x4& x, const u32x4& g, const u32x4& o) {
    float xv[8], gv[8], ov[8]; unpack8(x, xv); unpack8(g, gv); unpack8(o, ov);
#pragma unroll
    for (int e = 0; e < 8; ++e) ov[e] += xv[e] * sigmoidf_(gv[e]);
    return pack8(ov);
}
struct EpiBf16 {
    static constexpr int PERM = 2;
    bf16_t* O; LAS unsigned char* sh; int ldc; int pad_;
    __device__ __forceinline__ void operator()(const f32x4 (&acc)[2][2][4][2], const Unit& u, int wr, int wc, int fr, int fq) const {
        LAS unsigned char* my = sh + (wr * 4 + wc) * CSH_SLICE; const int lane = fq * 16 + fr, r8 = lane >> 3, c8 = lane & 7;
        LAS unsigned char* wp = my + fr * CSH_STR + fq * 16; const LAS unsigned char* rp = my + r8 * CSH_STR + c8 * 16;
        bf16_t* ob = O + (size_t)(u.pm * BM + wr * 64 + r8) * ldc + u.pn * BM + wc * 64 + 8 * c8;
#pragma unroll
        for (int ai = 0; ai < 2; ++ai)
#pragma unroll
            for (int m = 0; m < 4; ++m) { u32x4 x[2];
                const f32x4 a[2][2] = {{acc[ai][0][m][0], acc[ai][0][m][1]}, {acc[ai][1][m][0], acc[ai][1][m][1]}};
                relay16(a, wp, rp, x);
                bf16_t* rowp = ob + (size_t)(ai * HALF + m * 16) * ldc;
                *(u32x4*)rowp = x[0]; *(u32x4*)(rowp + (size_t)8 * ldc) = x[1]; }
    }
};
struct EpiWin {
    static constexpr int PERM = 2;
    bf16_t* O; bf16_t* QR; bf16_t* KV; const f32x2* CS; LAS unsigned char* sh;
    __device__ __forceinline__ void operator()(const f32x4 (&acc)[2][2][4][2], const Unit& u, int wr, int wc, int fr, int fq) const {
        const int row0 = u.pm * BM + wr * 64 + fr;
        if (u.pn < 6 || u.pn > 8) {
            LAS unsigned char* my = sh + (wr * 4 + wc) * CSH_SLICE; const int lane = fq * 16 + fr, r8 = lane >> 3, c8 = lane & 7;
            LAS unsigned char* wp = my + fr * CSH_STR + fq * 16; const LAS unsigned char* rp = my + r8 * CSH_STR + c8 * 16;
            bf16_t* ob = O + (size_t)(u.pm * BM + wr * 64 + r8) * NP + u.pn * BM + wc * 64 + 8 * c8;
#pragma unroll
            for (int ai = 0; ai < 2; ++ai)
#pragma unroll
                for (int m = 0; m < 4; ++m) {
#pragma unroll
                    for (int bj = 0; bj < 2; ++bj) { const f32x4 v0 = acc[ai][bj][m][0], v1 = acc[ai][bj][m][1];
                        u32x4 w; w.x = cvt_pk_bf16(v0[0], v0[1]); w.y = cvt_pk_bf16(v0[2], v0[3]); w.z = cvt_pk_bf16(v1[0], v1[1]); w.w = cvt_pk_bf16(v1[2], v1[3]);
                        *(LAS u32x4*)(wp + bj * 64) = w; }
                    asm volatile("" ::: "memory"); __builtin_amdgcn_wave_barrier();
                    const u32x4 x0 = *(const LAS u32x4*)rp, x1 = *(const LAS u32x4*)(rp + 8 * CSH_STR);
                    asm volatile("" ::: "memory"); __builtin_amdgcn_wave_barrier();
                    bf16_t* rowp = ob + (size_t)(ai * HALF + m * 16) * NP;
                    *(u32x4*)rowp = x0; *(u32x4*)(rowp + (size_t)8 * NP) = x1; }
            return;
        }
        const bool lat = u.pm < 64; const bool isq = u.pn < 8; const bool rot = isq || wc < 2;
#pragma unroll
        for (int ai = 0; ai < 2; ++ai)
#pragma unroll
            for (int m = 0; m < 4; ++m) { const int row = row0 + ai * HALF + m * 16; const int sp = row & (SEQ - 1);
#pragma unroll
                for (int bj = 0; bj < 2; ++bj) { const f32x4 v0 = acc[ai][bj][m][0], v1 = acc[ai][bj][m][1]; float o[8];
                    const int ps = bj ? (sp & 63) : (sp >> 6);
                    f32x4 c01 = (f32x4){1.f, 0.f, 1.f, 0.f}, c23 = c01;
                    if (lat && rot) { const f32x4* cp = (const f32x4*)(CS + ps * 16 + 4 * fq); c01 = cp[0]; c23 = cp[1]; }
                    if (rot) {
                        o[0] = v0[0] * c01[0] - v0[1] * c01[1]; o[1] = v0[1] * c01[0] + v0[0] * c01[1]; o[2] = v0[2] * c01[2] - v0[3] * c01[3]; o[3] = v0[3] * c01[2] + v0[2] * c01[3];
                        o[4] = v1[0] * c23[0] - v1[1] * c23[1]; o[5] = v1[1] * c23[0] + v1[0] * c23[1]; o[6] = v1[2] * c23[2] - v1[3] * c23[3]; o[7] = v1[3] * c23[2] + v1[2] * c23[3];
                    } else { o[0] = v0[0]; o[1] = v0[1]; o[2] = v0[2]; o[3] = v0[3]; o[4] = v1[0]; o[5] = v1[1]; o[6] = v1[2]; o[7] = v1[3]; }
                    u32x4 w;
                    if (isq) { w.x = cvt_pk_bf16(o[0] * QSCALE, o[1] * QSCALE); w.y = cvt_pk_bf16(o[2] * QSCALE, o[3] * QSCALE); w.z = cvt_pk_bf16(o[4] * QSCALE, o[5] * QSCALE); w.w = cvt_pk_bf16(o[6] * QSCALE, o[7] * QSCALE);
                        *(u32x4*)(QR + (size_t)row * 512 + (u.pn - 6) * 256 + wc * 64 + bj * 32 + 8 * fq) = w; }
                    else { w.x = cvt_pk_bf16(o[0], o[1]); w.y = cvt_pk_bf16(o[2], o[3]); w.z = cvt_pk_bf16(o[4], o[5]); w.w = cvt_pk_bf16(o[6], o[7]);
                        *(u32x4*)(KV + (size_t)row * 256 + wc * 64 + bj * 32 + 8 * fq) = w; } } }
    }
};
__device__ __forceinline__ u32x4 gate8(const f32x4& v0, const f32x4& v1, const u32x4& g) {
    u32x4 w;
    w.x = cvt_pk_bf16(v0[0] * sigmoidf_(bf_lo(g.x)), v0[1] * sigmoidf_(bf_hi(g.x))); w.y = cvt_pk_bf16(v0[2] * sigmoidf_(bf_lo(g.y)), v0[3] * sigmoidf_(bf_hi(g.y)));
    w.z = cvt_pk_bf16(v1[0] * sigmoidf_(bf_lo(g.z)), v1[1] * sigmoidf_(bf_hi(g.z))); w.w = cvt_pk_bf16(v1[2] * sigmoidf_(bf_lo(g.w)), v1[3] * sigmoidf_(bf_hi(g.w))); return w; }
__device__ __forceinline__ u32x4 gate8acc(const f32x4& v0, const f32x4& v1, const u32x4& g, const u32x4& o) {
    u32x4 w;
    w.x = cvt_pk_bf16(bf_lo(o.x) + v0[0] * sigmoidf_(bf_lo(g.x)), bf_hi(o.x) + v0[1] * sigmoidf_(bf_hi(g.x))); w.y = cvt_pk_bf16(bf_lo(o.y) + v0[2] * sigmoidf_(bf_lo(g.y)), bf_hi(o.y) + v0[3] * sigmoidf_(bf_hi(g.y)));
    w.z = cvt_pk_bf16(bf_lo(o.z) + v1[0] * sigmoidf_(bf_lo(g.z)), bf_hi(o.z) + v1[1] * sigmoidf_(bf_hi(g.z))); w.w = cvt_pk_bf16(bf_lo(o.w) + v1[2] * sigmoidf_(bf_lo(g.w)), bf_hi(o.w) + v1[3] * sigmoidf_(bf_hi(g.w))); return w; }
struct EpiGate {
    static constexpr int PERM = 2;
    bf16_t* O; const bf16_t* Pg; LAS unsigned char* sh;
    __device__ __forceinline__ void operator()(const f32x4 (&acc)[2][2][4][2], const Unit& u, int wr, int wc, int fr, int fq) const {
        LAS unsigned char* my = sh + (wr * 4 + wc) * CSH_SLICE; const int lane = fq * 16 + fr, r8 = lane >> 3, c8 = lane & 7;
        LAS unsigned char* wp = my + fr * CSH_STR + fq * 16; const LAS unsigned char* rp = my + r8 * CSH_STR + c8 * 16;
        const int rowb = u.pm * BM + wr * 64 + r8, colb = u.pn * BM + wc * 64 + 8 * c8;
#pragma unroll
        for (int ai = 0; ai < 2; ++ai)
#pragma unroll
            for (int m = 0; m < 4; ++m) { const size_t row = (size_t)(rowb + ai * HALF + m * 16);
                u32x4 g[2], x[2];
#pragma unroll
                for (int hh = 0; hh < 2; ++hh) g[hh] = *(const u32x4*)(Pg + (row + 8 * hh) * NP + P_GATE + colb);
                const f32x4 a[2][2] = {{acc[ai][0][m][0], acc[ai][0][m][1]}, {acc[ai][1][m][0], acc[ai][1][m][1]}};
                relay16(a, wp, rp, x);
#pragma unroll
                for (int hh = 0; hh < 2; ++hh) *(u32x4*)(O + (row + 8 * hh) * 3072 + colb) = gate8x(x[hh], g[hh], (u32x4){0u, 0u, 0u, 0u}); }
    }
};
struct EpiMerge {
    static constexpr int PERM = 2;
    bf16_t* MG; const bf16_t* Pg; LAS unsigned char* sh;
    __device__ __forceinline__ void operator()(const f32x4 (&acc)[2][2][4][2], const Unit& u, int wr, int wc, int fr, int fq) const {
        LAS unsigned char* my = sh + (wr * 4 + wc) * CSH_SLICE; const int lane = fq * 16 + fr, r8 = lane >> 3, c8 = lane & 7;
        LAS unsigned char* wp = my + fr * CSH_STR + fq * 16; const LAS unsigned char* rp = my + r8 * CSH_STR + c8 * 16;
        const int rowb = u.pm * BM + wr * 64 + r8, colb = u.pn * BM + wc * 64 + 8 * c8; const int gcol = P_GATE + u.part * 1024 + colb;
#pragma unroll
        for (int ai = 0; ai < 2; ++ai)
#pragma unroll
            for (int m = 0; m < 4; ++m) { const size_t row = (size_t)(rowb + ai * HALF + m * 16);
                u32x4 g[2], o[2], x[2];
#pragma unroll
                for (int hh = 0; hh < 2; ++hh) { g[hh] = *(const u32x4*)(Pg + (row + 8 * hh) * NP + gcol); o[hh] = u.part ? *(const u32x4*)(MG + (row + 8 * hh) * D + colb) : (u32x4){0u, 0u, 0u, 0u}; }
                const f32x4 a[2][2] = {{acc[ai][0][m][0], acc[ai][0][m][1]}, {acc[ai][1][m][0], acc[ai][1][m][1]}};
                relay16(a, wp, rp, x);
#pragma unroll
                for (int hh = 0; hh < 2; ++hh) *(u32x4*)(MG + (row + 8 * hh) * D + colb) = gate8x(x[hh], g[hh], o[hh]); }
    }
};
struct EpiResid {
    static constexpr int PERM = 2;
    bf16_t* X; const float* modg; float* PART; const void* Xold; LAS unsigned char* sh; int oldf32; int pad_;
    __device__ __forceinline__ void operator()(const f32x4 (&acc)[2][2][4][2], const Unit& u, int wr, int wc, int fr, int fq) const {
        if (u.part >= 0) {
            LAS unsigned char* my = sh + (wr * 4 + wc) * CSH_SLICE; const int lane = fq * 16 + fr, r8 = lane >> 3, c8 = lane & 7;
            LAS unsigned char* wp = my + fr * CSH_STR + fq * 32; const LAS unsigned char* rp = my + r8 * CSH_STR + c8 * 16;
            float* pb = PART + ((size_t)u.part * TC + (u.pm * BM + wr * 64 + r8 - TL)) * D + u.pn * BM + wc * 64 + 4 * c8;
#pragma unroll
            for (int ai = 0; ai < 2; ++ai)
#pragma unroll
                for (int m = 0; m < 4; ++m) { float* rowp = pb + (size_t)(ai * HALF + m * 16) * D;
#pragma unroll
                    for (int bj = 0; bj < 2; ++bj) {
                        *(LAS f32x4*)wp = acc[ai][bj][m][0]; *(LAS f32x4*)(wp + 16) = acc[ai][bj][m][1];
                        asm volatile("" ::: "memory"); __builtin_amdgcn_wave_barrier();
                        const f32x4 x0 = *(const LAS f32x4*)rp, x1 = *(const LAS f32x4*)(rp + 8 * CSH_STR);
                        asm volatile("" ::: "memory"); __builtin_amdgcn_wave_barrier();
                        *(f32x4*)(rowp + bj * 32) = x0; *(f32x4*)(rowp + (size_t)8 * D + bj * 32) = x1; } }
            return;
        }
        const float* mg = modg + (size_t)mod_row(u.pm * BM) * 6144 + u.pn * BM + wc * 64 + 8 * fq;
        f32x4 gv[2][2];
#pragma unroll
        for (int bj = 0; bj < 2; ++bj)
#pragma unroll
            for (int n = 0; n < 2; ++n) gv[bj][n] = *(const f32x4*)(mg + bj * 32 + n * 4);
        LAS unsigned char* my = sh + (wr * 4 + wc) * CSH_SLICE; const int lane = fq * 16 + fr, r8 = lane >> 3, c8 = lane & 7;
        LAS unsigned char* wp = my + fr * CSH_STR + fq * 16; const LAS unsigned char* rp = my + r8 * CSH_STR + c8 * 16;
        const size_t ro0 = (size_t)(u.pm * BM + wr * 64 + r8) * D + u.pn * BM + wc * 64 + 8 * c8;
#pragma unroll
        for (int ai = 0; ai < 2; ++ai)
#pragma unroll
            for (int m = 0; m < 4; ++m) { const size_t ro = ro0 + (size_t)(ai * HALF + m * 16) * D;
                f32x4 oa[2][2];
#pragma unroll
                for (int hh = 0; hh < 2; ++hh) { const size_t rr = ro + (size_t)hh * 8 * D;
                    if (oldf32) { oa[hh][0] = *(const f32x4*)((const float*)Xold + rr); oa[hh][1] = *(const f32x4*)((const float*)Xold + rr + 4); }
                    else { const u32x4 w = *(const u32x4*)((const bf16_t*)Xold + rr); oa[hh][0] = (f32x4){__uint_as_float(w.x), __uint_as_float(w.y), __uint_as_float(w.z), __uint_as_float(w.w)}; oa[hh][1] = oa[hh][0]; } }
#pragma unroll
                for (int bj = 0; bj < 2; ++bj) { const f32x4 v0 = gv[bj][0] * acc[ai][bj][m][0], v1 = gv[bj][1] * acc[ai][bj][m][1];
                    u32x4 w; w.x = cvt_pk_bf16(v0[0], v0[1]); w.y = cvt_pk_bf16(v0[2], v0[3]); w.z = cvt_pk_bf16(v1[0], v1[1]); w.w = cvt_pk_bf16(v1[2], v1[3]);
                    *(LAS u32x4*)(wp + bj * 64) = w; }
                asm volatile("" ::: "memory"); __builtin_amdgcn_wave_barrier();
                u32x4 dx[2]; dx[0] = *(const LAS u32x4*)rp; dx[1] = *(const LAS u32x4*)(rp + 8 * CSH_STR);
                asm volatile("" ::: "memory"); __builtin_amdgcn_wave_barrier();
#pragma unroll
                for (int hh = 0; hh < 2; ++hh) { float o[8], dl[8]; unpack8(dx[hh], dl);
                    if (oldf32) { o[0] = oa[hh][0][0]; o[1] = oa[hh][0][1]; o[2] = oa[hh][0][2]; o[3] = oa[hh][0][3]; o[4] = oa[hh][1][0]; o[5] = oa[hh][1][1]; o[6] = oa[hh][1][2]; o[7] = oa[hh][1][3]; }
                    else { u32x4 w; w.x = __float_as_uint(oa[hh][0][0]); w.y = __float_as_uint(oa[hh][0][1]); w.z = __float_as_uint(oa[hh][0][2]); w.w = __float_as_uint(oa[hh][0][3]); unpack8(w, o); }
#pragma unroll
                    for (int e = 0; e < 8; ++e) o[e] += dl[e];
                    *(u32x4*)(X + ro + (size_t)hh * 8 * D) = pack8(o); } }
    }
};
struct EpiSwiglu {
    static constexpr bool PERM = true;
    bf16_t* O;
    __device__ __forceinline__ void operator()(const f32x4 (&acc)[2][2][4][2], const Unit& u, int wr, int wc, int fr, int fq) const {
        const int row0 = u.pm * BM + wr * 64 + fr; const int chunk = u.pn * 4 + wc;
#pragma unroll
        for (int ai = 0; ai < 2; ++ai)
#pragma unroll
            for (int m = 0; m < 4; ++m) { const int row = row0 + ai * HALF + m * 16; bf16_t* rowp = O + ((size_t)(row >> 1) * (DFF / 32) + chunk) * 64 + (row & 1) * 32 + 8 * fq;
                const f32x4 a0 = acc[ai][0][m][0], a1 = acc[ai][0][m][1], b0 = acc[ai][1][m][0], b1 = acc[ai][1][m][1];
                u32x4 w; w.x = cvt_pk_bf16(siluf_(a0[0]) * b0[0], siluf_(a0[1]) * b0[1]); w.y = cvt_pk_bf16(siluf_(a0[2]) * b0[2], siluf_(a0[3]) * b0[3]);
                w.z = cvt_pk_bf16(siluf_(a1[0]) * b1[0], siluf_(a1[1]) * b1[1]); w.w = cvt_pk_bf16(siluf_(a1[2]) * b1[2], siluf_(a1[3]) * b1[3]);
                *(u32x4*)rowp = w; }
    }
};
}

#define XB_TMO      128
#define XB_XCNT(j)  (256  + 64 * (j))
#define XB_XSUB(j)  (1280 + 64 * (j))
#define XB_XGEN(j)  (2304 + 64 * (j))
#define XB_TOP      3328
#define XB_TOPGEN   3392
#define XCD_BAR_WORDS 3456
#define XB_SPIN_CAP (1u << 18)
__device__ __forceinline__ unsigned xb_ld(unsigned* p)              { return __hip_atomic_load(p, __ATOMIC_RELAXED, __HIP_MEMORY_SCOPE_AGENT); }
__device__ __forceinline__ unsigned xb_add(unsigned* p, unsigned v) { return __hip_atomic_fetch_add(p, v, __ATOMIC_RELAXED, __HIP_MEMORY_SCOPE_AGENT); }
__device__ __forceinline__ unsigned xb_xcc_id() { return (unsigned)__builtin_amdgcn_s_getreg((3 << 11) | 20) & 0xFu; }
#define XB_SPIN(cond, bar) do { unsigned _sp = 0; while (cond) { __builtin_amdgcn_s_sleep(1); \
    if ((++_sp & 255u) == 0u) { if (xb_ld(&(bar)[XB_TMO])) break; if (_sp > XB_SPIN_CAP) { atomicAdd(&(bar)[XB_TMO], 1u); break; } } } } while (0)
struct XcdBarrier { unsigned* bar; unsigned x; volatile LAS unsigned* st; };
__device__ __forceinline__ XcdBarrier xcd_barrier_post(unsigned* bar, volatile LAS unsigned* st) {
    XcdBarrier b; b.bar = bar; b.x = (unsigned)__builtin_amdgcn_readfirstlane((int)xb_xcc_id()); b.st = st;
    if (threadIdx.x == 0) (void)xb_add(&bar[XB_XCNT(b.x)], 1u);
    return b;
}
__device__ __forceinline__ void xcd_barrier_complete(unsigned* bar, unsigned x, unsigned& nloc, unsigned& nx) {
    const unsigned G = gridDim.x * gridDim.y * gridDim.z;
    unsigned sum, cnt, mine, sp = 0u;
    for (;;) {
        sum = 0u; cnt = 0u; mine = 0u;
#pragma unroll
        for (unsigned j = 0; j < 16; ++j) { const unsigned c = xb_ld(&bar[XB_XCNT(j)]); sum += c; cnt += (c > 0u) ? 1u : 0u; mine = (j == x) ? c : mine; }
        if (sum == G) break;
        __builtin_amdgcn_s_sleep(1);
        if ((++sp & 255u) == 0u) { if (xb_ld(&bar[XB_TMO])) break; if (sp > XB_SPIN_CAP) { atomicAdd(&bar[XB_TMO], 1u); break; } }
    }
    nloc = mine > 0u ? mine : 1u; nx = cnt > 0u ? cnt : 1u;
}
template <bool FIRST> __device__ __forceinline__ void xcd_barrier_t(const XcdBarrier& b, const Ctx cx) {
    asm volatile("s_waitcnt vmcnt(0)" ::: "memory");
    __syncthreads();
    if (tidx(cx) == 0) {
        unsigned* bar = b.bar; unsigned bx = b.x; OPQ_S(bar); OPQ_S(bx);
        __builtin_amdgcn_s_waitcnt(0);
        unsigned nloc = b.st[0], nx = b.st[1];
        if (FIRST) { if (nloc == 0u) { xcd_barrier_complete(bar, bx, nloc, nx); b.st[0] = nloc; b.st[1] = nx; } }
        const unsigned old = xb_add(&bar[XB_XSUB(bx)], 1u);
        const unsigned gen = old / nloc;
        if (old + 1u == (gen + 1u) * nloc) {
            __builtin_amdgcn_fence(__ATOMIC_RELEASE, "agent");
            asm volatile("s_waitcnt vmcnt(0)" ::: "memory");
            const unsigned og = xb_add(&bar[XB_TOP], 1u);
            const unsigned tg = og / nx;
            if (og + 1u == (tg + 1u) * nx) xb_add(&bar[XB_TOPGEN], 1u);
            else XB_SPIN(xb_ld(&bar[XB_TOPGEN]) == tg, bar);
            __builtin_amdgcn_fence(__ATOMIC_ACQUIRE, "agent");
            xb_add(&bar[XB_XGEN(bx)], 1u);
            asm volatile("s_waitcnt vmcnt(0)" ::: "memory");
        } else {
            XB_SPIN(xb_ld(&bar[XB_XGEN(bx)]) == gen, bar);
            __builtin_amdgcn_fence(__ATOMIC_ACQUIRE, "agent");
            asm volatile("s_waitcnt vmcnt(0)" ::: "memory");
        }
    }
    __syncthreads();
}
__device__ __forceinline__ void xcd_barrier_first(const XcdBarrier& b, const Ctx cx) { xcd_barrier_t<true>(b, cx); }
__device__ __forceinline__ void xcd_barrier(const XcdBarrier& b, const Ctx cx) { xcd_barrier_t<false>(b, cx); }

constexpr int LDS_TEXP = 139264, LDS_BARW = LDS_TEXP + 1024, LDS_SBASE = LDS_BARW + 16, LDS_CSH = LDS_SBASE + 64 + 176 + 256, LDS_BYTES = LDS_CSH + 8 * pg8::CSH_SLICE;
constexpr int CW_BAR = 4096;

#define MMA16(acc, afrag, bfrag) acc = __builtin_amdgcn_mfma_f32_16x16x32_bf16(bfrag, afrag, acc, 0, 0, 0)
typedef short s16x4 __attribute__((ext_vector_type(4)));
constexpr int STR64 = 144, STR128 = 272;
__device__ __forceinline__ bf16x8 frag_row(const LAS unsigned char* img, int r, int k0, int stride) { return *(const LAS bf16x8*)(img + r * stride + k0 * 2); }
__device__ __forceinline__ bf16x8 frag_tr(const LAS unsigned char* img, int rowlo, int rowhi, int x0, int stride, int fr) {
    const int q = fr >> 2, p = fr & 3;
    const s16x4 lo = __builtin_amdgcn_ds_read_tr16_b64_v4i16((LAS s16x4*)(img + (rowlo + q) * stride + x0 * 2 + 8 * p));
    const s16x4 hi = __builtin_amdgcn_ds_read_tr16_b64_v4i16((LAS s16x4*)(img + (rowhi + q) * stride + x0 * 2 + 8 * p));
    return __builtin_shufflevector(lo, hi, 0, 1, 2, 3, 4, 5, 6, 7);
}

struct CvtJob { const float* s0; const float* s1; bf16_t* dst; int ldw, ldd, kd0, K, Nd, kind; };
__device__ __forceinline__ CvtJob mkjob(const float* s0, const float* s1, bf16_t* dst, int ldw, int ldd, int kd0, int K, int Nd, int kind) { CvtJob j; j.s0 = s0; j.s1 = s1; j.dst = dst; j.ldw = ldw; j.ldd = ldd; j.kd0 = kd0; j.K = K; j.Nd = Nd; j.kind = kind; return j; }
constexpr int CV_STR = 144;
__device__ __forceinline__ void cvt_src(const CvtJob& j, int n0, int n, const float*& src, int& col) {
    const int nh = n0 + (n & 32); src = j.s0; int sc = nh;
    if (j.kind == 1) { sc = nh < 3840 ? nh : (nh < 6912 ? nh + 32 : (nh < 6944 ? nh - 3072 : -1)); }
    else if (j.kind == 2) { const int tj = nh >> 8, r = nh & 255; if (r < 128) { sc = tj * 128 + r; } else { src = j.s1; sc = tj * 128 + r - 128; } }
    col = sc < 0 ? -1 : sc + (n & 31);
}
__device__ __forceinline__ void ph_convert(const CvtJob& j, LAS unsigned char* lds, const Ctx cx, int& rot) {
    const int tid = tidx(cx), c16 = tid & 15, kr = tid >> 4, lane = tid & 63, wid = tid >> 6, fr = lane & 15, fq = lane >> 4;
    const int kch = j.K / 256, nitems = (j.Nd / 64) * kch;
    int first = cx.bid - rot; if (first < 0) first += cx.nb;
    f32x4 v[8];
    auto issue = [&](int it) { const int nbk = it / kch, kc = it % kch, n0 = nbk * 64, k0 = kc * 256; const float* src; int col; cvt_src(j, n0, c16 * 4, src, col);
#pragma unroll
        for (int p = 0; p < 8; ++p) v[p] = col >= 0 ? *(const f32x4*)(src + (size_t)(k0 + p * 32 + kr) * j.ldw + col) : (f32x4){0.f, 0.f, 0.f, 0.f}; };
    if (first < nitems) issue(first);
    for (int it = first; it < nitems; it += cx.nb) {
        const int nbk = it / kch, kc = it % kch, n0 = nbk * 64, k0 = kc * 256;
        if (j.kind == 1 && n0 >= P_QA && n0 < P_VA) {
            const int e = (c16 * 4) & 31, blk = (c16 * 4) & 32;
#pragma unroll
            for (int p = 0; p < 8; ++p) { const unsigned w0 = cvt_pk_bf16(v[p][0], v[p][1]), w1 = cvt_pk_bf16(v[p][2], v[p][3]); LAS bf16_t* rowp = (LAS bf16_t*)(lds + (p * 32 + kr) * CV_STR) + blk;
#pragma unroll
                for (int q = 0; q < 4; ++q) { const int ee = e + q, pos = ee < 16 ? 2 * ee : 2 * (ee - 16) + 1; const unsigned w = q < 2 ? w0 : w1; rowp[pos] = (bf16_t)((q & 1) ? (w >> 16) : (w & 0xffffu)); } }
        } else {
#pragma unroll
        for (int p = 0; p < 8; ++p) { u32x2 w; w.x = cvt_pk_bf16(v[p][0], v[p][1]); w.y = cvt_pk_bf16(v[p][2], v[p][3]); *(LAS u32x2*)(lds + (p * 32 + kr) * CV_STR + c16 * 8) = w; }
        }
        __syncthreads();
        if (it + cx.nb < nitems) issue(it + cx.nb);
        { const int kq = wid & 3, nh = wid >> 2, r8 = lane >> 3, c8 = lane & 7;
          LAS unsigned char* my = lds + 256 * CV_STR + wid * (16 * CV_STR); LAS unsigned char* wp = my + fr * CV_STR + fq * 16; const LAS unsigned char* rp = my + (2 * r8 + (c8 >> 2)) * CV_STR + (c8 & 3) * 16;
#pragma unroll
          for (int q = 0; q < 2; ++q) { const int nb = nh * 2 + q;
              const bf16x8 oa = frag_tr(lds, (8 * kq + fq) * 8, (8 * kq + fq) * 8 + 4, nb * 16, CV_STR, fr), ob = frag_tr(lds, (8 * kq + 4 + fq) * 8, (8 * kq + 4 + fq) * 8 + 4, nb * 16, CV_STR, fr);
              *(LAS bf16x8*)wp = oa; *(LAS bf16x8*)(wp + 64) = ob;
              asm volatile("" ::: "memory"); __builtin_amdgcn_wave_barrier();
              const bf16x8 x0 = *(const LAS bf16x8*)rp, x1 = *(const LAS bf16x8*)(rp + 64);
              asm volatile("" ::: "memory"); __builtin_amdgcn_wave_barrier();
              bf16_t* dp = j.dst + ((size_t)(((n0 + nb * 16) >> 1) + r8) * (j.ldd >> 5) + ((j.kd0 + k0 + 64 * kq) >> 5)) * 64 + 8 * c8;
              *(bf16x8*)dp = x0; *(bf16x8*)(dp + 64) = x1; } }
        __syncthreads();
    }
    rot = (rot + nitems) % cx.nb;
}

__device__ __forceinline__ void ph_init(const float* x, const float* ctx, float* XS, f32x2* CS, const Ctx cx) {
    (void)x; (void)ctx; (void)XS;
    if (cx.bid == cx.nb - 1) for (int i = tidx(cx); i < 64 * 16; i += 512) { const int pos = i >> 4, f = i & 15; const float inv = powf(10000.0f, -(float)f / 16.0f); const float a = (float)pos * inv; CS[i] = (f32x2){cosf(a), sinf(a)}; }
}
__device__ __forceinline__ void ph_mod(const float* c, const float* c_ctx, const float* w_mod, const float* b_mod, float* MOD, LAS unsigned char* lds, const Ctx cx) {
    if (cx.bid >= DEPTH * 48) return;
    LAS float* sv = (LAS float*)lds; LAS float* red = sv + 9 * 1024;
    const int tid = tidx(cx);
    for (int i = tid; i < 9 * 1024; i += 512) { const float v = i < 8192 ? c[i] : c_ctx[i - 8192]; sv[i] = siluf_(v); }
    __syncthreads();
    const int c4 = (tid & 31) * 4, kg = tid >> 5;
    for (int it = cx.bid; it < DEPTH * 48; it += cx.nb) {
        const int l = it / 48, n0 = (it % 48) * 128;
        const float* w = w_mod + ((size_t)l * D + kg * 64) * 6144 + n0 + c4;
        f32x4 a[9];
#pragma unroll
        for (int r = 0; r < 9; ++r) a[r] = (f32x4){0.f, 0.f, 0.f, 0.f};
#pragma unroll 1
        for (int k0 = 0; k0 < 64; k0 += 8) { f32x4 wv[8];
#pragma unroll
            for (int u = 0; u < 8; ++u) wv[u] = *(const f32x4*)(w + (size_t)(k0 + u) * 6144);
#pragma unroll
            for (int u = 0; u < 8; ++u)
#pragma unroll
                for (int r = 0; r < 9; ++r) a[r] = a[r] + wv[u] * sv[r * 1024 + kg * 64 + k0 + u]; }
#pragma unroll
        for (int r = 0; r < 9; ++r) *(LAS f32x4*)(red + (kg * 9 + r) * 128 + c4) = a[r];
        __syncthreads();
        for (int i = tid; i < 9 * 128; i += 512) { const int r = i >> 7, cc = i & 127; float sacc = b_mod[(size_t)l * 6144 + n0 + cc];
#pragma unroll
            for (int g = 0; g < 16; ++g) sacc += red[(g * 9 + r) * 128 + cc];
            MOD[((size_t)l * 9 + r) * 6144 + n0 + cc] = sacc; }
        __syncthreads();
    }
}

struct NormArgs { bf16_t* XS; const void* Xl; const void* Xc; int lf32, cf32; bf16_t* H;
                  const float* g; const float* mod_shift; const float* mod_scale;
                  const bf16_t* Y; const int* POS; const float* TOPKp; const float* mod_g5prev;
                  const float* router; float* TOPK; unsigned* cnt; int nrows;
                  const float* PART; const float* mod_gpart; int npart; };
template <bool ROUTE> __device__ __forceinline__ void ph_norm(const NormArgs& a, bool combine, LAS unsigned char* lds, const Ctx cx) {
    const int lane = tidx(cx) & 63, wid = tidx(cx) >> 6;
    LAS unsigned* hist = (LAS unsigned*)(lds + LDS_SBASE);
    LAS float* rtab = (LAS float*)lds;
    if (ROUTE) { __syncthreads(); if (tidx(cx) < 8) hist[tidx(cx)] = 0u;
        for (int f = tidx(cx); f < 8192; f += 512) { const int e = f & 7, ln = (f >> 3) & 63, jq = f >> 9; rtab[f] = a.router[(size_t)(4 * (ln + 64 * (jq >> 2)) + (jq & 3)) * 8 + e]; }
        __syncthreads(); }
    f32x4 gq[4];
#pragma unroll
    for (int j = 0; j < 4; ++j) gq[j] = *(const f32x4*)(a.g + 4 * (lane + 64 * j));
    f32x4 xn[4];
    { const int r0 = cx.bid * 8 + wid; if (r0 < a.nrows) { const bool f = r0 < TL ? a.lf32 : a.cf32; const void* rp = r0 < TL ? a.Xl : a.Xc;
#pragma unroll
        for (int j = 0; j < 4; ++j) xn[j] = ldx_raw(rp, f, (size_t)r0 * D + 4 * (lane + 64 * j)); } }
    int cs1 = 0, cs2 = 0; float cp1 = 0.f, cp2 = 0.f; u32x2 y1n[4], y2n[4];
    if (combine) { const int rk = cx.bid * 8 + wid + lane * (cx.nb * 8);
        if (rk < a.nrows) { cs1 = a.POS[2 * rk]; cs2 = a.POS[2 * rk + 1]; cp1 = a.TOPKp[4 * rk + 2]; cp2 = a.TOPKp[4 * rk + 3]; }
        if (cx.bid * 8 + wid < a.nrows) { const int s1 = __builtin_amdgcn_readlane(cs1, 0), s2 = __builtin_amdgcn_readlane(cs2, 0);
#pragma unroll
            for (int j = 0; j < 4; ++j) { const int cc = 4 * (lane + 64 * j); y1n[j] = *(const u32x2*)(a.Y + (size_t)s1 * D + cc); y2n[j] = *(const u32x2*)(a.Y + (size_t)s2 * D + cc); } } }
    int it = 0;
    for (int row = cx.bid * 8 + wid; row < a.nrows; row += cx.nb * 8, ++it) {
        const int mr = mod_row(row);
        bf16_t* xr = a.XS + (size_t)row * D; const bool fcur = row < TL ? a.lf32 : a.cf32;
        f32x4 x[4], shq[4], scq[4];
#pragma unroll
        for (int j = 0; j < 4; ++j) { x[j] = cvx(xn[j], fcur); shq[j] = *(const f32x4*)(a.mod_shift + (size_t)mr * 6144 + 4 * (lane + 64 * j)); scq[j] = *(const f32x4*)(a.mod_scale + (size_t)mr * 6144 + 4 * (lane + 64 * j)); }
        if (row + cx.nb * 8 < a.nrows) {
            const int rn = row + cx.nb * 8; const bool f = rn < TL ? a.lf32 : a.cf32; const void* rp = rn < TL ? a.Xl : a.Xc;
#pragma unroll
            for (int j = 0; j < 4; ++j) xn[j] = ldx_raw(rp, f, (size_t)rn * D + 4 * (lane + 64 * j)); }
        if (combine) {
            const float p1 = __int_as_float(__builtin_amdgcn_readlane(__float_as_int(cp1), it)), p2 = __int_as_float(__builtin_amdgcn_readlane(__float_as_int(cp2), it));
            u32x2 y1c[4], y2c[4];
#pragma unroll
            for (int j = 0; j < 4; ++j) { y1c[j] = y1n[j]; y2c[j] = y2n[j]; }
            if (row + cx.nb * 8 < a.nrows) { const int s1 = __builtin_amdgcn_readlane(cs1, it + 1), s2 = __builtin_amdgcn_readlane(cs2, it + 1);
#pragma unroll
                for (int j = 0; j < 4; ++j) { const int cc = 4 * (lane + 64 * j); y1n[j] = *(const u32x2*)(a.Y + (size_t)s1 * D + cc); y2n[j] = *(const u32x2*)(a.Y + (size_t)s2 * D + cc); } }
#pragma unroll
            for (int j = 0; j < 4; ++j) { const int cc = 4 * (lane + 64 * j);
                const u32x2 y1 = y1c[j], y2 = y2c[j];
                const f32x4 mg = *(const f32x4*)(a.mod_g5prev + (size_t)mr * 6144 + cc);
                f32x4 e; e[0] = p1 * bf_lo(y1.x) + p2 * bf_lo(y2.x); e[1] = p1 * bf_hi(y1.x) + p2 * bf_hi(y2.x); e[2] = p1 * bf_lo(y1.y) + p2 * bf_lo(y2.y); e[3] = p1 * bf_hi(y1.y) + p2 * bf_hi(y2.y);
                x[j] = x[j] + mg * e; stx(xr + cc, x[j]); }
        }
        if (a.PART != nullptr && row >= TL) {
#pragma unroll
            for (int j = 0; j < 4; ++j) { const int cc = 4 * (lane + 64 * j); const float* pp = a.PART + (size_t)(row - TL) * D + cc;
                f32x4 e = (*(const f32x4*)pp + *(const f32x4*)(pp + (size_t)TC * D)) + (*(const f32x4*)(pp + (size_t)2 * TC * D) + *(const f32x4*)(pp + (size_t)3 * TC * D));
                e = e + (*(const f32x4*)(pp + (size_t)4 * TC * D) + *(const f32x4*)(pp + (size_t)5 * TC * D));
                if (a.npart == 7) e = e + *(const f32x4*)(pp + (size_t)6 * TC * D);
                const f32x4 mg = *(const f32x4*)(a.mod_gpart + (size_t)8 * 6144 + cc);
                x[j] = x[j] + mg * e; stx(xr + cc, x[j]); }
        }
        float ss = 0.f;
#pragma unroll
        for (int j = 0; j < 4; ++j) ss += x[j][0] * x[j][0] + x[j][1] * x[j][1] + x[j][2] * x[j][2] + x[j][3] * x[j][3];
        ss = wave_total(ss);
        const float rs = rsqrtf(ss * (1.0f / D) + EPS);
        f32x4 h[4];
#pragma unroll
        for (int j = 0; j < 4; ++j) { const int cc = 4 * (lane + 64 * j);
            h[j] = (x[j] * rs * gq[j]) * (scq[j] + 1.0f) + shq[j];
            u32x2 w; w.x = cvt_pk_bf16(h[j][0], h[j][1]); w.y = cvt_pk_bf16(h[j][2], h[j][3]);
            *(u32x2*)(a.H + (size_t)row * D + cc) = w; }
        if (ROUTE) {
            float lg[8];
#pragma unroll
            for (int e = 0; e < 8; ++e) lg[e] = 0.f;
#pragma unroll
            for (int j = 0; j < 4; ++j)
#pragma unroll
                for (int q = 0; q < 4; ++q) { const LAS float* rw = rtab + ((j * 4 + q) * 64 + lane) * 8; const f32x4 r0 = *(const LAS f32x4*)rw, r1 = *(const LAS f32x4*)(rw + 4); const float hv = h[j][q];
                    lg[0] += hv * r0[0]; lg[1] += hv * r0[1]; lg[2] += hv * r0[2]; lg[3] += hv * r0[3]; lg[4] += hv * r1[0]; lg[5] += hv * r1[1]; lg[6] += hv * r1[2]; lg[7] += hv * r1[3]; }
#pragma unroll
            for (int e = 0; e < 8; ++e) lg[e] = wave_total(lg[e]);
            if (lane == 0) {
                int e1 = 0; float v1 = lg[0];
#pragma unroll
                for (int e = 1; e < 8; ++e) if (lg[e] > v1) { v1 = lg[e]; e1 = e; }
                int e2 = -1; float v2 = -3.0e38f;
#pragma unroll
                for (int e = 0; e < 8; ++e) if (e != e1 && lg[e] > v2) { v2 = lg[e]; e2 = e; }
                const float p2 = 1.0f / (1.0f + __expf(v1 - v2)), p1 = 1.0f - p2;
                float* tk = a.TOPK + 4 * (size_t)row; tk[0] = __int_as_float(e1); tk[1] = __int_as_float(e2); tk[2] = p1; tk[3] = p2;
                lds_add(hist + e1, 1u); lds_add(hist + e2, 1u);
            }
        }
    }
    if (ROUTE) { __syncthreads(); if (tidx(cx) < 8) { const unsigned v = hist[tidx(cx)]; if (v) atomicAdd(a.cnt + tidx(cx), v); } __syncthreads(); }
}

__device__ __forceinline__ void ph_route(const float* TOPK, const bf16_t* H, bf16_t* HS, int* POS, unsigned* ctl, int j, int nrows, LAS unsigned char* lds, const Ctx cx) {
    LAS unsigned* sbase = (LAS unsigned*)(lds + LDS_SBASE);
    const int lane = tidx(cx) & 63, wid = tidx(cx) >> 6;
    __syncthreads();
    if (tidx(cx) == 0) { unsigned b = 0; for (int e = 0; e < 8; ++e) { sbase[e] = b; b += (xb_ld(ctl + CW_CNT + j * 64 + e) + 255u) & ~255u; } sbase[8] = b; }
    __syncthreads();
    if (cx.bid == 0) {
        if (tidx(cx) < 256) { const unsigned r0 = tidx(cx) * 256u; int e = 0;
            for (int q = 1; q < 8; ++q) if (r0 >= sbase[q]) e = q;
            ctl[CW_TEXP + j * 256 + tidx(cx)] = (unsigned)e; }
        if (tidx(cx) == 0) ctl[CW_NT + j] = sbase[8] / 256u;
    }
    for (int i = cx.bid * 8 + wid; i < 8 * 256; i += cx.nb * 8) { const int e = i >> 8, r = i & 255; const unsigned s = sbase[e] + xb_ld(ctl + CW_CNT + j * 64 + e) + r;
        if (s < sbase[e + 1]) {
#pragma unroll
            for (int q = 0; q < 2; ++q) ((u32x4*)(HS + (size_t)s * D))[lane + 64 * q] = ((const u32x4*)H)[lane + 64 * q]; } }
    LAS unsigned* wcnt = sbase + 16; LAS unsigned* wbase = sbase + 24;
    if (tidx(cx) < 8) wcnt[tidx(cx)] = 0u;
    const int nk = nrows / (cx.nb * 8); const int myrow = cx.bid * 8 + wid + lane * (cx.nb * 8); const bool own = lane < nk;
    int e1 = 0, e2 = 0; if (own) { const f32x2 t = *(const f32x2*)(TOPK + 4 * (size_t)myrow); e1 = __float_as_int(t[0]); e2 = __float_as_int(t[1]); }
    __syncthreads();
    if (own) { lds_add(wcnt + e1, 1u); lds_add(wcnt + e2, 1u); }
    __syncthreads();
    if (tidx(cx) < 8) { const unsigned n = wcnt[tidx(cx)]; wbase[tidx(cx)] = sbase[tidx(cx)] + (n ? atomicAdd(ctl + CW_FILL + j * 64 + tidx(cx), n) : 0u); wcnt[tidx(cx)] = 0u; }
    __syncthreads();
    int s1 = 0, s2 = 0;
    if (own) { s1 = (int)(wbase[e1] + lds_add(wcnt + e1, 1u)); s2 = (int)(wbase[e2] + lds_add(wcnt + e2, 1u)); POS[2 * myrow] = s1; POS[2 * myrow + 1] = s2; }
    u32x4 v[9][2];
#pragma unroll
    for (int k = 0; k < 9; ++k) if (k < nk) { const u32x4* src = (const u32x4*)(H + (size_t)(cx.bid * 8 + wid + k * (cx.nb * 8)) * D); v[k][0] = src[lane]; v[k][1] = src[lane + 64]; }
#pragma unroll
    for (int k = 0; k < 9; ++k) if (k < nk) { const int d1 = __builtin_amdgcn_readlane(s1, k), d2 = __builtin_amdgcn_readlane(s2, k);
        u32x4* o1 = (u32x4*)(HS + (size_t)d1 * D); u32x4* o2 = (u32x4*)(HS + (size_t)d2 * D);
        o1[lane] = v[k][0]; o1[lane + 64] = v[k][1]; o2[lane] = v[k][0]; o2[lane + 64] = v[k][1]; }
    __syncthreads();
}

struct CvIn { u32x4 cc[3], cu[3], cb; };
__device__ __forceinline__ void ph_conv(const bf16_t* P, bf16_t* BR, const float* conv_w, int nrows, const Ctx cx) {
    const int tid = tidx(cx), lane = tid & 63, wid = tid >> 6; const int c0 = lane * 8;
    float cw[3][8];
#pragma unroll
    for (int d = 0; d < 3; ++d)
#pragma unroll
        for (int e = 0; e < 8; ++e) cw[d][e] = conv_w[d * 512 + c0 + e];
    auto seqpos = [&](int row, int& sp, int& slen) { const bool lat = row < TL; sp = lat ? (row & (SEQ - 1)) : ((row - TL) & (CTXL - 1)); slen = lat ? SEQ : CTXL; };
    auto load = [&](int row, CvIn& in) { const bf16_t* pr = P + (size_t)row * NP; int sp, slen; seqpos(row, sp, slen);
#pragma unroll
        for (int d = 0; d < 3; ++d) { const int sq = sp + d - 1; const bool ok = sq >= 0 && sq < slen; const bf16_t* q = pr + (ptrdiff_t)(ok ? d - 1 : 0) * NP;
            in.cc[d] = *(const u32x4*)(q + P_CC + c0); in.cu[d] = *(const u32x4*)(q + P_CU + c0); }
        in.cb = *(const u32x4*)(pr + P_CB + c0); };
    const int stride = cx.nb * 8; int row = cx.bid * 8 + wid; CvIn cur, nxt;
    if (row < nrows) load(row, cur);
    for (; row < nrows; row += stride) {
        const int rn = row + stride; const bool hn = rn < nrows;
        if (hn) load(rn, nxt);
        int sp, slen; seqpos(row, sp, slen);
        float y[8];
#pragma unroll
        for (int e = 0; e < 8; ++e) y[e] = 0.f;
#pragma unroll
        for (int d = 0; d < 3; ++d) { const int sq = sp + d - 1; const float m = (sq >= 0 && sq < slen) ? 1.0f : 0.0f; float cv[8], uv[8]; unpack8(cur.cc[d], cv); unpack8(cur.cu[d], uv);
#pragma unroll
            for (int e = 0; e < 8; ++e) y[e] += (cv[e] * uv[e]) * (cw[d][e] * m); }
        float bv[8]; unpack8(cur.cb, bv);
#pragma unroll
        for (int e = 0; e < 8; ++e) y[e] *= bv[e];
        *(u32x4*)(BR + (size_t)row * 1536 + c0) = pack8(y);
        if (hn) cur = nxt;
    }
}

__device__ __forceinline__ void ph_final(const bf16_t* XS, const bf16_t* Y, const int* POS, const float* TOPK, const float* mod_g5, const float* g, float* out, const Ctx cx) {
    const int lane = tidx(cx) & 63, wid = tidx(cx) >> 6;
    f32x4 gq[4];
#pragma unroll
    for (int j = 0; j < 4; ++j) gq[j] = *(const f32x4*)(g + 4 * (lane + 64 * j));
    const int stride = cx.nb * 8; int row = cx.bid * 8 + wid;
    f32x4 xn[4]; u32x2 y1n[4], y2n[4]; float p1n = 0.f, p2n = 0.f;
    int cs1 = 0, cs2 = 0; float cp1 = 0.f, cp2 = 0.f;
    { const int rk = cx.bid * 8 + wid + lane * stride; if (rk < TL) { cs1 = POS[2 * rk]; cs2 = POS[2 * rk + 1]; cp1 = TOPK[4 * rk + 2]; cp2 = TOPK[4 * rk + 3]; } }
    auto fetch = [&](int r, int k) { const int s1 = __builtin_amdgcn_readlane(cs1, k), s2 = __builtin_amdgcn_readlane(cs2, k);
        p1n = __int_as_float(__builtin_amdgcn_readlane(__float_as_int(cp1), k)); p2n = __int_as_float(__builtin_amdgcn_readlane(__float_as_int(cp2), k));
#pragma unroll
        for (int j = 0; j < 4; ++j) { const int cc = 4 * (lane + 64 * j); xn[j] = ldx_raw(XS, false, (size_t)r * D + cc); y1n[j] = *(const u32x2*)(Y + (size_t)s1 * D + cc); y2n[j] = *(const u32x2*)(Y + (size_t)s2 * D + cc); } };
    if (row < TL) fetch(row, 0);
    int it = 0;
    for (; row < TL; row += stride, ++it) {
        const int mr = mod_row(row);
        f32x4 x[4]; u32x2 y1[4], y2[4]; const float p1 = p1n, p2 = p2n;
#pragma unroll
        for (int j = 0; j < 4; ++j) { x[j] = cvx(xn[j], false); y1[j] = y1n[j]; y2[j] = y2n[j]; }
        if (row + stride < TL) fetch(row + stride, it + 1);
        float ss = 0.f;
#pragma unroll
        for (int j = 0; j < 4; ++j) { const int cc = 4 * (lane + 64 * j);
            const f32x4 mg = *(const f32x4*)(mod_g5 + (size_t)mr * 6144 + cc);
            f32x4 e; e[0] = p1 * bf_lo(y1[j].x) + p2 * bf_lo(y2[j].x); e[1] = p1 * bf_hi(y1[j].x) + p2 * bf_hi(y2[j].x); e[2] = p1 * bf_lo(y1[j].y) + p2 * bf_lo(y2[j].y); e[3] = p1 * bf_hi(y1[j].y) + p2 * bf_hi(y2[j].y);
            x[j] = x[j] + mg * e; ss += x[j][0] * x[j][0] + x[j][1] * x[j][1] + x[j][2] * x[j][2] + x[j][3] * x[j][3]; }
        ss = wave_total(ss); const float rs = rsqrtf(ss * (1.0f / D) + EPS);
#pragma unroll
        for (int j = 0; j < 4; ++j) { const int cc = 4 * (lane + 64 * j); *(f32x4*)(out + (size_t)row * D + cc) = x[j] * rs * gq[j]; }
    }
}

__device__ __forceinline__ float wave_incl_scan(float v) {
    v += __int_as_float(__builtin_amdgcn_update_dpp(0, __float_as_int(v), 0x111, 0xF, 0xF, true));
    v += __int_as_float(__builtin_amdgcn_update_dpp(0, __float_as_int(v), 0x112, 0xF, 0xF, true));
    v += __int_as_float(__builtin_amdgcn_update_dpp(0, __float_as_int(v), 0x114, 0xF, 0xF, true));
    v += __int_as_float(__builtin_amdgcn_update_dpp(0, __float_as_int(v), 0x118, 0xF, 0xF, true));
    v += __int_as_float(__builtin_amdgcn_update_dpp(0, __float_as_int(v), 0x142, 0xA, 0xF, false));
    v += __int_as_float(__builtin_amdgcn_update_dpp(0, __float_as_int(v), 0x143, 0xC, 0xF, false));
    return v;
}
__device__ __forceinline__ float lsig16(float z) { const float e = __builtin_amdgcn_exp2f(fmaxf(z, -80.0f) * -LOG2E); return __builtin_amdgcn_logf(1.0f + e) * (-0.6931471805599453f / 16.0f); }
__device__ __forceinline__ void gla_wave_decay(const bf16_t* P, int row0, int t, int h, int d, int ch0, const float* gla_w2, const float* gla_b, float (&b)[16]) {
    const u32x4* ap = (const u32x4*)(P + (size_t)(row0 + t) * NP + P_AG + d * 16);
    float a[16]; unpack8(ap[0], a); unpack8(ap[1], a + 8);
    const float* w2 = gla_w2 + (size_t)d * 16 * 256 + h * 64 + ch0; const float* bb = gla_b + d * 256 + h * 64 + ch0;
#pragma unroll
    for (int i = 0; i < 16; ++i) b[i] = bb[i];
#pragma unroll
    for (int r = 0; r < 16; ++r)
#pragma unroll
        for (int i = 0; i < 16; ++i) b[i] = __builtin_fmaf(a[r], w2[r * 256 + i], b[i]);
#pragma unroll
    for (int i = 0; i < 16; ++i) b[i] = wave_incl_scan(lsig16(b[i]));
}

constexpr int G_QD = 0, G_KI = G_QD + 2 * 64 * STR64, G_AT = G_KI + 2 * 64 * STR64, G_VI = G_AT + 2 * 64 * STR64, G_SE = G_VI + 64 * STR128, G_RED = G_SE + 2 * 64 * STR128, G_END = G_RED + 512;
constexpr int G1_KR = G_KI, G1_AR = G_KI + 64 * STR64, G1_ASTR = 80, G1_W2 = 73728;
struct G1In { u32x4 vv[2], kraw, araw; float bb[16]; };
__device__ __forceinline__ void g1_load(G1In& in, const bf16_t* P, const float* gla_b, int ci, int h, int tid) {
    const int row0 = ci * 64;
    { const int w = tid >> 6; const float* bb = gla_b + (w >> 2) * 256 + h * 64 + (w & 3) * 16;
#pragma unroll
      for (int i = 0; i < 16; ++i) in.bb[i] = bb[i]; }
#pragma unroll
    for (int q = 0; q < 2; ++q) { const int id = tid + 512 * q, r = id >> 4, c16 = id & 15; in.vv[q] = *(const u32x4*)(P + (size_t)(row0 + r) * NP + P_VG + h * 128 + c16 * 8); }
    in.kraw = *(const u32x4*)(P + (size_t)(row0 + (tid >> 3)) * NP + P_KG + h * 64 + (tid & 7) * 8);
    in.araw = (u32x4){0u, 0u, 0u, 0u}; if (tid < 256) in.araw = *(const u32x4*)(P + (size_t)(row0 + (tid >> 2)) * NP + P_AG + (tid & 3) * 8);
}
__device__ __forceinline__ void gla_state_unit(const G1In& in, G1In& nxt, int vnext  , const bf16_t* P, int ci, int h, const float* gla_b, float* DS, float* DEC, float* BC, LAS unsigned char* lds, const Ctx cx) {
    const int tid = tidx(cx), lane = tid & 63, wid = __builtin_amdgcn_readfirstlane(tid >> 6), fr = lane & 15, fq = lane >> 4;
    LAS unsigned char* Ke = lds + G_QD; LAS unsigned char* Vi = lds + G_VI; LAS unsigned char* Kr = lds + G1_KR; LAS unsigned char* Ar = lds + G1_AR; const LAS float* w2s = (const LAS float*)(lds + G1_W2);
    {
#pragma unroll
      for (int q = 0; q < 2; ++q) { const int id = tid + 512 * q, r = id >> 4, c16 = id & 15; *(LAS u32x4*)(Vi + r * STR128 + c16 * 16) = in.vv[q]; }
      *(LAS u32x4*)(Kr + (tid >> 3) * STR64 + (tid & 7) * 16) = in.kraw;
      if (tid < 256) *(LAS u32x4*)(Ar + (tid >> 2) * G1_ASTR + (tid & 3) * 16) = in.araw; }
    __syncthreads();
    const size_t ub = ((size_t)ci * 4 + h) * 2;
    { const int d = wid >> 2, ch0 = (wid & 3) * 16, t = d ? 63 - lane : lane; float b[16];
      const LAS u32x4* ap = (const LAS u32x4*)(Ar + t * G1_ASTR + d * 32); float a[16]; unpack8(ap[0], a); unpack8(ap[1], a + 8);
      const LAS u32x4* kp = (const LAS u32x4*)(Kr + t * STR64 + ch0 * 2); const u32x4 k0 = kp[0], k1 = kp[1];
      const LAS float* w2 = w2s + d * 16 * 256 + h * 64 + ch0;
#pragma unroll
      for (int i = 0; i < 16; ++i) b[i] = in.bb[i];
#pragma unroll
      for (int r = 0; r < 16; ++r)
#pragma unroll
          for (int i = 0; i < 16; ++i) b[i] = __builtin_fmaf(a[r], w2[r * 256 + i], b[i]);
#pragma unroll
      for (int i = 0; i < 16; ++i) b[i] = wave_incl_scan(lsig16(b[i]));
      { float* bp = BC + ((ub + d) * 64 + ch0) * 64 + t;
#pragma unroll
        for (int i = 0; i < 16; ++i) bp[i * 64] = b[i]; }
      float kf[16], o[16]; unpack8(k0, kf); unpack8(k1, kf + 8);
#pragma unroll
      for (int i = 0; i < 16; ++i) { const float bt = __int_as_float(__builtin_amdgcn_readlane(__float_as_int(b[i]), 63)); o[i] = kf[i] * __expf(bt - b[i]); b[i] = bt; }
      *(LAS u32x4*)(Ke + d * 64 * STR64 + t * STR64 + ch0 * 2) = pack8(o); *(LAS u32x4*)(Ke + d * 64 * STR64 + t * STR64 + ch0 * 2 + 16) = pack8(o + 8);
      if (lane < 16) { float dv = b[0];
#pragma unroll
          for (int i = 1; i < 16; ++i) dv = (lane == i) ? b[i] : dv;
          DEC[(ub + d) * 64 + ch0 + lane] = __expf(dv); } }
    __syncthreads();
    if (vnext >= 0) g1_load(nxt, P, gla_b, vnext >> 2, vnext & 3, tid);
    { const int d = wid >> 2, mt = wid & 3; f32x4 acc[8];
#pragma unroll
      for (int n = 0; n < 8; ++n) acc[n] = (f32x4){0.f, 0.f, 0.f, 0.f};
#pragma unroll
      for (int s = 0; s < 2; ++s) { const int r0 = 32 * s + 8 * fq; const bf16x8 af = frag_tr(Ke + d * 64 * STR64, r0, r0 + 4, mt * 16, STR64, fr);
#pragma unroll
          for (int n = 0; n < 8; ++n) { const bf16x8 bfr = frag_tr(Vi, r0, r0 + 4, n * 16, STR128, fr); MMA16(acc[n], af, bfr); } }
      LAS unsigned char* my = lds + G_AT + wid * (16 * STR64); const int r8 = lane >> 3, c8 = lane & 7;
      LAS unsigned char* wp = my + fr * STR64 + fq * 16; const LAS unsigned char* rp = my + r8 * STR64 + c8 * 16;
      float* dst = DS + ((ub + d) * 64 + mt * 16 + r8) * 128 + 4 * c8;
#pragma unroll
      for (int p = 0; p < 4; ++p) {
          *(LAS f32x4*)wp = acc[2 * p]; *(LAS f32x4*)(wp + 64) = acc[2 * p + 1];
          asm volatile("" ::: "memory"); __builtin_amdgcn_wave_barrier();
          const f32x4 x0 = *(const LAS f32x4*)rp, x1 = *(const LAS f32x4*)(rp + 8 * STR64);
          asm volatile("" ::: "memory"); __builtin_amdgcn_wave_barrier();
          *(f32x4*)(dst + p * 32) = x0; *(f32x4*)(dst + 8 * 128 + p * 32) = x1; } }
    __syncthreads();
}

__device__ __forceinline__ void ph_gla_scan2(const float* DS, const float* DEC, bf16_t* SE, const Ctx cx) {
    const int tid = tidx(cx);
    for (int vi = cx.bid * 512 + tid; vi < 64 * 2048; vi += cx.nb * 512) {
        const int sid = vi >> 11, dk = (vi >> 5) & 63, dvq = vi & 31; const int b = sid >> 3, h = (sid >> 1) & 3, d = sid & 1;
        f32x4 S = (f32x4){0.f, 0.f, 0.f, 0.f};
#pragma unroll 12
        for (int st = 0; st < 36; ++st) {
            const int ci = st < 4 ? (256 + 4 * b + (d ? 3 - st : st)) : (32 * b + (d ? 35 - st : st - 4));
            const size_t ub = ((size_t)ci * 4 + h) * 2 + d; const size_t eo = (ub * 64 + dk) * 128 + dvq * 4;
            u32x2 w; w.x = cvt_pk_bf16(S[0], S[1]); w.y = cvt_pk_bf16(S[2], S[3]); *(u32x2*)(SE + eo) = w;
            const float dec = DEC[ub * 64 + dk]; const f32x4 ds = *(const f32x4*)(DS + eo);
            S = S * dec + ds;
        }
    }
}

struct G3In { u32x4 vv[2], sv[4], qraw, kraw; float bb[16]; };
__device__ __forceinline__ void g3_load(G3In& in, const bf16_t* P, int ci, int h, const float* BC, const bf16_t* SE, int tid) {
    const int lane = tid & 63, wid = __builtin_amdgcn_readfirstlane(tid >> 6); const int row0 = ci * 64; const size_t ub = ((size_t)ci * 4 + h) * 2;
#pragma unroll
    for (int q = 0; q < 2; ++q) { const int id = tid + 512 * q, r = id >> 4, c16 = id & 15; in.vv[q] = *(const u32x4*)(P + (size_t)(row0 + r) * NP + P_VG + h * 128 + c16 * 8); }
#pragma unroll
    for (int q = 0; q < 4; ++q) { const int id = tid + 512 * q, r = id >> 4, c16 = id & 15; in.sv[q] = *(const u32x4*)(SE + (ub * 64 + r) * 128 + c16 * 8); }
    const int d = wid >> 2, ch0 = (wid & 3) * 16, t = d ? 63 - lane : lane;
    { const bf16_t* pr = P + (size_t)(row0 + (tid >> 3)) * NP + h * 64 + (tid & 7) * 8; in.qraw = *(const u32x4*)(pr + P_QG); in.kraw = *(const u32x4*)(pr + P_KG); }
    const float* bp = BC + ((ub + d) * 64 + ch0) * 64 + t;
#pragma unroll
    for (int i = 0; i < 16; ++i) in.bb[i] = bp[i * 64];
}
__device__ __forceinline__ void gla_out_unit(const G3In& in, const bf16_t* P, int ci, int h, const float* gng, bf16_t* BR, LAS unsigned char* lds, const Ctx cx) {
    const int tid = tidx(cx), lane = tid & 63, wid = __builtin_amdgcn_readfirstlane(tid >> 6), fr = lane & 15, fq = lane >> 4; const int row0 = ci * 64;
    LAS unsigned char* Qd = lds + G_QD; LAS unsigned char* Ki = lds + G_KI; LAS unsigned char* Vi = lds + G_VI; LAS unsigned char* Se = lds + G_SE; LAS unsigned char* At = lds + G_AT;
    { LAS unsigned char* Qr = At; LAS unsigned char* Kr = At + 64 * STR64;
      *(LAS u32x4*)(Qr + (tid >> 3) * STR64 + (tid & 7) * 16) = in.qraw; *(LAS u32x4*)(Kr + (tid >> 3) * STR64 + (tid & 7) * 16) = in.kraw; }
#pragma unroll
    for (int q = 0; q < 2; ++q) { const int id = tid + 512 * q, r = id >> 4, c16 = id & 15; *(LAS u32x4*)(Vi + r * STR128 + c16 * 16) = in.vv[q]; }
#pragma unroll
    for (int q = 0; q < 4; ++q) { const int id = tid + 512 * q, r = id >> 4, c16 = id & 15; *(LAS u32x4*)(Se + r * STR128 + c16 * 16) = in.sv[q]; }
    __syncthreads();
    { const int d = wid >> 2, ch0 = (wid & 3) * 16, t = d ? 63 - lane : lane; float b[16];
      const LAS u32x4* qp = (const LAS u32x4*)(At + t * STR64 + ch0 * 2); const LAS u32x4* kp = (const LAS u32x4*)(At + 64 * STR64 + t * STR64 + ch0 * 2);
      const u32x4 q0 = qp[0], q1 = qp[1], k0 = kp[0], k1 = kp[1];
#pragma unroll
      for (int i = 0; i < 16; ++i) b[i] = in.bb[i];
      float qf[16], kf[16]; unpack8(q0, qf); unpack8(q1, qf + 8); unpack8(k0, kf); unpack8(k1, kf + 8);
#pragma unroll
      for (int i = 0; i < 16; ++i) { const float e = __expf(b[i]); qf[i] = qf[i] * 0.125f * e; kf[i] = kf[i] * __builtin_amdgcn_rcpf(e); }
      LAS unsigned char* qd = Qd + d * 64 * STR64 + t * STR64 + ch0 * 2; LAS unsigned char* ki = Ki + d * 64 * STR64 + t * STR64 + ch0 * 2;
      *(LAS u32x4*)qd = pack8(qf); *(LAS u32x4*)(qd + 16) = pack8(qf + 8); *(LAS u32x4*)ki = pack8(kf); *(LAS u32x4*)(ki + 16) = pack8(kf + 8); }
    __syncthreads();
    { const int d = wid >> 2, mt = wid & 3; f32x4 acc[4];
#pragma unroll
      for (int n = 0; n < 4; ++n) acc[n] = (f32x4){0.f, 0.f, 0.f, 0.f};
#pragma unroll
      for (int s = 0; s < 2; ++s) { const bf16x8 af = frag_row(Qd + d * 64 * STR64, mt * 16 + fr, 32 * s + 8 * fq, STR64);
#pragma unroll
          for (int n = 0; n < 4; ++n) { const bf16x8 bfr = frag_row(Ki + d * 64 * STR64, n * 16 + fr, 32 * s + 8 * fq, STR64); MMA16(acc[n], af, bfr); } }
      const int l = mt * 16 + fr;
#pragma unroll
      for (int n = 0; n < 4; ++n) { float v[4];
#pragma unroll
          for (int j = 0; j < 4; ++j) { const int s = n * 16 + 4 * fq + j; const bool keep = d ? (s >= l) : (s <= l); v[j] = keep ? acc[n][j] : 0.f; }
          u32x2 w; w.x = cvt_pk_bf16(v[0], v[1]); w.y = cvt_pk_bf16(v[2], v[3]); *(LAS u32x2*)(At + d * 64 * STR64 + l * STR64 + (n * 16 + 4 * fq) * 2) = w; } }
    __syncthreads();
    { const int mt = wid & 3, nh = wid >> 2; f32x4 acc[4];
      const int l = mt * 16 + fr; const size_t row = (size_t)row0 + l;
      u32x2 rw[4]; f32x4 gg[4];
#pragma unroll
      for (int n = 0; n < 4; ++n) { const int v0 = (nh * 4 + n) * 16 + 4 * fq; rw[n] = *(const u32x2*)(P + row * NP + P_RG + h * 128 + v0); gg[n] = *(const f32x4*)(gng + h * 128 + v0); }
#pragma unroll
      for (int n = 0; n < 4; ++n) acc[n] = (f32x4){0.f, 0.f, 0.f, 0.f};
#pragma unroll
      for (int d = 0; d < 2; ++d)
#pragma unroll
          for (int s = 0; s < 2; ++s) { const int r0 = 32 * s + 8 * fq;
              const bf16x8 af = frag_row(At + d * 64 * STR64, mt * 16 + fr, r0, STR64), aq = frag_row(Qd + d * 64 * STR64, mt * 16 + fr, r0, STR64);
#pragma unroll
              for (int n = 0; n < 4; ++n) { const int x0 = (nh * 4 + n) * 16;
                  const bf16x8 bv = frag_tr(Vi, r0, r0 + 4, x0, STR128, fr); MMA16(acc[n], af, bv);
                  const bf16x8 bs = frag_tr(Se + d * 64 * STR128, r0, r0 + 4, x0, STR128, fr); MMA16(acc[n], aq, bs); } }
      float ss = 0.f;
#pragma unroll
      for (int n = 0; n < 4; ++n) ss += acc[n][0] * acc[n][0] + acc[n][1] * acc[n][1] + acc[n][2] * acc[n][2] + acc[n][3] * acc[n][3];
      ss = row4_sum(ss);
      LAS float* red = (LAS float*)(lds + G_RED);
      if (fq == 0) red[l * 2 + nh] = ss;
      __syncthreads();
      const float rs = rsqrtf((red[l * 2] + red[l * 2 + 1]) * (1.0f / 128.0f) + EPS);
#pragma unroll
      for (int n = 0; n < 4; ++n) { const int v0 = (nh * 4 + n) * 16 + 4 * fq;
          const float y0 = acc[n][0] * rs * gg[n][0] * siluf_(bf_lo(rw[n].x)), y1 = acc[n][1] * rs * gg[n][1] * siluf_(bf_hi(rw[n].x)), y2 = acc[n][2] * rs * gg[n][2] * siluf_(bf_lo(rw[n].y)), y3 = acc[n][3] * rs * gg[n][3] * siluf_(bf_hi(rw[n].y));
          u32x2 w; w.x = cvt_pk_bf16(y0, y1); w.y = cvt_pk_bf16(y2, y3); *(u32x2*)(BR + row * 1536 + 1024 + h * 128 + v0) = w; } }
    __syncthreads();
}

constexpr int A_KBUF = 0, A_VBUF = 64 * STR64, A_BUF = 2 * 64 * STR64;
__device__ __forceinline__ void attn_unit(const bf16_t* QR, const bf16_t* KV, bf16_t* BR, const float* sink, int b, int kh, int qrow0  , int qpos0  , LAS unsigned char* lds, const Ctx cx) {
    const int tid = tidx(cx), lane = tid & 63, wid = tid >> 6, fr = lane & 15, fq = lane >> 4; const int hq = wid >> 1, qh = wid & 1;
    const bool lat = qpos0 >= 0;
    int kt0 = 0, kt1 = 0; if (lat) { kt0 = (qpos0 >> 6) - 2; if (kt0 < 0) kt0 = 0; kt1 = (qpos0 >> 6) + 4; if (kt1 > 32) kt1 = 32; }
    const int ntile = (kt1 - kt0) + 4;
    bf16x8 qf[4][2];
#pragma unroll
    for (int mt = 0; mt < 4; ++mt)
#pragma unroll
        for (int ks = 0; ks < 2; ++ks) qf[mt][ks] = *(const bf16x8*)(QR + (size_t)(qrow0 + 64 * qh + 16 * mt + fr) * 512 + (4 * kh + hq) * 64 + 32 * ks + 8 * fq);
    const float sk = sink[4 * kh + hq] * LOG2E;
    f32x4 oacc[4][4]; float mrun[4], lrun[4];
#pragma unroll
    for (int mt = 0; mt < 4; ++mt) { mrun[mt] = sk; lrun[mt] = (fq == 0) ? 1.0f : 0.0f;
#pragma unroll
        for (int dt = 0; dt < 4; ++dt) oacc[mt][dt] = (f32x4){0.f, 0.f, 0.f, 0.f}; }
    const int sr = tid >> 3, sc = tid & 7;
    auto tile_row0 = [&](int t) -> int { return t < (kt1 - kt0) ? b * SEQ + (kt0 + t) * 64 : TL + b * CTXL + (t - (kt1 - kt0)) * 64; };
    u32x4 kreg, vreg;
    { const bf16_t* src = KV + (size_t)(tile_row0(0) + sr) * 256 + kh * 64 + sc * 8; kreg = *(const u32x4*)src; vreg = *(const u32x4*)(src + 128); }
    *(LAS u32x4*)(lds + A_KBUF + sr * STR64 + sc * 16) = kreg; *(LAS u32x4*)(lds + A_VBUF + sr * STR64 + sc * 16) = vreg;
    __syncthreads();
    for (int t = 0; t < ntile; ++t) {
        LAS unsigned char* Kb = lds + (t & 1) * A_BUF + A_KBUF; LAS unsigned char* Vb = lds + (t & 1) * A_BUF + A_VBUF;
        if (t + 1 < ntile) { const bf16_t* src = KV + (size_t)(tile_row0(t + 1) + sr) * 256 + kh * 64 + sc * 8; kreg = *(const u32x4*)src; vreg = *(const u32x4*)(src + 128); }
        const bool latt = t < (kt1 - kt0); const int kpos0 = (kt0 + t) * 64;
        const int qlo = qpos0 + 64 * qh;
        const bool active = !latt || (kpos0 + 63 >= qlo - 128 && kpos0 <= qlo + 63 + 128);
        const bool needmask = latt && (kpos0 > qlo + 65 || kpos0 < qlo - 65);
        if (active) {
            u32x4 pf[4][2];
            { bf16x8 kf[4][2];
#pragma unroll
              for (int nt = 0; nt < 4; ++nt)
#pragma unroll
                  for (int ks = 0; ks < 2; ++ks) kf[nt][ks] = frag_row(Kb, nt * 16 + fr, 32 * ks + 8 * fq, STR64);
#pragma unroll
              for (int mt = 0; mt < 4; ++mt) {
                f32x4 s[4];
#pragma unroll
                for (int nt = 0; nt < 4; ++nt) { s[nt] = (f32x4){0.f, 0.f, 0.f, 0.f}; MMA16(s[nt], qf[mt][0], kf[nt][0]); MMA16(s[nt], qf[mt][1], kf[nt][1]); }
                if (needmask) { const int qp = qlo + 16 * mt + fr;
#pragma unroll
                    for (int nt = 0; nt < 4; ++nt)
#pragma unroll
                        for (int j = 0; j < 4; ++j) { const int dlt = kpos0 + nt * 16 + 4 * fq + j - qp; if (dlt > 128 || dlt < -128) s[nt][j] = -3.0e38f; } }
                float mx = vmax2(vmax2(vmax2(s[0][0], s[0][1]), vmax2(s[0][2], s[0][3])), vmax2(vmax2(s[1][0], s[1][1]), vmax2(s[1][2], s[1][3])));
                mx = vmax2(mx, vmax2(vmax2(vmax2(s[2][0], s[2][1]), vmax2(s[2][2], s[2][3])), vmax2(vmax2(s[3][0], s[3][1]), vmax2(s[3][2], s[3][3]))));
                mx = row4_max(mx);
                const float mnew = vmax2(mrun[mt], mx), alpha = __builtin_amdgcn_exp2f(mrun[mt] - mnew); mrun[mt] = mnew;
                float ps = 0.f;
#pragma unroll
                for (int nt = 0; nt < 4; ++nt)
#pragma unroll
                    for (int j = 0; j < 4; ++j) { const float p = __builtin_amdgcn_exp2f(s[nt][j] - mnew); s[nt][j] = p; ps += p; }
                lrun[mt] = lrun[mt] * alpha + ps;
                pf[mt][0].x = cvt_pk_bf16(s[0][0], s[0][1]); pf[mt][0].y = cvt_pk_bf16(s[0][2], s[0][3]); pf[mt][0].z = cvt_pk_bf16(s[1][0], s[1][1]); pf[mt][0].w = cvt_pk_bf16(s[1][2], s[1][3]);
                pf[mt][1].x = cvt_pk_bf16(s[2][0], s[2][1]); pf[mt][1].y = cvt_pk_bf16(s[2][2], s[2][3]); pf[mt][1].z = cvt_pk_bf16(s[3][0], s[3][1]); pf[mt][1].w = cvt_pk_bf16(s[3][2], s[3][3]);
#pragma unroll
                for (int dt = 0; dt < 4; ++dt) oacc[mt][dt] = oacc[mt][dt] * alpha;
              } }
#pragma unroll
            for (int dt = 0; dt < 4; ++dt) {
                const bf16x8 v0 = frag_tr(Vb, 4 * fq, 16 + 4 * fq, dt * 16, STR64, fr), v1 = frag_tr(Vb, 32 + 4 * fq, 48 + 4 * fq, dt * 16, STR64, fr);
#pragma unroll
                for (int mt = 0; mt < 4; ++mt) { MMA16(oacc[mt][dt], __builtin_bit_cast(bf16x8, pf[mt][0]), v0); MMA16(oacc[mt][dt], __builtin_bit_cast(bf16x8, pf[mt][1]), v1); } }
        }
        if (t + 1 < ntile) { LAS unsigned char* nb_ = lds + ((t + 1) & 1) * A_BUF; *(LAS u32x4*)(nb_ + A_KBUF + sr * STR64 + sc * 16) = kreg; *(LAS u32x4*)(nb_ + A_VBUF + sr * STR64 + sc * 16) = vreg; }
        __syncthreads();
    }
#pragma unroll
    for (int mt = 0; mt < 4; ++mt) { const float l = row4_sum(lrun[mt]); const float inv = 1.0f / l;
        bf16_t* op = BR + (size_t)(qrow0 + 64 * qh + 16 * mt + fr) * 1536 + 512 + (4 * kh + hq) * 64 + 4 * fq;
#pragma unroll
        for (int dt = 0; dt < 4; ++dt) { u32x2 w; w.x = cvt_pk_bf16(oacc[mt][dt][0] * inv, oacc[mt][dt][1] * inv); w.y = cvt_pk_bf16(oacc[mt][dt][2] * inv, oacc[mt][dt][3] * inv); *(u32x2*)(op + dt * 16) = w; } }
}

__device__ __forceinline__ void ph_mixA(const bf16_t* P, const bf16_t* QR, const bf16_t* KV, bf16_t* BR, const float* sink, const float* gla_w2, const float* gla_b, float* DS, float* DEC, float* BC, bool ctxq, LAS unsigned char* lds, const Ctx cx) {
    { LAS float* w2s = (LAS float*)(lds + G1_W2); for (int i = tidx(cx); i < 2 * 16 * 256; i += 512) w2s[i] = gla_w2[i]; }
    for (int u = cx.bid; u < 256; u += cx.nb) { const int b = u >> 5, n = (u >> 1) & 15, kh = u & 1; attn_unit(QR, KV, BR, sink, b, kh, b * SEQ + n * 128, n * 128, lds, cx); }
    if (cx.nb == 256) {
        const int n = (cx.bid >> 1) & 15; const bool edge = (n == 0 || n == 15);
        if (ctxq && edge) { const int b = cx.bid >> 5, kh = cx.bid & 1; attn_unit(QR, KV, BR, sink, b, kh, TL + b * CTXL + (n == 15 ? 128 : 0), -1000000, lds, cx); }
        int rank; if (!ctxq) rank = cx.bid; else { const int blk = cx.bid >> 5, w = cx.bid & 31; rank = edge ? -1 : blk * 28 + (w - 2); }
        const int nv = (rank >= 0 && rank < 128) ? 5 : 4;
        G1In cur, nxt; g1_load(cur, P, gla_b, cx.bid >> 2, cx.bid & 3, tidx(cx));
#pragma unroll 1
        for (int k = 0; k < nv; ++k) { const int v = k < 4 ? cx.bid + 256 * k : 1024 + rank; const int vn = (k + 1 < nv) ? ((k + 1) < 4 ? cx.bid + 256 * (k + 1) : 1024 + rank) : -1;
            gla_state_unit(cur, nxt, vn, P, v >> 2, v & 3, gla_b, DS, DEC, BC, lds, cx);
            if (vn >= 0) cur = nxt; }
        return;
    }
    const int nsmall = (ctxq ? 32 : 0) + 1152;
    for (int u = cx.bid; u < nsmall; u += cx.nb) {
        int v = u;
        if (ctxq) { if (v < 32) { const int b = v >> 2, n = (v >> 1) & 1, kh = v & 1; attn_unit(QR, KV, BR, sink, b, kh, TL + b * CTXL + n * 128, -1000000, lds, cx); continue; } v -= 32; }
        { G1In cur, nxt; g1_load(cur, P, gla_b, v >> 2, v & 3, tidx(cx)); gla_state_unit(cur, nxt, -1, P, v >> 2, v & 3, gla_b, DS, DEC, BC, lds, cx); }
    }
}
__device__ __forceinline__ void ph_mixC(const bf16_t* P, const float* BC, const bf16_t* SE, const float* gng, bf16_t* BR, int nchunks, LAS unsigned char* lds, const Ctx cx) {
    const int n = nchunks * 4; int u = cx.bid; G3In cur, nxt;
    if (u < n) g3_load(cur, P, u >> 2, u & 3, BC, SE, tidx(cx));
    for (; u < n; u += cx.nb) { const int un = u + cx.nb; const bool hn = un < n;
        if (hn) g3_load(nxt, P, un >> 2, un & 3, BC, SE, tidx(cx));
        gla_out_unit(cur, P, u >> 2, u & 3, gng, BR, lds, cx);
        if (hn) cur = nxt; }
}

template <int MODE, class Epi, int ABLK = 0> __device__ __forceinline__ void ph_gemm(LAS unsigned char* lds, const bf16_t* A, const bf16_t* Bt, int lda, int ldb, int K, int nM, int nN, const Epi& E, unsigned* ctl, int moe_j, size_t bexp, const Ctx cx) {
    pg8::Prob<MODE> P; P.A = A; P.Bt = Bt; P.lda = lda; P.ldb = ldb; P.K = K; P.nM = nM; P.nN = nN; P.G = cx.nb; P.c = cx.bid; P.texp = (LAS int*)(lds + LDS_TEXP); P.bexp = bexp; P.nctx = (MODE == 3) ? moe_j : 0;
    if (MODE == 2) {
        __syncthreads();
        if (tidx(cx) < 256) ((LAS int*)(lds + LDS_TEXP))[tidx(cx)] = (int)xb_ld(ctl + CW_TEXP + moe_j * 256 + tidx(cx));
        P.nM = (int)xb_ld(ctl + CW_NT + moe_j);
        __syncthreads();
    }
    pg8::gemm_phase<Epi, pg8::Prob<MODE>, ABLK>(lds, P, E, cx);
}

__device__ __forceinline__ bool idle_ctx(unsigned* ctl, int j, int nN, Ctx& cx) {
    const int U = (int)xb_ld(ctl + CW_NT + j) * nN, rounds = (U + cx.nb - 1) / cx.nb, nidle = rounds * cx.nb - U;
    if (nidle < 64) return true;
    const int first = cx.nb - nidle; if (cx.bid < first) return false;
    cx.bid -= first; cx.nb = nidle; return true;
}

struct MKP { const float* in[24]; float* out; char* ws; };
typedef const MKP __attribute__((address_space(4)))* KPtr;
__device__ __forceinline__ KPtr kp() { KPtr q = (KPtr)__builtin_amdgcn_kernarg_segment_ptr(); OPQ_S(q); return q; }
#define IN_(i) ((const float*)q->in[i])
#define WSP(off) (ws + (off))

__global__ void __launch_bounds__(512, 2) mk_fwd(MKP p_unused) {
    extern __shared__ __attribute__((aligned(16))) unsigned char shm[];
    LAS unsigned char* lds = (LAS unsigned char*)shm;
    const int nb = gridDim.x; const int wv = __builtin_amdgcn_readfirstlane((int)(threadIdx.x >> 6));
    XcdBarrier bar;
    { KPtr q = kp(); char* ws = q->ws;
      if (threadIdx.x == 0) *(LAS u32x4*)(lds + LDS_BARW) = (u32x4){0u, 0u, 0u, 0u};
      __syncthreads();
      bar = xcd_barrier_post((unsigned*)WSP(WS_CTL) + CW_BAR, (volatile LAS unsigned*)(lds + LDS_BARW)); }

    { KPtr q = kp(); char* ws = q->ws; Ctx cx; cx.bid = blockIdx.x; cx.nb = nb; cx.wv = wv; OPQ_S(cx.bid); OPQ_S(cx.wv);
      ph_init(IN_(0), IN_(2), (float*)nullptr, (f32x2*)WSP(WS_CS), cx);
      ph_mod(IN_(1), IN_(3), IN_(4), IN_(5), (float*)WSP(WS_MOD), lds, cx);
      __syncthreads(); }
    { int rot = 0;
#pragma unroll 1
      for (int l = 0; l < DEPTH; ++l) {
          KPtr q = kp(); char* ws = q->ws; Ctx cx; cx.bid = blockIdx.x; cx.nb = nb; cx.wv = wv; OPQ_S(cx.bid); OPQ_S(cx.wv);
          ph_convert(mkjob(IN_(8) + (size_t)l * D * DIN, nullptr, (bf16_t*)WSP(WS_WIN) + (size_t)l * NP * D, DIN, D, 0, D, NP, 1), lds, cx, rot);
          ph_convert(mkjob(IN_(15) + (size_t)l * D * D, nullptr, (bf16_t*)WSP(WS_WO3) + (size_t)l * D * D, D, D, 0, D, D, 0), lds, cx, rot);
#pragma unroll 1
          for (int i = 0; i < 3; ++i) {
              ph_convert(mkjob(IN_(14) + ((size_t)l * 3 + i) * 512 * D, nullptr, (bf16_t*)WSP(WS_WBR) + (size_t)l * D * 1536, D, 1536, i * 512, 512, 1024, 0), lds, cx, rot);
          }
      }
#pragma unroll 1
      for (int j = 0; j < 2; ++j) {
          KPtr q = kp(); char* ws = q->ws; Ctx cx; cx.bid = blockIdx.x; cx.nb = nb; cx.wv = wv; OPQ_S(cx.bid); OPQ_S(cx.wv);
          ph_convert(mkjob(IN_(16) + (size_t)j * D * DFF, IN_(17) + (size_t)j * D * DFF, (bf16_t*)WSP(WS_WUPD) + (size_t)j * NUP * D, DFF, D, 0, D, NUP, 2), lds, cx, rot);
          ph_convert(mkjob(IN_(18) + (size_t)j * DFF * D, nullptr, (bf16_t*)WSP(WS_WDND) + (size_t)j * D * DFF, D, DFF, 0, DFF, D, 0), lds, cx, rot);
      }
    }
    { Ctx cx; cx.bid = 0; cx.nb = nb; cx.wv = wv; OPQ_S(cx.wv); xcd_barrier_first(bar, cx); }

#pragma unroll 1
    for (int l = 0; l < DEPTH; ++l) {
        const bool last = (l == DEPTH - 1), moe = (l & 1); const int j = l >> 1; const int nrows = last ? TL : T; const int nMr = nrows / 256;
        { KPtr q = kp(); char* ws = q->ws; Ctx cx; cx.bid = blockIdx.x; cx.nb = nb; cx.wv = wv; OPQ_S(cx.bid); OPQ_S(cx.wv); const float* modl = (const float*)WSP(WS_MOD) + (size_t)l * 9 * 6144;
          NormArgs a; a.XS = (bf16_t*)WSP(WS_XS); a.lf32 = a.cf32 = (l == 0); a.Xl = l ? (const void*)WSP(WS_XS) : (const void*)IN_(0); a.Xc = l ? (const void*)WSP(WS_XS) : (const void*)(IN_(2) - (size_t)TL * D); a.H = (bf16_t*)WSP(WS_H); a.g = IN_(6) + l * D; a.mod_shift = modl; a.mod_scale = modl + 1024; a.nrows = T;
          a.Y = (const bf16_t*)WSP(WS_YB); a.POS = (const int*)WSP(WS_POS); a.TOPKp = (const float*)WSP(WS_TOPK); a.mod_g5prev = (const float*)WSP(WS_MOD) + (size_t)(l > 0 ? l - 1 : 0) * 9 * 6144 + 5 * 1024; a.router = nullptr; a.TOPK = nullptr; a.cnt = nullptr;
          a.npart = 7; a.PART = (l == 1 || l == 3) ? (const float*)WSP(WS_PART) : nullptr; a.mod_gpart = (const float*)WSP(WS_MOD) + (size_t)(l > 0 ? l - 1 : 0) * 9 * 6144 + 5 * 1024;
          ph_norm<false>(a, l == 2, lds, cx); }
        { Ctx cx; cx.bid = 0; cx.nb = nb; cx.wv = wv; OPQ_S(cx.wv); xcd_barrier(bar, cx); }
        { KPtr q = kp(); char* ws = q->ws; Ctx cx; cx.bid = blockIdx.x; cx.nb = nb; cx.wv = wv; OPQ_S(cx.bid); OPQ_S(cx.wv);
          pg8::EpiWin E{(bf16_t*)WSP(WS_PH), (bf16_t*)WSP(WS_QR), (bf16_t*)WSP(WS_KV), (const f32x2*)WSP(WS_CS), lds + LDS_CSH}; ph_gemm<0>(lds, (const bf16_t*)WSP(WS_H), (const bf16_t*)WSP(WS_WIN) + (size_t)l * NP * D, D, D, D, T / 256, NP / 256, E, nullptr, 0, 0, cx); }
        { Ctx cx; cx.bid = 0; cx.nb = nb; cx.wv = wv; OPQ_S(cx.wv); xcd_barrier(bar, cx); }
        { KPtr q = kp(); char* ws = q->ws; Ctx cx; cx.bid = blockIdx.x; cx.nb = nb; cx.wv = wv; OPQ_S(cx.bid); OPQ_S(cx.wv);
          ph_mixA((const bf16_t*)WSP(WS_PH), (const bf16_t*)WSP(WS_QR), (const bf16_t*)WSP(WS_KV), (bf16_t*)WSP(WS_BR), IN_(10) + l * 8, IN_(11) + (size_t)l * 2 * 16 * 256, IN_(12) + (size_t)l * 2 * 256,
                  (float*)WSP(WS_R3), (float*)WSP(WS_DEC), (float*)WSP(WS_YB), !last, lds, cx); }
        { Ctx cx; cx.bid = 0; cx.nb = nb; cx.wv = wv; OPQ_S(cx.wv); xcd_barrier(bar, cx); }
        { KPtr q = kp(); char* ws = q->ws; Ctx cx; cx.bid = blockIdx.x; cx.nb = nb; cx.wv = wv; OPQ_S(cx.bid); OPQ_S(cx.wv);
          ph_gla_scan2((const float*)WSP(WS_R3), (const float*)WSP(WS_DEC), (bf16_t*)(WSP(WS_R3) + (size_t)2 * T * 512 * 4), cx); }
        { Ctx cx; cx.bid = 0; cx.nb = nb; cx.wv = wv; OPQ_S(cx.wv); xcd_barrier(bar, cx); }
        { KPtr q = kp(); char* ws = q->ws; Ctx cx; cx.bid = blockIdx.x; cx.nb = nb; cx.wv = wv; OPQ_S(cx.bid); OPQ_S(cx.wv);
          ph_conv((const bf16_t*)WSP(WS_PH), (bf16_t*)WSP(WS_BR), IN_(9) + (size_t)l * 3 * 512, nrows, cx);
          ph_mixC((const bf16_t*)WSP(WS_PH), (const float*)WSP(WS_YB), (const bf16_t*)(WSP(WS_R3) + (size_t)2 * T * 512 * 4), IN_(13) + l * 512, (bf16_t*)WSP(WS_BR), nrows / 64, lds, cx); }
        { Ctx cx; cx.bid = 0; cx.nb = nb; cx.wv = wv; OPQ_S(cx.wv); xcd_barrier(bar, cx); }
        { KPtr q = kp(); char* ws = q->ws; Ctx cx; cx.bid = blockIdx.x; cx.nb = nb; cx.wv = wv; OPQ_S(cx.bid); OPQ_S(cx.wv);
          constexpr size_t MG3C_OFF = (size_t)TL * D * 2;
          if (!last) { pg8::EpiGate E{(bf16_t*)(WSP(WS_R3) + MG3C_OFF), (const bf16_t*)WSP(WS_PH) + (size_t)TL * NP, lds + LDS_CSH}; ph_gemm<1>(lds, (const bf16_t*)WSP(WS_BR) + (size_t)TL * 1536, (const bf16_t*)WSP(WS_WBR) + (size_t)l * D * 1536, 1536, 1536, 512, 8, 12, E, nullptr, 0, 0, cx); }
          { pg8::EpiMerge E{(bf16_t*)WSP(WS_R3), (const bf16_t*)WSP(WS_PH), lds + LDS_CSH}; ph_gemm<4>(lds, (const bf16_t*)WSP(WS_BR), (const bf16_t*)WSP(WS_WBR) + (size_t)l * D * 1536, 1536, 1536, 1536, 64, 4, E, nullptr, 0, 0, cx); } }
        { Ctx cx; cx.bid = 0; cx.nb = nb; cx.wv = wv; OPQ_S(cx.wv); xcd_barrier(bar, cx); }
        { KPtr q = kp(); char* ws = q->ws; Ctx cx; cx.bid = blockIdx.x; cx.nb = nb; cx.wv = wv; OPQ_S(cx.bid); OPQ_S(cx.wv);
          constexpr size_t MG3C_OFF = (size_t)TL * D * 2;
          pg8::EpiResid E{(bf16_t*)WSP(WS_XS), (const float*)WSP(WS_MOD) + (size_t)l * 9 * 6144 + 2 * 1024, (float*)WSP(WS_PART), l ? (const void*)WSP(WS_XS) : (const void*)IN_(0), lds + LDS_CSH, l == 0, 0};
          if (!last) ph_gemm<5>(lds, (const bf16_t*)(WSP(WS_R3) + MG3C_OFF) - (size_t)TL * 3072, (const bf16_t*)WSP(WS_WO3) + (size_t)l * D * D, 3072, D, 512, 8, 4, E, nullptr, 0, 0, cx);
          ph_gemm<0>(lds, (const bf16_t*)WSP(WS_R3), (const bf16_t*)WSP(WS_WO3) + (size_t)l * D * D, D, D, D, 64, 4, E, nullptr, 0, 0, cx); }
        { Ctx cx; cx.bid = 0; cx.nb = nb; cx.wv = wv; OPQ_S(cx.wv); xcd_barrier(bar, cx); }
        { KPtr q = kp(); char* ws = q->ws; Ctx cx; cx.bid = blockIdx.x; cx.nb = nb; cx.wv = wv; OPQ_S(cx.bid); OPQ_S(cx.wv); const float* modl = (const float*)WSP(WS_MOD) + (size_t)l * 9 * 6144;
          NormArgs a; a.XS = (bf16_t*)WSP(WS_XS); a.lf32 = 0; a.cf32 = (l == 0); a.Xl = (const void*)WSP(WS_XS); a.Xc = l ? (const void*)WSP(WS_XS) : (const void*)(IN_(2) - (size_t)TL * D); a.H = (bf16_t*)WSP(WS_H); a.g = IN_(7) + l * D; a.mod_shift = modl + 3 * 1024; a.mod_scale = modl + 4 * 1024; a.nrows = nrows;
          a.Y = nullptr; a.POS = nullptr; a.TOPKp = nullptr; a.mod_g5prev = nullptr; a.router = IN_(19) + (size_t)j * D * 8; a.TOPK = (float*)WSP(WS_TOPK); a.cnt = (unsigned*)WSP(WS_CTL) + CW_CNT + j * 64;
          a.npart = 6; a.PART = last ? nullptr : (const float*)WSP(WS_PART); a.mod_gpart = modl + 2 * 1024;
          if (moe) ph_norm<true>(a, false, lds, cx); else ph_norm<false>(a, false, lds, cx); }
        if (moe && j == 0) {
            int rot = 0;
#pragma unroll 1
            for (int e = 0; e < NEXP; ++e) { KPtr q = kp(); char* ws = q->ws; Ctx cx; cx.bid = blockIdx.x; cx.nb = nb; cx.wv = wv; OPQ_S(cx.bid); OPQ_S(cx.wv); const size_t eo = ((size_t)j * NEXP + e) * D * DFF;
                ph_convert(mkjob(IN_(20) + eo, IN_(21) + eo, (bf16_t*)WSP(WS_WUPM) + (size_t)e * NUP * D, DFF, D, 0, D, NUP, 2), lds, cx, rot);
            }
        }
        { Ctx cx; cx.bid = 0; cx.nb = nb; cx.wv = wv; OPQ_S(cx.wv); xcd_barrier(bar, cx); }
        if (!moe) {
            { KPtr q = kp(); char* ws = q->ws; Ctx cx; cx.bid = blockIdx.x; cx.nb = nb; cx.wv = wv; OPQ_S(cx.bid); OPQ_S(cx.wv);
              pg8::EpiSwiglu E{(bf16_t*)WSP(WS_PH)}; ph_gemm<0>(lds, (const bf16_t*)WSP(WS_H), (const bf16_t*)WSP(WS_WUPD) + (size_t)j * NUP * D, D, D, D, nMr, NUP / 256, E, nullptr, 0, 0, cx); }
            { Ctx cx; cx.bid = 0; cx.nb = nb; cx.wv = wv; OPQ_S(cx.wv); xcd_barrier(bar, cx); }
            { KPtr q = kp(); char* ws = q->ws; Ctx cx; cx.bid = blockIdx.x; cx.nb = nb; cx.wv = wv; OPQ_S(cx.bid); OPQ_S(cx.wv);
              pg8::EpiResid E{(bf16_t*)WSP(WS_XS), (const float*)WSP(WS_MOD) + (size_t)l * 9 * 6144 + 5 * 1024, (float*)WSP(WS_PART), (const void*)WSP(WS_XS), lds + LDS_CSH, 0, 0}; ph_gemm<3, pg8::EpiResid, 1>(lds, (const bf16_t*)WSP(WS_PH), (const bf16_t*)WSP(WS_WDND) + (size_t)j * D * DFF, DFF, DFF, DFF, nMr, 4, E, nullptr, last ? 0 : 224, 0, cx); }
            { Ctx cx; cx.bid = 0; cx.nb = nb; cx.wv = wv; OPQ_S(cx.wv); xcd_barrier(bar, cx); }
        } else {
            { KPtr q = kp(); char* ws = q->ws; Ctx cx; cx.bid = blockIdx.x; cx.nb = nb; cx.wv = wv; OPQ_S(cx.bid); OPQ_S(cx.wv);
              ph_route((const float*)WSP(WS_TOPK), (const bf16_t*)WSP(WS_H), (bf16_t*)WSP(WS_R3), (int*)WSP(WS_POS), (unsigned*)WSP(WS_CTL), j, nrows, lds, cx); }
            { Ctx cx; cx.bid = 0; cx.nb = nb; cx.wv = wv; OPQ_S(cx.wv); xcd_barrier(bar, cx); }
            { KPtr q = kp(); char* ws = q->ws; Ctx cx; cx.bid = blockIdx.x; cx.nb = nb; cx.wv = wv; OPQ_S(cx.bid); OPQ_S(cx.wv);
              pg8::EpiSwiglu E{(bf16_t*)WSP(WS_PH)}; ph_gemm<2>(lds, (const bf16_t*)WSP(WS_R3), (const bf16_t*)WSP(WS_WUPM), D, D, D, 0, NUP / 256, E, (unsigned*)WSP(WS_CTL), j, (size_t)NUP * D, cx);
              { Ctx c2 = cx; if (idle_ctx((unsigned*)WSP(WS_CTL), j, NUP / 256, c2)) { int rot = 0;
#pragma unroll 1
                  for (int e = 0; e < NEXP; ++e) { const size_t eo = ((size_t)j * NEXP + e) * D * DFF; ph_convert(mkjob(IN_(22) + eo, nullptr, (bf16_t*)WSP(WS_WDNM) + (size_t)e * D * DFF, D, DFF, 0, DFF, D, 0), lds, c2, rot); } } } }
            { Ctx cx; cx.bid = 0; cx.nb = nb; cx.wv = wv; OPQ_S(cx.wv); xcd_barrier(bar, cx); }
            { KPtr q = kp(); char* ws = q->ws; Ctx cx; cx.bid = blockIdx.x; cx.nb = nb; cx.wv = wv; OPQ_S(cx.bid); OPQ_S(cx.wv);
              pg8::EpiBf16 E{(bf16_t*)WSP(WS_YB), lds + LDS_CSH, D, 0}; ph_gemm<2, pg8::EpiBf16, 1>(lds, (const bf16_t*)WSP(WS_PH), (const bf16_t*)WSP(WS_WDNM), DFF, DFF, DFF, 0, 4, E, (unsigned*)WSP(WS_CTL), j, (size_t)D * DFF, cx);
              if (j == 0) { Ctx c2 = cx; if (idle_ctx((unsigned*)WSP(WS_CTL), j, 4, c2)) { int rot = 0;
#pragma unroll 1
                  for (int e = 0; e < NEXP; ++e) { const size_t eo = ((size_t)NEXP + e) * D * DFF; ph_convert(mkjob(IN_(20) + eo, IN_(21) + eo, (bf16_t*)WSP(WS_WUPM) + (size_t)e * NUP * D, DFF, D, 0, D, NUP, 2), lds, c2, rot); } } } }
            { Ctx cx; cx.bid = 0; cx.nb = nb; cx.wv = wv; OPQ_S(cx.wv); xcd_barrier(bar, cx); }
        }
    }
    { KPtr q = kp(); char* ws = q->ws; Ctx cx; cx.bid = blockIdx.x; cx.nb = nb; cx.wv = wv; OPQ_S(cx.bid); OPQ_S(cx.wv);
      ph_final((const bf16_t*)WSP(WS_XS), (const bf16_t*)WSP(WS_YB), (const int*)WSP(WS_POS), (const float*)WSP(WS_TOPK), (const float*)WSP(WS_MOD) + (size_t)3 * 9 * 6144 + 5 * 1024, IN_(23), q->out, cx); }
}

extern "C" void kernel_launch(void* const* d_in, const int* in_sizes, int n_in, void* d_out, int out_size, void* d_ws, size_t ws_size, hipStream_t stream) {
    (void)in_sizes; (void)out_size;
    if (n_in != 24 || ws_size < WS_END) return;
    static int grid = 0;
    if (!grid) {
        int dev = 0, cus = 0, per_cu = 0;
        if (hipGetDevice(&dev) != hipSuccess || hipDeviceGetAttribute(&cus, hipDeviceAttributeMultiprocessorCount, dev) != hipSuccess) return;
        if (hipFuncSetAttribute((const void*)mk_fwd, hipFuncAttributeMaxDynamicSharedMemorySize, LDS_BYTES) != hipSuccess) return;
        if (hipOccupancyMaxActiveBlocksPerMultiprocessor(&per_cu, mk_fwd, 512, LDS_BYTES) != hipSuccess || per_cu < 1) return;
        if (cus != 256) return;
        grid = cus;
    }
    (void)hipMemsetAsync((char*)d_ws + WS_CTL, 0, CTL_BYTES, stream);
    MKP p;
    for (int i = 0; i < 24; ++i) p.in[i] = (const float*)d_in[i];
    p.out = (float*)d_out; p.ws = (char*)d_ws;
    hipLaunchKernelGGL(mk_fwd, dim3(grid), dim3(512), LDS_BYTES, stream, p);
}
```

```cpp
#include <hip/hip_runtime.h>
#include <stdint.h>
#include <stddef.h>

#define LAS __attribute__((address_space(3)))
typedef unsigned short bf16_t;
typedef short bf16x8 __attribute__((ext_vector_type(8)));
typedef float f32x4 __attribute__((ext_vector_type(4)));
typedef float f32x2 __attribute__((ext_vector_type(2)));
typedef unsigned u32x4 __attribute__((ext_vector_type(4)));
typedef unsigned u32x2 __attribute__((ext_vector_type(2)));

constexpr int D = 1024, NBATCH = 8, SEQ = 2048, CTXL = 256, DEPTH = 4;
constexpr int TL = NBATCH * SEQ, TC = NBATCH * CTXL, T = TL + TC;
constexpr int DIN = 6944, NP = 7168;
constexpr int DFF = 3584, NUP = 2 * DFF;
constexpr int NEXP = 8;
constexpr int MAXR = 2 * T + NEXP * 256;
constexpr int P_CB = 0, P_CC = 512, P_CU = 1024, P_QA = 1536, P_KA = 2048, P_VA = 2176, P_QG = 2304, P_KG = 2560, P_VG = 2816, P_RG = 3328, P_GATE = 3840, P_AG = 6912;
constexpr float EPS = 1e-6f;
constexpr float LOG2E = 1.4426950408889634f, QSCALE = 0.125f * LOG2E;

constexpr size_t al256(size_t x) { return (x + 255) & ~(size_t)255; }
constexpr size_t WS_CTL = 0;                                   constexpr size_t CTL_BYTES = 65536;
constexpr size_t WS_MOD = WS_CTL + CTL_BYTES;                  constexpr size_t MOD_BYTES = (size_t)DEPTH * 9 * 6 * D * 4;
constexpr size_t WS_CS = al256(WS_MOD + MOD_BYTES);            constexpr size_t CS_BYTES = 64 * 16 * 8;
constexpr size_t WS_XS = al256(WS_CS + CS_BYTES);              constexpr size_t XS_BYTES = (size_t)T * D * 4;
constexpr size_t WS_H = al256(WS_XS + XS_BYTES);               constexpr size_t H_BYTES = (size_t)T * D * 2;
constexpr size_t WS_PH = al256(WS_H + H_BYTES);                constexpr size_t PH_BYTES = (size_t)MAXR * DFF * 2;
constexpr size_t WS_BR = al256(WS_PH + PH_BYTES);              constexpr size_t BR_BYTES = (size_t)T * 1536 * 2;
constexpr size_t WS_R3 = al256(WS_BR + BR_BYTES);              constexpr size_t R3_BYTES = (size_t)T * 3072 * 2;
constexpr size_t WS_YB = al256(WS_R3 + R3_BYTES);              constexpr size_t YB_BYTES = (size_t)MAXR * D * 2;
constexpr size_t WS_QR = al256(WS_YB + YB_BYTES);              constexpr size_t QR_BYTES = (size_t)T * 512 * 2;
constexpr size_t WS_KV = al256(WS_QR + QR_BYTES);              constexpr size_t KV_BYTES = (size_t)T * 256 * 2;
constexpr size_t WS_TOPK = al256(WS_KV + KV_BYTES);            constexpr size_t TOPK_BYTES = (size_t)T * 16;
constexpr size_t WS_POS = al256(WS_TOPK + TOPK_BYTES);         constexpr size_t POS_BYTES = (size_t)T * 8;
constexpr size_t WS_IDX = al256(WS_POS + POS_BYTES);           constexpr size_t IDX_BYTES = (size_t)MAXR * 4;
constexpr size_t WS_DEC = al256(WS_IDX + IDX_BYTES);           constexpr size_t DEC_BYTES = (size_t)(T / 64) * 4 * 2 * 64 * 4;
constexpr size_t WS_PART = al256(WS_DEC + DEC_BYTES);         constexpr size_t PART_BYTES = (size_t)7 * TC * D * 4;
constexpr size_t WS_WIN = al256(WS_PART + PART_BYTES);           constexpr size_t WIN_BYTES = (size_t)DEPTH * NP * D * 2;
constexpr size_t WS_WBR = al256(WS_WIN + WIN_BYTES);           constexpr size_t WBR_BYTES = (size_t)DEPTH * D * 1536 * 2;
constexpr size_t WS_WO3 = al256(WS_WBR + WBR_BYTES);           constexpr size_t WO3_BYTES = (size_t)DEPTH * D * D * 2;
constexpr size_t WS_WUPD = al256(WS_WO3 + WO3_BYTES);          constexpr size_t WUPD_BYTES = (size_t)2 * NUP * D * 2;
constexpr size_t WS_WDND = al256(WS_WUPD + WUPD_BYTES);        constexpr size_t WDND_BYTES = (size_t)2 * D * DFF * 2;
constexpr size_t WS_WUPM = al256(WS_WDND + WDND_BYTES);        constexpr size_t WUPM_BYTES = (size_t)NEXP * NUP * D * 2;
constexpr size_t WS_WDNM = al256(WS_WUPM + WUPM_BYTES);        constexpr size_t WDNM_BYTES = (size_t)NEXP * D * DFF * 2;
constexpr size_t WS_END = al256(WS_WDNM + WDNM_BYTES);
constexpr int CW_CNT = 0;
constexpr int CW_FILL = 128;
constexpr int CW_TEXP = 1024;
constexpr int CW_NT = 1536;

typedef __bf16 bf16x2_t __attribute__((ext_vector_type(2)));
__device__ __forceinline__ unsigned cvt_pk_bf16(float lo, float hi) { const f32x2 v = {lo, hi}; return __builtin_bit_cast(unsigned, __builtin_convertvector(v, bf16x2_t)); }
__device__ __forceinline__ float bf_lo(unsigned w) { return __uint_as_float(w << 16); }
__device__ __forceinline__ float bf_hi(unsigned w) { return __uint_as_float(w & 0xffff0000u); }
__device__ __forceinline__ float bf2f(bf16_t b) { return __uint_as_float(((unsigned)b) << 16); }
__device__ __forceinline__ bf16_t f2bf(float f) { return (bf16_t)(cvt_pk_bf16(f, 0.f) & 0xffffu); }
__device__ __forceinline__ float sigmoidf_(float x) { return __builtin_amdgcn_rcpf(1.0f + __builtin_amdgcn_exp2f(x * -1.4426950408889634f)); }
__device__ __forceinline__ float siluf_(float x) { return x * __builtin_amdgcn_rcpf(1.0f + __builtin_amdgcn_exp2f(x * -1.4426950408889634f)); }
__device__ __forceinline__ float shx(float v, int mask, int lane) { return __int_as_float(__builtin_amdgcn_ds_bpermute((lane ^ mask) << 2, __float_as_int(v))); }
__device__ __forceinline__ float shl_(float v, int src) { return __int_as_float(__builtin_amdgcn_ds_bpermute(src << 2, __float_as_int(v))); }
__device__ __forceinline__ float wave_total(float v) {
    v += __int_as_float(__builtin_amdgcn_update_dpp(0, __float_as_int(v), 0x111, 0xF, 0xF, true));
    v += __int_as_float(__builtin_amdgcn_update_dpp(0, __float_as_int(v), 0x112, 0xF, 0xF, true));
    v += __int_as_float(__builtin_amdgcn_update_dpp(0, __float_as_int(v), 0x114, 0xF, 0xF, true));
    v += __int_as_float(__builtin_amdgcn_update_dpp(0, __float_as_int(v), 0x118, 0xF, 0xF, true));
    v += __int_as_float(__builtin_amdgcn_update_dpp(0, __float_as_int(v), 0x142, 0xA, 0xF, false));
    v += __int_as_float(__builtin_amdgcn_update_dpp(0, __float_as_int(v), 0x143, 0xC, 0xF, false));
    return __int_as_float(__builtin_amdgcn_readlane(__float_as_int(v), 63));
}
__device__ __forceinline__ float wave_sum(float v, int lane) {
#pragma unroll
    for (int o = 32; o >= 1; o >>= 1) v += shx(v, o, lane);
    return v;
}
__device__ __forceinline__ float wave_max(float v, int lane) {
#pragma unroll
    for (int o = 32; o >= 1; o >>= 1) v = fmaxf(v, shx(v, o, lane));
    return v;
}
__device__ __forceinline__ unsigned lds_add(LAS unsigned* p, unsigned v) { return __hip_atomic_fetch_add(p, v, __ATOMIC_RELAXED, __HIP_MEMORY_SCOPE_WORKGROUP); }
__device__ __forceinline__ f32x4 ldx_raw(const void* base, bool f32src, size_t idx) { if (f32src) return *(const f32x4*)((const float*)base + idx); const u32x2 w = *(const u32x2*)((const bf16_t*)base + idx); return (f32x4){__uint_as_float(w.x), __uint_as_float(w.y), 0.f, 0.f}; }
__device__ __forceinline__ f32x4 cvx(const f32x4 raw, bool f32src) { if (f32src) return raw; const unsigned a = __float_as_uint(raw[0]), b = __float_as_uint(raw[1]); return (f32x4){__uint_as_float(a << 16), __uint_as_float(a & 0xffff0000u), __uint_as_float(b << 16), __uint_as_float(b & 0xffff0000u)}; }
__device__ __forceinline__ void stx(bf16_t* p, const f32x4 v) { u32x2 w; w.x = cvt_pk_bf16(v[0], v[1]); w.y = cvt_pk_bf16(v[2], v[3]); *(u32x2*)p = w; }
__device__ __forceinline__ int mod_row(int row) { return row < TL ? (row >> 11) : 8; }
struct Ctx { int bid, nb, wv; };
__device__ __forceinline__ int tidx(const Ctx& cx) { int z = cx.wv << 6; asm volatile("" : "+s"(z)); return (int)__builtin_amdgcn_mbcnt_hi(~0u, __builtin_amdgcn_mbcnt_lo(~0u, (unsigned)z)); }
#define OPQ_S(x) asm volatile("" : "+s"(x))
__device__ __forceinline__ float vmax2(float a, float b) { return __builtin_elementwise_maximum(a, b); }
__device__ __forceinline__ float row4_max(float v) { auto a = __builtin_amdgcn_permlane16_swap(__float_as_uint(v), __float_as_uint(v), false, false); v = vmax2(__uint_as_float(a[0]), __uint_as_float(a[1]));
    auto b = __builtin_amdgcn_permlane32_swap(__float_as_uint(v), __float_as_uint(v), false, false); return vmax2(__uint_as_float(b[0]), __uint_as_float(b[1])); }
__device__ __forceinline__ float row4_sum(float v) { auto a = __builtin_amdgcn_permlane16_swap(__float_as_uint(v), __float_as_uint(v), false, false); v = __uint_as_float(a[0]) + __uint_as_float(a[1]);
    auto b = __builtin_amdgcn_permlane32_swap(__float_as_uint(v), __float_as_uint(v), false, false); return __uint_as_float(b[0]) + __uint_as_float(b[1]); }

__device__ __forceinline__ u32x4 pack8(const float* v) { u32x4 w; w.x = cvt_pk_bf16(v[0], v[1]); w.y = cvt_pk_bf16(v[2], v[3]); w.z = cvt_pk_bf16(v[4], v[5]); w.w = cvt_pk_bf16(v[6], v[7]); return w; }
__device__ __forceinline__ void unpack8(const u32x4 w, float* v) { v[0] = bf_lo(w.x); v[1] = bf_hi(w.x); v[2] = bf_lo(w.y); v[3] = bf_hi(w.y); v[4] = bf_lo(w.z); v[5] = bf_hi(w.z); v[6] = bf_lo(w.w); v[7] = bf_hi(w.w); }
namespace pg8 {
constexpr int BM = 256, BK = 64, HALF = 128, HTB = HALF * BK * 2, STAGE_BYTES = 8 * HTB, NXCD = 8, WGM = 8;
constexpr int CSH_STR = 144, CSH_SLICE = 16 * CSH_STR;
__host__ __device__ __forceinline__ int lds_byte(int r, int c) { const int st = (r >> 4) * 2 + (c >> 5), rr = r & 15, cc = c & 31, ob = rr * 64 + cc * 2; return st * 1024 + (ob ^ (((ob >> 9) & 1) << 5)); }
__host__ __device__ __forceinline__ void stage_rc(int b, int& R, int& C) { const int st = b / 1024, sb = b % 1024, swz = sb ^ (((sb >> 9) & 1) << 5); R = (st >> 1) * 16 + swz / 64; C = (st & 1) * 32 + (swz % 64) / 2; }
__host__ __device__ __forceinline__ int perm32(int rho) { const int n = rho >> 4, i = rho & 15; return 8 * (i >> 2) + 4 * n + (i & 3); }
struct Unit { int pm, pn, kofs, kofsB, nt, part; };

__device__ __forceinline__ bool static_next(int i, int G, int c, int nM, int nN, Unit& u) {
    const int nwg = nM * nN; const long L = (long)i * G + c; if (L >= nwg) return false;
    int wgid = (int)L; { const int q = nwg / NXCD, r = nwg % NXCD, xcd = wgid % NXCD, off = wgid / NXCD; wgid = (xcd < r ? xcd * (q + 1) : r * (q + 1) + (xcd - r) * q) + off; }
    const int nig = WGM * nN, gid = wgid / nig, fm = gid * WGM, gsz = (nM - fm) < WGM ? (nM - fm) : WGM;
    u.pm = fm + ((wgid % nig) % gsz); u.pn = (wgid % nig) / gsz; return true;
}

template <int MODE> struct Prob {
    const bf16_t* A; const bf16_t* Bt; int lda, ldb, K, nM, nN, G, c; const LAS int* texp; size_t bexp; int nctx;
    __device__ __forceinline__ bool next(int i, Unit& u) const {
        u.kofs = 0; u.kofsB = 0; u.nt = K / BK; u.part = -1;
        if (MODE == 3) {
            const int idx = i + (c < nctx ? 0 : 1);
            if (idx == 0) { const int ct = c / 7; u.pm = 64 + (ct >> 2); u.pn = ct & 3; u.part = c - ct * 7; u.nt = K / (7 * BK); u.kofs = u.part * (K / 7); u.kofsB = u.kofs; return true; }
            return static_next(idx - 1, G, c, 64, 4, u);
        }
        if (MODE == 4) { const int seg = i % 3; u.kofs = seg * 512; u.kofsB = u.kofs; u.nt = 8; u.part = seg; return static_next(i / 3, G, c, 64, 4, u); }
        if (MODE == 5) { const int L = i * G + c; if (L >= 192) return false; const int ct = L / 6, sub = L - ct * 6; u.pm = 64 + (ct >> 2); u.pn = ct & 3; u.part = sub; u.nt = 8; u.kofs = (sub >> 1) * 1024 + (sub & 1) * 512; u.kofsB = (sub & 1) * 512; return true; }
        const bool ok = static_next(i, G, c, nM, nN, u);
        if (MODE == 1) { u.kofs = (u.pn >> 2) * 512; u.kofsB = u.kofs; }
        return ok;
    }
    __device__ __forceinline__ const char* a_base(const Unit& u, bool ablk) const { return (const char*)(A + (size_t)u.pm * BM * lda + (ablk ? 2 * u.kofs : u.kofs)); }
    __device__ __forceinline__ const char* b_base(const Unit& u) const { const bf16_t* p = Bt + (size_t)(MODE == 1 ? (u.pn & 3) : u.pn) * BM * ldb + 2 * u.kofsB; if (MODE == 2) p += (size_t)texp[u.pm] * bexp; return (const char*)p; }
};

template <class Epi, class PB, int ABLK>
__device__ __forceinline__ void gemm_phase(LAS unsigned char* lds, const PB& P, const Epi& E, const Ctx cx) {
    const int tid = tidx(cx), wid = __builtin_amdgcn_readfirstlane(tid >> 6), lane = tid & 63, wr = wid >> 2, wc = wid & 3, fr = lane & 15, fq = lane >> 4;
    unsigned voffA[2], voffB[2];
#pragma unroll
    for (int i = 0; i < 2; ++i) { int R, C; stage_rc(tid * 16 + i * 8192, R, C); const int Rb = (int)Epi::PERM == 2 ? (2 * (R & ~31) + perm32(R & 31)) : Epi::PERM ? ((R & ~31) + perm32(R & 31)) : R;
        voffA[i] = ABLK ? (unsigned)((((R >> 1) * (P.lda >> 5) + (C >> 5)) * 64 + (R & 1) * 32 + (C & 31)) * 2) : (unsigned)(R * P.lda + C) * 2u;     voffB[i] = (unsigned)((((Rb >> 1) * (P.ldb >> 5) + (C >> 5)) * 64 + (Rb & 1) * 32 + (C & 31)) * 2);     }
    const size_t kstep = (size_t)(BK * 4), kstepA = ABLK ? (size_t)(BK * 4) : (size_t)(BK * 2);
    const size_t hstepA = (size_t)HALF * P.lda * 2, hstepB = (size_t)((int)Epi::PERM == 2 ? 32 : HALF) * P.ldb * 2;
    const unsigned ldsw = (unsigned)wid * 1024u;
    const int aoff = lds_byte(wr * 64 + fr, fq * 8), boff = lds_byte(wc * 32 + fr, fq * 8);
#define PG8_SA(b, h) (((b) * 2 + (h)) * HTB)
#define PG8_SB(b, h) ((4 + (b) * 2 + (h)) * HTB)
#define PG8_STAGE(bufoff, gbase, voff) do { _Pragma("unroll") for (int _i = 0; _i < 2; ++_i) \
        __builtin_amdgcn_global_load_lds((const unsigned*)((const char*)(gbase) + (voff)[_i]), (LAS unsigned*)(lds + (bufoff) + ldsw + _i * 8192), 16, 0, 0); } while (0)
#define PG8_LDA(dst, b, h) do { _Pragma("unroll") for (int m = 0; m < 4; ++m) _Pragma("unroll") for (int k = 0; k < 2; ++k) dst[m][k] = *(const LAS bf16x8*)(lds + PG8_SA(b, h) + aoff + m * 2048 + k * 1024); } while (0)
#define PG8_LDB(dst, b, h) do { _Pragma("unroll") for (int n = 0; n < 2; ++n) _Pragma("unroll") for (int k = 0; k < 2; ++k) dst[n][k] = *(const LAS bf16x8*)(lds + PG8_SB(b, h) + boff + n * 2048 + k * 1024); } while (0)
#define PG8_MMA(ai, bj, At, Bt) do { __builtin_amdgcn_s_setprio(1); _Pragma("unroll") for (int m = 0; m < 4; ++m) _Pragma("unroll") for (int n = 0; n < 2; ++n) _Pragma("unroll") for (int k = 0; k < 2; ++k) \
        acc[ai][bj][m][n] = __builtin_amdgcn_mfma_f32_16x16x32_bf16(Bt[n][k], At[m][k], acc[ai][bj][m][n], 0, 0, 0); __builtin_amdgcn_s_setprio(0); } while (0)
#define PG8_WAIT_V(n) asm volatile("s_waitcnt vmcnt(" #n ")" ::: "memory")
#define PG8_WAIT_L(n) asm volatile("s_waitcnt lgkmcnt(" #n ")" ::: "memory")
#define PG8_BAR __builtin_amdgcn_s_barrier()
#define PG8_SCHED __builtin_amdgcn_sched_barrier(0)
    Unit cur, nxt; int ui = 0;
    if (!P.next(0, cur)) return;
    f32x4 acc[2][2][4][2];
#pragma unroll
    for (int a = 0; a < 2; ++a)
#pragma unroll
        for (int b = 0; b < 2; ++b)
#pragma unroll
            for (int m = 0; m < 4; ++m)
#pragma unroll
                for (int n = 0; n < 2; ++n) acc[a][b][m][n] = (f32x4){0.f, 0.f, 0.f, 0.f};
    bf16x8 At[4][2], B0[2][2], B1[2][2];
    const char* cA = P.a_base(cur, ABLK != 0); const char* cB = P.b_base(cur);
    PG8_STAGE(PG8_SB(0, 0), cB, voffB); PG8_STAGE(PG8_SB(0, 1), cB + hstepB, voffB); PG8_STAGE(PG8_SA(0, 0), cA, voffA); PG8_STAGE(PG8_SA(0, 1), cA + hstepA, voffA);
    if (wr == 1) PG8_BAR;
    PG8_WAIT_V(2); PG8_BAR;
    PG8_STAGE(PG8_SB(1, 0), cB + kstep, voffB); PG8_STAGE(PG8_SA(1, 0), cA + kstepA, voffA); PG8_STAGE(PG8_SB(1, 1), cB + hstepB + kstep, voffB);
    PG8_WAIT_V(6); PG8_BAR;
    for (;;) {
        const bool has_next = P.next(ui + 1, nxt);
        const char* nA = has_next ? P.a_base(nxt, ABLK != 0) : cA; const char* nB = has_next ? P.b_base(nxt) : cB;
        const int nt = cur.nt;
        for (int t = 0; t < nt; t += 2) {
            const bool last = (t == nt - 2);
            const char* a1 = cA + (size_t)(t + 1) * kstepA;
            const char* a2 = last ? nA : cA + (size_t)(t + 2) * kstepA; const char* b2 = last ? nB : cB + (size_t)(t + 2) * kstep;
            const char* a3 = a2 + kstepA; const char* b3 = b2 + kstep;
            PG8_LDB(B0, 0, 0); PG8_LDB(B1, 0, 1); PG8_SCHED; PG8_LDA(At, 0, 0); PG8_STAGE(PG8_SA(1, 1), a1 + hstepA, voffA);
            PG8_WAIT_V(8); PG8_WAIT_L(0); PG8_BAR; PG8_MMA(0, 0, At, B0); PG8_MMA(0, 1, At, B1); PG8_BAR; PG8_SCHED;
            PG8_LDA(At, 0, 1); PG8_STAGE(PG8_SB(0, 0), b2, voffB); PG8_STAGE(PG8_SB(0, 1), b2 + hstepB, voffB); PG8_STAGE(PG8_SA(0, 0), a2, voffA);
            PG8_WAIT_V(8); PG8_WAIT_L(0); PG8_BAR; PG8_MMA(1, 0, At, B0); PG8_MMA(1, 1, At, B1); PG8_BAR; PG8_SCHED;
            PG8_LDB(B0, 1, 0); PG8_LDB(B1, 1, 1); PG8_SCHED; PG8_LDA(At, 1, 0); PG8_STAGE(PG8_SA(0, 1), a2 + hstepA, voffA);
            PG8_WAIT_V(8); PG8_WAIT_L(0); PG8_BAR; PG8_MMA(0, 0, At, B0); PG8_MMA(0, 1, At, B1); PG8_BAR; PG8_SCHED;
            PG8_LDA(At, 1, 1); PG8_STAGE(PG8_SB(1, 0), b3, voffB); PG8_STAGE(PG8_SB(1, 1), b3 + hstepB, voffB); PG8_STAGE(PG8_SA(1, 0), a3, voffA);
            PG8_WAIT_V(8); PG8_WAIT_L(0); PG8_BAR; PG8_MMA(1, 0, At, B0); PG8_MMA(1, 1, At, B1); PG8_BAR; PG8_SCHED;
        }
        if (wr == 0) PG8_BAR;
        E(acc, cur, wr, wc, fr, fq);
        if (!has_next) break;
#pragma unroll
        for (int a = 0; a < 2; ++a)
#pragma unroll
            for (int b = 0; b < 2; ++b)
#pragma unroll
                for (int m = 0; m < 4; ++m)
#pragma unroll
                    for (int n = 0; n < 2; ++n) acc[a][b][m][n] = (f32x4){0.f, 0.f, 0.f, 0.f};
        cur = nxt; cA = nA; cB = nB; ++ui;
        if (wr == 1) PG8_BAR;
    }
    PG8_WAIT_V(0);
    PG8_BAR;
#undef PG8_SA
#undef PG8_SB
#undef PG8_STAGE
#undef PG8_LDA
#undef PG8_LDB
#undef PG8_MMA
#undef PG8_WAIT_V
#undef PG8_WAIT_L
#undef PG8_BAR
#undef PG8_SCHED
}

__device__ __forceinline__ void relay16(const f32x4 (&a)[2][2], LAS unsigned char* wp, const LAS unsigned char* rp, u32x4 (&x)[2]) {
#pragma unroll
    for (int bj = 0; bj < 2; ++bj) { u32x4 w; w.x = cvt_pk_bf16(a[bj][0][0], a[bj][0][1]); w.y = cvt_pk_bf16(a[bj][0][2], a[bj][0][3]); w.z = cvt_pk_bf16(a[bj][1][0], a[bj][1][1]); w.w = cvt_pk_bf16(a[bj][1][2], a[bj][1][3]);
        *(LAS u32x4*)(wp + bj * 64) = w; }
    asm volatile("" ::: "memory"); __builtin_amdgcn_wave_barrier();
    x[0] = *(const LAS u32x4*)rp; x[1] = *(const LAS u32x4*)(rp + 8 * CSH_STR);
    asm volatile("" ::: "memory"); __builtin_amdgcn_wave_barrier();
}
__device__ __forceinline__ u32x4 gate8x(const u32x4& x, const u32x4& g, const u32x4& o) {
    float xv[8], gv[8], ov[8]; unpack8(x, xv); unpack8(g, gv); unpack8(o, ov);
#pragma unroll
    for (int e = 0; e < 8; ++e) ov[e] += xv[e] * sigmoidf_(gv[e]);
    return pack8(ov);
}
struct EpiBf16 {
    static constexpr int PERM = 2;
    bf16_t* O; LAS unsigned char* sh; int ldc; int pad_;
    __device__ __forceinline__ void operator()(const f32x4 (&acc)[2][2][4][2], const Unit& u, int wr, int wc, int fr, int fq) const {
        LAS unsigned char* my = sh + (wr * 4 + wc) * CSH_SLICE; const int lane = fq * 16 + fr, r8 = lane >> 3, c8 = lane & 7;
        LAS unsigned char* wp = my + fr * CSH_STR + fq * 16; const LAS unsigned char* rp = my + r8 * CSH_STR + c8 * 16;
        bf16_t* ob = O + (size_t)(u.pm * BM + wr * 64 + r8) * ldc + u.pn * BM + wc * 64 + 8 * c8;
#pragma unroll
        for (int ai = 0; ai < 2; ++ai)
#pragma unroll
            for (int m = 0; m < 4; ++m) { u32x4 x[2];
                const f32x4 a[2][2] = {{acc[ai][0][m][0], acc[ai][0][m][1]}, {acc[ai][1][m][0], acc[ai][1][m][1]}};
                relay16(a, wp, rp, x);
                bf16_t* rowp = ob + (size_t)(ai * HALF + m * 16) * ldc;
                *(u32x4*)rowp = x[0]; *(u32x4*)(rowp + (size_t)8 * ldc) = x[1]; }
    }
};
struct EpiWin {
    static constexpr int PERM = 2;
    bf16_t* O; bf16_t* QR; bf16_t* KV; const f32x2* CS; LAS unsigned char* sh;
    __device__ __forceinline__ void operator()(const f32x4 (&acc)[2][2][4][2], const Unit& u, int wr, int wc, int fr, int fq) const {
        const int row0 = u.pm * BM + wr * 64 + fr;
        if (u.pn < 6 || u.pn > 8) {
            LAS unsigned char* my = sh + (wr * 4 + wc) * CSH_SLICE; const int lane = fq * 16 + fr, r8 = lane >> 3, c8 = lane & 7;
            LAS unsigned char* wp = my + fr * CSH_STR + fq * 16; const LAS unsigned char* rp = my + r8 * CSH_STR + c8 * 16;
            bf16_t* ob = O + (size_t)(u.pm * BM + wr * 64 + r8) * NP + u.pn * BM + wc * 64 + 8 * c8;
#pragma unroll
            for (int ai = 0; ai < 2; ++ai)
#pragma unroll
                for (int m = 0; m < 4; ++m) {
#pragma unroll
                    for (int bj = 0; bj < 2; ++bj) { const f32x4 v0 = acc[ai][bj][m][0], v1 = acc[ai][bj][m][1];
                        u32x4 w; w.x = cvt_pk_bf16(v0[0], v0[1]); w.y = cvt_pk_bf16(v0[2], v0[3]); w.z = cvt_pk_bf16(v1[0], v1[1]); w.w = cvt_pk_bf16(v1[2], v1[3]);
                        *(LAS u32x4*)(wp + bj * 64) = w; }
                    asm volatile("" ::: "memory"); __builtin_amdgcn_wave_barrier();
                    const u32x4 x0 = *(const LAS u32x4*)rp, x1 = *(const LAS u32x4*)(rp + 8 * CSH_STR);
                    asm volatile("" ::: "memory"); __builtin_amdgcn_wave_barrier();
                    bf16_t* rowp = ob + (size_t)(ai * HALF + m * 16) * NP;
                    *(u32x4*)rowp = x0; *(u32x4*)(rowp + (size_t)8 * NP) = x1; }
            return;
        }
        const bool lat = u.pm < 64; const bool isq = u.pn < 8; const bool rot = isq || wc < 2;
#pragma unroll
        for (int ai = 0; ai < 2; ++ai)
#pragma unroll
            for (int m = 0; m < 4; ++m) { const int row = row0 + ai * HALF + m * 16; const int sp = row & (SEQ - 1);
#pragma unroll
                for (int bj = 0; bj < 2; ++bj) { const f32x4 v0 = acc[ai][bj][m][0], v1 = acc[ai][bj][m][1]; float o[8];
                    const int ps = bj ? (sp & 63) : (sp >> 6);
                    f32x4 c01 = (f32x4){1.f, 0.f, 1.f, 0.f}, c23 = c01;
                    if (lat && rot) { const f32x4* cp = (const f32x4*)(CS + ps * 16 + 4 * fq); c01 = cp[0]; c23 = cp[1]; }
                    if (rot) {
                        o[0] = v0[0] * c01[0] - v0[1] * c01[1]; o[1] = v0[1] * c01[0] + v0[0] * c01[1]; o[2] = v0[2] * c01[2] - v0[3] * c01[3]; o[3] = v0[3] * c01[2] + v0[2] * c01[3];
                        o[4] = v1[0] * c23[0] - v1[1] * c23[1]; o[5] = v1[1] * c23[0] + v1[0] * c23[1]; o[6] = v1[2] * c23[2] - v1[3] * c23[3]; o[7] = v1[3] * c23[2] + v1[2] * c23[3];
                    } else { o[0] = v0[0]; o[1] = v0[1]; o[2] = v0[2]; o[3] = v0[3]; o[4] = v1[0]; o[5] = v1[1]; o[6] = v1[2]; o[7] = v1[3]; }
                    u32x4 w;
                    if (isq) { w.x = cvt_pk_bf16(o[0] * QSCALE, o[1] * QSCALE); w.y = cvt_pk_bf16(o[2] * QSCALE, o[3] * QSCALE); w.z = cvt_pk_bf16(o[4] * QSCALE, o[5] * QSCALE); w.w = cvt_pk_bf16(o[6] * QSCALE, o[7] * QSCALE);
                        *(u32x4*)(QR + (size_t)row * 512 + (u.pn - 6) * 256 + wc * 64 + bj * 32 + 8 * fq) = w; }
                    else { w.x = cvt_pk_bf16(o[0], o[1]); w.y = cvt_pk_bf16(o[2], o[3]); w.z = cvt_pk_bf16(o[4], o[5]); w.w = cvt_pk_bf16(o[6], o[7]);
                        *(u32x4*)(KV + (size_t)row * 256 + wc * 64 + bj * 32 + 8 * fq) = w; } } }
    }
};
__device__ __forceinline__ u32x4 gate8(const f32x4& v0, const f32x4& v1, const u32x4& g) {
    u32x4 w;
    w.x = cvt_pk_bf16(v0[0] * sigmoidf_(bf_lo(g.x)), v0[1] * sigmoidf_(bf_hi(g.x))); w.y = cvt_pk_bf16(v0[2] * sigmoidf_(bf_lo(g.y)), v0[3] * sigmoidf_(bf_hi(g.y)));
    w.z = cvt_pk_bf16(v1[0] * sigmoidf_(bf_lo(g.z)), v1[1] * sigmoidf_(bf_hi(g.z))); w.w = cvt_pk_bf16(v1[2] * sigmoidf_(bf_lo(g.w)), v1[3] * sigmoidf_(bf_hi(g.w))); return w; }
__device__ __forceinline__ u32x4 gate8acc(const f32x4& v0, const f32x4& v1, const u32x4& g, const u32x4& o) {
    u32x4 w;
    w.x = cvt_pk_bf16(bf_lo(o.x) + v0[0] * sigmoidf_(bf_lo(g.x)), bf_hi(o.x) + v0[1] * sigmoidf_(bf_hi(g.x))); w.y = cvt_pk_bf16(bf_lo(o.y) + v0[2] * sigmoidf_(bf_lo(g.y)), bf_hi(o.y) + v0[3] * sigmoidf_(bf_hi(g.y)));
    w.z = cvt_pk_bf16(bf_lo(o.z) + v1[0] * sigmoidf_(bf_lo(g.z)), bf_hi(o.z) + v1[1] * sigmoidf_(bf_hi(g.z))); w.w = cvt_pk_bf16(bf_lo(o.w) + v1[2] * sigmoidf_(bf_lo(g.w)), bf_hi(o.w) + v1[3] * sigmoidf_(bf_hi(g.w))); return w; }
struct EpiGate {
    static constexpr int PERM = 2;
    bf16_t* O; const bf16_t* Pg; LAS unsigned char* sh;
    __device__ __forceinline__ void operator()(const f32x4 (&acc)[2][2][4][2], const Unit& u, int wr, int wc, int fr, int fq) const {
        LAS unsigned char* my = sh + (wr * 4 + wc) * CSH_SLICE; const int lane = fq * 16 + fr, r8 = lane >> 3, c8 = lane & 7;
        LAS unsigned char* wp = my + fr * CSH_STR + fq * 16; const LAS unsigned char* rp = my + r8 * CSH_STR + c8 * 16;
        const int rowb = u.pm * BM + wr * 64 + r8, colb = u.pn * BM + wc * 64 + 8 * c8;
#pragma unroll
        for (int ai = 0; ai < 2; ++ai)
#pragma unroll
            for (int m = 0; m < 4; ++m) { const size_t row = (size_t)(rowb + ai * HALF + m * 16);
                u32x4 g[2], x[2];
#pragma unroll
                for (int hh = 0; hh < 2; ++hh) g[hh] = *(const u32x4*)(Pg + (row + 8 * hh) * NP + P_GATE + colb);
                const f32x4 a[2][2] = {{acc[ai][0][m][0], acc[ai][0][m][1]}, {acc[ai][1][m][0], acc[ai][1][m][1]}};
                relay16(a, wp, rp, x);
#pragma unroll
                for (int hh = 0; hh < 2; ++hh) *(u32x4*)(O + (row + 8 * hh) * 3072 + colb) = gate8x(x[hh], g[hh], (u32x4){0u, 0u, 0u, 0u}); }
    }
};
struct EpiMerge {
    static constexpr int PERM = 2;
    bf16_t* MG; const bf16_t* Pg; LAS unsigned char* sh;
    __device__ __forceinline__ void operator()(const f32x4 (&acc)[2][2][4][2], const Unit& u, int wr, int wc, int fr, int fq) const {
        LAS unsigned char* my = sh + (wr * 4 + wc) * CSH_SLICE; const int lane = fq * 16 + fr, r8 = lane >> 3, c8 = lane & 7;
        LAS unsigned char* wp = my + fr * CSH_STR + fq * 16; const LAS unsigned char* rp = my + r8 * CSH_STR + c8 * 16;
        const int rowb = u.pm * BM + wr * 64 + r8, colb = u.pn * BM + wc * 64 + 8 * c8; const int gcol = P_GATE + u.part * 1024 + colb;
#pragma unroll
        for (int ai = 0; ai < 2; ++ai)
#pragma unroll
            for (int m = 0; m < 4; ++m) { const size_t row = (size_t)(rowb + ai * HALF + m * 16);
                u32x4 g[2], o[2], x[2];
#pragma unroll
                for (int hh = 0; hh < 2; ++hh) { g[hh] = *(const u32x4*)(Pg + (row + 8 * hh) * NP + gcol); o[hh] = u.part ? *(const u32x4*)(MG + (row + 8 * hh) * D + colb) : (u32x4){0u, 0u, 0u, 0u}; }
                const f32x4 a[2][2] = {{acc[ai][0][m][0], acc[ai][0][m][1]}, {acc[ai][1][m][0], acc[ai][1][m][1]}};
                relay16(a, wp, rp, x);
#pragma unroll
                for (int hh = 0; hh < 2; ++hh) *(u32x4*)(MG + (row + 8 * hh) * D + colb) = gate8x(x[hh], g[hh], o[hh]); }
    }
};
struct EpiResid {
    static constexpr int PERM = 2;
    bf16_t* X; const float* modg; float* PART; const void* Xold; LAS unsigned char* sh; int oldf32; int pad_;
    __device__ __forceinline__ void operator()(const f32x4 (&acc)[2][2][4][2], const Unit& u, int wr, int wc, int fr, int fq) const {
        if (u.part >= 0) {
            LAS unsigned char* my = sh + (wr * 4 + wc) * CSH_SLICE; const int lane = fq * 16 + fr, r8 = lane >> 3, c8 = lane & 7;
            LAS unsigned char* wp = my + fr * CSH_STR + fq * 32; const LAS unsigned char* rp = my + r8 * CSH_STR + c8 * 16;
            float* pb = PART + ((size_t)u.part * TC + (u.pm * BM + wr * 64 + r8 - TL)) * D + u.pn * BM + wc * 64 + 4 * c8;
#pragma unroll
            for (int ai = 0; ai < 2; ++ai)
#pragma unroll
                for (int m = 0; m < 4; ++m) { float* rowp = pb + (size_t)(ai * HALF + m * 16) * D;
#pragma unroll
                    for (int bj = 0; bj < 2; ++bj) {
                        *(LAS f32x4*)wp = acc[ai][bj][m][0]; *(LAS f32x4*)(wp + 16) = acc[ai][bj][m][1];
                        asm volatile("" ::: "memory"); __builtin_amdgcn_wave_barrier();
                        const f32x4 x0 = *(const LAS f32x4*)rp, x1 = *(const LAS f32x4*)(rp + 8 * CSH_STR);
                        asm volatile("" ::: "memory"); __builtin_amdgcn_wave_barrier();
                        *(f32x4*)(rowp + bj * 32) = x0; *(f32x4*)(rowp + (size_t)8 * D + bj * 32) = x1; } }
            return;
        }
        const float* mg = modg + (size_t)mod_row(u.pm * BM) * 6144 + u.pn * BM + wc * 64 + 8 * fq;
        f32x4 gv[2][2];
#pragma unroll
        for (int bj = 0; bj < 2; ++bj)
#pragma unroll
            for (int n = 0; n < 2; ++n) gv[bj][n] = *(const f32x4*)(mg + bj * 32 + n * 4);
        LAS unsigned char* my = sh + (wr * 4 + wc) * CSH_SLICE; const int lane = fq * 16 + fr, r8 = lane >> 3, c8 = lane & 7;
        LAS unsigned char* wp = my + fr * CSH_STR + fq * 16; const LAS unsigned char* rp = my + r8 * CSH_STR + c8 * 16;
        const size_t ro0 = (size_t)(u.pm * BM + wr * 64 + r8) * D + u.pn * BM + wc * 64 + 8 * c8;
#pragma unroll
        for (int ai = 0; ai < 2; ++ai)
#pragma unroll
            for (int m = 0; m < 4; ++m) { const size_t ro = ro0 + (size_t)(ai * HALF + m * 16) * D;
                f32x4 oa[2][2];
#pragma unroll
                for (int hh = 0; hh < 2; ++hh) { const size_t rr = ro + (size_t)hh * 8 * D;
                    if (oldf32) { oa[hh][0] = *(const f32x4*)((const float*)Xold + rr); oa[hh][1] = *(const f32x4*)((const float*)Xold + rr + 4); }
                    else { const u32x4 w = *(const u32x4*)((const bf16_t*)Xold + rr); oa[hh][0] = (f32x4){__uint_as_float(w.x), __uint_as_float(w.y), __uint_as_float(w.z), __uint_as_float(w.w)}; oa[hh][1] = oa[hh][0]; } }
#pragma unroll
                for (int bj = 0; bj < 2; ++bj) { const f32x4 v0 = gv[bj][0] * acc[ai][bj][m][0], v1 = gv[bj][1] * acc[ai][bj][m][1];
                    u32x4 w; w.x = cvt_pk_bf16(v0[0], v0[1]); w.y = cvt_pk_bf16(v0[2], v0[3]); w.z = cvt_pk_bf16(v1[0], v1[1]); w.w = cvt_pk_bf16(v1[2], v1[3]);
                    *(LAS u32x4*)(wp + bj * 64) = w; }
                asm volatile("" ::: "memory"); __builtin_amdgcn_wave_barrier();
                u32x4 dx[2]; dx[0] = *(const LAS u32x4*)rp; dx[1] = *(const LAS u32x4*)(rp + 8 * CSH_STR);
                asm volatile("" ::: "memory"); __builtin_amdgcn_wave_barrier();
#pragma unroll
                for (int hh = 0; hh < 2; ++hh) { float o[8], dl[8]; unpack8(dx[hh], dl);
                    if (oldf32) { o[0] = oa[hh][0][0]; o[1] = oa[hh][0][1]; o[2] = oa[hh][0][2]; o[3] = oa[hh][0][3]; o[4] = oa[hh][1][0]; o[5] = oa[hh][1][1]; o[6] = oa[hh][1][2]; o[7] = oa[hh][1][3]; }
                    else { u32x4 w; w.x = __float_as_uint(oa[hh][0][0]); w.y = __float_as_uint(oa[hh][0][1]); w.z = __float_as_uint(oa[hh][0][2]); w.w = __float_as_uint(oa[hh][0][3]); unpack8(w, o); }
#pragma unroll
                    for (int e = 0; e < 8; ++e) o[e] += dl[e];
                    *(u32x4*)(X + ro + (size_t)hh * 8 * D) = pack8(o); } }
    }
};
struct EpiSwiglu {
    static constexpr bool PERM = true;
    bf16_t* O;
    __device__ __forceinline__ void operator()(const f32x4 (&acc)[2][2][4][2], const Unit& u, int wr, int wc, int fr, int fq) const {
        const int row0 = u.pm * BM + wr * 64 + fr; const int chunk = u.pn * 4 + wc;
#pragma unroll
        for (int ai = 0; ai < 2; ++ai)
#pragma unroll
            for (int m = 0; m < 4; ++m) { const int row = row0 + ai * HALF + m * 16; bf16_t* rowp = O + ((size_t)(row >> 1) * (DFF / 32) + chunk) * 64 + (row & 1) * 32 + 8 * fq;
                const f32x4 a0 = acc[ai][0][m][0], a1 = acc[ai][0][m][1], b0 = acc[ai][1][m][0], b1 = acc[ai][1][m][1];
                u32x4 w; w.x = cvt_pk_bf16(siluf_(a0[0]) * b0[0], siluf_(a0[1]) * b0[1]); w.y = cvt_pk_bf16(siluf_(a0[2]) * b0[2], siluf_(a0[3]) * b0[3]);
                w.z = cvt_pk_bf16(siluf_(a1[0]) * b1[0], siluf_(a1[1]) * b1[1]); w.w = cvt_pk_bf16(siluf_(a1[2]) * b1[2], siluf_(a1[3]) * b1[3]);
                *(u32x4*)rowp = w; }
    }
};
}

#define XB_TMO      128
#define XB_XCNT(j)  (256  + 64 * (j))
#define XB_XSUB(j)  (1280 + 64 * (j))
#define XB_XGEN(j)  (2304 + 64 * (j))
#define XB_TOP      3328
#define XB_TOPGEN   3392
#define XCD_BAR_WORDS 3456
#define XB_SPIN_CAP (1u << 18)
__device__ __forceinline__ unsigned xb_ld(unsigned* p)              { return __hip_atomic_load(p, __ATOMIC_RELAXED, __HIP_MEMORY_SCOPE_AGENT); }
__device__ __forceinline__ unsigned xb_add(unsigned* p, unsigned v) { return __hip_atomic_fetch_add(p, v, __ATOMIC_RELAXED, __HIP_MEMORY_SCOPE_AGENT); }
__device__ __forceinline__ unsigned xb_xcc_id() { return (unsigned)__builtin_amdgcn_s_getreg((3 << 11) | 20) & 0xFu; }
#define XB_SPIN(cond, bar) do { unsigned _sp = 0; while (cond) { __builtin_amdgcn_s_sleep(1); \
    if ((++_sp & 255u) == 0u) { if (xb_ld(&(bar)[XB_TMO])) break; if (_sp > XB_SPIN_CAP) { atomicAdd(&(bar)[XB_TMO], 1u); break; } } } } while (0)
struct XcdBarrier { unsigned* bar; unsigned x; volatile LAS unsigned* st; };
__device__ __forceinline__ XcdBarrier xcd_barrier_post(unsigned* bar, volatile LAS unsigned* st) {
    XcdBarrier b; b.bar = bar; b.x = (unsigned)__builtin_amdgcn_readfirstlane((int)xb_xcc_id()); b.st = st;
    if (threadIdx.x == 0) (void)xb_add(&bar[XB_XCNT(b.x)], 1u);
    return b;
}
__device__ __forceinline__ void xcd_barrier_complete(unsigned* bar, unsigned x, unsigned& nloc, unsigned& nx) {
    const unsigned G = gridDim.x * gridDim.y * gridDim.z;
    unsigned sum, cnt, mine, sp = 0u;
    for (;;) {
        sum = 0u; cnt = 0u; mine = 0u;
#pragma unroll
        for (unsigned j = 0; j < 16; ++j) { const unsigned c = xb_ld(&bar[XB_XCNT(j)]); sum += c; cnt += (c > 0u) ? 1u : 0u; mine = (j == x) ? c : mine; }
        if (sum == G) break;
        __builtin_amdgcn_s_sleep(1);
        if ((++sp & 255u) == 0u) { if (xb_ld(&bar[XB_TMO])) break; if (sp > XB_SPIN_CAP) { atomicAdd(&bar[XB_TMO], 1u); break; } }
    }
    nloc = mine > 0u ? mine : 1u; nx = cnt > 0u ? cnt : 1u;
}
template <bool FIRST> __device__ __forceinline__ void xcd_barrier_t(const XcdBarrier& b, const Ctx cx) {
    asm volatile("s_waitcnt vmcnt(0)" ::: "memory");
    __syncthreads();
    if (tidx(cx) == 0) {
        unsigned* bar = b.bar; unsigned bx = b.x; OPQ_S(bar); OPQ_S(bx);
        __builtin_amdgcn_s_waitcnt(0);
        unsigned nloc = b.st[0], nx = b.st[1];
        if (FIRST) { if (nloc == 0u) { xcd_barrier_complete(bar, bx, nloc, nx); b.st[0] = nloc; b.st[1] = nx; } }
        const unsigned old = xb_add(&bar[XB_XSUB(bx)], 1u);
        const unsigned gen = old / nloc;
        if (old + 1u == (gen + 1u) * nloc) {
            __builtin_amdgcn_fence(__ATOMIC_RELEASE, "agent");
            asm volatile("s_waitcnt vmcnt(0)" ::: "memory");
            const unsigned og = xb_add(&bar[XB_TOP], 1u);
            const unsigned tg = og / nx;
            if (og + 1u == (tg + 1u) * nx) xb_add(&bar[XB_TOPGEN], 1u);
            else XB_SPIN(xb_ld(&bar[XB_TOPGEN]) == tg, bar);
            __builtin_amdgcn_fence(__ATOMIC_ACQUIRE, "agent");
            xb_add(&bar[XB_XGEN(bx)], 1u);
            asm volatile("s_waitcnt vmcnt(0)" ::: "memory");
        } else {
            XB_SPIN(xb_ld(&bar[XB_XGEN(bx)]) == gen, bar);
            __builtin_amdgcn_fence(__ATOMIC_ACQUIRE, "agent");
            asm volatile("s_waitcnt vmcnt(0)" ::: "memory");
        }
    }
    __syncthreads();
}
__device__ __forceinline__ void xcd_barrier_first(const XcdBarrier& b, const Ctx cx) { xcd_barrier_t<true>(b, cx); }
__device__ __forceinline__ void xcd_barrier(const XcdBarrier& b, const Ctx cx) { xcd_barrier_t<false>(b, cx); }

constexpr int LDS_TEXP = 139264, LDS_BARW = LDS_TEXP + 1024, LDS_SBASE = LDS_BARW + 16, LDS_CSH = LDS_SBASE + 64 + 176 + 256, LDS_BYTES = LDS_CSH + 8 * pg8::CSH_SLICE;
constexpr int CW_BAR = 4096;

#define MMA16(acc, afrag, bfrag) acc = __builtin_amdgcn_mfma_f32_16x16x32_bf16(bfrag, afrag, acc, 0, 0, 0)
typedef short s16x4 __attribute__((ext_vector_type(4)));
constexpr int STR64 = 144, STR128 = 272;
__device__ __forceinline__ bf16x8 frag_row(const LAS unsigned char* img, int r, int k0, int stride) { return *(const LAS bf16x8*)(img + r * stride + k0 * 2); }
__device__ __forceinline__ bf16x8 frag_tr(const LAS unsigned char* img, int rowlo, int rowhi, int x0, int stride, int fr) {
    const int q = fr >> 2, p = fr & 3;
    const s16x4 lo = __builtin_amdgcn_ds_read_tr16_b64_v4i16((LAS s16x4*)(img + (rowlo + q) * stride + x0 * 2 + 8 * p));
    const s16x4 hi = __builtin_amdgcn_ds_read_tr16_b64_v4i16((LAS s16x4*)(img + (rowhi + q) * stride + x0 * 2 + 8 * p));
    return __builtin_shufflevector(lo, hi, 0, 1, 2, 3, 4, 5, 6, 7);
}

struct CvtJob { const float* s0; const float* s1; bf16_t* dst; int ldw, ldd, kd0, K, Nd, kind; };
__device__ __forceinline__ CvtJob mkjob(const float* s0, const float* s1, bf16_t* dst, int ldw, int ldd, int kd0, int K, int Nd, int kind) { CvtJob j; j.s0 = s0; j.s1 = s1; j.dst = dst; j.ldw = ldw; j.ldd = ldd; j.kd0 = kd0; j.K = K; j.Nd = Nd; j.kind = kind; return j; }
constexpr int CV_STR = 144;
__device__ __forceinline__ void cvt_src(const CvtJob& j, int n0, int n, const float*& src, int& col) {
    const int nh = n0 + (n & 32); src = j.s0; int sc = nh;
    if (j.kind == 1) { sc = nh < 3840 ? nh : (nh < 6912 ? nh + 32 : (nh < 6944 ? nh - 3072 : -1)); }
    else if (j.kind == 2) { const int tj = nh >> 8, r = nh & 255; if (r < 128) { sc = tj * 128 + r; } else { src = j.s1; sc = tj * 128 + r - 128; } }
    col = sc < 0 ? -1 : sc + (n & 31);
}
__device__ __forceinline__ void ph_convert(const CvtJob& j, LAS unsigned char* lds, const Ctx cx, int& rot) {
    const int tid = tidx(cx), c16 = tid & 15, kr = tid >> 4, lane = tid & 63, wid = tid >> 6, fr = lane & 15, fq = lane >> 4;
    const int kch = j.K / 256, nitems = (j.Nd / 64) * kch;
    int first = cx.bid - rot; if (first < 0) first += cx.nb;
    f32x4 v[8];
    auto issue = [&](int it) { const int nbk = it / kch, kc = it % kch, n0 = nbk * 64, k0 = kc * 256; const float* src; int col; cvt_src(j, n0, c16 * 4, src, col);
#pragma unroll
        for (int p = 0; p < 8; ++p) v[p] = col >= 0 ? *(const f32x4*)(src + (size_t)(k0 + p * 32 + kr) * j.ldw + col) : (f32x4){0.f, 0.f, 0.f, 0.f}; };
    if (first < nitems) issue(first);
    for (int it = first; it < nitems; it += cx.nb) {
        const int nbk = it / kch, kc = it % kch, n0 = nbk * 64, k0 = kc * 256;
        if (j.kind == 1 && n0 >= P_QA && n0 < P_VA) {
            const int e = (c16 * 4) & 31, blk = (c16 * 4) & 32;
#pragma unroll
            for (int p = 0; p < 8; ++p) { const unsigned w0 = cvt_pk_bf16(v[p][0], v[p][1]), w1 = cvt_pk_bf16(v[p][2], v[p][3]); LAS bf16_t* rowp = (LAS bf16_t*)(lds + (p * 32 + kr) * CV_STR) + blk;
#pragma unroll
                for (int q = 0; q < 4; ++q) { const int ee = e + q, pos = ee < 16 ? 2 * ee : 2 * (ee - 16) + 1; const unsigned w = q < 2 ? w0 : w1; rowp[pos] = (bf16_t)((q & 1) ? (w >> 16) : (w & 0xffffu)); } }
        } else {
#pragma unroll
        for (int p = 0; p < 8; ++p) { u32x2 w; w.x = cvt_pk_bf16(v[p][0], v[p][1]); w.y = cvt_pk_bf16(v[p][2], v[p][3]); *(LAS u32x2*)(lds + (p * 32 + kr) * CV_STR + c16 * 8) = w; }
        }
        __syncthreads();
        if (it + cx.nb < nitems) issue(it + cx.nb);
        { const int kq = wid & 3, nh = wid >> 2, r8 = lane >> 3, c8 = lane & 7;
          LAS unsigned char* my = lds + 256 * CV_STR + wid * (16 * CV_STR); LAS unsigned char* wp = my + fr * CV_STR + fq * 16; const LAS unsigned char* rp = my + (2 * r8 + (c8 >> 2)) * CV_STR + (c8 & 3) * 16;
#pragma unroll
          for (int q = 0; q < 2; ++q) { const int nb = nh * 2 + q;
              const bf16x8 oa = frag_tr(lds, (8 * kq + fq) * 8, (8 * kq + fq) * 8 + 4, nb * 16, CV_STR, fr), ob = frag_tr(lds, (8 * kq + 4 + fq) * 8, (8 * kq + 4 + fq) * 8 + 4, nb * 16, CV_STR, fr);
              *(LAS bf16x8*)wp = oa; *(LAS bf16x8*)(wp + 64) = ob;
              asm volatile("" ::: "memory"); __builtin_amdgcn_wave_barrier();
              const bf16x8 x0 = *(const LAS bf16x8*)rp, x1 = *(const LAS bf16x8*)(rp + 64);
              asm volatile("" ::: "memory"); __builtin_amdgcn_wave_barrier();
              bf16_t* dp = j.dst + ((size_t)(((n0 + nb * 16) >> 1) + r8) * (j.ldd >> 5) + ((j.kd0 + k0 + 64 * kq) >> 5)) * 64 + 8 * c8;
              *(bf16x8*)dp = x0; *(bf16x8*)(dp + 64) = x1; } }
        __syncthreads();
    }
    rot = (rot + nitems) % cx.nb;
}

__device__ __forceinline__ void ph_init(const float* x, const float* ctx, float* XS, f32x2* CS, const Ctx cx) {
    (void)x; (void)ctx; (void)XS;
    if (cx.bid == cx.nb - 1) for (int i = tidx(cx); i < 64 * 16; i += 512) { const int pos = i >> 4, f = i & 15; const float inv = powf(10000.0f, -(float)f / 16.0f); const float a = (float)pos * inv; CS[i] = (f32x2){cosf(a), sinf(a)}; }
}
__device__ __forceinline__ void ph_mod(const float* c, const float* c_ctx, const float* w_mod, const float* b_mod, float* MOD, LAS unsigned char* lds, const Ctx cx) {
    if (cx.bid >= DEPTH * 48) return;
    LAS float* sv = (LAS float*)lds; LAS float* red = sv + 9 * 1024;
    const int tid = tidx(cx);
    for (int i = tid; i < 9 * 1024; i += 512) { const float v = i < 8192 ? c[i] : c_ctx[i - 8192]; sv[i] = siluf_(v); }
    __syncthreads();
    const int c4 = (tid & 31) * 4, kg = tid >> 5;
    for (int it = cx.bid; it < DEPTH * 48; it += cx.nb) {
        const int l = it / 48, n0 = (it % 48) * 128;
        const float* w = w_mod + ((size_t)l * D + kg * 64) * 6144 + n0 + c4;
        f32x4 a[9];
#pragma unroll
        for (int r = 0; r < 9; ++r) a[r] = (f32x4){0.f, 0.f, 0.f, 0.f};
#pragma unroll 1
        for (int k0 = 0; k0 < 64; k0 += 8) { f32x4 wv[8];
#pragma unroll
            for (int u = 0; u < 8; ++u) wv[u] = *(const f32x4*)(w + (size_t)(k0 + u) * 6144);
#pragma unroll
            for (int u = 0; u < 8; ++u)
#pragma unroll
                for (int r = 0; r < 9; ++r) a[r] = a[r] + wv[u] * sv[r * 1024 + kg * 64 + k0 + u]; }
#pragma unroll
        for (int r = 0; r < 9; ++r) *(LAS f32x4*)(red + (kg * 9 + r) * 128 + c4) = a[r];
        __syncthreads();
        for (int i = tid; i < 9 * 128; i += 512) { const int r = i >> 7, cc = i & 127; float sacc = b_mod[(size_t)l * 6144 + n0 + cc];
#pragma unroll
            for (int g = 0; g < 16; ++g) sacc += red[(g * 9 + r) * 128 + cc];
            MOD[((size_t)l * 9 + r) * 6144 + n0 + cc] = sacc; }
        __syncthreads();
    }
}

struct NormArgs { bf16_t* XS; const void* Xl; const void* Xc; int lf32, cf32; bf16_t* H;
                  const float* g; const float* mod_shift; const float* mod_scale;
                  const bf16_t* Y; const int* POS; const float* TOPKp; const float* mod_g5prev;
                  const float* router; float* TOPK; unsigned* cnt; int nrows;
                  const float* PART; const float* mod_gpart; int npart; };
template <bool ROUTE> __device__ __forceinline__ void ph_norm(const NormArgs& a, bool combine, LAS unsigned char* lds, const Ctx cx) {
    const int lane = tidx(cx) & 63, wid = tidx(cx) >> 6;
    LAS unsigned* hist = (LAS unsigned*)(lds + LDS_SBASE);
    LAS float* rtab = (LAS float*)lds;
    if (ROUTE) { __syncthreads(); if (tidx(cx) < 8) hist[tidx(cx)] = 0u;
        for (int f = tidx(cx); f < 8192; f += 512) { const int e = f & 7, ln = (f >> 3) & 63, jq = f >> 9; rtab[f] = a.router[(size_t)(4 * (ln + 64 * (jq >> 2)) + (jq & 3)) * 8 + e]; }
        __syncthreads(); }
    f32x4 gq[4];
#pragma unroll
    for (int j = 0; j < 4; ++j) gq[j] = *(const f32x4*)(a.g + 4 * (lane + 64 * j));
    f32x4 xn[4];
    { const int r0 = cx.bid * 8 + wid; if (r0 < a.nrows) { const bool f = r0 < TL ? a.lf32 : a.cf32; const void* rp = r0 < TL ? a.Xl : a.Xc;
#pragma unroll
        for (int j = 0; j < 4; ++j) xn[j] = ldx_raw(rp, f, (size_t)r0 * D + 4 * (lane + 64 * j)); } }
    int cs1 = 0, cs2 = 0; float cp1 = 0.f, cp2 = 0.f; u32x2 y1n[4], y2n[4];
    if (combine) { const int rk = cx.bid * 8 + wid + lane * (cx.nb * 8);
        if (rk < a.nrows) { cs1 = a.POS[2 * rk]; cs2 = a.POS[2 * rk + 1]; cp1 = a.TOPKp[4 * rk + 2]; cp2 = a.TOPKp[4 * rk + 3]; }
        if (cx.bid * 8 + wid < a.nrows) { const int s1 = __builtin_amdgcn_readlane(cs1, 0), s2 = __builtin_amdgcn_readlane(cs2, 0);
#pragma unroll
            for (int j = 0; j < 4; ++j) { const int cc = 4 * (lane + 64 * j); y1n[j] = *(const u32x2*)(a.Y + (size_t)s1 * D + cc); y2n[j] = *(const u32x2*)(a.Y + (size_t)s2 * D + cc); } } }
    int it = 0;
    for (int row = cx.bid * 8 + wid; row < a.nrows; row += cx.nb * 8, ++it) {
        const int mr = mod_row(row);
        bf16_t* xr = a.XS + (size_t)row * D; const bool fcur = row < TL ? a.lf32 : a.cf32;
        f32x4 x[4], shq[4], scq[4];
#pragma unroll
        for (int j = 0; j < 4; ++j) { x[j] = cvx(xn[j], fcur); shq[j] = *(const f32x4*)(a.mod_shift + (size_t)mr * 6144 + 4 * (lane + 64 * j)); scq[j] = *(const f32x4*)(a.mod_scale + (size_t)mr * 6144 + 4 * (lane + 64 * j)); }
        if (row + cx.nb * 8 < a.nrows) {
            const int rn = row + cx.nb * 8; const bool f = rn < TL ? a.lf32 : a.cf32; const void* rp = rn < TL ? a.Xl : a.Xc;
#pragma unroll
            for (int j = 0; j < 4; ++j) xn[j] = ldx_raw(rp, f, (size_t)rn * D + 4 * (lane + 64 * j)); }
        if (combine) {
            const float p1 = __int_as_float(__builtin_amdgcn_readlane(__float_as_int(cp1), it)), p2 = __int_as_float(__builtin_amdgcn_readlane(__float_as_int(cp2), it));
            u32x2 y1c[4], y2c[4];
#pragma unroll
            for (int j = 0; j < 4; ++j) { y1c[j] = y1n[j]; y2c[j] = y2n[j]; }
            if (row + cx.nb * 8 < a.nrows) { const int s1 = __builtin_amdgcn_readlane(cs1, it + 1), s2 = __builtin_amdgcn_readlane(cs2, it + 1);
#pragma unroll
                for (int j = 0; j < 4; ++j) { const int cc = 4 * (lane + 64 * j); y1n[j] = *(const u32x2*)(a.Y + (size_t)s1 * D + cc); y2n[j] = *(const u32x2*)(a.Y + (size_t)s2 * D + cc); } }
#pragma unroll
            for (int j = 0; j < 4; ++j) { const int cc = 4 * (lane + 64 * j);
                const u32x2 y1 = y1c[j], y2 = y2c[j];
                const f32x4 mg = *(const f32x4*)(a.mod_g5prev + (size_t)mr * 6144 + cc);
                f32x4 e; e[0] = p1 * bf_lo(y1.x) + p2 * bf_lo(y2.x); e[1] = p1 * bf_hi(y1.x) + p2 * bf_hi(y2.x); e[2] = p1 * bf_lo(y1.y) + p2 * bf_lo(y2.y); e[3] = p1 * bf_hi(y1.y) + p2 * bf_hi(y2.y);
                x[j] = x[j] + mg * e; stx(xr + cc, x[j]); }
        }
        if (a.PART != nullptr && row >= TL) {
#pragma unroll
            for (int j = 0; j < 4; ++j) { const int cc = 4 * (lane + 64 * j); const float* pp = a.PART + (size_t)(row - TL) * D + cc;
                f32x4 e = (*(const f32x4*)pp + *(const f32x4*)(pp + (size_t)TC * D)) + (*(const f32x4*)(pp + (size_t)2 * TC * D) + *(const f32x4*)(pp + (size_t)3 * TC * D));
                e = e + (*(const f32x4*)(pp + (size_t)4 * TC * D) + *(const f32x4*)(pp + (size_t)5 * TC * D));
                if (a.npart == 7) e = e + *(const f32x4*)(pp + (size_t)6 * TC * D);
                const f32x4 mg = *(const f32x4*)(a.mod_gpart + (size_t)8 * 6144 + cc);
                x[j] = x[j] + mg * e; stx(xr + cc, x[j]); }
        }
        float ss = 0.f;
#pragma unroll
        for (int j = 0; j < 4; ++j) ss += x[j][0] * x[j][0] + x[j][1] * x[j][1] + x[j][2] * x[j][2] + x[j][3] * x[j][3];
        ss = wave_total(ss);
        const float rs = rsqrtf(ss * (1.0f / D) + EPS);
        f32x4 h[4];
#pragma unroll
        for (int j = 0; j < 4; ++j) { const int cc = 4 * (lane + 64 * j);
            h[j] = (x[j] * rs * gq[j]) * (scq[j] + 1.0f) + shq[j];
            u32x2 w; w.x = cvt_pk_bf16(h[j][0], h[j][1]); w.y = cvt_pk_bf16(h[j][2], h[j][3]);
            *(u32x2*)(a.H + (size_t)row * D + cc) = w; }
        if (ROUTE) {
            float lg[8];
#pragma unroll
            for (int e = 0; e < 8; ++e) lg[e] = 0.f;
#pragma unroll
            for (int j = 0; j < 4; ++j)
#pragma unroll
                for (int q = 0; q < 4; ++q) { const LAS float* rw = rtab + ((j * 4 + q) * 64 + lane) * 8; const f32x4 r0 = *(const LAS f32x4*)rw, r1 = *(const LAS f32x4*)(rw + 4); const float hv = h[j][q];
                    lg[0] += hv * r0[0]; lg[1] += hv * r0[1]; lg[2] += hv * r0[2]; lg[3] += hv * r0[3]; lg[4] += hv * r1[0]; lg[5] += hv * r1[1]; lg[6] += hv * r1[2]; lg[7] += hv * r1[3]; }
#pragma unroll
            for (int e = 0; e < 8; ++e) lg[e] = wave_total(lg[e]);
            if (lane == 0) {
                int e1 = 0; float v1 = lg[0];
#pragma unroll
                for (int e = 1; e < 8; ++e) if (lg[e] > v1) { v1 = lg[e]; e1 = e; }
                int e2 = -1; float v2 = -3.0e38f;
#pragma unroll
                for (int e = 0; e < 8; ++e) if (e != e1 && lg[e] > v2) { v2 = lg[e]; e2 = e; }
                const float p2 = 1.0f / (1.0f + __expf(v1 - v2)), p1 = 1.0f - p2;
                float* tk = a.TOPK + 4 * (size_t)row; tk[0] = __int_as_float(e1); tk[1] = __int_as_float(e2); tk[2] = p1; tk[3] = p2;
                lds_add(hist + e1, 1u); lds_add(hist + e2, 1u);
            }
        }
    }
    if (ROUTE) { __syncthreads(); if (tidx(cx) < 8) { const unsigned v = hist[tidx(cx)]; if (v) atomicAdd(a.cnt + tidx(cx), v); } __syncthreads(); }
}

__device__ __forceinline__ void ph_route(const float* TOPK, const bf16_t* H, bf16_t* HS, int* POS, unsigned* ctl, int j, int nrows, LAS unsigned char* lds, const Ctx cx) {
    LAS unsigned* sbase = (LAS unsigned*)(lds + LDS_SBASE);
    const int lane = tidx(cx) & 63, wid = tidx(cx) >> 6;
    __syncthreads();
    if (tidx(cx) == 0) { unsigned b = 0; for (int e = 0; e < 8; ++e) { sbase[e] = b; b += (xb_ld(ctl + CW_CNT + j * 64 + e) + 255u) & ~255u; } sbase[8] = b; }
    __syncthreads();
    if (cx.bid == 0) {
        if (tidx(cx) < 256) { const unsigned r0 = tidx(cx) * 256u; int e = 0;
            for (int q = 1; q < 8; ++q) if (r0 >= sbase[q]) e = q;
            ctl[CW_TEXP + j * 256 + tidx(cx)] = (unsigned)e; }
        if (tidx(cx) == 0) ctl[CW_NT + j] = sbase[8] / 256u;
    }
    for (int i = cx.bid * 8 + wid; i < 8 * 256; i += cx.nb * 8) { const int e = i >> 8, r = i & 255; const unsigned s = sbase[e] + xb_ld(ctl + CW_CNT + j * 64 + e) + r;
        if (s < sbase[e + 1]) {
#pragma unroll
            for (int q = 0; q < 2; ++q) ((u32x4*)(HS + (size_t)s * D))[lane + 64 * q] = ((const u32x4*)H)[lane + 64 * q]; } }
    LAS unsigned* wcnt = sbase + 16; LAS unsigned* wbase = sbase + 24;
    if (tidx(cx) < 8) wcnt[tidx(cx)] = 0u;
    const int nk = nrows / (cx.nb * 8); const int myrow = cx.bid * 8 + wid + lane * (cx.nb * 8); const bool own = lane < nk;
    int e1 = 0, e2 = 0; if (own) { const f32x2 t = *(const f32x2*)(TOPK + 4 * (size_t)myrow); e1 = __float_as_int(t[0]); e2 = __float_as_int(t[1]); }
    __syncthreads();
    if (own) { lds_add(wcnt + e1, 1u); lds_add(wcnt + e2, 1u); }
    __syncthreads();
    if (tidx(cx) < 8) { const unsigned n = wcnt[tidx(cx)]; wbase[tidx(cx)] = sbase[tidx(cx)] + (n ? atomicAdd(ctl + CW_FILL + j * 64 + tidx(cx), n) : 0u); wcnt[tidx(cx)] = 0u; }
    __syncthreads();
    int s1 = 0, s2 = 0;
    if (own) { s1 = (int)(wbase[e1] + lds_add(wcnt + e1, 1u)); s2 = (int)(wbase[e2] + lds_add(wcnt + e2, 1u)); POS[2 * myrow] = s1; POS[2 * myrow + 1] = s2; }
    u32x4 v[9][2];
#pragma unroll
    for (int k = 0; k < 9; ++k) if (k < nk) { const u32x4* src = (const u32x4*)(H + (size_t)(cx.bid * 8 + wid + k * (cx.nb * 8)) * D); v[k][0] = src[lane]; v[k][1] = src[lane + 64]; }
#pragma unroll
    for (int k = 0; k < 9; ++k) if (k < nk) { const int d1 = __builtin_amdgcn_readlane(s1, k), d2 = __builtin_amdgcn_readlane(s2, k);
        u32x4* o1 = (u32x4*)(HS + (size_t)d1 * D); u32x4* o2 = (u32x4*)(HS + (size_t)d2 * D);
        o1[lane] = v[k][0]; o1[lane + 64] = v[k][1]; o2[lane] = v[k][0]; o2[lane + 64] = v[k][1]; }
    __syncthreads();
}

struct CvIn { u32x4 cc[3], cu[3], cb; };
__device__ __forceinline__ void ph_conv(const bf16_t* P, bf16_t* BR, const float* conv_w, int nrows, const Ctx cx) {
    const int tid = tidx(cx), lane = tid & 63, wid = tid >> 6; const int c0 = lane * 8;
    float cw[3][8];
#pragma unroll
    for (int d = 0; d < 3; ++d)
#pragma unroll
        for (int e = 0; e < 8; ++e) cw[d][e] = conv_w[d * 512 + c0 + e];
    auto seqpos = [&](int row, int& sp, int& slen) { const bool lat = row < TL; sp = lat ? (row & (SEQ - 1)) : ((row - TL) & (CTXL - 1)); slen = lat ? SEQ : CTXL; };
    auto load = [&](int row, CvIn& in) { const bf16_t* pr = P + (size_t)row * NP; int sp, slen; seqpos(row, sp, slen);
#pragma unroll
        for (int d = 0; d < 3; ++d) { const int sq = sp + d - 1; const bool ok = sq >= 0 && sq < slen; const bf16_t* q = pr + (ptrdiff_t)(ok ? d - 1 : 0) * NP;
            in.cc[d] = *(const u32x4*)(q + P_CC + c0); in.cu[d] = *(const u32x4*)(q + P_CU + c0); }
        in.cb = *(const u32x4*)(pr + P_CB + c0); };
    const int stride = cx.nb * 8; int row = cx.bid * 8 + wid; CvIn cur, nxt;
    if (row < nrows) load(row, cur);
    for (; row < nrows; row += stride) {
        const int rn = row + stride; const bool hn = rn < nrows;
        if (hn) load(rn, nxt);
        int sp, slen; seqpos(row, sp, slen);
        float y[8];
#pragma unroll
        for (int e = 0; e < 8; ++e) y[e] = 0.f;
#pragma unroll
        for (int d = 0; d < 3; ++d) { const int sq = sp + d - 1; const float m = (sq >= 0 && sq < slen) ? 1.0f : 0.0f; float cv[8], uv[8]; unpack8(cur.cc[d], cv); unpack8(cur.cu[d], uv);
#pragma unroll
            for (int e = 0; e < 8; ++e) y[e] += (cv[e] * uv[e]) * (cw[d][e] * m); }
        float bv[8]; unpack8(cur.cb, bv);
#pragma unroll
        for (int e = 0; e < 8; ++e) y[e] *= bv[e];
        *(u32x4*)(BR + (size_t)row * 1536 + c0) = pack8(y);
        if (hn) cur = nxt;
    }
}

__device__ __forceinline__ void ph_final(const bf16_t* XS, const bf16_t* Y, const int* POS, const float* TOPK, const float* mod_g5, const float* g, float* out, const Ctx cx) {
    const int lane = tidx(cx) & 63, wid = tidx(cx) >> 6;
    f32x4 gq[4];
#pragma unroll
    for (int j = 0; j < 4; ++j) gq[j] = *(const f32x4*)(g + 4 * (lane + 64 * j));
    const int stride = cx.nb * 8; int row = cx.bid * 8 + wid;
    f32x4 xn[4]; u32x2 y1n[4], y2n[4]; float p1n = 0.f, p2n = 0.f;
    int cs1 = 0, cs2 = 0; float cp1 = 0.f, cp2 = 0.f;
    { const int rk = cx.bid * 8 + wid + lane * stride; if (rk < TL) { cs1 = POS[2 * rk]; cs2 = POS[2 * rk + 1]; cp1 = TOPK[4 * rk + 2]; cp2 = TOPK[4 * rk + 3]; } }
    auto fetch = [&](int r, int k) { const int s1 = __builtin_amdgcn_readlane(cs1, k), s2 = __builtin_amdgcn_readlane(cs2, k);
        p1n = __int_as_float(__builtin_amdgcn_readlane(__float_as_int(cp1), k)); p2n = __int_as_float(__builtin_amdgcn_readlane(__float_as_int(cp2), k));
#pragma unroll
        for (int j = 0; j < 4; ++j) { const int cc = 4 * (lane + 64 * j); xn[j] = ldx_raw(XS, false, (size_t)r * D + cc); y1n[j] = *(const u32x2*)(Y + (size_t)s1 * D + cc); y2n[j] = *(const u32x2*)(Y + (size_t)s2 * D + cc); } };
    if (row < TL) fetch(row, 0);
    int it = 0;
    for (; row < TL; row += stride, ++it) {
        const int mr = mod_row(row);
        f32x4 x[4]; u32x2 y1[4], y2[4]; const float p1 = p1n, p2 = p2n;
#pragma unroll
        for (int j = 0; j < 4; ++j) { x[j] = cvx(xn[j], false); y1[j] = y1n[j]; y2[j] = y2n[j]; }
        if (row + stride < TL) fetch(row + stride, it + 1);
        float ss = 0.f;
#pragma unroll
        for (int j = 0; j < 4; ++j) { const int cc = 4 * (lane + 64 * j);
            const f32x4 mg = *(const f32x4*)(mod_g5 + (size_t)mr * 6144 + cc);
            f32x4 e; e[0] = p1 * bf_lo(y1[j].x) + p2 * bf_lo(y2[j].x); e[1] = p1 * bf_hi(y1[j].x) + p2 * bf_hi(y2[j].x); e[2] = p1 * bf_lo(y1[j].y) + p2 * bf_lo(y2[j].y); e[3] = p1 * bf_hi(y1[j].y) + p2 * bf_hi(y2[j].y);
            x[j] = x[j] + mg * e; ss += x[j][0] * x[j][0] + x[j][1] * x[j][1] + x[j][2] * x[j][2] + x[j][3] * x[j][3]; }
        ss = wave_total(ss); const float rs = rsqrtf(ss * (1.0f / D) + EPS);
#pragma unroll
        for (int j = 0; j < 4; ++j) { const int cc = 4 * (lane + 64 * j); *(f32x4*)(out + (size_t)row * D + cc) = x[j] * rs * gq[j]; }
    }
}

__device__ __forceinline__ float wave_incl_scan(float v) {
    v += __int_as_float(__builtin_amdgcn_update_dpp(0, __float_as_int(v), 0x111, 0xF, 0xF, true));
    v += __int_as_float(__builtin_amdgcn_update_dpp(0, __float_as_int(v), 0x112, 0xF, 0xF, true));
    v += __int_as_float(__builtin_amdgcn_update_dpp(0, __float_as_int(v), 0x114, 0xF, 0xF, true));
    v += __int_as_float(__builtin_amdgcn_update_dpp(0, __float_as_int(v), 0x118, 0xF, 0xF, true));
    v += __int_as_float(__builtin_amdgcn_update_dpp(0, __float_as_int(v), 0x142, 0xA, 0xF, false));
    v += __int_as_float(__builtin_amdgcn_update_dpp(0, __float_as_int(v), 0x143, 0xC, 0xF, false));
    return v;
}
__device__ __forceinline__ float lsig16(float z) { const float e = __builtin_amdgcn_exp2f(fmaxf(z, -80.0f) * -LOG2E); return __builtin_amdgcn_logf(1.0f + e) * (-0.6931471805599453f / 16.0f); }
__device__ __forceinline__ void gla_wave_decay(const bf16_t* P, int row0, int t, int h, int d, int ch0, const float* gla_w2, const float* gla_b, float (&b)[16]) {
    const u32x4* ap = (const u32x4*)(P + (size_t)(row0 + t) * NP + P_AG + d * 16);
    float a[16]; unpack8(ap[0], a); unpack8(ap[1], a + 8);
    const float* w2 = gla_w2 + (size_t)d * 16 * 256 + h * 64 + ch0; const float* bb = gla_b + d * 256 + h * 64 + ch0;
#pragma unroll
    for (int i = 0; i < 16; ++i) b[i] = bb[i];
#pragma unroll
    for (int r = 0; r < 16; ++r)
#pragma unroll
        for (int i = 0; i < 16; ++i) b[i] = __builtin_fmaf(a[r], w2[r * 256 + i], b[i]);
#pragma unroll
    for (int i = 0; i < 16; ++i) b[i] = wave_incl_scan(lsig16(b[i]));
}

constexpr int G_QD = 0, G_KI = G_QD + 2 * 64 * STR64, G_AT = G_KI + 2 * 64 * STR64, G_VI = G_AT + 2 * 64 * STR64, G_SE = G_VI + 64 * STR128, G_RED = G_SE + 2 * 64 * STR128, G_END = G_RED + 512;
constexpr int G1_KR = G_KI, G1_AR = G_KI + 64 * STR64, G1_ASTR = 80, G1_W2 = 73728;
struct G1In { u32x4 vv[2], kraw, araw; float bb[16]; };
__device__ __forceinline__ void g1_load(G1In& in, const bf16_t* P, const float* gla_b, int ci, int h, int tid) {
    const int row0 = ci * 64;
    { const int w = tid >> 6; const float* bb = gla_b + (w >> 2) * 256 + h * 64 + (w & 3) * 16;
#pragma unroll
      for (int i = 0; i < 16; ++i) in.bb[i] = bb[i]; }
#pragma unroll
    for (int q = 0; q < 2; ++q) { const int id = tid + 512 * q, r = id >> 4, c16 = id & 15; in.vv[q] = *(const u32x4*)(P + (size_t)(row0 + r) * NP + P_VG + h * 128 + c16 * 8); }
    in.kraw = *(const u32x4*)(P + (size_t)(row0 + (tid >> 3)) * NP + P_KG + h * 64 + (tid & 7) * 8);
    in.araw = (u32x4){0u, 0u, 0u, 0u}; if (tid < 256) in.araw = *(const u32x4*)(P + (size_t)(row0 + (tid >> 2)) * NP + P_AG + (tid & 3) * 8);
}
__device__ __forceinline__ void gla_state_unit(const G1In& in, G1In& nxt, int vnext  , const bf16_t* P, int ci, int h, const float* gla_b, float* DS, float* DEC, float* BC, LAS unsigned char* lds, const Ctx cx) {
    const int tid = tidx(cx), lane = tid & 63, wid = __builtin_amdgcn_readfirstlane(tid >> 6), fr = lane & 15, fq = lane >> 4;
    LAS unsigned char* Ke = lds + G_QD; LAS unsigned char* Vi = lds + G_VI; LAS unsigned char* Kr = lds + G1_KR; LAS unsigned char* Ar = lds + G1_AR; const LAS float* w2s = (const LAS float*)(lds + G1_W2);
    {
#pragma unroll
      for (int q = 0; q < 2; ++q) { const int id = tid + 512 * q, r = id >> 4, c16 = id & 15; *(LAS u32x4*)(Vi + r * STR128 + c16 * 16) = in.vv[q]; }
      *(LAS u32x4*)(Kr + (tid >> 3) * STR64 + (tid & 7) * 16) = in.kraw;
      if (tid < 256) *(LAS u32x4*)(Ar + (tid >> 2) * G1_ASTR + (tid & 3) * 16) = in.araw; }
    __syncthreads();
    const size_t ub = ((size_t)ci * 4 + h) * 2;
    { const int d = wid >> 2, ch0 = (wid & 3) * 16, t = d ? 63 - lane : lane; float b[16];
      const LAS u32x4* ap = (const LAS u32x4*)(Ar + t * G1_ASTR + d * 32); float a[16]; unpack8(ap[0], a); unpack8(ap[1], a + 8);
      const LAS u32x4* kp = (const LAS u32x4*)(Kr + t * STR64 + ch0 * 2); const u32x4 k0 = kp[0], k1 = kp[1];
      const LAS float* w2 = w2s + d * 16 * 256 + h * 64 + ch0;
#pragma unroll
      for (int i = 0; i < 16; ++i) b[i] = in.bb[i];
#pragma unroll
      for (int r = 0; r < 16; ++r)
#pragma unroll
          for (int i = 0; i < 16; ++i) b[i] = __builtin_fmaf(a[r], w2[r * 256 + i], b[i]);
#pragma unroll
      for (int i = 0; i < 16; ++i) b[i] = wave_incl_scan(lsig16(b[i]));
      { float* bp = BC + ((ub + d) * 64 + ch0) * 64 + t;
#pragma unroll
        for (int i = 0; i < 16; ++i) bp[i * 64] = b[i]; }
      float kf[16], o[16]; unpack8(k0, kf); unpack8(k1, kf + 8);
#pragma unroll
      for (int i = 0; i < 16; ++i) { const float bt = __int_as_float(__builtin_amdgcn_readlane(__float_as_int(b[i]), 63)); o[i] = kf[i] * __expf(bt - b[i]); b[i] = bt; }
      *(LAS u32x4*)(Ke + d * 64 * STR64 + t * STR64 + ch0 * 2) = pack8(o); *(LAS u32x4*)(Ke + d * 64 * STR64 + t * STR64 + ch0 * 2 + 16) = pack8(o + 8);
      if (lane < 16) { float dv = b[0];
#pragma unroll
          for (int i = 1; i < 16; ++i) dv = (lane == i) ? b[i] : dv;
          DEC[(ub + d) * 64 + ch0 + lane] = __expf(dv); } }
    __syncthreads();
    if (vnext >= 0) g1_load(nxt, P, gla_b, vnext >> 2, vnext & 3, tid);
    { const int d = wid >> 2, mt = wid & 3; f32x4 acc[8];
#pragma unroll
      for (int n = 0; n < 8; ++n) acc[n] = (f32x4){0.f, 0.f, 0.f, 0.f};
#pragma unroll
      for (int s = 0; s < 2; ++s) { const int r0 = 32 * s + 8 * fq; const bf16x8 af = frag_tr(Ke + d * 64 * STR64, r0, r0 + 4, mt * 16, STR64, fr);
#pragma unroll
          for (int n = 0; n < 8; ++n) { const bf16x8 bfr = frag_tr(Vi, r0, r0 + 4, n * 16, STR128, fr); MMA16(acc[n], af, bfr); } }
      LAS unsigned char* my = lds + G_AT + wid * (16 * STR64); const int r8 = lane >> 3, c8 = lane & 7;
      LAS unsigned char* wp = my + fr * STR64 + fq * 16; const LAS unsigned char* rp = my + r8 * STR64 + c8 * 16;
      float* dst = DS + ((ub + d) * 64 + mt * 16 + r8) * 128 + 4 * c8;
#pragma unroll
      for (int p = 0; p < 4; ++p) {
          *(LAS f32x4*)wp = acc[2 * p]; *(LAS f32x4*)(wp + 64) = acc[2 * p + 1];
          asm volatile("" ::: "memory"); __builtin_amdgcn_wave_barrier();
          const f32x4 x0 = *(const LAS f32x4*)rp, x1 = *(const LAS f32x4*)(rp + 8 * STR64);
          asm volatile("" ::: "memory"); __builtin_amdgcn_wave_barrier();
          *(f32x4*)(dst + p * 32) = x0; *(f32x4*)(dst + 8 * 128 + p * 32) = x1; } }
    __syncthreads();
}

__device__ __forceinline__ void ph_gla_scan2(const float* DS, const float* DEC, bf16_t* SE, const Ctx cx) {
    const int tid = tidx(cx);
    for (int vi = cx.bid * 512 + tid; vi < 64 * 2048; vi += cx.nb * 512) {
        const int sid = vi >> 11, dk = (vi >> 5) & 63, dvq = vi & 31; const int b = sid >> 3, h = (sid >> 1) & 3, d = sid & 1;
        f32x4 S = (f32x4){0.f, 0.f, 0.f, 0.f};
#pragma unroll 12
        for (int st = 0; st < 36; ++st) {
            const int ci = st < 4 ? (256 + 4 * b + (d ? 3 - st : st)) : (32 * b + (d ? 35 - st : st - 4));
            const size_t ub = ((size_t)ci * 4 + h) * 2 + d; const size_t eo = (ub * 64 + dk) * 128 + dvq * 4;
            u32x2 w; w.x = cvt_pk_bf16(S[0], S[1]); w.y = cvt_pk_bf16(S[2], S[3]); *(u32x2*)(SE + eo) = w;
            const float dec = DEC[ub * 64 + dk]; const f32x4 ds = *(const f32x4*)(DS + eo);
            S = S * dec + ds;
        }
    }
}

struct G3In { u32x4 vv[2], sv[4], qraw, kraw; float bb[16]; };
__device__ __forceinline__ void g3_load(G3In& in, const bf16_t* P, int ci, int h, const float* BC, const bf16_t* SE, int tid) {
    const int lane = tid & 63, wid = __builtin_amdgcn_readfirstlane(tid >> 6); const int row0 = ci * 64; const size_t ub = ((size_t)ci * 4 + h) * 2;
#pragma unroll
    for (int q = 0; q < 2; ++q) { const int id = tid + 512 * q, r = id >> 4, c16 = id & 15; in.vv[q] = *(const u32x4*)(P + (size_t)(row0 + r) * NP + P_VG + h * 128 + c16 * 8); }
#pragma unroll
    for (int q = 0; q < 4; ++q) { const int id = tid + 512 * q, r = id >> 4, c16 = id & 15; in.sv[q] = *(const u32x4*)(SE + (ub * 64 + r) * 128 + c16 * 8); }
    const int d = wid >> 2, ch0 = (wid & 3) * 16, t = d ? 63 - lane : lane;
    { const bf16_t* pr = P + (size_t)(row0 + (tid >> 3)) * NP + h * 64 + (tid & 7) * 8; in.qraw = *(const u32x4*)(pr + P_QG); in.kraw = *(const u32x4*)(pr + P_KG); }
    const float* bp = BC + ((ub + d) * 64 + ch0) * 64 + t;
#pragma unroll
    for (int i = 0; i < 16; ++i) in.bb[i] = bp[i * 64];
}
__device__ __forceinline__ void gla_out_unit(const G3In& in, const bf16_t* P, int ci, int h, const float* gng, bf16_t* BR, LAS unsigned char* lds, const Ctx cx) {
    const int tid = tidx(cx), lane = tid & 63, wid = __builtin_amdgcn_readfirstlane(tid >> 6), fr = lane & 15, fq = lane >> 4; const int row0 = ci * 64;
    LAS unsigned char* Qd = lds + G_QD; LAS unsigned char* Ki = lds + G_KI; LAS unsigned char* Vi = lds + G_VI; LAS unsigned char* Se = lds + G_SE; LAS unsigned char* At = lds + G_AT;
    { LAS unsigned char* Qr = At; LAS unsigned char* Kr = At + 64 * STR64;
      *(LAS u32x4*)(Qr + (tid >> 3) * STR64 + (tid & 7) * 16) = in.qraw; *(LAS u32x4*)(Kr + (tid >> 3) * STR64 + (tid & 7) * 16) = in.kraw; }
#pragma unroll
    for (int q = 0; q < 2; ++q) { const int id = tid + 512 * q, r = id >> 4, c16 = id & 15; *(LAS u32x4*)(Vi + r * STR128 + c16 * 16) = in.vv[q]; }
#pragma unroll
    for (int q = 0; q < 4; ++q) { const int id = tid + 512 * q, r = id >> 4, c16 = id & 15; *(LAS u32x4*)(Se + r * STR128 + c16 * 16) = in.sv[q]; }
    __syncthreads();
    { const int d = wid >> 2, ch0 = (wid & 3) * 16, t = d ? 63 - lane : lane; float b[16];
      const LAS u32x4* qp = (const LAS u32x4*)(At + t * STR64 + ch0 * 2); const LAS u32x4* kp = (const LAS u32x4*)(At + 64 * STR64 + t * STR64 + ch0 * 2);
      const u32x4 q0 = qp[0], q1 = qp[1], k0 = kp[0], k1 = kp[1];
#pragma unroll
      for (int i = 0; i < 16; ++i) b[i] = in.bb[i];
      float qf[16], kf[16]; unpack8(q0, qf); unpack8(q1, qf + 8); unpack8(k0, kf); unpack8(k1, kf + 8);
#pragma unroll
      for (int i = 0; i < 16; ++i) { const float e = __expf(b[i]); qf[i] = qf[i] * 0.125f * e; kf[i] = kf[i] * __builtin_amdgcn_rcpf(e); }
      LAS unsigned char* qd = Qd + d * 64 * STR64 + t * STR64 + ch0 * 2; LAS unsigned char* ki = Ki + d * 64 * STR64 + t * STR64 + ch0 * 2;
      *(LAS u32x4*)qd = pack8(qf); *(LAS u32x4*)(qd + 16) = pack8(qf + 8); *(LAS u32x4*)ki = pack8(kf); *(LAS u32x4*)(ki + 16) = pack8(kf + 8); }
    __syncthreads();
    { const int d = wid >> 2, mt = wid & 3; f32x4 acc[4];
#pragma unroll
      for (int n = 0; n < 4; ++n) acc[n] = (f32x4){0.f, 0.f, 0.f, 0.f};
#pragma unroll
      for (int s = 0; s < 2; ++s) { const bf16x8 af = frag_row(Qd + d * 64 * STR64, mt * 16 + fr, 32 * s + 8 * fq, STR64);
#pragma unroll
          for (int n = 0; n < 4; ++n) { const bf16x8 bfr = frag_row(Ki + d * 64 * STR64, n * 16 + fr, 32 * s + 8 * fq, STR64); MMA16(acc[n], af, bfr); } }
      const int l = mt * 16 + fr;
#pragma unroll
      for (int n = 0; n < 4; ++n) { float v[4];
#pragma unroll
          for (int j = 0; j < 4; ++j) { const int s = n * 16 + 4 * fq + j; const bool keep = d ? (s >= l) : (s <= l); v[j] = keep ? acc[n][j] : 0.f; }
          u32x2 w; w.x = cvt_pk_bf16(v[0], v[1]); w.y = cvt_pk_bf16(v[2], v[3]); *(LAS u32x2*)(At + d * 64 * STR64 + l * STR64 + (n * 16 + 4 * fq) * 2) = w; } }
    __syncthreads();
    { const int mt = wid & 3, nh = wid >> 2; f32x4 acc[4];
      const int l = mt * 16 + fr; const size_t row = (size_t)row0 + l;
      u32x2 rw[4]; f32x4 gg[4];
#pragma unroll
      for (int n = 0; n < 4; ++n) { const int v0 = (nh * 4 + n) * 16 + 4 * fq; rw[n] = *(const u32x2*)(P + row * NP + P_RG + h * 128 + v0); gg[n] = *(const f32x4*)(gng + h * 128 + v0); }
#pragma unroll
      for (int n = 0; n < 4; ++n) acc[n] = (f32x4){0.f, 0.f, 0.f, 0.f};
#pragma unroll
      for (int d = 0; d < 2; ++d)
#pragma unroll
          for (int s = 0; s < 2; ++s) { const int r0 = 32 * s + 8 * fq;
              const bf16x8 af = frag_row(At + d * 64 * STR64, mt * 16 + fr, r0, STR64), aq = frag_row(Qd + d * 64 * STR64, mt * 16 + fr, r0, STR64);
#pragma unroll
              for (int n = 0; n < 4; ++n) { const int x0 = (nh * 4 + n) * 16;
                  const bf16x8 bv = frag_tr(Vi, r0, r0 + 4, x0, STR128, fr); MMA16(acc[n], af, bv);
                  const bf16x8 bs = frag_tr(Se + d * 64 * STR128, r0, r0 + 4, x0, STR128, fr); MMA16(acc[n], aq, bs); } }
      float ss = 0.f;
#pragma unroll
      for (int n = 0; n < 4; ++n) ss += acc[n][0] * acc[n][0] + acc[n][1] * acc[n][1] + acc[n][2] * acc[n][2] + acc[n][3] * acc[n][3];
      ss = row4_sum(ss);
      LAS float* red = (LAS float*)(lds + G_RED);
      if (fq == 0) red[l * 2 + nh] = ss;
      __syncthreads();
      const float rs = rsqrtf((red[l * 2] + red[l * 2 + 1]) * (1.0f / 128.0f) + EPS);
#pragma unroll
      for (int n = 0; n < 4; ++n) { const int v0 = (nh * 4 + n) * 16 + 4 * fq;
          const float y0 = acc[n][0] * rs * gg[n][0] * siluf_(bf_lo(rw[n].x)), y1 = acc[n][1] * rs * gg[n][1] * siluf_(bf_hi(rw[n].x)), y2 = acc[n][2] * rs * gg[n][2] * siluf_(bf_lo(rw[n].y)), y3 = acc[n][3] * rs * gg[n][3] * siluf_(bf_hi(rw[n].y));
          u32x2 w; w.x = cvt_pk_bf16(y0, y1); w.y = cvt_pk_bf16(y2, y3); *(u32x2*)(BR + row * 1536 + 1024 + h * 128 + v0) = w; } }
    __syncthreads();
}

constexpr float ATT_THR = 8.0f;
constexpr int A_KBUF = 0, A_VBUF = 64 * STR64, A_BUF = 2 * 64 * STR64;
__device__ __forceinline__ void attn_unit(const bf16_t* QR, const bf16_t* KV, bf16_t* BR, const float* sink, int b, int kh, int qrow0  , int qpos0  , LAS unsigned char* lds, const Ctx cx) {
    const int tid = tidx(cx), lane = tid & 63, wid = tid >> 6, fr = lane & 15, fq = lane >> 4; const int hq = wid >> 1, qh = wid & 1;
    const bool lat = qpos0 >= 0;
    int kt0 = 0, kt1 = 0; if (lat) { kt0 = (qpos0 >> 6) - 2; if (kt0 < 0) kt0 = 0; kt1 = (qpos0 >> 6) + 4; if (kt1 > 32) kt1 = 32; }
    const int ntile = (kt1 - kt0) + 4;
    bf16x8 qf[4][2];
#pragma unroll
    for (int mt = 0; mt < 4; ++mt)
#pragma unroll
        for (int ks = 0; ks < 2; ++ks) qf[mt][ks] = *(const bf16x8*)(QR + (size_t)(qrow0 + 64 * qh + 16 * mt + fr) * 512 + (4 * kh + hq) * 64 + 32 * ks + 8 * fq);
    const float sk = sink[4 * kh + hq] * LOG2E;
    f32x4 oacc[4][4]; float mrun[4], lrun[4];
#pragma unroll
    for (int mt = 0; mt < 4; ++mt) { mrun[mt] = sk; lrun[mt] = (fq == 0) ? 1.0f : 0.0f;
#pragma unroll
        for (int dt = 0; dt < 4; ++dt) oacc[mt][dt] = (f32x4){0.f, 0.f, 0.f, 0.f}; }
    const int sr = tid >> 3, sc = tid & 7;
    auto tile_row0 = [&](int t) -> int { return t < (kt1 - kt0) ? b * SEQ + (kt0 + t) * 64 : TL + b * CTXL + (t - (kt1 - kt0)) * 64; };
    u32x4 kreg, vreg;
    { const bf16_t* src = KV + (size_t)(tile_row0(0) + sr) * 256 + kh * 64 + sc * 8; kreg = *(const u32x4*)src; vreg = *(const u32x4*)(src + 128); }
    *(LAS u32x4*)(lds + A_KBUF + sr * STR64 + sc * 16) = kreg; *(LAS u32x4*)(lds + A_VBUF + sr * STR64 + sc * 16) = vreg;
    __syncthreads();
    for (int t = 0; t < ntile; ++t) {
        LAS unsigned char* Kb = lds + (t & 1) * A_BUF + A_KBUF; LAS unsigned char* Vb = lds + (t & 1) * A_BUF + A_VBUF;
        if (t + 1 < ntile) { const bf16_t* src = KV + (size_t)(tile_row0(t + 1) + sr) * 256 + kh * 64 + sc * 8; kreg = *(const u32x4*)src; vreg = *(const u32x4*)(src + 128); }
        const bool latt = t < (kt1 - kt0); const int kpos0 = (kt0 + t) * 64;
        const int qlo = qpos0 + 64 * qh;
        const bool active = !latt || (kpos0 + 63 >= qlo - 128 && kpos0 <= qlo + 63 + 128);
        const bool needmask = latt && (kpos0 > qlo + 65 || kpos0 < qlo - 65);
        if (active) {
            u32x4 pf[4][2];
            { bf16x8 kf[4][2];
#pragma unroll
              for (int nt = 0; nt < 4; ++nt)
#pragma unroll
                  for (int ks = 0; ks < 2; ++ks) kf[nt][ks] = frag_row(Kb, nt * 16 + fr, 32 * ks + 8 * fq, STR64);
#pragma unroll
              for (int mt = 0; mt < 4; ++mt) {
                f32x4 s[4];
                const float nm = -mrun[mt];
#pragma unroll
                for (int nt = 0; nt < 4; ++nt) { s[nt] = (f32x4){nm, nm, nm, nm}; MMA16(s[nt], qf[mt][0], kf[nt][0]); MMA16(s[nt], qf[mt][1], kf[nt][1]); }
                if (needmask) { const int qp = qlo + 16 * mt + fr;
#pragma unroll
                    for (int nt = 0; nt < 4; ++nt)
#pragma unroll
                        for (int j = 0; j < 4; ++j) { const int dlt = kpos0 + nt * 16 + 4 * fq + j - qp; if (dlt > 128 || dlt < -128) s[nt][j] = -3.0e38f; } }
                float mx = vmax2(vmax2(vmax2(s[0][0], s[0][1]), vmax2(s[0][2], s[0][3])), vmax2(vmax2(s[1][0], s[1][1]), vmax2(s[1][2], s[1][3])));
                mx = vmax2(mx, vmax2(vmax2(vmax2(s[2][0], s[2][1]), vmax2(s[2][2], s[2][3])), vmax2(vmax2(s[3][0], s[3][1]), vmax2(s[3][2], s[3][3]))));
                mx = row4_max(mx);
                if (__builtin_amdgcn_ballot_w64(mx > ATT_THR) != 0ull) {
                    const float d = mx > ATT_THR ? mx : 0.f; const float alpha = __builtin_amdgcn_exp2f(-d); mrun[mt] += d; lrun[mt] *= alpha;
#pragma unroll
                    for (int dt = 0; dt < 4; ++dt) oacc[mt][dt] = oacc[mt][dt] * alpha;
#pragma unroll
                    for (int nt = 0; nt < 4; ++nt) s[nt] = s[nt] - d; }
                float ps = 0.f;
#pragma unroll
                for (int nt = 0; nt < 4; ++nt)
#pragma unroll
                    for (int j = 0; j < 4; ++j) { const float p = __builtin_amdgcn_exp2f(s[nt][j]); s[nt][j] = p; ps += p; }
                lrun[mt] += ps;
                pf[mt][0].x = cvt_pk_bf16(s[0][0], s[0][1]); pf[mt][0].y = cvt_pk_bf16(s[0][2], s[0][3]); pf[mt][0].z = cvt_pk_bf16(s[1][0], s[1][1]); pf[mt][0].w = cvt_pk_bf16(s[1][2], s[1][3]);
                pf[mt][1].x = cvt_pk_bf16(s[2][0], s[2][1]); pf[mt][1].y = cvt_pk_bf16(s[2][2], s[2][3]); pf[mt][1].z = cvt_pk_bf16(s[3][0], s[3][1]); pf[mt][1].w = cvt_pk_bf16(s[3][2], s[3][3]);
              } }
#pragma unroll
            for (int dt = 0; dt < 4; ++dt) {
                const bf16x8 v0 = frag_tr(Vb, 4 * fq, 16 + 4 * fq, dt * 16, STR64, fr), v1 = frag_tr(Vb, 32 + 4 * fq, 48 + 4 * fq, dt * 16, STR64, fr);
#pragma unroll
                for (int mt = 0; mt < 4; ++mt) { MMA16(oacc[mt][dt], __builtin_bit_cast(bf16x8, pf[mt][0]), v0); MMA16(oacc[mt][dt], __builtin_bit_cast(bf16x8, pf[mt][1]), v1); } }
        }
        if (t + 1 < ntile) { LAS unsigned char* nb_ = lds + ((t + 1) & 1) * A_BUF; *(LAS u32x4*)(nb_ + A_KBUF + sr * STR64 + sc * 16) = kreg; *(LAS u32x4*)(nb_ + A_VBUF + sr * STR64 + sc * 16) = vreg; }
        __syncthreads();
    }
#pragma unroll
    for (int mt = 0; mt < 4; ++mt) { const float l = row4_sum(lrun[mt]); const float inv = 1.0f / l;
        bf16_t* op = BR + (size_t)(qrow0 + 64 * qh + 16 * mt + fr) * 1536 + 512 + (4 * kh + hq) * 64 + 4 * fq;
#pragma unroll
        for (int dt = 0; dt < 4; ++dt) { u32x2 w; w.x = cvt_pk_bf16(oacc[mt][dt][0] * inv, oacc[mt][dt][1] * inv); w.y = cvt_pk_bf16(oacc[mt][dt][2] * inv, oacc[mt][dt][3] * inv); *(u32x2*)(op + dt * 16) = w; } }
}

__device__ __forceinline__ void ph_mixA(const bf16_t* P, const bf16_t* QR, const bf16_t* KV, bf16_t* BR, const float* sink, const float* gla_w2, const float* gla_b, float* DS, float* DEC, float* BC, bool ctxq, LAS unsigned char* lds, const Ctx cx) {
    { LAS float* w2s = (LAS float*)(lds + G1_W2); for (int i = tidx(cx); i < 2 * 16 * 256; i += 512) w2s[i] = gla_w2[i]; }
    for (int u = cx.bid; u < 256; u += cx.nb) { const int b = u >> 5, n = (u >> 1) & 15, kh = u & 1; attn_unit(QR, KV, BR, sink, b, kh, b * SEQ + n * 128, n * 128, lds, cx); }
    if (cx.nb == 256) {
        const int n = (cx.bid >> 1) & 15; const bool edge = (n == 0 || n == 15);
        if (ctxq && edge) { const int b = cx.bid >> 5, kh = cx.bid & 1; attn_unit(QR, KV, BR, sink, b, kh, TL + b * CTXL + (n == 15 ? 128 : 0), -1000000, lds, cx); }
        int rank; if (!ctxq) rank = cx.bid; else { const int blk = cx.bid >> 5, w = cx.bid & 31; rank = edge ? -1 : blk * 28 + (w - 2); }
        const int nv = (rank >= 0 && rank < 128) ? 5 : 4;
        G1In cur, nxt; g1_load(cur, P, gla_b, cx.bid >> 2, cx.bid & 3, tidx(cx));
#pragma unroll 1
        for (int k = 0; k < nv; ++k) { const int v = k < 4 ? cx.bid + 256 * k : 1024 + rank; const int vn = (k + 1 < nv) ? ((k + 1) < 4 ? cx.bid + 256 * (k + 1) : 1024 + rank) : -1;
            gla_state_unit(cur, nxt, vn, P, v >> 2, v & 3, gla_b, DS, DEC, BC, lds, cx);
            if (vn >= 0) cur = nxt; }
        return;
    }
    const int nsmall = (ctxq ? 32 : 0) + 1152;
    for (int u = cx.bid; u < nsmall; u += cx.nb) {
        int v = u;
        if (ctxq) { if (v < 32) { const int b = v >> 2, n = (v >> 1) & 1, kh = v & 1; attn_unit(QR, KV, BR, sink, b, kh, TL + b * CTXL + n * 128, -1000000, lds, cx); continue; } v -= 32; }
        { G1In cur, nxt; g1_load(cur, P, gla_b, v >> 2, v & 3, tidx(cx)); gla_state_unit(cur, nxt, -1, P, v >> 2, v & 3, gla_b, DS, DEC, BC, lds, cx); }
    }
}
__device__ __forceinline__ void ph_mixC(const bf16_t* P, const float* BC, const bf16_t* SE, const float* gng, bf16_t* BR, int nchunks, LAS unsigned char* lds, const Ctx cx) {
    const int n = nchunks * 4; int u = cx.bid; G3In cur, nxt;
    if (u < n) g3_load(cur, P, u >> 2, u & 3, BC, SE, tidx(cx));
    for (; u < n; u += cx.nb) { const int un = u + cx.nb; const bool hn = un < n;
        if (hn) g3_load(nxt, P, un >> 2, un & 3, BC, SE, tidx(cx));
        gla_out_unit(cur, P, u >> 2, u & 3, gng, BR, lds, cx);
        if (hn) cur = nxt; }
}

template <int MODE, class Epi, int ABLK = 0> __device__ __forceinline__ void ph_gemm(LAS unsigned char* lds, const bf16_t* A, const bf16_t* Bt, int lda, int ldb, int K, int nM, int nN, const Epi& E, unsigned* ctl, int moe_j, size_t bexp, const Ctx cx) {
    pg8::Prob<MODE> P; P.A = A; P.Bt = Bt; P.lda = lda; P.ldb = ldb; P.K = K; P.nM = nM; P.nN = nN; P.G = cx.nb; P.c = cx.bid; P.texp = (LAS int*)(lds + LDS_TEXP); P.bexp = bexp; P.nctx = (MODE == 3) ? moe_j : 0;
    if (MODE == 2) {
        __syncthreads();
        if (tidx(cx) < 256) ((LAS int*)(lds + LDS_TEXP))[tidx(cx)] = (int)xb_ld(ctl + CW_TEXP + moe_j * 256 + tidx(cx));
        P.nM = (int)xb_ld(ctl + CW_NT + moe_j);
        __syncthreads();
    }
    pg8::gemm_phase<Epi, pg8::Prob<MODE>, ABLK>(lds, P, E, cx);
}

__device__ __forceinline__ bool idle_ctx(unsigned* ctl, int j, int nN, Ctx& cx) {
    const int U = (int)xb_ld(ctl + CW_NT + j) * nN, rounds = (U + cx.nb - 1) / cx.nb, nidle = rounds * cx.nb - U;
    if (nidle < 64) return true;
    const int first = cx.nb - nidle; if (cx.bid < first) return false;
    cx.bid -= first; cx.nb = nidle; return true;
}

struct MKP { const float* in[24]; float* out; char* ws; };
typedef const MKP __attribute__((address_space(4)))* KPtr;
__device__ __forceinline__ KPtr kp() { KPtr q = (KPtr)__builtin_amdgcn_kernarg_segment_ptr(); OPQ_S(q); return q; }
#define IN_(i) ((const float*)q->in[i])
#define WSP(off) (ws + (off))

__global__ void __launch_bounds__(512, 2) mk_fwd(MKP p_unused) {
    extern __shared__ __attribute__((aligned(16))) unsigned char shm[];
    LAS unsigned char* lds = (LAS unsigned char*)shm;
    const int nb = gridDim.x; const int wv = __builtin_amdgcn_readfirstlane((int)(threadIdx.x >> 6));
    XcdBarrier bar;
    { KPtr q = kp(); char* ws = q->ws;
      if (threadIdx.x == 0) *(LAS u32x4*)(lds + LDS_BARW) = (u32x4){0u, 0u, 0u, 0u};
      __syncthreads();
      bar = xcd_barrier_post((unsigned*)WSP(WS_CTL) + CW_BAR, (volatile LAS unsigned*)(lds + LDS_BARW)); }

    { KPtr q = kp(); char* ws = q->ws; Ctx cx; cx.bid = blockIdx.x; cx.nb = nb; cx.wv = wv; OPQ_S(cx.bid); OPQ_S(cx.wv);
      ph_init(IN_(0), IN_(2), (float*)nullptr, (f32x2*)WSP(WS_CS), cx);
      ph_mod(IN_(1), IN_(3), IN_(4), IN_(5), (float*)WSP(WS_MOD), lds, cx);
      __syncthreads(); }
    { int rot = 0;
#pragma unroll 1
      for (int l = 0; l < DEPTH; ++l) {
          KPtr q = kp(); char* ws = q->ws; Ctx cx; cx.bid = blockIdx.x; cx.nb = nb; cx.wv = wv; OPQ_S(cx.bid); OPQ_S(cx.wv);
          ph_convert(mkjob(IN_(8) + (size_t)l * D * DIN, nullptr, (bf16_t*)WSP(WS_WIN) + (size_t)l * NP * D, DIN, D, 0, D, NP, 1), lds, cx, rot);
          ph_convert(mkjob(IN_(15) + (size_t)l * D * D, nullptr, (bf16_t*)WSP(WS_WO3) + (size_t)l * D * D, D, D, 0, D, D, 0), lds, cx, rot);
#pragma unroll 1
          for (int i = 0; i < 3; ++i) {
              ph_convert(mkjob(IN_(14) + ((size_t)l * 3 + i) * 512 * D, nullptr, (bf16_t*)WSP(WS_WBR) + (size_t)l * D * 1536, D, 1536, i * 512, 512, 1024, 0), lds, cx, rot);
          }
      }
#pragma unroll 1
      for (int j = 0; j < 2; ++j) {
          KPtr q = kp(); char* ws = q->ws; Ctx cx; cx.bid = blockIdx.x; cx.nb = nb; cx.wv = wv; OPQ_S(cx.bid); OPQ_S(cx.wv);
          ph_convert(mkjob(IN_(16) + (size_t)j * D * DFF, IN_(17) + (size_t)j * D * DFF, (bf16_t*)WSP(WS_WUPD) + (size_t)j * NUP * D, DFF, D, 0, D, NUP, 2), lds, cx, rot);
          ph_convert(mkjob(IN_(18) + (size_t)j * DFF * D, nullptr, (bf16_t*)WSP(WS_WDND) + (size_t)j * D * DFF, D, DFF, 0, DFF, D, 0), lds, cx, rot);
      }
    }
    { Ctx cx; cx.bid = 0; cx.nb = nb; cx.wv = wv; OPQ_S(cx.wv); xcd_barrier_first(bar, cx); }

#pragma unroll 1
    for (int l = 0; l < DEPTH; ++l) {
        const bool last = (l == DEPTH - 1), moe = (l & 1); const int j = l >> 1; const int nrows = last ? TL : T; const int nMr = nrows / 256;
        { KPtr q = kp(); char* ws = q->ws; Ctx cx; cx.bid = blockIdx.x; cx.nb = nb; cx.wv = wv; OPQ_S(cx.bid); OPQ_S(cx.wv); const float* modl = (const float*)WSP(WS_MOD) + (size_t)l * 9 * 6144;
          NormArgs a; a.XS = (bf16_t*)WSP(WS_XS); a.lf32 = a.cf32 = (l == 0); a.Xl = l ? (const void*)WSP(WS_XS) : (const void*)IN_(0); a.Xc = l ? (const void*)WSP(WS_XS) : (const void*)(IN_(2) - (size_t)TL * D); a.H = (bf16_t*)WSP(WS_H); a.g = IN_(6) + l * D; a.mod_shift = modl; a.mod_scale = modl + 1024; a.nrows = T;
          a.Y = (const bf16_t*)WSP(WS_YB); a.POS = (const int*)WSP(WS_POS); a.TOPKp = (const float*)WSP(WS_TOPK); a.mod_g5prev = (const float*)WSP(WS_MOD) + (size_t)(l > 0 ? l - 1 : 0) * 9 * 6144 + 5 * 1024; a.router = nullptr; a.TOPK = nullptr; a.cnt = nullptr;
          a.npart = 7; a.PART = (l == 1 || l == 3) ? (const float*)WSP(WS_PART) : nullptr; a.mod_gpart = (const float*)WSP(WS_MOD) + (size_t)(l > 0 ? l - 1 : 0) * 9 * 6144 + 5 * 1024;
          ph_norm<false>(a, l == 2, lds, cx); }
        { Ctx cx; cx.bid = 0; cx.nb = nb; cx.wv = wv; OPQ_S(cx.wv); xcd_barrier(bar, cx); }
        { KPtr q = kp(); char* ws = q->ws; Ctx cx; cx.bid = blockIdx.x; cx.nb = nb; cx.wv = wv; OPQ_S(cx.bid); OPQ_S(cx.wv);
          pg8::EpiWin E{(bf16_t*)WSP(WS_PH), (bf16_t*)WSP(WS_QR), (bf16_t*)WSP(WS_KV), (const f32x2*)WSP(WS_CS), lds + LDS_CSH}; ph_gemm<0>(lds, (const bf16_t*)WSP(WS_H), (const bf16_t*)WSP(WS_WIN) + (size_t)l * NP * D, D, D, D, T / 256, NP / 256, E, nullptr, 0, 0, cx); }
        { Ctx cx; cx.bid = 0; cx.nb = nb; cx.wv = wv; OPQ_S(cx.wv); xcd_barrier(bar, cx); }
        { KPtr q = kp(); char* ws = q->ws; Ctx cx; cx.bid = blockIdx.x; cx.nb = nb; cx.wv = wv; OPQ_S(cx.bid); OPQ_S(cx.wv);
          ph_mixA((const bf16_t*)WSP(WS_PH), (const bf16_t*)WSP(WS_QR), (const bf16_t*)WSP(WS_KV), (bf16_t*)WSP(WS_BR), IN_(10) + l * 8, IN_(11) + (size_t)l * 2 * 16 * 256, IN_(12) + (size_t)l * 2 * 256,
                  (float*)WSP(WS_R3), (float*)WSP(WS_DEC), (float*)WSP(WS_YB), !last, lds, cx); }
        { Ctx cx; cx.bid = 0; cx.nb = nb; cx.wv = wv; OPQ_S(cx.wv); xcd_barrier(bar, cx); }
        { KPtr q = kp(); char* ws = q->ws; Ctx cx; cx.bid = blockIdx.x; cx.nb = nb; cx.wv = wv; OPQ_S(cx.bid); OPQ_S(cx.wv);
          ph_gla_scan2((const float*)WSP(WS_R3), (const float*)WSP(WS_DEC), (bf16_t*)(WSP(WS_R3) + (size_t)2 * T * 512 * 4), cx); }
        { Ctx cx; cx.bid = 0; cx.nb = nb; cx.wv = wv; OPQ_S(cx.wv); xcd_barrier(bar, cx); }
        { KPtr q = kp(); char* ws = q->ws; Ctx cx; cx.bid = blockIdx.x; cx.nb = nb; cx.wv = wv; OPQ_S(cx.bid); OPQ_S(cx.wv);
          ph_conv((const bf16_t*)WSP(WS_PH), (bf16_t*)WSP(WS_BR), IN_(9) + (size_t)l * 3 * 512, nrows, cx);
          ph_mixC((const bf16_t*)WSP(WS_PH), (const float*)WSP(WS_YB), (const bf16_t*)(WSP(WS_R3) + (size_t)2 * T * 512 * 4), IN_(13) + l * 512, (bf16_t*)WSP(WS_BR), nrows / 64, lds, cx); }
        { Ctx cx; cx.bid = 0; cx.nb = nb; cx.wv = wv; OPQ_S(cx.wv); xcd_barrier(bar, cx); }
        { KPtr q = kp(); char* ws = q->ws; Ctx cx; cx.bid = blockIdx.x; cx.nb = nb; cx.wv = wv; OPQ_S(cx.bid); OPQ_S(cx.wv);
          constexpr size_t MG3C_OFF = (size_t)TL * D * 2;
          if (!last) { pg8::EpiGate E{(bf16_t*)(WSP(WS_R3) + MG3C_OFF), (const bf16_t*)WSP(WS_PH) + (size_t)TL * NP, lds + LDS_CSH}; ph_gemm<1>(lds, (const bf16_t*)WSP(WS_BR) + (size_t)TL * 1536, (const bf16_t*)WSP(WS_WBR) + (size_t)l * D * 1536, 1536, 1536, 512, 8, 12, E, nullptr, 0, 0, cx); }
          { pg8::EpiMerge E{(bf16_t*)WSP(WS_R3), (const bf16_t*)WSP(WS_PH), lds + LDS_CSH}; ph_gemm<4>(lds, (const bf16_t*)WSP(WS_BR), (const bf16_t*)WSP(WS_WBR) + (size_t)l * D * 1536, 1536, 1536, 1536, 64, 4, E, nullptr, 0, 0, cx); } }
        { Ctx cx; cx.bid = 0; cx.nb = nb; cx.wv = wv; OPQ_S(cx.wv); xcd_barrier(bar, cx); }
        { KPtr q = kp(); char* ws = q->ws; Ctx cx; cx.bid = blockIdx.x; cx.nb = nb; cx.wv = wv; OPQ_S(cx.bid); OPQ_S(cx.wv);
          constexpr size_t MG3C_OFF = (size_t)TL * D * 2;
          pg8::EpiResid E{(bf16_t*)WSP(WS_XS), (const float*)WSP(WS_MOD) + (size_t)l * 9 * 6144 + 2 * 1024, (float*)WSP(WS_PART), l ? (const void*)WSP(WS_XS) : (const void*)IN_(0), lds + LDS_CSH, l == 0, 0};
          if (!last) ph_gemm<5>(lds, (const bf16_t*)(WSP(WS_R3) + MG3C_OFF) - (size_t)TL * 3072, (const bf16_t*)WSP(WS_WO3) + (size_t)l * D * D, 3072, D, 512, 8, 4, E, nullptr, 0, 0, cx);
          ph_gemm<0>(lds, (const bf16_t*)WSP(WS_R3), (const bf16_t*)WSP(WS_WO3) + (size_t)l * D * D, D, D, D, 64, 4, E, nullptr, 0, 0, cx); }
        { Ctx cx; cx.bid = 0; cx.nb = nb; cx.wv = wv; OPQ_S(cx.wv); xcd_barrier(bar, cx); }
        { KPtr q = kp(); char* ws = q->ws; Ctx cx; cx.bid = blockIdx.x; cx.nb = nb; cx.wv = wv; OPQ_S(cx.bid); OPQ_S(cx.wv); const float* modl = (const float*)WSP(WS_MOD) + (size_t)l * 9 * 6144;
          NormArgs a; a.XS = (bf16_t*)WSP(WS_XS); a.lf32 = 0; a.cf32 = (l == 0); a.Xl = (const void*)WSP(WS_XS); a.Xc = l ? (const void*)WSP(WS_XS) : (const void*)(IN_(2) - (size_t)TL * D); a.H = (bf16_t*)WSP(WS_H); a.g = IN_(7) + l * D; a.mod_shift = modl + 3 * 1024; a.mod_scale = modl + 4 * 1024; a.nrows = nrows;
          a.Y = nullptr; a.POS = nullptr; a.TOPKp = nullptr; a.mod_g5prev = nullptr; a.router = IN_(19) + (size_t)j * D * 8; a.TOPK = (float*)WSP(WS_TOPK); a.cnt = (unsigned*)WSP(WS_CTL) + CW_CNT + j * 64;
          a.npart = 6; a.PART = last ? nullptr : (const float*)WSP(WS_PART); a.mod_gpart = modl + 2 * 1024;
          if (moe) ph_norm<true>(a, false, lds, cx); else ph_norm<false>(a, false, lds, cx); }
        if (moe && j == 0) {
            int rot = 0;
#pragma unroll 1
            for (int e = 0; e < NEXP; ++e) { KPtr q = kp(); char* ws = q->ws; Ctx cx; cx.bid = blockIdx.x; cx.nb = nb; cx.wv = wv; OPQ_S(cx.bid); OPQ_S(cx.wv); const size_t eo = ((size_t)j * NEXP + e) * D * DFF;
                ph_convert(mkjob(IN_(20) + eo, IN_(21) + eo, (bf16_t*)WSP(WS_WUPM) + (size_t)e * NUP * D, DFF, D, 0, D, NUP, 2), lds, cx, rot);
            }
        }
        { Ctx cx; cx.bid = 0; cx.nb = nb; cx.wv = wv; OPQ_S(cx.wv); xcd_barrier(bar, cx); }
        if (!moe) {
            { KPtr q = kp(); char* ws = q->ws; Ctx cx; cx.bid = blockIdx.x; cx.nb = nb; cx.wv = wv; OPQ_S(cx.bid); OPQ_S(cx.wv);
              pg8::EpiSwiglu E{(bf16_t*)WSP(WS_PH)}; ph_gemm<0>(lds, (const bf16_t*)WSP(WS_H), (const bf16_t*)WSP(WS_WUPD) + (size_t)j * NUP * D, D, D, D, nMr, NUP / 256, E, nullptr, 0, 0, cx); }
            { Ctx cx; cx.bid = 0; cx.nb = nb; cx.wv = wv; OPQ_S(cx.wv); xcd_barrier(bar, cx); }
            { KPtr q = kp(); char* ws = q->ws; Ctx cx; cx.bid = blockIdx.x; cx.nb = nb; cx.wv = wv; OPQ_S(cx.bid); OPQ_S(cx.wv);
              pg8::EpiResid E{(bf16_t*)WSP(WS_XS), (const float*)WSP(WS_MOD) + (size_t)l * 9 * 6144 + 5 * 1024, (float*)WSP(WS_PART), (const void*)WSP(WS_XS), lds + LDS_CSH, 0, 0}; ph_gemm<3, pg8::EpiResid, 1>(lds, (const bf16_t*)WSP(WS_PH), (const bf16_t*)WSP(WS_WDND) + (size_t)j * D * DFF, DFF, DFF, DFF, nMr, 4, E, nullptr, last ? 0 : 224, 0, cx); }
            { Ctx cx; cx.bid = 0; cx.nb = nb; cx.wv = wv; OPQ_S(cx.wv); xcd_barrier(bar, cx); }
        } else {
            { KPtr q = kp(); char* ws = q->ws; Ctx cx; cx.bid = blockIdx.x; cx.nb = nb; cx.wv = wv; OPQ_S(cx.bid); OPQ_S(cx.wv);
              ph_route((const float*)WSP(WS_TOPK), (const bf16_t*)WSP(WS_H), (bf16_t*)WSP(WS_R3), (int*)WSP(WS_POS), (unsigned*)WSP(WS_CTL), j, nrows, lds, cx); }
            { Ctx cx; cx.bid = 0; cx.nb = nb; cx.wv = wv; OPQ_S(cx.wv); xcd_barrier(bar, cx); }
            { KPtr q = kp(); char* ws = q->ws; Ctx cx; cx.bid = blockIdx.x; cx.nb = nb; cx.wv = wv; OPQ_S(cx.bid); OPQ_S(cx.wv);
              pg8::EpiSwiglu E{(bf16_t*)WSP(WS_PH)}; ph_gemm<2>(lds, (const bf16_t*)WSP(WS_R3), (const bf16_t*)WSP(WS_WUPM), D, D, D, 0, NUP / 256, E, (unsigned*)WSP(WS_CTL), j, (size_t)NUP * D, cx);
              { Ctx c2 = cx; if (idle_ctx((unsigned*)WSP(WS_CTL), j, NUP / 256, c2)) { int rot = 0;
#pragma unroll 1
                  for (int e = 0; e < NEXP; ++e) { const size_t eo = ((size_t)j * NEXP + e) * D * DFF; ph_convert(mkjob(IN_(22) + eo, nullptr, (bf16_t*)WSP(WS_WDNM) + (size_t)e * D * DFF, D, DFF, 0, DFF, D, 0), lds, c2, rot); } } } }
            { Ctx cx; cx.bid = 0; cx.nb = nb; cx.wv = wv; OPQ_S(cx.wv); xcd_barrier(bar, cx); }
            { KPtr q = kp(); char* ws = q->ws; Ctx cx; cx.bid = blockIdx.x; cx.nb = nb; cx.wv = wv; OPQ_S(cx.bid); OPQ_S(cx.wv);
              pg8::EpiBf16 E{(bf16_t*)WSP(WS_YB), lds + LDS_CSH, D, 0}; ph_gemm<2, pg8::EpiBf16, 1>(lds, (const bf16_t*)WSP(WS_PH), (const bf16_t*)WSP(WS_WDNM), DFF, DFF, DFF, 0, 4, E, (unsigned*)WSP(WS_CTL), j, (size_t)D * DFF, cx);
              if (j == 0) { Ctx c2 = cx; if (idle_ctx((unsigned*)WSP(WS_CTL), j, 4, c2)) { int rot = 0;
#pragma unroll 1
                  for (int e = 0; e < NEXP; ++e) { const size_t eo = ((size_t)NEXP + e) * D * DFF; ph_convert(mkjob(IN_(20) + eo, IN_(21) + eo, (bf16_t*)WSP(WS_WUPM) + (size_t)e * NUP * D, DFF, D, 0, D, NUP, 2), lds, c2, rot); } } } }
            { Ctx cx; cx.bid = 0; cx.nb = nb; cx.wv = wv; OPQ_S(cx.wv); xcd_barrier(bar, cx); }
        }
    }
    { KPtr q = kp(); char* ws = q->ws; Ctx cx; cx.bid = blockIdx.x; cx.nb = nb; cx.wv = wv; OPQ_S(cx.bid); OPQ_S(cx.wv);
      ph_final((const bf16_t*)WSP(WS_XS), (const bf16_t*)WSP(WS_YB), (const int*)WSP(WS_POS), (const float*)WSP(WS_TOPK), (const float*)WSP(WS_MOD) + (size_t)3 * 9 * 6144 + 5 * 1024, IN_(23), q->out, cx); }
}

extern "C" void kernel_launch(void* const* d_in, const int* in_sizes, int n_in, void* d_out, int out_size, void* d_ws, size_t ws_size, hipStream_t stream) {
    (void)in_sizes; (void)out_size;
    if (n_in != 24 || ws_size < WS_END) return;
    static int grid = 0;
    if (!grid) {
        int dev = 0, cus = 0, per_cu = 0;
        if (hipGetDevice(&dev) != hipSuccess || hipDeviceGetAttribute(&cus, hipDeviceAttributeMultiprocessorCount, dev) != hipSuccess) return;
        if (hipFuncSetAttribute((const void*)mk_fwd, hipFuncAttributeMaxDynamicSharedMemorySize, LDS_BYTES) != hipSuccess) return;
        if (hipOccupancyMaxActiveBlocksPerMultiprocessor(&per_cu, mk_fwd, 512, LDS_BYTES) != hipSuccess || per_cu < 1) return;
        if (cus != 256) return;
        grid = cus;
    }
    (void)hipMemsetAsync((char*)d_ws + WS_CTL, 0, CTL_BYTES, stream);
    MKP p;
    for (int i = 0; i < 24; ++i) p.in[i] = (const float*)d_in[i];
    p.out = (float*)d_out; p.ws = (char*)d_ws;
    hipLaunchKernelGGL(mk_fwd, dim3(grid), dim3(512), LDS_BYTES, stream, p);
}
```

```cpp
#include <hip/hip_runtime.h>
#include <stdint.h>
#include <stddef.h>

#define LAS __attribute__((address_space(3)))
typedef unsigned short bf16_t;
typedef short bf16x8 __attribute__((ext_vector_type(8)));
typedef float f32x4 __attribute__((ext_vector_type(4)));
typedef float f32x2 __attribute__((ext_vector_type(2)));
typedef unsigned u32x4 __attribute__((ext_vector_type(4)));
typedef unsigned u32x2 __attribute__((ext_vector_type(2)));

constexpr int D = 1024, NBATCH = 8, SEQ = 2048, CTXL = 256, DEPTH = 4;
constexpr int TL = NBATCH * SEQ, TC = NBATCH * CTXL, T = TL + TC;
constexpr int DIN = 6944, NP = 7168;
constexpr int DFF = 3584, NUP = 2 * DFF;
constexpr int NEXP = 8;
constexpr int MAXR = 2 * T + NEXP * 256;
constexpr int P_CB = 0, P_CC = 512, P_CU = 1024, P_QA = 1536, P_KA = 2048, P_VA = 2176, P_QG = 2304, P_KG = 2560, P_VG = 2816, P_RG = 3328, P_GATE = 3840, P_AG = 6912;
constexpr float EPS = 1e-6f;
constexpr float LOG2E = 1.4426950408889634f, QSCALE = 0.125f * LOG2E;

constexpr size_t al256(size_t x) { return (x + 255) & ~(size_t)255; }
constexpr size_t WS_CTL = 0;                                   constexpr size_t CTL_BYTES = 65536;
constexpr size_t WS_MOD = WS_CTL + CTL_BYTES;                  constexpr size_t MOD_BYTES = (size_t)DEPTH * 9 * 6 * D * 4;
constexpr size_t WS_CS = al256(WS_MOD + MOD_BYTES);            constexpr size_t CS_BYTES = 64 * 16 * 8;
constexpr size_t WS_XS = al256(WS_CS + CS_BYTES);              constexpr size_t XS_BYTES = (size_t)T * D * 4;
constexpr size_t WS_H = al256(WS_XS + XS_BYTES);               constexpr size_t H_BYTES = (size_t)T * D * 2;
constexpr size_t WS_PH = al256(WS_H + H_BYTES);                constexpr size_t PH_BYTES = (size_t)MAXR * DFF * 2;
constexpr size_t WS_BR = al256(WS_PH + PH_BYTES);              constexpr size_t BR_BYTES = (size_t)T * 1536 * 2;
constexpr size_t WS_R3 = al256(WS_BR + BR_BYTES);              constexpr size_t R3_BYTES = (size_t)T * 3072 * 2;
constexpr size_t WS_YB = al256(WS_R3 + R3_BYTES);              constexpr size_t YB_BYTES = (size_t)MAXR * D * 2;
constexpr size_t WS_QR = al256(WS_YB + YB_BYTES);              constexpr size_t QR_BYTES = (size_t)T * 512 * 2;
constexpr size_t WS_KV = al256(WS_QR + QR_BYTES);              constexpr size_t KV_BYTES = (size_t)T * 256 * 2;
constexpr size_t WS_TOPK = al256(WS_KV + KV_BYTES);            constexpr size_t TOPK_BYTES = (size_t)T * 16;
constexpr size_t WS_POS = al256(WS_TOPK + TOPK_BYTES);         constexpr size_t POS_BYTES = (size_t)T * 8;
constexpr size_t WS_IDX = al256(WS_POS + POS_BYTES);           constexpr size_t IDX_BYTES = (size_t)MAXR * 4;
constexpr size_t WS_DEC = al256(WS_IDX + IDX_BYTES);           constexpr size_t DEC_BYTES = (size_t)(T / 64) * 4 * 2 * 64 * 4;
constexpr size_t WS_PART = al256(WS_DEC + DEC_BYTES);         constexpr size_t PART_BYTES = (size_t)7 * TC * D * 4;
constexpr size_t WS_WIN = al256(WS_PART + PART_BYTES);           constexpr size_t WIN_BYTES = (size_t)DEPTH * NP * D * 2;
constexpr size_t WS_WBR = al256(WS_WIN + WIN_BYTES);           constexpr size_t WBR_BYTES = (size_t)DEPTH * D * 1536 * 2;
constexpr size_t WS_WO3 = al256(WS_WBR + WBR_BYTES);           constexpr size_t WO3_BYTES = (size_t)DEPTH * D * D * 2;
constexpr size_t WS_WUPD = al256(WS_WO3 + WO3_BYTES);          constexpr size_t WUPD_BYTES = (size_t)2 * NUP * D * 2;
constexpr size_t WS_WDND = al256(WS_WUPD + WUPD_BYTES);        constexpr size_t WDND_BYTES = (size_t)2 * D * DFF * 2;
constexpr size_t WS_WUPM = al256(WS_WDND + WDND_BYTES);        constexpr size_t WUPM_BYTES = (size_t)NEXP * NUP * D * 2;
constexpr size_t WS_WDNM = al256(WS_WUPM + WUPM_BYTES);        constexpr size_t WDNM_BYTES = (size_t)NEXP * D * DFF * 2;
constexpr size_t WS_END = al256(WS_WDNM + WDNM_BYTES);
constexpr int CW_CNT = 0;
constexpr int CW_FILL = 128;
constexpr int CW_TEXP = 1024;
constexpr int CW_NT = 1536;

typedef __bf16 bf16x2_t __attribute__((ext_vector_type(2)));
__device__ __forceinline__ unsigned cvt_pk_bf16(float lo, float hi) { const f32x2 v = {lo, hi}; return __builtin_bit_cast(unsigned, __builtin_convertvector(v, bf16x2_t)); }
__device__ __forceinline__ float bf_lo(unsigned w) { return __uint_as_float(w << 16); }
__device__ __forceinline__ float bf_hi(unsigned w) { return __uint_as_float(w & 0xffff0000u); }
__device__ __forceinline__ float bf2f(bf16_t b) { return __uint_as_float(((unsigned)b) << 16); }
__device__ __forceinline__ bf16_t f2bf(float f) { return (bf16_t)(cvt_pk_bf16(f, 0.f) & 0xffffu); }
__device__ __forceinline__ float sigmoidf_(float x) { return __builtin_amdgcn_rcpf(1.0f + __builtin_amdgcn_exp2f(x * -1.4426950408889634f)); }
__device__ __forceinline__ float swg_(float a, float b) { return (a * b) * __builtin_amdgcn_rcpf(1.0f + __builtin_amdgcn_exp2f(a)); }
__device__ __forceinline__ float siluf_(float x) { return x * __builtin_amdgcn_rcpf(1.0f + __builtin_amdgcn_exp2f(x * -1.4426950408889634f)); }
__device__ __forceinline__ float shx(float v, int mask, int lane) { return __int_as_float(__builtin_amdgcn_ds_bpermute((lane ^ mask) << 2, __float_as_int(v))); }
__device__ __forceinline__ float shl_(float v, int src) { return __int_as_float(__builtin_amdgcn_ds_bpermute(src << 2, __float_as_int(v))); }
__device__ __forceinline__ float wave_total(float v) {
    v += __int_as_float(__builtin_amdgcn_update_dpp(0, __float_as_int(v), 0x111, 0xF, 0xF, true));
    v += __int_as_float(__builtin_amdgcn_update_dpp(0, __float_as_int(v), 0x112, 0xF, 0xF, true));
    v += __int_as_float(__builtin_amdgcn_update_dpp(0, __float_as_int(v), 0x114, 0xF, 0xF, true));
    v += __int_as_float(__builtin_amdgcn_update_dpp(0, __float_as_int(v), 0x118, 0xF, 0xF, true));
    v += __int_as_float(__builtin_amdgcn_update_dpp(0, __float_as_int(v), 0x142, 0xA, 0xF, false));
    v += __int_as_float(__builtin_amdgcn_update_dpp(0, __float_as_int(v), 0x143, 0xC, 0xF, false));
    return __int_as_float(__builtin_amdgcn_readlane(__float_as_int(v), 63));
}
__device__ __forceinline__ float wave_sum(float v, int lane) {
#pragma unroll
    for (int o = 32; o >= 1; o >>= 1) v += shx(v, o, lane);
    return v;
}
__device__ __forceinline__ float wave_max(float v, int lane) {
#pragma unroll
    for (int o = 32; o >= 1; o >>= 1) v = fmaxf(v, shx(v, o, lane));
    return v;
}
__device__ __forceinline__ unsigned lds_add(LAS unsigned* p, unsigned v) { return __hip_atomic_fetch_add(p, v, __ATOMIC_RELAXED, __HIP_MEMORY_SCOPE_WORKGROUP); }
__device__ __forceinline__ f32x4 ldx_raw(const void* base, bool f32src, size_t idx) { if (f32src) return *(const f32x4*)((const float*)base + idx); const u32x2 w = *(const u32x2*)((const bf16_t*)base + idx); return (f32x4){__uint_as_float(w.x), __uint_as_float(w.y), 0.f, 0.f}; }
__device__ __forceinline__ f32x4 cvx(const f32x4 raw, bool f32src) { if (f32src) return raw; const unsigned a = __float_as_uint(raw[0]), b = __float_as_uint(raw[1]); return (f32x4){__uint_as_float(a << 16), __uint_as_float(a & 0xffff0000u), __uint_as_float(b << 16), __uint_as_float(b & 0xffff0000u)}; }
__device__ __forceinline__ void stx(bf16_t* p, const f32x4 v) { u32x2 w; w.x = cvt_pk_bf16(v[0], v[1]); w.y = cvt_pk_bf16(v[2], v[3]); *(u32x2*)p = w; }
__device__ __forceinline__ int mod_row(int row) { return row < TL ? (row >> 11) : 8; }
struct Ctx { int bid, nb, wv; };
__device__ __forceinline__ int tidx(const Ctx& cx) { int z = cx.wv << 6; asm volatile("" : "+s"(z)); return (int)__builtin_amdgcn_mbcnt_hi(~0u, __builtin_amdgcn_mbcnt_lo(~0u, (unsigned)z)); }
#define OPQ_S(x) asm volatile("" : "+s"(x))
__device__ __forceinline__ float vmax2(float a, float b) { return __builtin_elementwise_maximum(a, b); }
__device__ __forceinline__ float row4_max(float v) { auto a = __builtin_amdgcn_permlane16_swap(__float_as_uint(v), __float_as_uint(v), false, false); v = vmax2(__uint_as_float(a[0]), __uint_as_float(a[1]));
    auto b = __builtin_amdgcn_permlane32_swap(__float_as_uint(v), __float_as_uint(v), false, false); return vmax2(__uint_as_float(b[0]), __uint_as_float(b[1])); }
__device__ __forceinline__ float row4_sum(float v) { auto a = __builtin_amdgcn_permlane16_swap(__float_as_uint(v), __float_as_uint(v), false, false); v = __uint_as_float(a[0]) + __uint_as_float(a[1]);
    auto b = __builtin_amdgcn_permlane32_swap(__float_as_uint(v), __float_as_uint(v), false, false); return __uint_as_float(b[0]) + __uint_as_float(b[1]); }

__device__ __forceinline__ u32x4 pack8(const float* v) { u32x4 w; w.x = cvt_pk_bf16(v[0], v[1]); w.y = cvt_pk_bf16(v[2], v[3]); w.z = cvt_pk_bf16(v[4], v[5]); w.w = cvt_pk_bf16(v[6], v[7]); return w; }
__device__ __forceinline__ void unpack8(const u32x4 w, float* v) { v[0] = bf_lo(w.x); v[1] = bf_hi(w.x); v[2] = bf_lo(w.y); v[3] = bf_hi(w.y); v[4] = bf_lo(w.z); v[5] = bf_hi(w.z); v[6] = bf_lo(w.w); v[7] = bf_hi(w.w); }
namespace pg8 {
constexpr int BM = 256, BK = 64, HALF = 128, HTB = HALF * BK * 2, STAGE_BYTES = 8 * HTB, NXCD = 8, WGM = 8;
constexpr int CSH_STR = 144, CSH_SLICE = 16 * CSH_STR;
__host__ __device__ __forceinline__ int lds_byte(int r, int c) { const int st = (r >> 4) * 2 + (c >> 5), rr = r & 15, cc = c & 31, ob = rr * 64 + cc * 2; return st * 1024 + (ob ^ (((ob >> 9) & 1) << 5)); }
__host__ __device__ __forceinline__ void stage_rc(int b, int& R, int& C) { const int st = b / 1024, sb = b % 1024, swz = sb ^ (((sb >> 9) & 1) << 5); R = (st >> 1) * 16 + swz / 64; C = (st & 1) * 32 + (swz % 64) / 2; }
__host__ __device__ __forceinline__ int perm32(int rho) { const int n = rho >> 4, i = rho & 15; return 8 * (i >> 2) + 4 * n + (i & 3); }
struct Unit { int pm, pn, kofs, kofsB, nt, part; };

__device__ __forceinline__ bool static_next(int i, int G, int c, int nM, int nN, Unit& u) {
    const int nwg = nM * nN; const long L = (long)i * G + c; if (L >= nwg) return false;
    int wgid = (int)L; { const int q = nwg / NXCD, r = nwg % NXCD, xcd = wgid % NXCD, off = wgid / NXCD; wgid = (xcd < r ? xcd * (q + 1) : r * (q + 1) + (xcd - r) * q) + off; }
    const int nig = WGM * nN, gid = wgid / nig, fm = gid * WGM, gsz = (nM - fm) < WGM ? (nM - fm) : WGM;
    u.pm = fm + ((wgid % nig) % gsz); u.pn = (wgid % nig) / gsz; return true;
}

template <int MODE> struct Prob {
    const bf16_t* A; const bf16_t* Bt; int lda, ldb, K, nM, nN, G, c; const LAS int* texp; size_t bexp; int nctx;
    __device__ __forceinline__ bool next(int i, Unit& u) const {
        u.kofs = 0; u.kofsB = 0; u.nt = K / BK; u.part = -1;
        if (MODE == 3) {
            const int idx = i + (c < nctx ? 0 : 1);
            if (idx == 0) { const int ct = c / 7; u.pm = 64 + (ct >> 2); u.pn = ct & 3; u.part = c - ct * 7; u.nt = K / (7 * BK); u.kofs = u.part * (K / 7); u.kofsB = u.kofs; return true; }
            return static_next(idx - 1, G, c, 64, 4, u);
        }
        if (MODE == 4) { const int seg = i % 3; u.kofs = seg * 512; u.kofsB = u.kofs; u.nt = 8; u.part = seg; return static_next(i / 3, G, c, 64, 4, u); }
        if (MODE == 5) { const int L = i * G + c; if (L >= 192) return false; const int ct = L / 6, sub = L - ct * 6; u.pm = 64 + (ct >> 2); u.pn = ct & 3; u.part = sub; u.nt = 8; u.kofs = (sub >> 1) * 1024 + (sub & 1) * 512; u.kofsB = (sub & 1) * 512; return true; }
        const bool ok = static_next(i, G, c, nM, nN, u);
        if (MODE == 1) { u.kofs = (u.pn >> 2) * 512; u.kofsB = u.kofs; }
        return ok;
    }
    __device__ __forceinline__ const char* a_base(const Unit& u, bool ablk) const { return (const char*)(A + (size_t)u.pm * BM * lda + (ablk ? 2 * u.kofs : u.kofs)); }
    __device__ __forceinline__ const char* b_base(const Unit& u) const { const bf16_t* p = Bt + (size_t)(MODE == 1 ? (u.pn & 3) : u.pn) * BM * ldb + 2 * u.kofsB; if (MODE == 2) p += (size_t)texp[u.pm] * bexp; return (const char*)p; }
};

template <class Epi, class PB, int ABLK>
__device__ __forceinline__ void gemm_phase(LAS unsigned char* lds, const PB& P, const Epi& E, const Ctx cx) {
    const int tid = tidx(cx), wid = __builtin_amdgcn_readfirstlane(tid >> 6), lane = tid & 63, wr = wid >> 2, wc = wid & 3, fr = lane & 15, fq = lane >> 4;
    unsigned voffA[2], voffB[2];
#pragma unroll
    for (int i = 0; i < 2; ++i) { int R, C; stage_rc(tid * 16 + i * 8192, R, C); const int Rb = (int)Epi::PERM == 2 ? (2 * (R & ~31) + perm32(R & 31)) : Epi::PERM ? ((R & ~31) + perm32(R & 31)) : R;
        voffA[i] = ABLK ? (unsigned)((((R >> 1) * (P.lda >> 5) + (C >> 5)) * 64 + (R & 1) * 32 + (C & 31)) * 2) : (unsigned)(R * P.lda + C) * 2u;     voffB[i] = (unsigned)((((Rb >> 1) * (P.ldb >> 5) + (C >> 5)) * 64 + (Rb & 1) * 32 + (C & 31)) * 2);     }
    const size_t kstep = (size_t)(BK * 4), kstepA = ABLK ? (size_t)(BK * 4) : (size_t)(BK * 2);
    const size_t hstepA = (size_t)HALF * P.lda * 2, hstepB = (size_t)((int)Epi::PERM == 2 ? 32 : HALF) * P.ldb * 2;
    const unsigned ldsw = (unsigned)wid * 1024u;
    const int aoff = lds_byte(wr * 64 + fr, fq * 8), boff = lds_byte(wc * 32 + fr, fq * 8);
#define PG8_SA(b, h) (((b) * 2 + (h)) * HTB)
#define PG8_SB(b, h) ((4 + (b) * 2 + (h)) * HTB)
#define PG8_STAGE(bufoff, gbase, voff) do { _Pragma("unroll") for (int _i = 0; _i < 2; ++_i) \
        __builtin_amdgcn_global_load_lds((const unsigned*)((const char*)(gbase) + (voff)[_i]), (LAS unsigned*)(lds + (bufoff) + ldsw + _i * 8192), 16, 0, 0); } while (0)
#define PG8_LDA(dst, b, h) do { _Pragma("unroll") for (int m = 0; m < 4; ++m) _Pragma("unroll") for (int k = 0; k < 2; ++k) dst[m][k] = *(const LAS bf16x8*)(lds + PG8_SA(b, h) + aoff + m * 2048 + k * 1024); } while (0)
#define PG8_LDB(dst, b, h) do { _Pragma("unroll") for (int n = 0; n < 2; ++n) _Pragma("unroll") for (int k = 0; k < 2; ++k) dst[n][k] = *(const LAS bf16x8*)(lds + PG8_SB(b, h) + boff + n * 2048 + k * 1024); } while (0)
#define PG8_MMA(ai, bj, At, Bt) do { __builtin_amdgcn_s_setprio(1); _Pragma("unroll") for (int m = 0; m < 4; ++m) _Pragma("unroll") for (int n = 0; n < 2; ++n) _Pragma("unroll") for (int k = 0; k < 2; ++k) \
        acc[ai][bj][m][n] = __builtin_amdgcn_mfma_f32_16x16x32_bf16(Bt[n][k], At[m][k], acc[ai][bj][m][n], 0, 0, 0); __builtin_amdgcn_s_setprio(0); } while (0)
#define PG8_WAIT_V(n) asm volatile("s_waitcnt vmcnt(" #n ")" ::: "memory")
#define PG8_WAIT_L(n) asm volatile("s_waitcnt lgkmcnt(" #n ")" ::: "memory")
#define PG8_BAR __builtin_amdgcn_s_barrier()
#define PG8_SCHED __builtin_amdgcn_sched_barrier(0)
    Unit cur, nxt; int ui = 0;
    if (!P.next(0, cur)) return;
    f32x4 acc[2][2][4][2];
#pragma unroll
    for (int a = 0; a < 2; ++a)
#pragma unroll
        for (int b = 0; b < 2; ++b)
#pragma unroll
            for (int m = 0; m < 4; ++m)
#pragma unroll
                for (int n = 0; n < 2; ++n) acc[a][b][m][n] = (f32x4){0.f, 0.f, 0.f, 0.f};
    bf16x8 At[4][2], B0[2][2], B1[2][2];
    const char* cA = P.a_base(cur, ABLK != 0); const char* cB = P.b_base(cur);
    PG8_STAGE(PG8_SB(0, 0), cB, voffB); PG8_STAGE(PG8_SB(0, 1), cB + hstepB, voffB); PG8_STAGE(PG8_SA(0, 0), cA, voffA); PG8_STAGE(PG8_SA(0, 1), cA + hstepA, voffA);
    if (wr == 1) PG8_BAR;
    PG8_WAIT_V(2); PG8_BAR;
    PG8_STAGE(PG8_SB(1, 0), cB + kstep, voffB); PG8_STAGE(PG8_SA(1, 0), cA + kstepA, voffA); PG8_STAGE(PG8_SB(1, 1), cB + hstepB + kstep, voffB);
    PG8_WAIT_V(6); PG8_BAR;
    for (;;) {
        const bool has_next = P.next(ui + 1, nxt);
        const char* nA = has_next ? P.a_base(nxt, ABLK != 0) : cA; const char* nB = has_next ? P.b_base(nxt) : cB;
        const int nt = cur.nt;
        for (int t = 0; t < nt; t += 2) {
            const bool last = (t == nt - 2);
            const char* a1 = cA + (size_t)(t + 1) * kstepA;
            const char* a2 = last ? nA : cA + (size_t)(t + 2) * kstepA; const char* b2 = last ? nB : cB + (size_t)(t + 2) * kstep;
            const char* a3 = a2 + kstepA; const char* b3 = b2 + kstep;
            PG8_LDB(B0, 0, 0); PG8_LDB(B1, 0, 1); PG8_SCHED; PG8_LDA(At, 0, 0); PG8_STAGE(PG8_SA(1, 1), a1 + hstepA, voffA);
            PG8_WAIT_V(8); PG8_WAIT_L(0); PG8_BAR; PG8_MMA(0, 0, At, B0); PG8_MMA(0, 1, At, B1); PG8_BAR; PG8_SCHED;
            PG8_LDA(At, 0, 1); PG8_STAGE(PG8_SB(0, 0), b2, voffB); PG8_STAGE(PG8_SB(0, 1), b2 + hstepB, voffB); PG8_STAGE(PG8_SA(0, 0), a2, voffA);
            PG8_WAIT_V(8); PG8_WAIT_L(0); PG8_BAR; PG8_MMA(1, 0, At, B0); PG8_MMA(1, 1, At, B1); PG8_BAR; PG8_SCHED;
            PG8_LDB(B0, 1, 0); PG8_LDB(B1, 1, 1); PG8_SCHED; PG8_LDA(At, 1, 0); PG8_STAGE(PG8_SA(0, 1), a2 + hstepA, voffA);
            PG8_WAIT_V(8); PG8_WAIT_L(0); PG8_BAR; PG8_MMA(0, 0, At, B0); PG8_MMA(0, 1, At, B1); PG8_BAR; PG8_SCHED;
            PG8_LDA(At, 1, 1); PG8_STAGE(PG8_SB(1, 0), b3, voffB); PG8_STAGE(PG8_SB(1, 1), b3 + hstepB, voffB); PG8_STAGE(PG8_SA(1, 0), a3, voffA);
            PG8_WAIT_V(8); PG8_WAIT_L(0); PG8_BAR; PG8_MMA(1, 0, At, B0); PG8_MMA(1, 1, At, B1); PG8_BAR; PG8_SCHED;
        }
        if (wr == 0) PG8_BAR;
        E(acc, cur, wr, wc, fr, fq);
        if (!has_next) break;
#pragma unroll
        for (int a = 0; a < 2; ++a)
#pragma unroll
            for (int b = 0; b < 2; ++b)
#pragma unroll
                for (int m = 0; m < 4; ++m)
#pragma unroll
                    for (int n = 0; n < 2; ++n) acc[a][b][m][n] = (f32x4){0.f, 0.f, 0.f, 0.f};
        cur = nxt; cA = nA; cB = nB; ++ui;
        if (wr == 1) PG8_BAR;
    }
    PG8_WAIT_V(0);
    PG8_BAR;
#undef PG8_SA
#undef PG8_SB
#undef PG8_STAGE
#undef PG8_LDA
#undef PG8_LDB
#undef PG8_MMA
#undef PG8_WAIT_V
#undef PG8_WAIT_L
#undef PG8_BAR
#undef PG8_SCHED
}

__device__ __forceinline__ void relay16(const f32x4 (&a)[2][2], LAS unsigned char* wp, const LAS unsigned char* rp, u32x4 (&x)[2]) {
#pragma unroll
    for (int bj = 0; bj < 2; ++bj) { u32x4 w; w.x = cvt_pk_bf16(a[bj][0][0], a[bj][0][1]); w.y = cvt_pk_bf16(a[bj][0][2], a[bj][0][3]); w.z = cvt_pk_bf16(a[bj][1][0], a[bj][1][1]); w.w = cvt_pk_bf16(a[bj][1][2], a[bj][1][3]);
        *(LAS u32x4*)(wp + bj * 64) = w; }
    asm volatile("" ::: "memory"); __builtin_amdgcn_wave_barrier();
    x[0] = *(const LAS u32x4*)rp; x[1] = *(const LAS u32x4*)(rp + 8 * CSH_STR);
    asm volatile("" ::: "memory"); __builtin_amdgcn_wave_barrier();
}
__device__ __forceinline__ u32x4 gate8x(const u32x4& x, const u32x4& g, const u32x4& o) {
    float xv[8], gv[8], ov[8]; unpack8(x, xv); unpack8(g, gv); unpack8(o, ov);
#pragma unroll
    for (int e = 0; e < 8; ++e) ov[e] += xv[e] * sigmoidf_(gv[e]);
    return pack8(ov);
}
struct EpiBf16 {
    static constexpr int PERM = 2;
    bf16_t* O; LAS unsigned char* sh; int ldc; int pad_;
    __device__ __forceinline__ void operator()(const f32x4 (&acc)[2][2][4][2], const Unit& u, int wr, int wc, int fr, int fq) const {
        LAS unsigned char* my = sh + (wr * 4 + wc) * CSH_SLICE; const int lane = fq * 16 + fr, r8 = lane >> 3, c8 = lane & 7;
        LAS unsigned char* wp = my + fr * CSH_STR + fq * 16; const LAS unsigned char* rp = my + r8 * CSH_STR + c8 * 16;
        bf16_t* ob = O + (size_t)(u.pm * BM + wr * 64 + r8) * ldc + u.pn * BM + wc * 64 + 8 * c8;
#pragma unroll
        for (int ai = 0; ai < 2; ++ai)
#pragma unroll
            for (int m = 0; m < 4; ++m) { u32x4 x[2];
                const f32x4 a[2][2] = {{acc[ai][0][m][0], acc[ai][0][m][1]}, {acc[ai][1][m][0], acc[ai][1][m][1]}};
                relay16(a, wp, rp, x);
                bf16_t* rowp = ob + (size_t)(ai * HALF + m * 16) * ldc;
                *(u32x4*)rowp = x[0]; *(u32x4*)(rowp + (size_t)8 * ldc) = x[1]; }
    }
};
struct EpiWin {
    static constexpr int PERM = 2;
    bf16_t* O; bf16_t* QR; bf16_t* KV; const f32x2* CS; LAS unsigned char* sh;
    __device__ __forceinline__ void operator()(const f32x4 (&acc)[2][2][4][2], const Unit& u, int wr, int wc, int fr, int fq) const {
        const int row0 = u.pm * BM + wr * 64 + fr;
        if (u.pn < 6 || u.pn > 8) {
            LAS unsigned char* my = sh + (wr * 4 + wc) * CSH_SLICE; const int lane = fq * 16 + fr, r8 = lane >> 3, c8 = lane & 7;
            LAS unsigned char* wp = my + fr * CSH_STR + fq * 16; const LAS unsigned char* rp = my + r8 * CSH_STR + c8 * 16;
            bf16_t* ob = O + (size_t)(u.pm * BM + wr * 64 + r8) * NP + u.pn * BM + wc * 64 + 8 * c8;
#pragma unroll
            for (int ai = 0; ai < 2; ++ai)
#pragma unroll
                for (int m = 0; m < 4; ++m) {
#pragma unroll
                    for (int bj = 0; bj < 2; ++bj) { const f32x4 v0 = acc[ai][bj][m][0], v1 = acc[ai][bj][m][1];
                        u32x4 w; w.x = cvt_pk_bf16(v0[0], v0[1]); w.y = cvt_pk_bf16(v0[2], v0[3]); w.z = cvt_pk_bf16(v1[0], v1[1]); w.w = cvt_pk_bf16(v1[2], v1[3]);
                        *(LAS u32x4*)(wp + bj * 64) = w; }
                    asm volatile("" ::: "memory"); __builtin_amdgcn_wave_barrier();
                    const u32x4 x0 = *(const LAS u32x4*)rp, x1 = *(const LAS u32x4*)(rp + 8 * CSH_STR);
                    asm volatile("" ::: "memory"); __builtin_amdgcn_wave_barrier();
                    bf16_t* rowp = ob + (size_t)(ai * HALF + m * 16) * NP;
                    *(u32x4*)rowp = x0; *(u32x4*)(rowp + (size_t)8 * NP) = x1; }
            return;
        }
        const bool lat = u.pm < 64; const bool isq = u.pn < 8; const bool rot = isq || wc < 2;
#pragma unroll
        for (int ai = 0; ai < 2; ++ai)
#pragma unroll
            for (int m = 0; m < 4; ++m) { const int row = row0 + ai * HALF + m * 16; const int sp = row & (SEQ - 1);
#pragma unroll
                for (int bj = 0; bj < 2; ++bj) { const f32x4 v0 = acc[ai][bj][m][0], v1 = acc[ai][bj][m][1]; float o[8];
                    const int ps = bj ? (sp & 63) : (sp >> 6);
                    f32x4 c01 = (f32x4){1.f, 0.f, 1.f, 0.f}, c23 = c01;
                    if (lat && rot) { const f32x4* cp = (const f32x4*)(CS + ps * 16 + 4 * fq); c01 = cp[0]; c23 = cp[1]; }
                    if (rot) {
                        o[0] = v0[0] * c01[0] - v0[1] * c01[1]; o[1] = v0[1] * c01[0] + v0[0] * c01[1]; o[2] = v0[2] * c01[2] - v0[3] * c01[3]; o[3] = v0[3] * c01[2] + v0[2] * c01[3];
                        o[4] = v1[0] * c23[0] - v1[1] * c23[1]; o[5] = v1[1] * c23[0] + v1[0] * c23[1]; o[6] = v1[2] * c23[2] - v1[3] * c23[3]; o[7] = v1[3] * c23[2] + v1[2] * c23[3];
                    } else { o[0] = v0[0]; o[1] = v0[1]; o[2] = v0[2]; o[3] = v0[3]; o[4] = v1[0]; o[5] = v1[1]; o[6] = v1[2]; o[7] = v1[3]; }
                    u32x4 w;
                    if (isq) { w.x = cvt_pk_bf16(o[0] * QSCALE, o[1] * QSCALE); w.y = cvt_pk_bf16(o[2] * QSCALE, o[3] * QSCALE); w.z = cvt_pk_bf16(o[4] * QSCALE, o[5] * QSCALE); w.w = cvt_pk_bf16(o[6] * QSCALE, o[7] * QSCALE);
                        *(u32x4*)(QR + (size_t)row * 512 + (u.pn - 6) * 256 + wc * 64 + bj * 32 + 8 * fq) = w; }
                    else { w.x = cvt_pk_bf16(o[0], o[1]); w.y = cvt_pk_bf16(o[2], o[3]); w.z = cvt_pk_bf16(o[4], o[5]); w.w = cvt_pk_bf16(o[6], o[7]);
                        *(u32x4*)(KV + (size_t)row * 256 + wc * 64 + bj * 32 + 8 * fq) = w; } } }
    }
};
__device__ __forceinline__ u32x4 gate8(const f32x4& v0, const f32x4& v1, const u32x4& g) {
    u32x4 w;
    w.x = cvt_pk_bf16(v0[0] * sigmoidf_(bf_lo(g.x)), v0[1] * sigmoidf_(bf_hi(g.x))); w.y = cvt_pk_bf16(v0[2] * sigmoidf_(bf_lo(g.y)), v0[3] * sigmoidf_(bf_hi(g.y)));
    w.z = cvt_pk_bf16(v1[0] * sigmoidf_(bf_lo(g.z)), v1[1] * sigmoidf_(bf_hi(g.z))); w.w = cvt_pk_bf16(v1[2] * sigmoidf_(bf_lo(g.w)), v1[3] * sigmoidf_(bf_hi(g.w))); return w; }
__device__ __forceinline__ u32x4 gate8acc(const f32x4& v0, const f32x4& v1, const u32x4& g, const u32x4& o) {
    u32x4 w;
    w.x = cvt_pk_bf16(bf_lo(o.x) + v0[0] * sigmoidf_(bf_lo(g.x)), bf_hi(o.x) + v0[1] * sigmoidf_(bf_hi(g.x))); w.y = cvt_pk_bf16(bf_lo(o.y) + v0[2] * sigmoidf_(bf_lo(g.y)), bf_hi(o.y) + v0[3] * sigmoidf_(bf_hi(g.y)));
    w.z = cvt_pk_bf16(bf_lo(o.z) + v1[0] * sigmoidf_(bf_lo(g.z)), bf_hi(o.z) + v1[1] * sigmoidf_(bf_hi(g.z))); w.w = cvt_pk_bf16(bf_lo(o.w) + v1[2] * sigmoidf_(bf_lo(g.w)), bf_hi(o.w) + v1[3] * sigmoidf_(bf_hi(g.w))); return w; }
struct EpiGate {
    static constexpr int PERM = 2;
    bf16_t* O; const bf16_t* Pg; LAS unsigned char* sh;
    __device__ __forceinline__ void operator()(const f32x4 (&acc)[2][2][4][2], const Unit& u, int wr, int wc, int fr, int fq) const {
        LAS unsigned char* my = sh + (wr * 4 + wc) * CSH_SLICE; const int lane = fq * 16 + fr, r8 = lane >> 3, c8 = lane & 7;
        LAS unsigned char* wp = my + fr * CSH_STR + fq * 16; const LAS unsigned char* rp = my + r8 * CSH_STR + c8 * 16;
        const int rowb = u.pm * BM + wr * 64 + r8, colb = u.pn * BM + wc * 64 + 8 * c8;
#pragma unroll
        for (int ai = 0; ai < 2; ++ai)
#pragma unroll
            for (int m = 0; m < 4; ++m) { const size_t row = (size_t)(rowb + ai * HALF + m * 16);
                u32x4 g[2], x[2];
#pragma unroll
                for (int hh = 0; hh < 2; ++hh) g[hh] = *(const u32x4*)(Pg + (row + 8 * hh) * NP + P_GATE + colb);
                const f32x4 a[2][2] = {{acc[ai][0][m][0], acc[ai][0][m][1]}, {acc[ai][1][m][0], acc[ai][1][m][1]}};
                relay16(a, wp, rp, x);
#pragma unroll
                for (int hh = 0; hh < 2; ++hh) *(u32x4*)(O + (row + 8 * hh) * 3072 + colb) = gate8x(x[hh], g[hh], (u32x4){0u, 0u, 0u, 0u}); }
    }
};
struct EpiMerge {
    static constexpr int PERM = 2;
    bf16_t* MG; const bf16_t* Pg; LAS unsigned char* sh;
    __device__ __forceinline__ void operator()(const f32x4 (&acc)[2][2][4][2], const Unit& u, int wr, int wc, int fr, int fq) const {
        LAS unsigned char* my = sh + (wr * 4 + wc) * CSH_SLICE; const int lane = fq * 16 + fr, r8 = lane >> 3, c8 = lane & 7;
        LAS unsigned char* wp = my + fr * CSH_STR + fq * 16; const LAS unsigned char* rp = my + r8 * CSH_STR + c8 * 16;
        const int rowb = u.pm * BM + wr * 64 + r8, colb = u.pn * BM + wc * 64 + 8 * c8; const int gcol = P_GATE + u.part * 1024 + colb;
#pragma unroll
        for (int ai = 0; ai < 2; ++ai)
#pragma unroll
            for (int m = 0; m < 4; ++m) { const size_t row = (size_t)(rowb + ai * HALF + m * 16);
                u32x4 g[2], o[2], x[2];
#pragma unroll
                for (int hh = 0; hh < 2; ++hh) { g[hh] = *(const u32x4*)(Pg + (row + 8 * hh) * NP + gcol); o[hh] = u.part ? *(const u32x4*)(MG + (row + 8 * hh) * D + colb) : (u32x4){0u, 0u, 0u, 0u}; }
                const f32x4 a[2][2] = {{acc[ai][0][m][0], acc[ai][0][m][1]}, {acc[ai][1][m][0], acc[ai][1][m][1]}};
                relay16(a, wp, rp, x);
#pragma unroll
                for (int hh = 0; hh < 2; ++hh) *(u32x4*)(MG + (row + 8 * hh) * D + colb) = gate8x(x[hh], g[hh], o[hh]); }
    }
};
struct EpiResid {
    static constexpr int PERM = 2;
    bf16_t* X; const float* modg; float* PART; const void* Xold; LAS unsigned char* sh; int oldf32; int pad_;
    __device__ __forceinline__ void operator()(const f32x4 (&acc)[2][2][4][2], const Unit& u, int wr, int wc, int fr, int fq) const {
        if (u.part >= 0) {
            LAS unsigned char* my = sh + (wr * 4 + wc) * CSH_SLICE; const int lane = fq * 16 + fr, r8 = lane >> 3, c8 = lane & 7;
            LAS unsigned char* wp = my + fr * CSH_STR + fq * 32; const LAS unsigned char* rp = my + r8 * CSH_STR + c8 * 16;
            float* pb = PART + ((size_t)u.part * TC + (u.pm * BM + wr * 64 + r8 - TL)) * D + u.pn * BM + wc * 64 + 4 * c8;
#pragma unroll
            for (int ai = 0; ai < 2; ++ai)
#pragma unroll
                for (int m = 0; m < 4; ++m) { float* rowp = pb + (size_t)(ai * HALF + m * 16) * D;
#pragma unroll
                    for (int bj = 0; bj < 2; ++bj) {
                        *(LAS f32x4*)wp = acc[ai][bj][m][0]; *(LAS f32x4*)(wp + 16) = acc[ai][bj][m][1];
                        asm volatile("" ::: "memory"); __builtin_amdgcn_wave_barrier();
                        const f32x4 x0 = *(const LAS f32x4*)rp, x1 = *(const LAS f32x4*)(rp + 8 * CSH_STR);
                        asm volatile("" ::: "memory"); __builtin_amdgcn_wave_barrier();
                        *(f32x4*)(rowp + bj * 32) = x0; *(f32x4*)(rowp + (size_t)8 * D + bj * 32) = x1; } }
            return;
        }
        const float* mg = modg + (size_t)mod_row(u.pm * BM) * 6144 + u.pn * BM + wc * 64 + 8 * fq;
        f32x4 gv[2][2];
#pragma unroll
        for (int bj = 0; bj < 2; ++bj)
#pragma unroll
            for (int n = 0; n < 2; ++n) gv[bj][n] = *(const f32x4*)(mg + bj * 32 + n * 4);
        LAS unsigned char* my = sh + (wr * 4 + wc) * CSH_SLICE; const int lane = fq * 16 + fr, r8 = lane >> 3, c8 = lane & 7;
        LAS unsigned char* wp = my + fr * CSH_STR + fq * 16; const LAS unsigned char* rp = my + r8 * CSH_STR + c8 * 16;
        const size_t ro0 = (size_t)(u.pm * BM + wr * 64 + r8) * D + u.pn * BM + wc * 64 + 8 * c8;
#pragma unroll
        for (int ai = 0; ai < 2; ++ai)
#pragma unroll
            for (int m = 0; m < 4; ++m) { const size_t ro = ro0 + (size_t)(ai * HALF + m * 16) * D;
                f32x4 oa[2][2];
#pragma unroll
                for (int hh = 0; hh < 2; ++hh) { const size_t rr = ro + (size_t)hh * 8 * D;
                    if (oldf32) { oa[hh][0] = *(const f32x4*)((const float*)Xold + rr); oa[hh][1] = *(const f32x4*)((const float*)Xold + rr + 4); }
                    else { const u32x4 w = *(const u32x4*)((const bf16_t*)Xold + rr); oa[hh][0] = (f32x4){__uint_as_float(w.x), __uint_as_float(w.y), __uint_as_float(w.z), __uint_as_float(w.w)}; oa[hh][1] = oa[hh][0]; } }
#pragma unroll
                for (int bj = 0; bj < 2; ++bj) { const f32x4 v0 = gv[bj][0] * acc[ai][bj][m][0], v1 = gv[bj][1] * acc[ai][bj][m][1];
                    u32x4 w; w.x = cvt_pk_bf16(v0[0], v0[1]); w.y = cvt_pk_bf16(v0[2], v0[3]); w.z = cvt_pk_bf16(v1[0], v1[1]); w.w = cvt_pk_bf16(v1[2], v1[3]);
                    *(LAS u32x4*)(wp + bj * 64) = w; }
                asm volatile("" ::: "memory"); __builtin_amdgcn_wave_barrier();
                u32x4 dx[2]; dx[0] = *(const LAS u32x4*)rp; dx[1] = *(const LAS u32x4*)(rp + 8 * CSH_STR);
                asm volatile("" ::: "memory"); __builtin_amdgcn_wave_barrier();
#pragma unroll
                for (int hh = 0; hh < 2; ++hh) { float o[8], dl[8]; unpack8(dx[hh], dl);
                    if (oldf32) { o[0] = oa[hh][0][0]; o[1] = oa[hh][0][1]; o[2] = oa[hh][0][2]; o[3] = oa[hh][0][3]; o[4] = oa[hh][1][0]; o[5] = oa[hh][1][1]; o[6] = oa[hh][1][2]; o[7] = oa[hh][1][3]; }
                    else { u32x4 w; w.x = __float_as_uint(oa[hh][0][0]); w.y = __float_as_uint(oa[hh][0][1]); w.z = __float_as_uint(oa[hh][0][2]); w.w = __float_as_uint(oa[hh][0][3]); unpack8(w, o); }
#pragma unroll
                    for (int e = 0; e < 8; ++e) o[e] += dl[e];
                    *(u32x4*)(X + ro + (size_t)hh * 8 * D) = pack8(o); } }
    }
};
struct EpiSwiglu {
    static constexpr bool PERM = true;
    bf16_t* O;
    __device__ __forceinline__ void operator()(const f32x4 (&acc)[2][2][4][2], const Unit& u, int wr, int wc, int fr, int fq) const {
        const int row0 = u.pm * BM + wr * 64 + fr; const int chunk = u.pn * 4 + wc;
#pragma unroll
        for (int ai = 0; ai < 2; ++ai)
#pragma unroll
            for (int m = 0; m < 4; ++m) { const int row = row0 + ai * HALF + m * 16; bf16_t* rowp = O + ((size_t)(row >> 1) * (DFF / 32) + chunk) * 64 + (row & 1) * 32 + 8 * fq;
                const f32x4 a0 = acc[ai][0][m][0], a1 = acc[ai][0][m][1], b0 = acc[ai][1][m][0], b1 = acc[ai][1][m][1];
                u32x4 w; w.x = cvt_pk_bf16(swg_(a0[0], b0[0]), swg_(a0[1], b0[1])); w.y = cvt_pk_bf16(swg_(a0[2], b0[2]), swg_(a0[3], b0[3]));
                w.z = cvt_pk_bf16(swg_(a1[0], b1[0]), swg_(a1[1], b1[1])); w.w = cvt_pk_bf16(swg_(a1[2], b1[2]), swg_(a1[3], b1[3]));
                *(u32x4*)rowp = w; }
    }
};
}

#define XB_TMO      128
#define XB_XCNT(j)  (256  + 64 * (j))
#define XB_XSUB(j)  (1280 + 64 * (j))
#define XB_XGEN(j)  (2304 + 64 * (j))
#define XB_TOP      3328
#define XB_TOPGEN   3392
#define XCD_BAR_WORDS 3456
#define XB_SPIN_CAP (1u << 18)
__device__ __forceinline__ unsigned xb_ld(unsigned* p)              { return __hip_atomic_load(p, __ATOMIC_RELAXED, __HIP_MEMORY_SCOPE_AGENT); }
__device__ __forceinline__ unsigned xb_add(unsigned* p, unsigned v) { return __hip_atomic_fetch_add(p, v, __ATOMIC_RELAXED, __HIP_MEMORY_SCOPE_AGENT); }
__device__ __forceinline__ unsigned xb_xcc_id() { return (unsigned)__builtin_amdgcn_s_getreg((3 << 11) | 20) & 0xFu; }
#define XB_SPIN(cond, bar) do { unsigned _sp = 0; while (cond) { __builtin_amdgcn_s_sleep(1); \
    if ((++_sp & 255u) == 0u) { if (xb_ld(&(bar)[XB_TMO])) break; if (_sp > XB_SPIN_CAP) { atomicAdd(&(bar)[XB_TMO], 1u); break; } } } } while (0)
struct XcdBarrier { unsigned* bar; unsigned x; volatile LAS unsigned* st; };
__device__ __forceinline__ XcdBarrier xcd_barrier_post(unsigned* bar, volatile LAS unsigned* st) {
    XcdBarrier b; b.bar = bar; b.x = (unsigned)__builtin_amdgcn_readfirstlane((int)xb_xcc_id()); b.st = st;
    if (threadIdx.x == 0) (void)xb_add(&bar[XB_XCNT(b.x)], 1u);
    return b;
}
__device__ __forceinline__ void xcd_barrier_complete(unsigned* bar, unsigned x, unsigned& nloc, unsigned& nx) {
    const unsigned G = gridDim.x * gridDim.y * gridDim.z;
    unsigned sum, cnt, mine, sp = 0u;
    for (;;) {
        sum = 0u; cnt = 0u; mine = 0u;
#pragma unroll
        for (unsigned j = 0; j < 16; ++j) { const unsigned c = xb_ld(&bar[XB_XCNT(j)]); sum += c; cnt += (c > 0u) ? 1u : 0u; mine = (j == x) ? c : mine; }
        if (sum == G) break;
        __builtin_amdgcn_s_sleep(1);
        if ((++sp & 255u) == 0u) { if (xb_ld(&bar[XB_TMO])) break; if (sp > XB_SPIN_CAP) { atomicAdd(&bar[XB_TMO], 1u); break; } }
    }
    nloc = mine > 0u ? mine : 1u; nx = cnt > 0u ? cnt : 1u;
}
template <bool FIRST> __device__ __forceinline__ void xcd_barrier_t(const XcdBarrier& b, const Ctx cx) {
    asm volatile("s_waitcnt vmcnt(0)" ::: "memory");
    __syncthreads();
    if (tidx(cx) == 0) {
        unsigned* bar = b.bar; unsigned bx = b.x; OPQ_S(bar); OPQ_S(bx);
        __builtin_amdgcn_s_waitcnt(0);
        unsigned nloc = b.st[0], nx = b.st[1];
        if (FIRST) { if (nloc == 0u) { xcd_barrier_complete(bar, bx, nloc, nx); b.st[0] = nloc; b.st[1] = nx; } }
        const unsigned old = xb_add(&bar[XB_XSUB(bx)], 1u);
        const unsigned gen = old / nloc;
        if (old + 1u == (gen + 1u) * nloc) {
            __builtin_amdgcn_fence(__ATOMIC_RELEASE, "agent");
            asm volatile("s_waitcnt vmcnt(0)" ::: "memory");
            const unsigned og = xb_add(&bar[XB_TOP], 1u);
            const unsigned tg = og / nx;
            if (og + 1u == (tg + 1u) * nx) xb_add(&bar[XB_TOPGEN], 1u);
            else XB_SPIN(xb_ld(&bar[XB_TOPGEN]) == tg, bar);
            __builtin_amdgcn_fence(__ATOMIC_ACQUIRE, "agent");
            xb_add(&bar[XB_XGEN(bx)], 1u);
            asm volatile("s_waitcnt vmcnt(0)" ::: "memory");
        } else {
            XB_SPIN(xb_ld(&bar[XB_XGEN(bx)]) == gen, bar);
            __builtin_amdgcn_fence(__ATOMIC_ACQUIRE, "agent");
            asm volatile("s_waitcnt vmcnt(0)" ::: "memory");
        }
    }
    __syncthreads();
}
__device__ __forceinline__ void xcd_barrier_first(const XcdBarrier& b, const Ctx cx) { xcd_barrier_t<true>(b, cx); }
__device__ __forceinline__ void xcd_barrier(const XcdBarrier& b, const Ctx cx) { xcd_barrier_t<false>(b, cx); }

constexpr int LDS_TEXP = 139264, LDS_BARW = LDS_TEXP + 1024, LDS_SBASE = LDS_BARW + 16, LDS_CSH = LDS_SBASE + 64 + 176 + 256, LDS_BYTES = LDS_CSH + 8 * pg8::CSH_SLICE;
constexpr int CW_BAR = 4096;

#define MMA16(acc, afrag, bfrag) acc = __builtin_amdgcn_mfma_f32_16x16x32_bf16(bfrag, afrag, acc, 0, 0, 0)
typedef short s16x4 __attribute__((ext_vector_type(4)));
constexpr int STR64 = 144, STR128 = 272;
__device__ __forceinline__ bf16x8 frag_row(const LAS unsigned char* img, int r, int k0, int stride) { return *(const LAS bf16x8*)(img + r * stride + k0 * 2); }
__device__ __forceinline__ bf16x8 frag_tr(const LAS unsigned char* img, int rowlo, int rowhi, int x0, int stride, int fr) {
    const int q = fr >> 2, p = fr & 3;
    const s16x4 lo = __builtin_amdgcn_ds_read_tr16_b64_v4i16((LAS s16x4*)(img + (rowlo + q) * stride + x0 * 2 + 8 * p));
    const s16x4 hi = __builtin_amdgcn_ds_read_tr16_b64_v4i16((LAS s16x4*)(img + (rowhi + q) * stride + x0 * 2 + 8 * p));
    return __builtin_shufflevector(lo, hi, 0, 1, 2, 3, 4, 5, 6, 7);
}

struct CvtJob { const float* s0; const float* s1; bf16_t* dst; int ldw, ldd, kd0, K, Nd, kind; };
__device__ __forceinline__ CvtJob mkjob(const float* s0, const float* s1, bf16_t* dst, int ldw, int ldd, int kd0, int K, int Nd, int kind) { CvtJob j; j.s0 = s0; j.s1 = s1; j.dst = dst; j.ldw = ldw; j.ldd = ldd; j.kd0 = kd0; j.K = K; j.Nd = Nd; j.kind = kind; return j; }
constexpr int CV_STR = 144;
__device__ __forceinline__ void cvt_src(const CvtJob& j, int n0, int n, const float*& src, int& col) {
    const int nh = n0 + (n & 32); src = j.s0; int sc = nh;
    if (j.kind == 1) { sc = nh < 3840 ? nh : (nh < 6912 ? nh + 32 : (nh < 6944 ? nh - 3072 : -1)); }
    else if (j.kind == 2) { const int tj = nh >> 8, r = nh & 255; if (r < 128) { sc = tj * 128 + r; } else { src = j.s1; sc = tj * 128 + r - 128; } }
    col = sc < 0 ? -1 : sc + (n & 31);
}
__device__ __forceinline__ void ph_convert(const CvtJob& j, LAS unsigned char* lds, const Ctx cx, int& rot) {
    const int tid = tidx(cx), c16 = tid & 15, kr = tid >> 4, lane = tid & 63, wid = tid >> 6, fr = lane & 15, fq = lane >> 4;
    const int kch = j.K / 256, nitems = (j.Nd / 64) * kch;
    int first = cx.bid - rot; if (first < 0) first += cx.nb;
    f32x4 v[8];
    auto issue = [&](int it) { const int nbk = it / kch, kc = it % kch, n0 = nbk * 64, k0 = kc * 256; const float* src; int col; cvt_src(j, n0, c16 * 4, src, col);
#pragma unroll
        for (int p = 0; p < 8; ++p) v[p] = col >= 0 ? *(const f32x4*)(src + (size_t)(k0 + p * 32 + kr) * j.ldw + col) : (f32x4){0.f, 0.f, 0.f, 0.f}; };
    if (first < nitems) issue(first);
    for (int it = first; it < nitems; it += cx.nb) {
        const int nbk = it / kch, kc = it % kch, n0 = nbk * 64, k0 = kc * 256;
        if (j.kind == 1 && n0 >= P_QA && n0 < P_VA) {
            const int e = (c16 * 4) & 31, blk = (c16 * 4) & 32;
#pragma unroll
            for (int p = 0; p < 8; ++p) { const unsigned w0 = cvt_pk_bf16(v[p][0], v[p][1]), w1 = cvt_pk_bf16(v[p][2], v[p][3]); LAS bf16_t* rowp = (LAS bf16_t*)(lds + (p * 32 + kr) * CV_STR) + blk;
#pragma unroll
                for (int q = 0; q < 4; ++q) { const int ee = e + q, pos = ee < 16 ? 2 * ee : 2 * (ee - 16) + 1; const unsigned w = q < 2 ? w0 : w1; rowp[pos] = (bf16_t)((q & 1) ? (w >> 16) : (w & 0xffffu)); } }
        } else {
        const float wsc = (j.kind == 2) ? ((((n0 + ((c16 * 4) & 32)) & 255) < 128) ? -LOG2E : -1.0f / LOG2E) : 1.0f;
#pragma unroll
        for (int p = 0; p < 8; ++p) { u32x2 w; w.x = cvt_pk_bf16(v[p][0] * wsc, v[p][1] * wsc); w.y = cvt_pk_bf16(v[p][2] * wsc, v[p][3] * wsc); *(LAS u32x2*)(lds + (p * 32 + kr) * CV_STR + c16 * 8) = w; }
        }
        __syncthreads();
        if (it + cx.nb < nitems) issue(it + cx.nb);
        { const int kq = wid & 3, nh = wid >> 2, r8 = lane >> 3, c8 = lane & 7;
          LAS unsigned char* my = lds + 256 * CV_STR + wid * (16 * CV_STR); LAS unsigned char* wp = my + fr * CV_STR + fq * 16; const LAS unsigned char* rp = my + (2 * r8 + (c8 >> 2)) * CV_STR + (c8 & 3) * 16;
#pragma unroll
          for (int q = 0; q < 2; ++q) { const int nb = nh * 2 + q;
              const bf16x8 oa = frag_tr(lds, (8 * kq + fq) * 8, (8 * kq + fq) * 8 + 4, nb * 16, CV_STR, fr), ob = frag_tr(lds, (8 * kq + 4 + fq) * 8, (8 * kq + 4 + fq) * 8 + 4, nb * 16, CV_STR, fr);
              *(LAS bf16x8*)wp = oa; *(LAS bf16x8*)(wp + 64) = ob;
              asm volatile("" ::: "memory"); __builtin_amdgcn_wave_barrier();
              const bf16x8 x0 = *(const LAS bf16x8*)rp, x1 = *(const LAS bf16x8*)(rp + 64);
              asm volatile("" ::: "memory"); __builtin_amdgcn_wave_barrier();
              bf16_t* dp = j.dst + ((size_t)(((n0 + nb * 16) >> 1) + r8) * (j.ldd >> 5) + ((j.kd0 + k0 + 64 * kq) >> 5)) * 64 + 8 * c8;
              *(bf16x8*)dp = x0; *(bf16x8*)(dp + 64) = x1; } }
        __syncthreads();
    }
    rot = (rot + nitems) % cx.nb;
}

__device__ __forceinline__ void ph_init(const float* x, const float* ctx, float* XS, f32x2* CS, const Ctx cx) {
    (void)x; (void)ctx; (void)XS;
    if (cx.bid == cx.nb - 1) for (int i = tidx(cx); i < 64 * 16; i += 512) { const int pos = i >> 4, f = i & 15; const float inv = powf(10000.0f, -(float)f / 16.0f); const float a = (float)pos * inv; CS[i] = (f32x2){cosf(a), sinf(a)}; }
}
__device__ __forceinline__ void ph_mod(const float* c, const float* c_ctx, const float* w_mod, const float* b_mod, float* MOD, LAS unsigned char* lds, const Ctx cx) {
    if (cx.bid >= DEPTH * 48) return;
    LAS float* sv = (LAS float*)lds; LAS float* red = sv + 9 * 1024;
    const int tid = tidx(cx);
    for (int i = tid; i < 9 * 1024; i += 512) { const float v = i < 8192 ? c[i] : c_ctx[i - 8192]; sv[i] = siluf_(v); }
    __syncthreads();
    const int c4 = (tid & 31) * 4, kg = tid >> 5;
    for (int it = cx.bid; it < DEPTH * 48; it += cx.nb) {
        const int l = it / 48, n0 = (it % 48) * 128;
        const float* w = w_mod + ((size_t)l * D + kg * 64) * 6144 + n0 + c4;
        f32x4 a[9];
#pragma unroll
        for (int r = 0; r < 9; ++r) a[r] = (f32x4){0.f, 0.f, 0.f, 0.f};
#pragma unroll 1
        for (int k0 = 0; k0 < 64; k0 += 8) { f32x4 wv[8];
#pragma unroll
            for (int u = 0; u < 8; ++u) wv[u] = *(const f32x4*)(w + (size_t)(k0 + u) * 6144);
#pragma unroll
            for (int u = 0; u < 8; ++u)
#pragma unroll
                for (int r = 0; r < 9; ++r) a[r] = a[r] + wv[u] * sv[r * 1024 + kg * 64 + k0 + u]; }
#pragma unroll
        for (int r = 0; r < 9; ++r) *(LAS f32x4*)(red + (kg * 9 + r) * 128 + c4) = a[r];
        __syncthreads();
        for (int i = tid; i < 9 * 128; i += 512) { const int r = i >> 7, cc = i & 127; float sacc = b_mod[(size_t)l * 6144 + n0 + cc];
#pragma unroll
            for (int g = 0; g < 16; ++g) sacc += red[(g * 9 + r) * 128 + cc];
            MOD[((size_t)l * 9 + r) * 6144 + n0 + cc] = sacc; }
        __syncthreads();
    }
}

struct NormArgs { bf16_t* XS; const void* Xl; const void* Xc; int lf32, cf32; bf16_t* H;
                  const float* g; const float* mod_shift; const float* mod_scale;
                  const bf16_t* Y; const int* POS; const float* TOPKp; const float* mod_g5prev;
                  const float* router; float* TOPK; unsigned* cnt; int nrows;
                  const float* PART; const float* mod_gpart; int npart; };
template <bool ROUTE> __device__ __forceinline__ void ph_norm(const NormArgs& a, bool combine, LAS unsigned char* lds, const Ctx cx) {
    const int lane = tidx(cx) & 63, wid = tidx(cx) >> 6;
    LAS unsigned* hist = (LAS unsigned*)(lds + LDS_SBASE);
    LAS float* rtab = (LAS float*)lds;
    if (ROUTE) { __syncthreads(); if (tidx(cx) < 8) hist[tidx(cx)] = 0u;
        for (int f = tidx(cx); f < 8192; f += 512) { const int e = f & 7, ln = (f >> 3) & 63, jq = f >> 9; rtab[f] = a.router[(size_t)(4 * (ln + 64 * (jq >> 2)) + (jq & 3)) * 8 + e]; }
        __syncthreads(); }
    f32x4 gq[4];
#pragma unroll
    for (int j = 0; j < 4; ++j) gq[j] = *(const f32x4*)(a.g + 4 * (lane + 64 * j));
    f32x4 xn[4];
    { const int r0 = cx.bid * 8 + wid; if (r0 < a.nrows) { const bool f = r0 < TL ? a.lf32 : a.cf32; const void* rp = r0 < TL ? a.Xl : a.Xc;
#pragma unroll
        for (int j = 0; j < 4; ++j) xn[j] = ldx_raw(rp, f, (size_t)r0 * D + 4 * (lane + 64 * j)); } }
    int cs1 = 0, cs2 = 0; float cp1 = 0.f, cp2 = 0.f; u32x2 y1n[4], y2n[4];
    if (combine) { const int rk = cx.bid * 8 + wid + lane * (cx.nb * 8);
        if (rk < a.nrows) { cs1 = a.POS[2 * rk]; cs2 = a.POS[2 * rk + 1]; cp1 = a.TOPKp[4 * rk + 2]; cp2 = a.TOPKp[4 * rk + 3]; }
        if (cx.bid * 8 + wid < a.nrows) { const int s1 = __builtin_amdgcn_readlane(cs1, 0), s2 = __builtin_amdgcn_readlane(cs2, 0);
#pragma unroll
            for (int j = 0; j < 4; ++j) { const int cc = 4 * (lane + 64 * j); y1n[j] = *(const u32x2*)(a.Y + (size_t)s1 * D + cc); y2n[j] = *(const u32x2*)(a.Y + (size_t)s2 * D + cc); } } }
    int it = 0;
    for (int row = cx.bid * 8 + wid; row < a.nrows; row += cx.nb * 8, ++it) {
        const int mr = mod_row(row);
        bf16_t* xr = a.XS + (size_t)row * D; const bool fcur = row < TL ? a.lf32 : a.cf32;
        f32x4 x[4], shq[4], scq[4];
#pragma unroll
        for (int j = 0; j < 4; ++j) { x[j] = cvx(xn[j], fcur); shq[j] = *(const f32x4*)(a.mod_shift + (size_t)mr * 6144 + 4 * (lane + 64 * j)); scq[j] = *(const f32x4*)(a.mod_scale + (size_t)mr * 6144 + 4 * (lane + 64 * j)); }
        if (row + cx.nb * 8 < a.nrows) {
            const int rn = row + cx.nb * 8; const bool f = rn < TL ? a.lf32 : a.cf32; const void* rp = rn < TL ? a.Xl : a.Xc;
#pragma unroll
            for (int j = 0; j < 4; ++j) xn[j] = ldx_raw(rp, f, (size_t)rn * D + 4 * (lane + 64 * j)); }
        if (combine) {
            const float p1 = __int_as_float(__builtin_amdgcn_readlane(__float_as_int(cp1), it)), p2 = __int_as_float(__builtin_amdgcn_readlane(__float_as_int(cp2), it));
            u32x2 y1c[4], y2c[4];
#pragma unroll
            for (int j = 0; j < 4; ++j) { y1c[j] = y1n[j]; y2c[j] = y2n[j]; }
            if (row + cx.nb * 8 < a.nrows) { const int s1 = __builtin_amdgcn_readlane(cs1, it + 1), s2 = __builtin_amdgcn_readlane(cs2, it + 1);
#pragma unroll
                for (int j = 0; j < 4; ++j) { const int cc = 4 * (lane + 64 * j); y1n[j] = *(const u32x2*)(a.Y + (size_t)s1 * D + cc); y2n[j] = *(const u32x2*)(a.Y + (size_t)s2 * D + cc); } }
#pragma unroll
            for (int j = 0; j < 4; ++j) { const int cc = 4 * (lane + 64 * j);
                const u32x2 y1 = y1c[j], y2 = y2c[j];
                const f32x4 mg = *(const f32x4*)(a.mod_g5prev + (size_t)mr * 6144 + cc);
                f32x4 e; e[0] = p1 * bf_lo(y1.x) + p2 * bf_lo(y2.x); e[1] = p1 * bf_hi(y1.x) + p2 * bf_hi(y2.x); e[2] = p1 * bf_lo(y1.y) + p2 * bf_lo(y2.y); e[3] = p1 * bf_hi(y1.y) + p2 * bf_hi(y2.y);
                x[j] = x[j] + mg * e; stx(xr + cc, x[j]); }
        }
        if (a.PART != nullptr && row >= TL) {
#pragma unroll
            for (int j = 0; j < 4; ++j) { const int cc = 4 * (lane + 64 * j); const float* pp = a.PART + (size_t)(row - TL) * D + cc;
                f32x4 e = (*(const f32x4*)pp + *(const f32x4*)(pp + (size_t)TC * D)) + (*(const f32x4*)(pp + (size_t)2 * TC * D) + *(const f32x4*)(pp + (size_t)3 * TC * D));
                e = e + (*(const f32x4*)(pp + (size_t)4 * TC * D) + *(const f32x4*)(pp + (size_t)5 * TC * D));
                if (a.npart == 7) e = e + *(const f32x4*)(pp + (size_t)6 * TC * D);
                const f32x4 mg = *(const f32x4*)(a.mod_gpart + (size_t)8 * 6144 + cc);
                x[j] = x[j] + mg * e; stx(xr + cc, x[j]); }
        }
        float ss = 0.f;
#pragma unroll
        for (int j = 0; j < 4; ++j) ss += x[j][0] * x[j][0] + x[j][1] * x[j][1] + x[j][2] * x[j][2] + x[j][3] * x[j][3];
        ss = wave_total(ss);
        const float rs = rsqrtf(ss * (1.0f / D) + EPS);
        f32x4 h[4];
#pragma unroll
        for (int j = 0; j < 4; ++j) { const int cc = 4 * (lane + 64 * j);
            h[j] = (x[j] * rs * gq[j]) * (scq[j] + 1.0f) + shq[j];
            u32x2 w; w.x = cvt_pk_bf16(h[j][0], h[j][1]); w.y = cvt_pk_bf16(h[j][2], h[j][3]);
            *(u32x2*)(a.H + (size_t)row * D + cc) = w; }
        if (ROUTE) {
            float lg[8];
#pragma unroll
            for (int e = 0; e < 8; ++e) lg[e] = 0.f;
#pragma unroll
            for (int j = 0; j < 4; ++j)
#pragma unroll
                for (int q = 0; q < 4; ++q) { const LAS float* rw = rtab + ((j * 4 + q) * 64 + lane) * 8; const f32x4 r0 = *(const LAS f32x4*)rw, r1 = *(const LAS f32x4*)(rw + 4); const float hv = h[j][q];
                    lg[0] += hv * r0[0]; lg[1] += hv * r0[1]; lg[2] += hv * r0[2]; lg[3] += hv * r0[3]; lg[4] += hv * r1[0]; lg[5] += hv * r1[1]; lg[6] += hv * r1[2]; lg[7] += hv * r1[3]; }
#pragma unroll
            for (int e = 0; e < 8; ++e) lg[e] = wave_total(lg[e]);
            if (lane == 0) {
                int e1 = 0; float v1 = lg[0];
#pragma unroll
                for (int e = 1; e < 8; ++e) if (lg[e] > v1) { v1 = lg[e]; e1 = e; }
                int e2 = -1; float v2 = -3.0e38f;
#pragma unroll
                for (int e = 0; e < 8; ++e) if (e != e1 && lg[e] > v2) { v2 = lg[e]; e2 = e; }
                const float p2 = 1.0f / (1.0f + __expf(v1 - v2)), p1 = 1.0f - p2;
                float* tk = a.TOPK + 4 * (size_t)row; tk[0] = __int_as_float(e1); tk[1] = __int_as_float(e2); tk[2] = p1; tk[3] = p2;
                lds_add(hist + e1, 1u); lds_add(hist + e2, 1u);
            }
        }
    }
    if (ROUTE) { __syncthreads(); if (tidx(cx) < 8) { const unsigned v = hist[tidx(cx)]; if (v) atomicAdd(a.cnt + tidx(cx), v); } __syncthreads(); }
}

__device__ __forceinline__ void ph_route(const float* TOPK, const bf16_t* H, bf16_t* HS, int* POS, unsigned* ctl, int j, int nrows, LAS unsigned char* lds, const Ctx cx) {
    LAS unsigned* sbase = (LAS unsigned*)(lds + LDS_SBASE);
    const int lane = tidx(cx) & 63, wid = tidx(cx) >> 6;
    __syncthreads();
    if (tidx(cx) == 0) { unsigned b = 0; for (int e = 0; e < 8; ++e) { sbase[e] = b; b += (xb_ld(ctl + CW_CNT + j * 64 + e) + 255u) & ~255u; } sbase[8] = b; }
    __syncthreads();
    if (cx.bid == 0) {
        if (tidx(cx) < 256) { const unsigned r0 = tidx(cx) * 256u; int e = 0;
            for (int q = 1; q < 8; ++q) if (r0 >= sbase[q]) e = q;
            ctl[CW_TEXP + j * 256 + tidx(cx)] = (unsigned)e; }
        if (tidx(cx) == 0) ctl[CW_NT + j] = sbase[8] / 256u;
    }
    for (int i = cx.bid * 8 + wid; i < 8 * 256; i += cx.nb * 8) { const int e = i >> 8, r = i & 255; const unsigned s = sbase[e] + xb_ld(ctl + CW_CNT + j * 64 + e) + r;
        if (s < sbase[e + 1]) {
#pragma unroll
            for (int q = 0; q < 2; ++q) ((u32x4*)(HS + (size_t)s * D))[lane + 64 * q] = ((const u32x4*)H)[lane + 64 * q]; } }
    LAS unsigned* wcnt = sbase + 16; LAS unsigned* wbase = sbase + 24;
    if (tidx(cx) < 8) wcnt[tidx(cx)] = 0u;
    const int nk = nrows / (cx.nb * 8); const int myrow = cx.bid * 8 + wid + lane * (cx.nb * 8); const bool own = lane < nk;
    int e1 = 0, e2 = 0; if (own) { const f32x2 t = *(const f32x2*)(TOPK + 4 * (size_t)myrow); e1 = __float_as_int(t[0]); e2 = __float_as_int(t[1]); }
    __syncthreads();
    if (own) { lds_add(wcnt + e1, 1u); lds_add(wcnt + e2, 1u); }
    __syncthreads();
    if (tidx(cx) < 8) { const unsigned n = wcnt[tidx(cx)]; wbase[tidx(cx)] = sbase[tidx(cx)] + (n ? atomicAdd(ctl + CW_FILL + j * 64 + tidx(cx), n) : 0u); wcnt[tidx(cx)] = 0u; }
    __syncthreads();
    int s1 = 0, s2 = 0;
    if (own) { s1 = (int)(wbase[e1] + lds_add(wcnt + e1, 1u)); s2 = (int)(wbase[e2] + lds_add(wcnt + e2, 1u)); POS[2 * myrow] = s1; POS[2 * myrow + 1] = s2; }
    u32x4 v[9][2];
#pragma unroll
    for (int k = 0; k < 9; ++k) if (k < nk) { const u32x4* src = (const u32x4*)(H + (size_t)(cx.bid * 8 + wid + k * (cx.nb * 8)) * D); v[k][0] = src[lane]; v[k][1] = src[lane + 64]; }
#pragma unroll
    for (int k = 0; k < 9; ++k) if (k < nk) { const int d1 = __builtin_amdgcn_readlane(s1, k), d2 = __builtin_amdgcn_readlane(s2, k);
        u32x4* o1 = (u32x4*)(HS + (size_t)d1 * D); u32x4* o2 = (u32x4*)(HS + (size_t)d2 * D);
        o1[lane] = v[k][0]; o1[lane + 64] = v[k][1]; o2[lane] = v[k][0]; o2[lane + 64] = v[k][1]; }
    __syncthreads();
}

struct CvIn { u32x4 cc[3], cu[3], cb; };
__device__ __forceinline__ void ph_conv(const bf16_t* P, bf16_t* BR, const float* conv_w, int nrows, const Ctx cx) {
    const int tid = tidx(cx), lane = tid & 63, wid = tid >> 6; const int c0 = lane * 8;
    float cw[3][8];
#pragma unroll
    for (int d = 0; d < 3; ++d)
#pragma unroll
        for (int e = 0; e < 8; ++e) cw[d][e] = conv_w[d * 512 + c0 + e];
    auto seqpos = [&](int row, int& sp, int& slen) { const bool lat = row < TL; sp = lat ? (row & (SEQ - 1)) : ((row - TL) & (CTXL - 1)); slen = lat ? SEQ : CTXL; };
    auto load = [&](int row, CvIn& in) { const bf16_t* pr = P + (size_t)row * NP; int sp, slen; seqpos(row, sp, slen);
#pragma unroll
        for (int d = 0; d < 3; ++d) { const int sq = sp + d - 1; const bool ok = sq >= 0 && sq < slen; const bf16_t* q = pr + (ptrdiff_t)(ok ? d - 1 : 0) * NP;
            in.cc[d] = *(const u32x4*)(q + P_CC + c0); in.cu[d] = *(const u32x4*)(q + P_CU + c0); }
        in.cb = *(const u32x4*)(pr + P_CB + c0); };
    const int stride = cx.nb * 8; int row = cx.bid * 8 + wid; CvIn cur, nxt;
    if (row < nrows) load(row, cur);
    for (; row < nrows; row += stride) {
        const int rn = row + stride; const bool hn = rn < nrows;
        if (hn) load(rn, nxt);
        int sp, slen; seqpos(row, sp, slen);
        float y[8];
#pragma unroll
        for (int e = 0; e < 8; ++e) y[e] = 0.f;
#pragma unroll
        for (int d = 0; d < 3; ++d) { const int sq = sp + d - 1; const float m = (sq >= 0 && sq < slen) ? 1.0f : 0.0f; float cv[8], uv[8]; unpack8(cur.cc[d], cv); unpack8(cur.cu[d], uv);
#pragma unroll
            for (int e = 0; e < 8; ++e) y[e] += (cv[e] * uv[e]) * (cw[d][e] * m); }
        float bv[8]; unpack8(cur.cb, bv);
#pragma unroll
        for (int e = 0; e < 8; ++e) y[e] *= bv[e];
        *(u32x4*)(BR + (size_t)row * 1536 + c0) = pack8(y);
        if (hn) cur = nxt;
    }
}

__device__ __forceinline__ void ph_final(const bf16_t* XS, const bf16_t* Y, const int* POS, const float* TOPK, const float* mod_g5, const float* g, float* out, const Ctx cx) {
    const int lane = tidx(cx) & 63, wid = tidx(cx) >> 6;
    f32x4 gq[4];
#pragma unroll
    for (int j = 0; j < 4; ++j) gq[j] = *(const f32x4*)(g + 4 * (lane + 64 * j));
    const int stride = cx.nb * 8; int row = cx.bid * 8 + wid;
    f32x4 xn[4]; u32x2 y1n[4], y2n[4]; float p1n = 0.f, p2n = 0.f;
    int cs1 = 0, cs2 = 0; float cp1 = 0.f, cp2 = 0.f;
    { const int rk = cx.bid * 8 + wid + lane * stride; if (rk < TL) { cs1 = POS[2 * rk]; cs2 = POS[2 * rk + 1]; cp1 = TOPK[4 * rk + 2]; cp2 = TOPK[4 * rk + 3]; } }
    auto fetch = [&](int r, int k) { const int s1 = __builtin_amdgcn_readlane(cs1, k), s2 = __builtin_amdgcn_readlane(cs2, k);
        p1n = __int_as_float(__builtin_amdgcn_readlane(__float_as_int(cp1), k)); p2n = __int_as_float(__builtin_amdgcn_readlane(__float_as_int(cp2), k));
#pragma unroll
        for (int j = 0; j < 4; ++j) { const int cc = 4 * (lane + 64 * j); xn[j] = ldx_raw(XS, false, (size_t)r * D + cc); y1n[j] = *(const u32x2*)(Y + (size_t)s1 * D + cc); y2n[j] = *(const u32x2*)(Y + (size_t)s2 * D + cc); } };
    if (row < TL) fetch(row, 0);
    int it = 0;
    for (; row < TL; row += stride, ++it) {
        const int mr = mod_row(row);
        f32x4 x[4]; u32x2 y1[4], y2[4]; const float p1 = p1n, p2 = p2n;
#pragma unroll
        for (int j = 0; j < 4; ++j) { x[j] = cvx(xn[j], false); y1[j] = y1n[j]; y2[j] = y2n[j]; }
        if (row + stride < TL) fetch(row + stride, it + 1);
        float ss = 0.f;
#pragma unroll
        for (int j = 0; j < 4; ++j) { const int cc = 4 * (lane + 64 * j);
            const f32x4 mg = *(const f32x4*)(mod_g5 + (size_t)mr * 6144 + cc);
            f32x4 e; e[0] = p1 * bf_lo(y1[j].x) + p2 * bf_lo(y2[j].x); e[1] = p1 * bf_hi(y1[j].x) + p2 * bf_hi(y2[j].x); e[2] = p1 * bf_lo(y1[j].y) + p2 * bf_lo(y2[j].y); e[3] = p1 * bf_hi(y1[j].y) + p2 * bf_hi(y2[j].y);
            x[j] = x[j] + mg * e; ss += x[j][0] * x[j][0] + x[j][1] * x[j][1] + x[j][2] * x[j][2] + x[j][3] * x[j][3]; }
        ss = wave_total(ss); const float rs = rsqrtf(ss * (1.0f / D) + EPS);
#pragma unroll
        for (int j = 0; j < 4; ++j) { const int cc = 4 * (lane + 64 * j); *(f32x4*)(out + (size_t)row * D + cc) = x[j] * rs * gq[j]; }
    }
}

__device__ __forceinline__ float wave_incl_scan(float v) {
    v += __int_as_float(__builtin_amdgcn_update_dpp(0, __float_as_int(v), 0x111, 0xF, 0xF, true));
    v += __int_as_float(__builtin_amdgcn_update_dpp(0, __float_as_int(v), 0x112, 0xF, 0xF, true));
    v += __int_as_float(__builtin_amdgcn_update_dpp(0, __float_as_int(v), 0x114, 0xF, 0xF, true));
    v += __int_as_float(__builtin_amdgcn_update_dpp(0, __float_as_int(v), 0x118, 0xF, 0xF, true));
    v += __int_as_float(__builtin_amdgcn_update_dpp(0, __float_as_int(v), 0x142, 0xA, 0xF, false));
    v += __int_as_float(__builtin_amdgcn_update_dpp(0, __float_as_int(v), 0x143, 0xC, 0xF, false));
    return v;
}
__device__ __forceinline__ float lsig16(float z) { const float e = __builtin_amdgcn_exp2f(fmaxf(z, -80.0f) * -LOG2E); return __builtin_amdgcn_logf(1.0f + e) * (-0.6931471805599453f / 16.0f); }
__device__ __forceinline__ void gla_wave_decay(const bf16_t* P, int row0, int t, int h, int d, int ch0, const float* gla_w2, const float* gla_b, float (&b)[16]) {
    const u32x4* ap = (const u32x4*)(P + (size_t)(row0 + t) * NP + P_AG + d * 16);
    float a[16]; unpack8(ap[0], a); unpack8(ap[1], a + 8);
    const float* w2 = gla_w2 + (size_t)d * 16 * 256 + h * 64 + ch0; const float* bb = gla_b + d * 256 + h * 64 + ch0;
#pragma unroll
    for (int i = 0; i < 16; ++i) b[i] = bb[i];
#pragma unroll
    for (int r = 0; r < 16; ++r)
#pragma unroll
        for (int i = 0; i < 16; ++i) b[i] = __builtin_fmaf(a[r], w2[r * 256 + i], b[i]);
#pragma unroll
    for (int i = 0; i < 16; ++i) b[i] = wave_incl_scan(lsig16(b[i]));
}

constexpr int G_QD = 0, G_KI = G_QD + 2 * 64 * STR64, G_AT = G_KI + 2 * 64 * STR64, G_VI = G_AT + 2 * 64 * STR64, G_SE = G_VI + 64 * STR128, G_RED = G_SE + 2 * 64 * STR128, G_END = G_RED + 512;
constexpr int G1_KR = G_KI, G1_AR = G_KI + 64 * STR64, G1_ASTR = 80, G1_W2 = 73728;
struct G1In { u32x4 vv[2], kraw, araw; float bb[16]; };
__device__ __forceinline__ void g1_load(G1In& in, const bf16_t* P, const float* gla_b, int ci, int h, int tid) {
    const int row0 = ci * 64;
    { const int w = tid >> 6; const float* bb = gla_b + (w >> 2) * 256 + h * 64 + (w & 3) * 16;
#pragma unroll
      for (int i = 0; i < 16; ++i) in.bb[i] = bb[i]; }
#pragma unroll
    for (int q = 0; q < 2; ++q) { const int id = tid + 512 * q, r = id >> 4, c16 = id & 15; in.vv[q] = *(const u32x4*)(P + (size_t)(row0 + r) * NP + P_VG + h * 128 + c16 * 8); }
    in.kraw = *(const u32x4*)(P + (size_t)(row0 + (tid >> 3)) * NP + P_KG + h * 64 + (tid & 7) * 8);
    in.araw = (u32x4){0u, 0u, 0u, 0u}; if (tid < 256) in.araw = *(const u32x4*)(P + (size_t)(row0 + (tid >> 2)) * NP + P_AG + (tid & 3) * 8);
}
__device__ __forceinline__ void gla_state_unit(const G1In& in, G1In& nxt, int vnext  , const bf16_t* P, int ci, int h, const float* gla_b, float* DS, float* DEC, float* BC, LAS unsigned char* lds, const Ctx cx) {
    const int tid = tidx(cx), lane = tid & 63, wid = __builtin_amdgcn_readfirstlane(tid >> 6), fr = lane & 15, fq = lane >> 4;
    LAS unsigned char* Ke = lds + G_QD; LAS unsigned char* Vi = lds + G_VI; LAS unsigned char* Kr = lds + G1_KR; LAS unsigned char* Ar = lds + G1_AR; const LAS float* w2s = (const LAS float*)(lds + G1_W2);
    {
#pragma unroll
      for (int q = 0; q < 2; ++q) { const int id = tid + 512 * q, r = id >> 4, c16 = id & 15; *(LAS u32x4*)(Vi + r * STR128 + c16 * 16) = in.vv[q]; }
      *(LAS u32x4*)(Kr + (tid >> 3) * STR64 + (tid & 7) * 16) = in.kraw;
      if (tid < 256) *(LAS u32x4*)(Ar + (tid >> 2) * G1_ASTR + (tid & 3) * 16) = in.araw; }
    __syncthreads();
    const size_t ub = ((size_t)ci * 4 + h) * 2;
    { const int d = wid >> 2, ch0 = (wid & 3) * 16, t = d ? 63 - lane : lane; float b[16];
      const LAS u32x4* ap = (const LAS u32x4*)(Ar + t * G1_ASTR + d * 32); float a[16]; unpack8(ap[0], a); unpack8(ap[1], a + 8);
      const LAS u32x4* kp = (const LAS u32x4*)(Kr + t * STR64 + ch0 * 2); const u32x4 k0 = kp[0], k1 = kp[1];
      const LAS float* w2 = w2s + d * 16 * 256 + h * 64 + ch0;
#pragma unroll
      for (int i = 0; i < 16; ++i) b[i] = in.bb[i];
#pragma unroll
      for (int r = 0; r < 16; ++r)
#pragma unroll
          for (int i = 0; i < 16; ++i) b[i] = __builtin_fmaf(a[r], w2[r * 256 + i], b[i]);
#pragma unroll
      for (int i = 0; i < 16; ++i) b[i] = wave_incl_scan(lsig16(b[i]));
      { float* bp = BC + ((ub + d) * 64 + ch0) * 64 + t;
#pragma unroll
        for (int i = 0; i < 16; ++i) bp[i * 64] = b[i]; }
      float kf[16], o[16]; unpack8(k0, kf); unpack8(k1, kf + 8);
#pragma unroll
      for (int i = 0; i < 16; ++i) { const float bt = __int_as_float(__builtin_amdgcn_readlane(__float_as_int(b[i]), 63)); o[i] = kf[i] * __expf(bt - b[i]); b[i] = bt; }
      *(LAS u32x4*)(Ke + d * 64 * STR64 + t * STR64 + ch0 * 2) = pack8(o); *(LAS u32x4*)(Ke + d * 64 * STR64 + t * STR64 + ch0 * 2 + 16) = pack8(o + 8);
      if (lane < 16) { float dv = b[0];
#pragma unroll
          for (int i = 1; i < 16; ++i) dv = (lane == i) ? b[i] : dv;
          DEC[(ub + d) * 64 + ch0 + lane] = __expf(dv); } }
    __syncthreads();
    if (vnext >= 0) g1_load(nxt, P, gla_b, vnext >> 2, vnext & 3, tid);
    { const int d = wid >> 2, mt = wid & 3; f32x4 acc[8];
#pragma unroll
      for (int n = 0; n < 8; ++n) acc[n] = (f32x4){0.f, 0.f, 0.f, 0.f};
#pragma unroll
      for (int s = 0; s < 2; ++s) { const int r0 = 32 * s + 8 * fq; const bf16x8 af = frag_tr(Ke + d * 64 * STR64, r0, r0 + 4, mt * 16, STR64, fr);
#pragma unroll
          for (int n = 0; n < 8; ++n) { const bf16x8 bfr = frag_tr(Vi, r0, r0 + 4, n * 16, STR128, fr); MMA16(acc[n], af, bfr); } }
      LAS unsigned char* my = lds + G_AT + wid * (16 * STR64); const int r8 = lane >> 3, c8 = lane & 7;
      LAS unsigned char* wp = my + fr * STR64 + fq * 16; const LAS unsigned char* rp = my + r8 * STR64 + c8 * 16;
      float* dst = DS + ((ub + d) * 64 + mt * 16 + r8) * 128 + 4 * c8;
#pragma unroll
      for (int p = 0; p < 4; ++p) {
          *(LAS f32x4*)wp = acc[2 * p]; *(LAS f32x4*)(wp + 64) = acc[2 * p + 1];
          asm volatile("" ::: "memory"); __builtin_amdgcn_wave_barrier();
          const f32x4 x0 = *(const LAS f32x4*)rp, x1 = *(const LAS f32x4*)(rp + 8 * STR64);
          asm volatile("" ::: "memory"); __builtin_amdgcn_wave_barrier();
          *(f32x4*)(dst + p * 32) = x0; *(f32x4*)(dst + 8 * 128 + p * 32) = x1; } }
    __syncthreads();
}

__device__ __forceinline__ void ph_gla_scan2(const float* DS, const float* DEC, bf16_t* SE, const Ctx cx) {
    const int tid = tidx(cx);
    for (int vi = cx.bid * 512 + tid; vi < 64 * 2048; vi += cx.nb * 512) {
        const int sid = vi >> 11, dk = (vi >> 5) & 63, dvq = vi & 31; const int b = sid >> 3, h = (sid >> 1) & 3, d = sid & 1;
        f32x4 S = (f32x4){0.f, 0.f, 0.f, 0.f};
#pragma unroll 12
        for (int st = 0; st < 36; ++st) {
            const int ci = st < 4 ? (256 + 4 * b + (d ? 3 - st : st)) : (32 * b + (d ? 35 - st : st - 4));
            const size_t ub = ((size_t)ci * 4 + h) * 2 + d; const size_t eo = (ub * 64 + dk) * 128 + dvq * 4;
            u32x2 w; w.x = cvt_pk_bf16(S[0], S[1]); w.y = cvt_pk_bf16(S[2], S[3]); *(u32x2*)(SE + eo) = w;
            const float dec = DEC[ub * 64 + dk]; const f32x4 ds = *(const f32x4*)(DS + eo);
            S = S * dec + ds;
        }
    }
}

struct G3In { u32x4 vv[2], sv[4], qraw, kraw; float bb[16]; };
__device__ __forceinline__ void g3_load(G3In& in, const bf16_t* P, int ci, int h, const float* BC, const bf16_t* SE, int tid) {
    const int lane = tid & 63, wid = __builtin_amdgcn_readfirstlane(tid >> 6); const int row0 = ci * 64; const size_t ub = ((size_t)ci * 4 + h) * 2;
#pragma unroll
    for (int q = 0; q < 2; ++q) { const int id = tid + 512 * q, r = id >> 4, c16 = id & 15; in.vv[q] = *(const u32x4*)(P + (size_t)(row0 + r) * NP + P_VG + h * 128 + c16 * 8); }
#pragma unroll
    for (int q = 0; q < 4; ++q) { const int id = tid + 512 * q, r = id >> 4, c16 = id & 15; in.sv[q] = *(const u32x4*)(SE + (ub * 64 + r) * 128 + c16 * 8); }
    const int d = wid >> 2, ch0 = (wid & 3) * 16, t = d ? 63 - lane : lane;
    { const bf16_t* pr = P + (size_t)(row0 + (tid >> 3)) * NP + h * 64 + (tid & 7) * 8; in.qraw = *(const u32x4*)(pr + P_QG); in.kraw = *(const u32x4*)(pr + P_KG); }
    const float* bp = BC + ((ub + d) * 64 + ch0) * 64 + t;
#pragma unroll
    for (int i = 0; i < 16; ++i) in.bb[i] = bp[i * 64];
}
__device__ __forceinline__ void gla_out_unit(const G3In& in, const bf16_t* P, int ci, int h, const float* gng, bf16_t* BR, LAS unsigned char* lds, const Ctx cx) {
    const int tid = tidx(cx), lane = tid & 63, wid = __builtin_amdgcn_readfirstlane(tid >> 6), fr = lane & 15, fq = lane >> 4; const int row0 = ci * 64;
    LAS unsigned char* Qd = lds + G_QD; LAS unsigned char* Ki = lds + G_KI; LAS unsigned char* Vi = lds + G_VI; LAS unsigned char* Se = lds + G_SE; LAS unsigned char* At = lds + G_AT;
    { LAS unsigned char* Qr = At; LAS unsigned char* Kr = At + 64 * STR64;
      *(LAS u32x4*)(Qr + (tid >> 3) * STR64 + (tid & 7) * 16) = in.qraw; *(LAS u32x4*)(Kr + (tid >> 3) * STR64 + (tid & 7) * 16) = in.kraw; }
#pragma unroll
    for (int q = 0; q < 2; ++q) { const int id = tid + 512 * q, r = id >> 4, c16 = id & 15; *(LAS u32x4*)(Vi + r * STR128 + c16 * 16) = in.vv[q]; }
#pragma unroll
    for (int q = 0; q < 4; ++q) { const int id = tid + 512 * q, r = id >> 4, c16 = id & 15; *(LAS u32x4*)(Se + r * STR128 + c16 * 16) = in.sv[q]; }
    __syncthreads();
    { const int d = wid >> 2, ch0 = (wid & 3) * 16, t = d ? 63 - lane : lane; float b[16];
      const LAS u32x4* qp = (const LAS u32x4*)(At + t * STR64 + ch0 * 2); const LAS u32x4* kp = (const LAS u32x4*)(At + 64 * STR64 + t * STR64 + ch0 * 2);
      const u32x4 q0 = qp[0], q1 = qp[1], k0 = kp[0], k1 = kp[1];
#pragma unroll
      for (int i = 0; i < 16; ++i) b[i] = in.bb[i];
      float qf[16], kf[16]; unpack8(q0, qf); unpack8(q1, qf + 8); unpack8(k0, kf); unpack8(k1, kf + 8);
#pragma unroll
      for (int i = 0; i < 16; ++i) { const float e = __expf(b[i]); qf[i] = qf[i] * 0.125f * e; kf[i] = kf[i] * __builtin_amdgcn_rcpf(e); }
      LAS unsigned char* qd = Qd + d * 64 * STR64 + t * STR64 + ch0 * 2; LAS unsigned char* ki = Ki + d * 64 * STR64 + t * STR64 + ch0 * 2;
      *(LAS u32x4*)qd = pack8(qf); *(LAS u32x4*)(qd + 16) = pack8(qf + 8); *(LAS u32x4*)ki = pack8(kf); *(LAS u32x4*)(ki + 16) = pack8(kf + 8); }
    __syncthreads();
    { const int d = wid >> 2, mt = wid & 3; f32x4 acc[4];
#pragma unroll
      for (int n = 0; n < 4; ++n) acc[n] = (f32x4){0.f, 0.f, 0.f, 0.f};
#pragma unroll
      for (int s = 0; s < 2; ++s) { const bf16x8 af = frag_row(Qd + d * 64 * STR64, mt * 16 + fr, 32 * s + 8 * fq, STR64);
#pragma unroll
          for (int n = 0; n < 4; ++n) { const bf16x8 bfr = frag_row(Ki + d * 64 * STR64, n * 16 + fr, 32 * s + 8 * fq, STR64); MMA16(acc[n], af, bfr); } }
      const int l = mt * 16 + fr;
#pragma unroll
      for (int n = 0; n < 4; ++n) { float v[4];
#pragma unroll
          for (int j = 0; j < 4; ++j) { const int s = n * 16 + 4 * fq + j; const bool keep = d ? (s >= l) : (s <= l); v[j] = keep ? acc[n][j] : 0.f; }
          u32x2 w; w.x = cvt_pk_bf16(v[0], v[1]); w.y = cvt_pk_bf16(v[2], v[3]); *(LAS u32x2*)(At + d * 64 * STR64 + l * STR64 + (n * 16 + 4 * fq) * 2) = w; } }
    __syncthreads();
    { const int mt = wid & 3, nh = wid >> 2; f32x4 acc[4];
      const int l = mt * 16 + fr; const size_t row = (size_t)row0 + l;
      u32x2 rw[4]; f32x4 gg[4];
#pragma unroll
      for (int n = 0; n < 4; ++n) { const int v0 = (nh * 4 + n) * 16 + 4 * fq; rw[n] = *(const u32x2*)(P + row * NP + P_RG + h * 128 + v0); gg[n] = *(const f32x4*)(gng + h * 128 + v0); }
#pragma unroll
      for (int n = 0; n < 4; ++n) acc[n] = (f32x4){0.f, 0.f, 0.f, 0.f};
#pragma unroll
      for (int d = 0; d < 2; ++d)
#pragma unroll
          for (int s = 0; s < 2; ++s) { const int r0 = 32 * s + 8 * fq;
              const bf16x8 af = frag_row(At + d * 64 * STR64, mt * 16 + fr, r0, STR64), aq = frag_row(Qd + d * 64 * STR64, mt * 16 + fr, r0, STR64);
#pragma unroll
              for (int n = 0; n < 4; ++n) { const int x0 = (nh * 4 + n) * 16;
                  const bf16x8 bv = frag_tr(Vi, r0, r0 + 4, x0, STR128, fr); MMA16(acc[n], af, bv);
                  const bf16x8 bs = frag_tr(Se + d * 64 * STR128, r0, r0 + 4, x0, STR128, fr); MMA16(acc[n], aq, bs); } }
      float ss = 0.f;
#pragma unroll
      for (int n = 0; n < 4; ++n) ss += acc[n][0] * acc[n][0] + acc[n][1] * acc[n][1] + acc[n][2] * acc[n][2] + acc[n][3] * acc[n][3];
      ss = row4_sum(ss);
      LAS float* red = (LAS float*)(lds + G_RED);
      if (fq == 0) red[l * 2 + nh] = ss;
      __syncthreads();
      const float rs = rsqrtf((red[l * 2] + red[l * 2 + 1]) * (1.0f / 128.0f) + EPS);
#pragma unroll
      for (int n = 0; n < 4; ++n) { const int v0 = (nh * 4 + n) * 16 + 4 * fq;
          const float y0 = acc[n][0] * rs * gg[n][0] * siluf_(bf_lo(rw[n].x)), y1 = acc[n][1] * rs * gg[n][1] * siluf_(bf_hi(rw[n].x)), y2 = acc[n][2] * rs * gg[n][2] * siluf_(bf_lo(rw[n].y)), y3 = acc[n][3] * rs * gg[n][3] * siluf_(bf_hi(rw[n].y));
          u32x2 w; w.x = cvt_pk_bf16(y0, y1); w.y = cvt_pk_bf16(y2, y3); *(u32x2*)(BR + row * 1536 + 1024 + h * 128 + v0) = w; } }
    __syncthreads();
}

constexpr float ATT_THR = 8.0f;
constexpr int A_KBUF = 0, A_VBUF = 64 * STR64, A_BUF = 2 * 64 * STR64;
__device__ __forceinline__ void attn_unit(const bf16_t* QR, const bf16_t* KV, bf16_t* BR, const float* sink, int b, int kh, int qrow0  , int qpos0  , LAS unsigned char* lds, const Ctx cx) {
    const int tid = tidx(cx), lane = tid & 63, wid = tid >> 6, fr = lane & 15, fq = lane >> 4; const int hq = wid >> 1, qh = wid & 1;
    const bool lat = qpos0 >= 0;
    int kt0 = 0, kt1 = 0; if (lat) { kt0 = (qpos0 >> 6) - 2; if (kt0 < 0) kt0 = 0; kt1 = (qpos0 >> 6) + 4; if (kt1 > 32) kt1 = 32; }
    const int ntile = (kt1 - kt0) + 4;
    bf16x8 qf[4][2];
#pragma unroll
    for (int mt = 0; mt < 4; ++mt)
#pragma unroll
        for (int ks = 0; ks < 2; ++ks) qf[mt][ks] = *(const bf16x8*)(QR + (size_t)(qrow0 + 64 * qh + 16 * mt + fr) * 512 + (4 * kh + hq) * 64 + 32 * ks + 8 * fq);
    const float sk = sink[4 * kh + hq] * LOG2E;
    f32x4 oacc[4][4]; float mrun[4], lrun[4];
#pragma unroll
    for (int mt = 0; mt < 4; ++mt) { mrun[mt] = sk; lrun[mt] = (fq == 0) ? 1.0f : 0.0f;
#pragma unroll
        for (int dt = 0; dt < 4; ++dt) oacc[mt][dt] = (f32x4){0.f, 0.f, 0.f, 0.f}; }
    const int sr = tid >> 3, sc = tid & 7;
    auto tile_row0 = [&](int t) -> int { return t < (kt1 - kt0) ? b * SEQ + (kt0 + t) * 64 : TL + b * CTXL + (t - (kt1 - kt0)) * 64; };
    u32x4 kreg, vreg;
    { const bf16_t* src = KV + (size_t)(tile_row0(0) + sr) * 256 + kh * 64 + sc * 8; kreg = *(const u32x4*)src; vreg = *(const u32x4*)(src + 128); }
    *(LAS u32x4*)(lds + A_KBUF + sr * STR64 + sc * 16) = kreg; *(LAS u32x4*)(lds + A_VBUF + sr * STR64 + sc * 16) = vreg;
    __syncthreads();
    for (int t = 0; t < ntile; ++t) {
        LAS unsigned char* Kb = lds + (t & 1) * A_BUF + A_KBUF; LAS unsigned char* Vb = lds + (t & 1) * A_BUF + A_VBUF;
        if (t + 1 < ntile) { const bf16_t* src = KV + (size_t)(tile_row0(t + 1) + sr) * 256 + kh * 64 + sc * 8; kreg = *(const u32x4*)src; vreg = *(const u32x4*)(src + 128); }
        const bool latt = t < (kt1 - kt0); const int kpos0 = (kt0 + t) * 64;
        const int qlo = qpos0 + 64 * qh;
        const bool active = !latt || (kpos0 + 63 >= qlo - 128 && kpos0 <= qlo + 63 + 128);
        const bool needmask = latt && (kpos0 > qlo + 65 || kpos0 < qlo - 65);
        if (active) {
            u32x4 pf[4][2];
            { bf16x8 kf[4][2];
#pragma unroll
              for (int nt = 0; nt < 4; ++nt)
#pragma unroll
                  for (int ks = 0; ks < 2; ++ks) kf[nt][ks] = frag_row(Kb, nt * 16 + fr, 32 * ks + 8 * fq, STR64);
#pragma unroll
              for (int mt = 0; mt < 4; ++mt) {
                f32x4 s[4];
                const float nm = -mrun[mt];
#pragma unroll
                for (int nt = 0; nt < 4; ++nt) { s[nt] = (f32x4){nm, nm, nm, nm}; MMA16(s[nt], qf[mt][0], kf[nt][0]); MMA16(s[nt], qf[mt][1], kf[nt][1]); }
                if (needmask) { const int qp = qlo + 16 * mt + fr;
#pragma unroll
                    for (int nt = 0; nt < 4; ++nt)
#pragma unroll
                        for (int j = 0; j < 4; ++j) { const int dlt = kpos0 + nt * 16 + 4 * fq + j - qp; if (dlt > 128 || dlt < -128) s[nt][j] = -3.0e38f; } }
                float mx = vmax2(vmax2(s[0][0], s[0][1]), s[0][2]);
                mx = vmax2(vmax2(mx, s[0][3]), s[1][0]); mx = vmax2(vmax2(mx, s[1][1]), s[1][2]); mx = vmax2(vmax2(mx, s[1][3]), s[2][0]); mx = vmax2(vmax2(mx, s[2][1]), s[2][2]);
                mx = vmax2(vmax2(mx, s[2][3]), s[3][0]); mx = vmax2(vmax2(mx, s[3][1]), s[3][2]); mx = vmax2(mx, s[3][3]);
                mx = row4_max(mx);
                if (__builtin_amdgcn_ballot_w64(mx > ATT_THR) != 0ull) {
                    const float d = mx > ATT_THR ? mx : 0.f; const float alpha = __builtin_amdgcn_exp2f(-d); mrun[mt] += d; lrun[mt] *= alpha;
#pragma unroll
                    for (int dt = 0; dt < 4; ++dt) oacc[mt][dt] = oacc[mt][dt] * alpha;
#pragma unroll
                    for (int nt = 0; nt < 4; ++nt) s[nt] = s[nt] - d; }
                float ps = 0.f;
#pragma unroll
                for (int nt = 0; nt < 4; ++nt)
#pragma unroll
                    for (int j = 0; j < 4; ++j) { const float p = __builtin_amdgcn_exp2f(s[nt][j]); s[nt][j] = p; ps += p; }
                lrun[mt] += ps;
                pf[mt][0].x = cvt_pk_bf16(s[0][0], s[0][1]); pf[mt][0].y = cvt_pk_bf16(s[0][2], s[0][3]); pf[mt][0].z = cvt_pk_bf16(s[1][0], s[1][1]); pf[mt][0].w = cvt_pk_bf16(s[1][2], s[1][3]);
                pf[mt][1].x = cvt_pk_bf16(s[2][0], s[2][1]); pf[mt][1].y = cvt_pk_bf16(s[2][2], s[2][3]); pf[mt][1].z = cvt_pk_bf16(s[3][0], s[3][1]); pf[mt][1].w = cvt_pk_bf16(s[3][2], s[3][3]);
              } }
#pragma unroll
            for (int dt = 0; dt < 4; ++dt) {
                const bf16x8 v0 = frag_tr(Vb, 4 * fq, 16 + 4 * fq, dt * 16, STR64, fr), v1 = frag_tr(Vb, 32 + 4 * fq, 48 + 4 * fq, dt * 16, STR64, fr);
#pragma unroll
                for (int mt = 0; mt < 4; ++mt) { MMA16(oacc[mt][dt], __builtin_bit_cast(bf16x8, pf[mt][0]), v0); MMA16(oacc[mt][dt], __builtin_bit_cast(bf16x8, pf[mt][1]), v1); } }
        }
        if (t + 1 < ntile) { LAS unsigned char* nb_ = lds + ((t + 1) & 1) * A_BUF; *(LAS u32x4*)(nb_ + A_KBUF + sr * STR64 + sc * 16) = kreg; *(LAS u32x4*)(nb_ + A_VBUF + sr * STR64 + sc * 16) = vreg; }
        __syncthreads();
    }
#pragma unroll
    for (int mt = 0; mt < 4; ++mt) { const float l = row4_sum(lrun[mt]); const float inv = 1.0f / l;
        bf16_t* op = BR + (size_t)(qrow0 + 64 * qh + 16 * mt + fr) * 1536 + 512 + (4 * kh + hq) * 64 + 4 * fq;
#pragma unroll
        for (int dt = 0; dt < 4; ++dt) { u32x2 w; w.x = cvt_pk_bf16(oacc[mt][dt][0] * inv, oacc[mt][dt][1] * inv); w.y = cvt_pk_bf16(oacc[mt][dt][2] * inv, oacc[mt][dt][3] * inv); *(u32x2*)(op + dt * 16) = w; } }
}

__device__ __forceinline__ void ph_mixA(const bf16_t* P, const bf16_t* QR, const bf16_t* KV, bf16_t* BR, const float* sink, const float* gla_w2, const float* gla_b, float* DS, float* DEC, float* BC, bool ctxq, LAS unsigned char* lds, const Ctx cx) {
    { LAS float* w2s = (LAS float*)(lds + G1_W2); for (int i = tidx(cx); i < 2 * 16 * 256; i += 512) w2s[i] = gla_w2[i]; }
    for (int u = cx.bid; u < 256; u += cx.nb) { const int b = u >> 5, n = (u >> 1) & 15, kh = u & 1; attn_unit(QR, KV, BR, sink, b, kh, b * SEQ + n * 128, n * 128, lds, cx); }
    if (cx.nb == 256) {
        const int n = (cx.bid >> 1) & 15; const bool edge = (n == 0 || n == 15);
        if (ctxq && edge) { const int b = cx.bid >> 5, kh = cx.bid & 1; attn_unit(QR, KV, BR, sink, b, kh, TL + b * CTXL + (n == 15 ? 128 : 0), -1000000, lds, cx); }
        int rank; if (!ctxq) rank = cx.bid; else { const int blk = cx.bid >> 5, w = cx.bid & 31; rank = edge ? -1 : blk * 28 + (w - 2); }
        const int nv = (rank >= 0 && rank < 128) ? 5 : 4;
        G1In cur, nxt; g1_load(cur, P, gla_b, cx.bid >> 2, cx.bid & 3, tidx(cx));
#pragma unroll 1
        for (int k = 0; k < nv; ++k) { const int v = k < 4 ? cx.bid + 256 * k : 1024 + rank; const int vn = (k + 1 < nv) ? ((k + 1) < 4 ? cx.bid + 256 * (k + 1) : 1024 + rank) : -1;
            gla_state_unit(cur, nxt, vn, P, v >> 2, v & 3, gla_b, DS, DEC, BC, lds, cx);
            if (vn >= 0) cur = nxt; }
        return;
    }
    const int nsmall = (ctxq ? 32 : 0) + 1152;
    for (int u = cx.bid; u < nsmall; u += cx.nb) {
        int v = u;
        if (ctxq) { if (v < 32) { const int b = v >> 2, n = (v >> 1) & 1, kh = v & 1; attn_unit(QR, KV, BR, sink, b, kh, TL + b * CTXL + n * 128, -1000000, lds, cx); continue; } v -= 32; }
        { G1In cur, nxt; g1_load(cur, P, gla_b, v >> 2, v & 3, tidx(cx)); gla_state_unit(cur, nxt, -1, P, v >> 2, v & 3, gla_b, DS, DEC, BC, lds, cx); }
    }
}
__device__ __forceinline__ void ph_mixC(const bf16_t* P, const float* BC, const bf16_t* SE, const float* gng, bf16_t* BR, int nchunks, LAS unsigned char* lds, const Ctx cx) {
    const int n = nchunks * 4; int u = cx.bid; G3In cur, nxt;
    if (u < n) g3_load(cur, P, u >> 2, u & 3, BC, SE, tidx(cx));
    for (; u < n; u += cx.nb) { const int un = u + cx.nb; const bool hn = un < n;
        if (hn) g3_load(nxt, P, un >> 2, un & 3, BC, SE, tidx(cx));
        gla_out_unit(cur, P, u >> 2, u & 3, gng, BR, lds, cx);
        if (hn) cur = nxt; }
}

template <int MODE, class Epi, int ABLK = 0> __device__ __forceinline__ void ph_gemm(LAS unsigned char* lds, const bf16_t* A, const bf16_t* Bt, int lda, int ldb, int K, int nM, int nN, const Epi& E, unsigned* ctl, int moe_j, size_t bexp, const Ctx cx) {
    pg8::Prob<MODE> P; P.A = A; P.Bt = Bt; P.lda = lda; P.ldb = ldb; P.K = K; P.nM = nM; P.nN = nN; P.G = cx.nb; P.c = cx.bid; P.texp = (LAS int*)(lds + LDS_TEXP); P.bexp = bexp; P.nctx = (MODE == 3) ? moe_j : 0;
    if (MODE == 2) {
        __syncthreads();
        if (tidx(cx) < 256) ((LAS int*)(lds + LDS_TEXP))[tidx(cx)] = (int)xb_ld(ctl + CW_TEXP + moe_j * 256 + tidx(cx));
        P.nM = (int)xb_ld(ctl + CW_NT + moe_j);
        __syncthreads();
    }
    pg8::gemm_phase<Epi, pg8::Prob<MODE>, ABLK>(lds, P, E, cx);
}

__device__ __forceinline__ bool idle_ctx(unsigned* ctl, int j, int nN, Ctx& cx) {
    const int U = (int)xb_ld(ctl + CW_NT + j) * nN, rounds = (U + cx.nb - 1) / cx.nb, nidle = rounds * cx.nb - U;
    if (nidle < 64) return true;
    const int first = cx.nb - nidle; if (cx.bid < first) return false;
    cx.bid -= first; cx.nb = nidle; return true;
}

struct MKP { const float* in[24]; float* out; char* ws; };
typedef const MKP __attribute__((address_space(4)))* KPtr;
__device__ __forceinline__ KPtr kp() { KPtr q = (KPtr)__builtin_amdgcn_kernarg_segment_ptr(); OPQ_S(q); return q; }
#define IN_(i) ((const float*)q->in[i])
#define WSP(off) (ws + (off))

__global__ void __launch_bounds__(512, 2) mk_fwd(MKP p_unused) {
    extern __shared__ __attribute__((aligned(16))) unsigned char shm[];
    LAS unsigned char* lds = (LAS unsigned char*)shm;
    const int nb = gridDim.x; const int wv = __builtin_amdgcn_readfirstlane((int)(threadIdx.x >> 6));
    XcdBarrier bar;
    { KPtr q = kp(); char* ws = q->ws;
      if (threadIdx.x == 0) *(LAS u32x4*)(lds + LDS_BARW) = (u32x4){0u, 0u, 0u, 0u};
      __syncthreads();
      bar = xcd_barrier_post((unsigned*)WSP(WS_CTL) + CW_BAR, (volatile LAS unsigned*)(lds + LDS_BARW)); }

    { KPtr q = kp(); char* ws = q->ws; Ctx cx; cx.bid = blockIdx.x; cx.nb = nb; cx.wv = wv; OPQ_S(cx.bid); OPQ_S(cx.wv);
      ph_init(IN_(0), IN_(2), (float*)nullptr, (f32x2*)WSP(WS_CS), cx);
      ph_mod(IN_(1), IN_(3), IN_(4), IN_(5), (float*)WSP(WS_MOD), lds, cx);
      __syncthreads(); }
    { int rot = 0;
#pragma unroll 1
      for (int l = 0; l < DEPTH; ++l) {
          KPtr q = kp(); char* ws = q->ws; Ctx cx; cx.bid = blockIdx.x; cx.nb = nb; cx.wv = wv; OPQ_S(cx.bid); OPQ_S(cx.wv);
          ph_convert(mkjob(IN_(8) + (size_t)l * D * DIN, nullptr, (bf16_t*)WSP(WS_WIN) + (size_t)l * NP * D, DIN, D, 0, D, NP, 1), lds, cx, rot);
          ph_convert(mkjob(IN_(15) + (size_t)l * D * D, nullptr, (bf16_t*)WSP(WS_WO3) + (size_t)l * D * D, D, D, 0, D, D, 0), lds, cx, rot);
#pragma unroll 1
          for (int i = 0; i < 3; ++i) {
              ph_convert(mkjob(IN_(14) + ((size_t)l * 3 + i) * 512 * D, nullptr, (bf16_t*)WSP(WS_WBR) + (size_t)l * D * 1536, D, 1536, i * 512, 512, 1024, 0), lds, cx, rot);
          }
      }
#pragma unroll 1
      for (int j = 0; j < 2; ++j) {
          KPtr q = kp(); char* ws = q->ws; Ctx cx; cx.bid = blockIdx.x; cx.nb = nb; cx.wv = wv; OPQ_S(cx.bid); OPQ_S(cx.wv);
          ph_convert(mkjob(IN_(16) + (size_t)j * D * DFF, IN_(17) + (size_t)j * D * DFF, (bf16_t*)WSP(WS_WUPD) + (size_t)j * NUP * D, DFF, D, 0, D, NUP, 2), lds, cx, rot);
          ph_convert(mkjob(IN_(18) + (size_t)j * DFF * D, nullptr, (bf16_t*)WSP(WS_WDND) + (size_t)j * D * DFF, D, DFF, 0, DFF, D, 0), lds, cx, rot);
      }
    }
    { Ctx cx; cx.bid = 0; cx.nb = nb; cx.wv = wv; OPQ_S(cx.wv); xcd_barrier_first(bar, cx); }

#pragma unroll 1
    for (int l = 0; l < DEPTH; ++l) {
        const bool last = (l == DEPTH - 1), moe = (l & 1); const int j = l >> 1; const int nrows = last ? TL : T; const int nMr = nrows / 256;
        { KPtr q = kp(); char* ws = q->ws; Ctx cx; cx.bid = blockIdx.x; cx.nb = nb; cx.wv = wv; OPQ_S(cx.bid); OPQ_S(cx.wv); const float* modl = (const float*)WSP(WS_MOD) + (size_t)l * 9 * 6144;
          NormArgs a; a.XS = (bf16_t*)WSP(WS_XS); a.lf32 = a.cf32 = (l == 0); a.Xl = l ? (const void*)WSP(WS_XS) : (const void*)IN_(0); a.Xc = l ? (const void*)WSP(WS_XS) : (const void*)(IN_(2) - (size_t)TL * D); a.H = (bf16_t*)WSP(WS_H); a.g = IN_(6) + l * D; a.mod_shift = modl; a.mod_scale = modl + 1024; a.nrows = T;
          a.Y = (const bf16_t*)WSP(WS_YB); a.POS = (const int*)WSP(WS_POS); a.TOPKp = (const float*)WSP(WS_TOPK); a.mod_g5prev = (const float*)WSP(WS_MOD) + (size_t)(l > 0 ? l - 1 : 0) * 9 * 6144 + 5 * 1024; a.router = nullptr; a.TOPK = nullptr; a.cnt = nullptr;
          a.npart = 7; a.PART = (l == 1 || l == 3) ? (const float*)WSP(WS_PART) : nullptr; a.mod_gpart = (const float*)WSP(WS_MOD) + (size_t)(l > 0 ? l - 1 : 0) * 9 * 6144 + 5 * 1024;
          ph_norm<false>(a, l == 2, lds, cx); }
        { Ctx cx; cx.bid = 0; cx.nb = nb; cx.wv = wv; OPQ_S(cx.wv); xcd_barrier(bar, cx); }
        { KPtr q = kp(); char* ws = q->ws; Ctx cx; cx.bid = blockIdx.x; cx.nb = nb; cx.wv = wv; OPQ_S(cx.bid); OPQ_S(cx.wv);
          pg8::EpiWin E{(bf16_t*)WSP(WS_PH), (bf16_t*)WSP(WS_QR), (bf16_t*)WSP(WS_KV), (const f32x2*)WSP(WS_CS), lds + LDS_CSH}; ph_gemm<0>(lds, (const bf16_t*)WSP(WS_H), (const bf16_t*)WSP(WS_WIN) + (size_t)l * NP * D, D, D, D, T / 256, NP / 256, E, nullptr, 0, 0, cx); }
        { Ctx cx; cx.bid = 0; cx.nb = nb; cx.wv = wv; OPQ_S(cx.wv); xcd_barrier(bar, cx); }
        { KPtr q = kp(); char* ws = q->ws; Ctx cx; cx.bid = blockIdx.x; cx.nb = nb; cx.wv = wv; OPQ_S(cx.bid); OPQ_S(cx.wv);
          ph_mixA((const bf16_t*)WSP(WS_PH), (const bf16_t*)WSP(WS_QR), (const bf16_t*)WSP(WS_KV), (bf16_t*)WSP(WS_BR), IN_(10) + l * 8, IN_(11) + (size_t)l * 2 * 16 * 256, IN_(12) + (size_t)l * 2 * 256,
                  (float*)WSP(WS_R3), (float*)WSP(WS_DEC), (float*)WSP(WS_YB), !last, lds, cx); }
        { Ctx cx; cx.bid = 0; cx.nb = nb; cx.wv = wv; OPQ_S(cx.wv); xcd_barrier(bar, cx); }
        { KPtr q = kp(); char* ws = q->ws; Ctx cx; cx.bid = blockIdx.x; cx.nb = nb; cx.wv = wv; OPQ_S(cx.bid); OPQ_S(cx.wv);
          ph_gla_scan2((const float*)WSP(WS_R3), (const float*)WSP(WS_DEC), (bf16_t*)(WSP(WS_R3) + (size_t)2 * T * 512 * 4), cx); }
        { Ctx cx; cx.bid = 0; cx.nb = nb; cx.wv = wv; OPQ_S(cx.wv); xcd_barrier(bar, cx); }
        { KPtr q = kp(); char* ws = q->ws; Ctx cx; cx.bid = blockIdx.x; cx.nb = nb; cx.wv = wv; OPQ_S(cx.bid); OPQ_S(cx.wv);
          ph_conv((const bf16_t*)WSP(WS_PH), (bf16_t*)WSP(WS_BR), IN_(9) + (size_t)l * 3 * 512, nrows, cx);
          ph_mixC((const bf16_t*)WSP(WS_PH), (const float*)WSP(WS_YB), (const bf16_t*)(WSP(WS_R3) + (size_t)2 * T * 512 * 4), IN_(13) + l * 512, (bf16_t*)WSP(WS_BR), nrows / 64, lds, cx); }
        { Ctx cx; cx.bid = 0; cx.nb = nb; cx.wv = wv; OPQ_S(cx.wv); xcd_barrier(bar, cx); }
        { KPtr q = kp(); char* ws = q->ws; Ctx cx; cx.bid = blockIdx.x; cx.nb = nb; cx.wv = wv; OPQ_S(cx.bid); OPQ_S(cx.wv);
          constexpr size_t MG3C_OFF = (size_t)TL * D * 2;
          if (!last) { pg8::EpiGate E{(bf16_t*)(WSP(WS_R3) + MG3C_OFF), (const bf16_t*)WSP(WS_PH) + (size_t)TL * NP, lds + LDS_CSH}; ph_gemm<1>(lds, (const bf16_t*)WSP(WS_BR) + (size_t)TL * 1536, (const bf16_t*)WSP(WS_WBR) + (size_t)l * D * 1536, 1536, 1536, 512, 8, 12, E, nullptr, 0, 0, cx); }
          { pg8::EpiMerge E{(bf16_t*)WSP(WS_R3), (const bf16_t*)WSP(WS_PH), lds + LDS_CSH}; ph_gemm<4>(lds, (const bf16_t*)WSP(WS_BR), (const bf16_t*)WSP(WS_WBR) + (size_t)l * D * 1536, 1536, 1536, 1536, 64, 4, E, nullptr, 0, 0, cx); } }
        { Ctx cx; cx.bid = 0; cx.nb = nb; cx.wv = wv; OPQ_S(cx.wv); xcd_barrier(bar, cx); }
        { KPtr q = kp(); char* ws = q->ws; Ctx cx; cx.bid = blockIdx.x; cx.nb = nb; cx.wv = wv; OPQ_S(cx.bid); OPQ_S(cx.wv);
          constexpr size_t MG3C_OFF = (size_t)TL * D * 2;
          pg8::EpiResid E{(bf16_t*)WSP(WS_XS), (const float*)WSP(WS_MOD) + (size_t)l * 9 * 6144 + 2 * 1024, (float*)WSP(WS_PART), l ? (const void*)WSP(WS_XS) : (const void*)IN_(0), lds + LDS_CSH, l == 0, 0};
          if (!last) ph_gemm<5>(lds, (const bf16_t*)(WSP(WS_R3) + MG3C_OFF) - (size_t)TL * 3072, (const bf16_t*)WSP(WS_WO3) + (size_t)l * D * D, 3072, D, 512, 8, 4, E, nullptr, 0, 0, cx);
          ph_gemm<0>(lds, (const bf16_t*)WSP(WS_R3), (const bf16_t*)WSP(WS_WO3) + (size_t)l * D * D, D, D, D, 64, 4, E, nullptr, 0, 0, cx); }
        { Ctx cx; cx.bid = 0; cx.nb = nb; cx.wv = wv; OPQ_S(cx.wv); xcd_barrier(bar, cx); }
        { KPtr q = kp(); char* ws = q->ws; Ctx cx; cx.bid = blockIdx.x; cx.nb = nb; cx.wv = wv; OPQ_S(cx.bid); OPQ_S(cx.wv); const float* modl = (const float*)WSP(WS_MOD) + (size_t)l * 9 * 6144;
          NormArgs a; a.XS = (bf16_t*)WSP(WS_XS); a.lf32 = 0; a.cf32 = (l == 0); a.Xl = (const void*)WSP(WS_XS); a.Xc = l ? (const void*)WSP(WS_XS) : (const void*)(IN_(2) - (size_t)TL * D); a.H = (bf16_t*)WSP(WS_H); a.g = IN_(7) + l * D; a.mod_shift = modl + 3 * 1024; a.mod_scale = modl + 4 * 1024; a.nrows = nrows;
          a.Y = nullptr; a.POS = nullptr; a.TOPKp = nullptr; a.mod_g5prev = nullptr; a.router = IN_(19) + (size_t)j * D * 8; a.TOPK = (float*)WSP(WS_TOPK); a.cnt = (unsigned*)WSP(WS_CTL) + CW_CNT + j * 64;
          a.npart = 6; a.PART = last ? nullptr : (const float*)WSP(WS_PART); a.mod_gpart = modl + 2 * 1024;
          if (moe) ph_norm<true>(a, false, lds, cx); else ph_norm<false>(a, false, lds, cx); }
        if (moe && j == 0) {
            int rot = 0;
#pragma unroll 1
            for (int e = 0; e < NEXP; ++e) { KPtr q = kp(); char* ws = q->ws; Ctx cx; cx.bid = blockIdx.x; cx.nb = nb; cx.wv = wv; OPQ_S(cx.bid); OPQ_S(cx.wv); const size_t eo = ((size_t)j * NEXP + e) * D * DFF;
                ph_convert(mkjob(IN_(20) + eo, IN_(21) + eo, (bf16_t*)WSP(WS_WUPM) + (size_t)e * NUP * D, DFF, D, 0, D, NUP, 2), lds, cx, rot);
            }
        }
        { Ctx cx; cx.bid = 0; cx.nb = nb; cx.wv = wv; OPQ_S(cx.wv); xcd_barrier(bar, cx); }
        if (!moe) {
            { KPtr q = kp(); char* ws = q->ws; Ctx cx; cx.bid = blockIdx.x; cx.nb = nb; cx.wv = wv; OPQ_S(cx.bid); OPQ_S(cx.wv);
              pg8::EpiSwiglu E{(bf16_t*)WSP(WS_PH)}; ph_gemm<0>(lds, (const bf16_t*)WSP(WS_H), (const bf16_t*)WSP(WS_WUPD) + (size_t)j * NUP * D, D, D, D, nMr, NUP / 256, E, nullptr, 0, 0, cx); }
            { Ctx cx; cx.bid = 0; cx.nb = nb; cx.wv = wv; OPQ_S(cx.wv); xcd_barrier(bar, cx); }
            { KPtr q = kp(); char* ws = q->ws; Ctx cx; cx.bid = blockIdx.x; cx.nb = nb; cx.wv = wv; OPQ_S(cx.bid); OPQ_S(cx.wv);
              pg8::EpiResid E{(bf16_t*)WSP(WS_XS), (const float*)WSP(WS_MOD) + (size_t)l * 9 * 6144 + 5 * 1024, (float*)WSP(WS_PART), (const void*)WSP(WS_XS), lds + LDS_CSH, 0, 0}; ph_gemm<3, pg8::EpiResid, 1>(lds, (const bf16_t*)WSP(WS_PH), (const bf16_t*)WSP(WS_WDND) + (size_t)j * D * DFF, DFF, DFF, DFF, nMr, 4, E, nullptr, last ? 0 : 224, 0, cx); }
            { Ctx cx; cx.bid = 0; cx.nb = nb; cx.wv = wv; OPQ_S(cx.wv); xcd_barrier(bar, cx); }
        } else {
            { KPtr q = kp(); char* ws = q->ws; Ctx cx; cx.bid = blockIdx.x; cx.nb = nb; cx.wv = wv; OPQ_S(cx.bid); OPQ_S(cx.wv);
              ph_route((const float*)WSP(WS_TOPK), (const bf16_t*)WSP(WS_H), (bf16_t*)WSP(WS_R3), (int*)WSP(WS_POS), (unsigned*)WSP(WS_CTL), j, nrows, lds, cx); }
            { Ctx cx; cx.bid = 0; cx.nb = nb; cx.wv = wv; OPQ_S(cx.wv); xcd_barrier(bar, cx); }
            { KPtr q = kp(); char* ws = q->ws; Ctx cx; cx.bid = blockIdx.x; cx.nb = nb; cx.wv = wv; OPQ_S(cx.bid); OPQ_S(cx.wv);
              pg8::EpiSwiglu E{(bf16_t*)WSP(WS_PH)}; ph_gemm<2>(lds, (const bf16_t*)WSP(WS_R3), (const bf16_t*)WSP(WS_WUPM), D, D, D, 0, NUP / 256, E, (unsigned*)WSP(WS_CTL), j, (size_t)NUP * D, cx);
              { Ctx c2 = cx; if (idle_ctx((unsigned*)WSP(WS_CTL), j, NUP / 256, c2)) { int rot = 0;
#pragma unroll 1
                  for (int e = 0; e < NEXP; ++e) { const size_t eo = ((size_t)j * NEXP + e) * D * DFF; ph_convert(mkjob(IN_(22) + eo, nullptr, (bf16_t*)WSP(WS_WDNM) + (size_t)e * D * DFF, D, DFF, 0, DFF, D, 0), lds, c2, rot); } } } }
            { Ctx cx; cx.bid = 0; cx.nb = nb; cx.wv = wv; OPQ_S(cx.wv); xcd_barrier(bar, cx); }
            { KPtr q = kp(); char* ws = q->ws; Ctx cx; cx.bid = blockIdx.x; cx.nb = nb; cx.wv = wv; OPQ_S(cx.bid); OPQ_S(cx.wv);
              pg8::EpiBf16 E{(bf16_t*)WSP(WS_YB), lds + LDS_CSH, D, 0}; ph_gemm<2, pg8::EpiBf16, 1>(lds, (const bf16_t*)WSP(WS_PH), (const bf16_t*)WSP(WS_WDNM), DFF, DFF, DFF, 0, 4, E, (unsigned*)WSP(WS_CTL), j, (size_t)D * DFF, cx);
              if (j == 0) { Ctx c2 = cx; if (idle_ctx((unsigned*)WSP(WS_CTL), j, 4, c2)) { int rot = 0;
#pragma unroll 1
                  for (int e = 0; e < NEXP; ++e) { const size_t eo = ((size_t)NEXP + e) * D * DFF; ph_convert(mkjob(IN_(20) + eo, IN_(21) + eo, (bf16_t*)WSP(WS_WUPM) + (size_t)e * NUP * D, DFF, D, 0, D, NUP, 2), lds, c2, rot); } } } }
            { Ctx cx; cx.bid = 0; cx.nb = nb; cx.wv = wv; OPQ_S(cx.wv); xcd_barrier(bar, cx); }
        }
    }
    { KPtr q = kp(); char* ws = q->ws; Ctx cx; cx.bid = blockIdx.x; cx.nb = nb; cx.wv = wv; OPQ_S(cx.bid); OPQ_S(cx.wv);
      ph_final((const bf16_t*)WSP(WS_XS), (const bf16_t*)WSP(WS_YB), (const int*)WSP(WS_POS), (const float*)WSP(WS_TOPK), (const float*)WSP(WS_MOD) + (size_t)3 * 9 * 6144 + 5 * 1024, IN_(23), q->out, cx); }
}

extern "C" void kernel_launch(void* const* d_in, const int* in_sizes, int n_in, void* d_out, int out_size, void* d_ws, size_t ws_size, hipStream_t stream) {
    (void)in_sizes; (void)out_size;
    if (n_in != 24 || ws_size < WS_END) return;
    static int grid = 0;
    if (!grid) {
        int dev = 0, cus = 0, per_cu = 0;
        if (hipGetDevice(&dev) != hipSuccess || hipDeviceGetAttribute(&cus, hipDeviceAttributeMultiprocessorCount, dev) != hipSuccess) return;
        if (hipFuncSetAttribute((const void*)mk_fwd, hipFuncAttributeMaxDynamicSharedMemorySize, LDS_BYTES) != hipSuccess) return;
        if (hipOccupancyMaxActiveBlocksPerMultiprocessor(&per_cu, mk_fwd, 512, LDS_BYTES) != hipSuccess || per_cu < 1) return;
        if (cus != 256) return;
        grid = cus;
    }
    (void)hipMemsetAsync((char*)d_ws + WS_CTL, 0, CTL_BYTES, stream);
    MKP p;
    for (int i = 0; i < 24; ++i) p.in[i] = (const float*)d_in[i];
    p.out = (float*)d_out; p.ws = (char*)d_ws;
    hipLaunchKernelGGL(mk_fwd, dim3(grid), dim3(512), LDS_BYTES, stream, p);
}
```

```cpp
#include <hip/hip_runtime.h>
#include <stdint.h>
#include <stddef.h>

#define LAS __attribute__((address_space(3)))
typedef unsigned short bf16_t;
typedef _Float16 f16_t;
typedef short bf16x8 __attribute__((ext_vector_type(8)));
typedef float f32x4 __attribute__((ext_vector_type(4)));
typedef float f32x2 __attribute__((ext_vector_type(2)));
typedef unsigned u32x4 __attribute__((ext_vector_type(4)));
typedef unsigned u32x2 __attribute__((ext_vector_type(2)));

constexpr int D = 1024, NBATCH = 8, SEQ = 2048, CTXL = 256, DEPTH = 4;
constexpr int TL = NBATCH * SEQ, TC = NBATCH * CTXL, T = TL + TC;
constexpr int DIN = 6944, NP = 7168;
constexpr int DFF = 3584, NUP = 2 * DFF;
constexpr int NEXP = 8;
constexpr int MAXR = 2 * T + NEXP * 256;
constexpr int P_CB = 0, P_CC = 512, P_CU = 1024, P_QA = 1536, P_KA = 2048, P_VA = 2176, P_QG = 2304, P_KG = 2560, P_VG = 2816, P_RG = 3328, P_GATE = 3840, P_AG = 6912;
constexpr float EPS = 1e-6f;
constexpr float LOG2E = 1.4426950408889634f, QSCALE = 0.125f * LOG2E;

constexpr size_t al256(size_t x) { return (x + 255) & ~(size_t)255; }
constexpr size_t WS_CTL = 0;                                   constexpr size_t CTL_BYTES = 65536;
constexpr size_t WS_MOD = WS_CTL + CTL_BYTES;                  constexpr size_t MOD_BYTES = (size_t)DEPTH * 9 * 6 * D * 4;
constexpr size_t WS_CS = al256(WS_MOD + MOD_BYTES);            constexpr size_t CS_BYTES = 64 * 16 * 8;
constexpr size_t WS_XS = al256(WS_CS + CS_BYTES);              constexpr size_t XS_BYTES = (size_t)T * D * 4;
constexpr size_t WS_H = al256(WS_XS + XS_BYTES);               constexpr size_t H_BYTES = (size_t)T * D * 2;
constexpr size_t WS_PH = al256(WS_H + H_BYTES);                constexpr size_t PH_BYTES = (size_t)MAXR * DFF * 2;
constexpr size_t WS_BR = al256(WS_PH + PH_BYTES);              constexpr size_t BR_BYTES = (size_t)T * 1536 * 2;
constexpr size_t WS_R3 = al256(WS_BR + BR_BYTES);              constexpr size_t R3_BYTES = (size_t)T * 3072 * 2;
constexpr size_t WS_YB = al256(WS_R3 + R3_BYTES);              constexpr size_t YB_BYTES = (size_t)MAXR * D * 2;
constexpr size_t WS_QR = al256(WS_YB + YB_BYTES);              constexpr size_t QR_BYTES = (size_t)T * 512 * 2;
constexpr size_t WS_KV = al256(WS_QR + QR_BYTES);              constexpr size_t KV_BYTES = (size_t)T * 256 * 2;
constexpr size_t WS_TOPK = al256(WS_KV + KV_BYTES);            constexpr size_t TOPK_BYTES = (size_t)T * 16;
constexpr size_t WS_POS = al256(WS_TOPK + TOPK_BYTES);         constexpr size_t POS_BYTES = (size_t)T * 8;
constexpr size_t WS_IDX = al256(WS_POS + POS_BYTES);           constexpr size_t IDX_BYTES = (size_t)MAXR * 4;
constexpr size_t WS_DEC = al256(WS_IDX + IDX_BYTES);           constexpr size_t DEC_BYTES = (size_t)(T / 64) * 4 * 2 * 64 * 4;
constexpr size_t WS_PART = al256(WS_DEC + DEC_BYTES);         constexpr size_t PART_BYTES = (size_t)7 * TC * D * 4;
constexpr size_t WS_WIN = al256(WS_PART + PART_BYTES);           constexpr size_t WIN_BYTES = (size_t)DEPTH * NP * D * 2;
constexpr size_t WS_WBR = al256(WS_WIN + WIN_BYTES);           constexpr size_t WBR_BYTES = (size_t)DEPTH * D * 1536 * 2;
constexpr size_t WS_WO3 = al256(WS_WBR + WBR_BYTES);           constexpr size_t WO3_BYTES = (size_t)DEPTH * D * D * 2;
constexpr size_t WS_WUPD = al256(WS_WO3 + WO3_BYTES);          constexpr size_t WUPD_BYTES = (size_t)2 * NUP * D * 2;
constexpr size_t WS_WDND = al256(WS_WUPD + WUPD_BYTES);        constexpr size_t WDND_BYTES = (size_t)2 * D * DFF * 2;
constexpr size_t WS_WUPM = al256(WS_WDND + WDND_BYTES);        constexpr size_t WUPM_BYTES = (size_t)NEXP * NUP * D * 2;
constexpr size_t WS_WDNM = al256(WS_WUPM + WUPM_BYTES);        constexpr size_t WDNM_BYTES = (size_t)NEXP * D * DFF * 2;
constexpr size_t WS_END = al256(WS_WDNM + WDNM_BYTES);
constexpr int CW_CNT = 0;
constexpr int CW_FILL = 128;
constexpr int CW_TEXP = 1024;
constexpr int CW_NT = 1536;

typedef __bf16 bf16x2_t __attribute__((ext_vector_type(2)));
__device__ __forceinline__ unsigned cvt_pk_bf16(float lo, float hi) { const f32x2 v = {lo, hi}; return __builtin_bit_cast(unsigned, __builtin_convertvector(v, bf16x2_t)); }
__device__ __forceinline__ float bf_lo(unsigned w) { return __uint_as_float(w << 16); }
__device__ __forceinline__ float bf_hi(unsigned w) { return __uint_as_float(w & 0xffff0000u); }
__device__ __forceinline__ float bf2f(bf16_t b) { return __uint_as_float(((unsigned)b) << 16); }
__device__ __forceinline__ bf16_t f2bf(float f) { return (bf16_t)(cvt_pk_bf16(f, 0.f) & 0xffffu); }
__device__ __forceinline__ float sigmoidf_(float x) { return __builtin_amdgcn_rcpf(1.0f + __builtin_amdgcn_exp2f(x * -1.4426950408889634f)); }
__device__ __forceinline__ float swg_(float a, float b) { return (a * b) * __builtin_amdgcn_rcpf(1.0f + __builtin_amdgcn_exp2f(a)); }
__device__ __forceinline__ float siluf_(float x) { return x * __builtin_amdgcn_rcpf(1.0f + __builtin_amdgcn_exp2f(x * -1.4426950408889634f)); }
__device__ __forceinline__ float shx(float v, int mask, int lane) { return __int_as_float(__builtin_amdgcn_ds_bpermute((lane ^ mask) << 2, __float_as_int(v))); }
__device__ __forceinline__ float shl_(float v, int src) { return __int_as_float(__builtin_amdgcn_ds_bpermute(src << 2, __float_as_int(v))); }
__device__ __forceinline__ float wave_total(float v) {
    v += __int_as_float(__builtin_amdgcn_update_dpp(0, __float_as_int(v), 0x111, 0xF, 0xF, true));
    v += __int_as_float(__builtin_amdgcn_update_dpp(0, __float_as_int(v), 0x112, 0xF, 0xF, true));
    v += __int_as_float(__builtin_amdgcn_update_dpp(0, __float_as_int(v), 0x114, 0xF, 0xF, true));
    v += __int_as_float(__builtin_amdgcn_update_dpp(0, __float_as_int(v), 0x118, 0xF, 0xF, true));
    v += __int_as_float(__builtin_amdgcn_update_dpp(0, __float_as_int(v), 0x142, 0xA, 0xF, false));
    v += __int_as_float(__builtin_amdgcn_update_dpp(0, __float_as_int(v), 0x143, 0xC, 0xF, false));
    return __int_as_float(__builtin_amdgcn_readlane(__float_as_int(v), 63));
}
__device__ __forceinline__ float wave_sum(float v, int lane) {
#pragma unroll
    for (int o = 32; o >= 1; o >>= 1) v += shx(v, o, lane);
    return v;
}
__device__ __forceinline__ float wave_max(float v, int lane) {
#pragma unroll
    for (int o = 32; o >= 1; o >>= 1) v = fmaxf(v, shx(v, o, lane));
    return v;
}
__device__ __forceinline__ unsigned lds_add(LAS unsigned* p, unsigned v) { return __hip_atomic_fetch_add(p, v, __ATOMIC_RELAXED, __HIP_MEMORY_SCOPE_WORKGROUP); }
__device__ __forceinline__ f32x4 ldx_raw(const void* base, bool f32src, size_t idx) { if (f32src) return *(const f32x4*)((const float*)base + idx); const u32x2 w = *(const u32x2*)((const bf16_t*)base + idx); return (f32x4){__uint_as_float(w.x), __uint_as_float(w.y), 0.f, 0.f}; }
__device__ __forceinline__ f32x4 cvx(const f32x4 raw, bool f32src) { if (f32src) return raw; const unsigned a = __float_as_uint(raw[0]), b = __float_as_uint(raw[1]); return (f32x4){__uint_as_float(a << 16), __uint_as_float(a & 0xffff0000u), __uint_as_float(b << 16), __uint_as_float(b & 0xffff0000u)}; }
__device__ __forceinline__ void stx(bf16_t* p, const f32x4 v) { u32x2 w; w.x = cvt_pk_bf16(v[0], v[1]); w.y = cvt_pk_bf16(v[2], v[3]); *(u32x2*)p = w; }
__device__ __forceinline__ int mod_row(int row) { return row < TL ? (row >> 11) : 8; }
struct Ctx { int bid, nb, wv; };
__device__ __forceinline__ int tidx(const Ctx& cx) { int z = cx.wv << 6; asm volatile("" : "+s"(z)); return (int)__builtin_amdgcn_mbcnt_hi(~0u, __builtin_amdgcn_mbcnt_lo(~0u, (unsigned)z)); }
#define OPQ_S(x) asm volatile("" : "+s"(x))
__device__ __forceinline__ float vmax2(float a, float b) { return __builtin_elementwise_maximum(a, b); }
__device__ __forceinline__ float row4_max(float v) { auto a = __builtin_amdgcn_permlane16_swap(__float_as_uint(v), __float_as_uint(v), false, false); v = vmax2(__uint_as_float(a[0]), __uint_as_float(a[1]));
    auto b = __builtin_amdgcn_permlane32_swap(__float_as_uint(v), __float_as_uint(v), false, false); return vmax2(__uint_as_float(b[0]), __uint_as_float(b[1])); }
__device__ __forceinline__ float row4_sum(float v) { auto a = __builtin_amdgcn_permlane16_swap(__float_as_uint(v), __float_as_uint(v), false, false); v = __uint_as_float(a[0]) + __uint_as_float(a[1]);
    auto b = __builtin_amdgcn_permlane32_swap(__float_as_uint(v), __float_as_uint(v), false, false); return __uint_as_float(b[0]) + __uint_as_float(b[1]); }

__device__ __forceinline__ u32x4 pack8(const float* v) { u32x4 w; w.x = cvt_pk_bf16(v[0], v[1]); w.y = cvt_pk_bf16(v[2], v[3]); w.z = cvt_pk_bf16(v[4], v[5]); w.w = cvt_pk_bf16(v[6], v[7]); return w; }
__device__ __forceinline__ void unpack8(const u32x4 w, float* v) { v[0] = bf_lo(w.x); v[1] = bf_hi(w.x); v[2] = bf_lo(w.y); v[3] = bf_hi(w.y); v[4] = bf_lo(w.z); v[5] = bf_hi(w.z); v[6] = bf_lo(w.w); v[7] = bf_hi(w.w); }
#define LDS_BAR() do { asm volatile("s_waitcnt lgkmcnt(0)" ::: "memory"); __builtin_amdgcn_s_barrier(); asm volatile("" ::: "memory"); } while (0)
namespace pg8 {
constexpr int BM = 256, BK = 64, HALF = 128, HTB = HALF * BK * 2, STAGE_BYTES = 8 * HTB, NXCD = 8, WGM = 8;
constexpr int CSH_STR = 144, CSH_SLICE = 16 * CSH_STR;
__host__ __device__ __forceinline__ int lds_byte(int r, int c) { const int st = (r >> 4) * 2 + (c >> 5), rr = r & 15, cc = c & 31, ob = rr * 64 + cc * 2; return st * 1024 + (ob ^ (((ob >> 9) & 1) << 5)); }
__host__ __device__ __forceinline__ void stage_rc(int b, int& R, int& C) { const int st = b / 1024, sb = b % 1024, swz = sb ^ (((sb >> 9) & 1) << 5); R = (st >> 1) * 16 + swz / 64; C = (st & 1) * 32 + (swz % 64) / 2; }
__host__ __device__ __forceinline__ int perm32(int rho) { const int n = rho >> 4, i = rho & 15; return 8 * (i >> 2) + 4 * n + (i & 3); }
struct Unit { int pm, pn, kofs, kofsB, nt, part; };

__device__ __forceinline__ bool static_next(int i, int G, int c, int nM, int nN, Unit& u) {
    const int nwg = nM * nN; const long L = (long)i * G + c; if (L >= nwg) return false;
    int wgid = (int)L; { const int q = nwg / NXCD, r = nwg % NXCD, xcd = wgid % NXCD, off = wgid / NXCD; wgid = (xcd < r ? xcd * (q + 1) : r * (q + 1) + (xcd - r) * q) + off; }
    const int nig = WGM * nN, gid = wgid / nig, fm = gid * WGM, gsz = (nM - fm) < WGM ? (nM - fm) : WGM;
    u.pm = fm + ((wgid % nig) % gsz); u.pn = (wgid % nig) / gsz; return true;
}

template <int MODE> struct Prob {
    const bf16_t* A; const bf16_t* Bt; int lda, ldb, K, nM, nN, G, c; const LAS int* texp; size_t bexp; int nctx;
    __device__ __forceinline__ bool next(int i, Unit& u) const {
        u.kofs = 0; u.kofsB = 0; u.nt = K / BK; u.part = -1;
        if (MODE == 3) {
            const int idx = i + (c < nctx ? 0 : 1);
            if (idx == 0) { const int ct = c / 7; u.pm = 64 + (ct >> 2); u.pn = ct & 3; u.part = c - ct * 7; u.nt = K / (7 * BK); u.kofs = u.part * (K / 7); u.kofsB = u.kofs; return true; }
            return static_next(idx - 1, G, c, 64, 4, u);
        }
        if (MODE == 4) { const int seg = i % 3; u.kofs = seg * 512; u.kofsB = u.kofs; u.nt = 8; u.part = seg; return static_next(i / 3, G, c, 64, 4, u); }
        if (MODE == 5) { const int L = i * G + c; if (L >= 192) return false; const int ct = L / 6, sub = L - ct * 6; u.pm = 64 + (ct >> 2); u.pn = ct & 3; u.part = sub; u.nt = 8; u.kofs = (sub >> 1) * 1024 + (sub & 1) * 512; u.kofsB = (sub & 1) * 512; return true; }
        const bool ok = static_next(i, G, c, nM, nN, u);
        if (MODE == 1) { u.kofs = (u.pn >> 2) * 512; u.kofsB = u.kofs; }
        return ok;
    }
    __device__ __forceinline__ const char* a_base(const Unit& u, bool ablk) const { return (const char*)(A + (size_t)u.pm * BM * lda + (ablk ? 2 * u.kofs : u.kofs)); }
    __device__ __forceinline__ const char* b_base(const Unit& u) const { const bf16_t* p = Bt + (size_t)(MODE == 1 ? (u.pn & 3) : u.pn) * BM * ldb + 2 * u.kofsB; if (MODE == 2) p += (size_t)texp[u.pm] * bexp; return (const char*)p; }
};

template <class Epi, class PB, int ABLK>
__device__ __forceinline__ void gemm_phase(LAS unsigned char* lds, const PB& P, const Epi& E, const Ctx cx) {
    const int tid = tidx(cx), wid = __builtin_amdgcn_readfirstlane(tid >> 6), lane = tid & 63, wr = wid >> 2, wc = wid & 3, fr = lane & 15, fq = lane >> 4;
    unsigned voffA[2], voffB[2];
#pragma unroll
    for (int i = 0; i < 2; ++i) { int R, C; stage_rc(tid * 16 + i * 8192, R, C); const int Rb = (int)Epi::PERM == 2 ? (2 * (R & ~31) + perm32(R & 31)) : Epi::PERM ? ((R & ~31) + perm32(R & 31)) : R;
        voffA[i] = ABLK ? (unsigned)((((R >> 1) * (P.lda >> 5) + (C >> 5)) * 64 + (R & 1) * 32 + (C & 31)) * 2) : (unsigned)(R * P.lda + C) * 2u;     voffB[i] = (unsigned)((((Rb >> 1) * (P.ldb >> 5) + (C >> 5)) * 64 + (Rb & 1) * 32 + (C & 31)) * 2);     }
    const size_t kstep = (size_t)(BK * 4), kstepA = ABLK ? (size_t)(BK * 4) : (size_t)(BK * 2);
    const size_t hstepA = (size_t)HALF * P.lda * 2, hstepB = (size_t)((int)Epi::PERM == 2 ? 32 : HALF) * P.ldb * 2;
    const unsigned ldsw = (unsigned)wid * 1024u;
    const int aoff = lds_byte(wr * 64 + fr, fq * 8), boff = lds_byte(wc * 32 + fr, fq * 8);
#define PG8_SA(b, h) (((b) * 2 + (h)) * HTB)
#define PG8_SB(b, h) ((4 + (b) * 2 + (h)) * HTB)
#define PG8_STAGE(bufoff, gbase, voff) do { _Pragma("unroll") for (int _i = 0; _i < 2; ++_i) \
        __builtin_amdgcn_global_load_lds((const unsigned*)((const char*)(gbase) + (voff)[_i]), (LAS unsigned*)(lds + (bufoff) + ldsw + _i * 8192), 16, 0, 0); } while (0)
#define PG8_LDA(dst, b, h) do { _Pragma("unroll") for (int m = 0; m < 4; ++m) _Pragma("unroll") for (int k = 0; k < 2; ++k) dst[m][k] = *(const LAS bf16x8*)(lds + PG8_SA(b, h) + aoff + m * 2048 + k * 1024); } while (0)
#define PG8_LDB(dst, b, h) do { _Pragma("unroll") for (int n = 0; n < 2; ++n) _Pragma("unroll") for (int k = 0; k < 2; ++k) dst[n][k] = *(const LAS bf16x8*)(lds + PG8_SB(b, h) + boff + n * 2048 + k * 1024); } while (0)
#define PG8_MMA(ai, bj, At, Bt) do { __builtin_amdgcn_s_setprio(1); _Pragma("unroll") for (int m = 0; m < 4; ++m) _Pragma("unroll") for (int n = 0; n < 2; ++n) _Pragma("unroll") for (int k = 0; k < 2; ++k) \
        acc[ai][bj][m][n] = __builtin_amdgcn_mfma_f32_16x16x32_bf16(Bt[n][k], At[m][k], acc[ai][bj][m][n], 0, 0, 0); __builtin_amdgcn_s_setprio(0); } while (0)
#define PG8_WAIT_V(n) asm volatile("s_waitcnt vmcnt(" #n ")" ::: "memory")
#define PG8_WAIT_L(n) asm volatile("s_waitcnt lgkmcnt(" #n ")" ::: "memory")
#define PG8_BAR __builtin_amdgcn_s_barrier()
#define PG8_SCHED __builtin_amdgcn_sched_barrier(0)
    Unit cur, nxt; int ui = 0;
    if (!P.next(0, cur)) return;
    f32x4 acc[2][2][4][2];
#pragma unroll
    for (int a = 0; a < 2; ++a)
#pragma unroll
        for (int b = 0; b < 2; ++b)
#pragma unroll
            for (int m = 0; m < 4; ++m)
#pragma unroll
                for (int n = 0; n < 2; ++n) acc[a][b][m][n] = (f32x4){0.f, 0.f, 0.f, 0.f};
    bf16x8 At[4][2], B0[2][2], B1[2][2];
    const char* cA = P.a_base(cur, ABLK != 0); const char* cB = P.b_base(cur);
    PG8_STAGE(PG8_SB(0, 0), cB, voffB); PG8_STAGE(PG8_SB(0, 1), cB + hstepB, voffB); PG8_STAGE(PG8_SA(0, 0), cA, voffA); PG8_STAGE(PG8_SA(0, 1), cA + hstepA, voffA);
    if (wr == 1) PG8_BAR;
    PG8_WAIT_V(2); PG8_BAR;
    PG8_STAGE(PG8_SB(1, 0), cB + kstep, voffB); PG8_STAGE(PG8_SA(1, 0), cA + kstepA, voffA); PG8_STAGE(PG8_SB(1, 1), cB + hstepB + kstep, voffB);
    PG8_WAIT_V(6); PG8_BAR;
    for (;;) {
        const bool has_next = P.next(ui + 1, nxt);
        const char* nA = has_next ? P.a_base(nxt, ABLK != 0) : cA; const char* nB = has_next ? P.b_base(nxt) : cB;
        const int nt = cur.nt;
        for (int t = 0; t < nt; t += 2) {
            const bool last = (t == nt - 2);
            const char* a1 = cA + (size_t)(t + 1) * kstepA;
            const char* a2 = last ? nA : cA + (size_t)(t + 2) * kstepA; const char* b2 = last ? nB : cB + (size_t)(t + 2) * kstep;
            const char* a3 = a2 + kstepA; const char* b3 = b2 + kstep;
            PG8_LDB(B0, 0, 0); PG8_LDB(B1, 0, 1); PG8_SCHED; PG8_LDA(At, 0, 0); PG8_STAGE(PG8_SA(1, 1), a1 + hstepA, voffA);
            PG8_WAIT_V(8); PG8_WAIT_L(0); PG8_BAR; PG8_MMA(0, 0, At, B0); PG8_MMA(0, 1, At, B1); PG8_BAR; PG8_SCHED;
            PG8_LDA(At, 0, 1); PG8_STAGE(PG8_SB(0, 0), b2, voffB); PG8_STAGE(PG8_SB(0, 1), b2 + hstepB, voffB); PG8_STAGE(PG8_SA(0, 0), a2, voffA);
            PG8_WAIT_V(8); PG8_WAIT_L(0); PG8_BAR; PG8_MMA(1, 0, At, B0); PG8_MMA(1, 1, At, B1); PG8_BAR; PG8_SCHED;
            PG8_LDB(B0, 1, 0); PG8_LDB(B1, 1, 1); PG8_SCHED; PG8_LDA(At, 1, 0); PG8_STAGE(PG8_SA(0, 1), a2 + hstepA, voffA);
            PG8_WAIT_V(8); PG8_WAIT_L(0); PG8_BAR; PG8_MMA(0, 0, At, B0); PG8_MMA(0, 1, At, B1); PG8_BAR; PG8_SCHED;
            PG8_LDA(At, 1, 1); PG8_STAGE(PG8_SB(1, 0), b3, voffB); PG8_STAGE(PG8_SB(1, 1), b3 + hstepB, voffB); PG8_STAGE(PG8_SA(1, 0), a3, voffA);
            PG8_WAIT_V(8); PG8_WAIT_L(0); PG8_BAR; PG8_MMA(1, 0, At, B0); PG8_MMA(1, 1, At, B1); PG8_BAR; PG8_SCHED;
        }
        if (wr == 0) PG8_BAR;
        E(acc, cur, wr, wc, fr, fq);
        if (!has_next) break;
#pragma unroll
        for (int a = 0; a < 2; ++a)
#pragma unroll
            for (int b = 0; b < 2; ++b)
#pragma unroll
                for (int m = 0; m < 4; ++m)
#pragma unroll
                    for (int n = 0; n < 2; ++n) acc[a][b][m][n] = (f32x4){0.f, 0.f, 0.f, 0.f};
        cur = nxt; cA = nA; cB = nB; ++ui;
        if (wr == 1) PG8_BAR;
    }
    PG8_WAIT_V(0);
    PG8_BAR;
#undef PG8_SA
#undef PG8_SB
#undef PG8_STAGE
#undef PG8_LDA
#undef PG8_LDB
#undef PG8_MMA
#undef PG8_WAIT_V
#undef PG8_WAIT_L
#undef PG8_BAR
#undef PG8_SCHED
}

__device__ __forceinline__ void relay16(const f32x4 (&a)[2][2], LAS unsigned char* wp, const LAS unsigned char* rp, u32x4 (&x)[2]) {
#pragma unroll
    for (int bj = 0; bj < 2; ++bj) { u32x4 w; w.x = cvt_pk_bf16(a[bj][0][0], a[bj][0][1]); w.y = cvt_pk_bf16(a[bj][0][2], a[bj][0][3]); w.z = cvt_pk_bf16(a[bj][1][0], a[bj][1][1]); w.w = cvt_pk_bf16(a[bj][1][2], a[bj][1][3]);
        *(LAS u32x4*)(wp + bj * 64) = w; }
    asm volatile("" ::: "memory"); __builtin_amdgcn_wave_barrier();
    x[0] = *(const LAS u32x4*)rp; x[1] = *(const LAS u32x4*)(rp + 8 * CSH_STR);
    asm volatile("" ::: "memory"); __builtin_amdgcn_wave_barrier();
}
__device__ __forceinline__ u32x4 gate8x(const u32x4& x, const u32x4& g, const u32x4& o) {
    float xv[8], gv[8], ov[8]; unpack8(x, xv); unpack8(g, gv); unpack8(o, ov);
#pragma unroll
    for (int e = 0; e < 8; ++e) ov[e] += xv[e] * __builtin_amdgcn_rcpf(1.0f + __builtin_amdgcn_exp2f(gv[e]));
    return pack8(ov);
}
__device__ __forceinline__ u32x4 gate8x0(const u32x4& x, const u32x4& g) {
    float xv[8], gv[8]; unpack8(x, xv); unpack8(g, gv);
#pragma unroll
    for (int e = 0; e < 8; ++e) xv[e] = xv[e] * __builtin_amdgcn_rcpf(1.0f + __builtin_amdgcn_exp2f(gv[e]));
    return pack8(xv);
}
struct EpiBf16 {
    static constexpr int PERM = 2;
    bf16_t* O; LAS unsigned char* sh; int ldc; int pad_;
    __device__ __forceinline__ void operator()(const f32x4 (&acc)[2][2][4][2], const Unit& u, int wr, int wc, int fr, int fq) const {
        LAS unsigned char* my = sh + (wr * 4 + wc) * CSH_SLICE; const int lane = fq * 16 + fr, r8 = lane >> 3, c8 = lane & 7;
        LAS unsigned char* wp = my + fr * CSH_STR + fq * 16; const LAS unsigned char* rp = my + r8 * CSH_STR + c8 * 16;
        bf16_t* ob = O + (size_t)(u.pm * BM + wr * 64 + r8) * ldc + u.pn * BM + wc * 64 + 8 * c8;
#pragma unroll
        for (int ai = 0; ai < 2; ++ai)
#pragma unroll
            for (int m = 0; m < 4; ++m) { u32x4 x[2];
                const f32x4 a[2][2] = {{acc[ai][0][m][0], acc[ai][0][m][1]}, {acc[ai][1][m][0], acc[ai][1][m][1]}};
                relay16(a, wp, rp, x);
                bf16_t* rowp = ob + (size_t)(ai * HALF + m * 16) * ldc;
                *(u32x4*)rowp = x[0]; *(u32x4*)(rowp + (size_t)8 * ldc) = x[1]; }
    }
};
struct EpiWin {
    static constexpr int PERM = 2;
    bf16_t* O; bf16_t* QR; bf16_t* KV; const f32x2* CS; LAS unsigned char* sh;
    __device__ __forceinline__ void operator()(const f32x4 (&acc)[2][2][4][2], const Unit& u, int wr, int wc, int fr, int fq) const {
        const int row0 = u.pm * BM + wr * 64 + fr;
        if (u.pn < 6 || u.pn > 8) {
            LAS unsigned char* my = sh + (wr * 4 + wc) * CSH_SLICE; const int lane = fq * 16 + fr, r8 = lane >> 3, c8 = lane & 7;
            LAS unsigned char* wp = my + fr * CSH_STR + fq * 16; const LAS unsigned char* rp = my + r8 * CSH_STR + c8 * 16;
            bf16_t* ob = O + (size_t)(u.pm * BM + wr * 64 + r8) * NP + u.pn * BM + wc * 64 + 8 * c8;
#pragma unroll
            for (int ai = 0; ai < 2; ++ai)
#pragma unroll
                for (int m = 0; m < 4; ++m) {
#pragma unroll
                    for (int bj = 0; bj < 2; ++bj) { const f32x4 v0 = acc[ai][bj][m][0], v1 = acc[ai][bj][m][1];
                        u32x4 w; w.x = cvt_pk_bf16(v0[0], v0[1]); w.y = cvt_pk_bf16(v0[2], v0[3]); w.z = cvt_pk_bf16(v1[0], v1[1]); w.w = cvt_pk_bf16(v1[2], v1[3]);
                        *(LAS u32x4*)(wp + bj * 64) = w; }
                    asm volatile("" ::: "memory"); __builtin_amdgcn_wave_barrier();
                    const u32x4 x0 = *(const LAS u32x4*)rp, x1 = *(const LAS u32x4*)(rp + 8 * CSH_STR);
                    asm volatile("" ::: "memory"); __builtin_amdgcn_wave_barrier();
                    bf16_t* rowp = ob + (size_t)(ai * HALF + m * 16) * NP;
                    *(u32x4*)rowp = x0; *(u32x4*)(rowp + (size_t)8 * NP) = x1; }
            return;
        }
        const bool lat = u.pm < 64; const bool isq = u.pn < 8; const bool rot = isq || wc < 2;
#pragma unroll
        for (int ai = 0; ai < 2; ++ai)
#pragma unroll
            for (int m = 0; m < 4; ++m) { const int row = row0 + ai * HALF + m * 16; const int sp = row & (SEQ - 1);
#pragma unroll
                for (int bj = 0; bj < 2; ++bj) { const f32x4 v0 = acc[ai][bj][m][0], v1 = acc[ai][bj][m][1]; float o[8];
                    const int ps = bj ? (sp & 63) : (sp >> 6);
                    f32x4 c01 = (f32x4){1.f, 0.f, 1.f, 0.f}, c23 = c01;
                    if (lat && rot) { const f32x4* cp = (const f32x4*)(CS + ps * 16 + 4 * fq); c01 = cp[0]; c23 = cp[1]; }
                    if (rot) {
                        o[0] = v0[0] * c01[0] - v0[1] * c01[1]; o[1] = v0[1] * c01[0] + v0[0] * c01[1]; o[2] = v0[2] * c01[2] - v0[3] * c01[3]; o[3] = v0[3] * c01[2] + v0[2] * c01[3];
                        o[4] = v1[0] * c23[0] - v1[1] * c23[1]; o[5] = v1[1] * c23[0] + v1[0] * c23[1]; o[6] = v1[2] * c23[2] - v1[3] * c23[3]; o[7] = v1[3] * c23[2] + v1[2] * c23[3];
                    } else { o[0] = v0[0]; o[1] = v0[1]; o[2] = v0[2]; o[3] = v0[3]; o[4] = v1[0]; o[5] = v1[1]; o[6] = v1[2]; o[7] = v1[3]; }
                    u32x4 w;
                    if (isq) { w.x = cvt_pk_bf16(o[0] * QSCALE, o[1] * QSCALE); w.y = cvt_pk_bf16(o[2] * QSCALE, o[3] * QSCALE); w.z = cvt_pk_bf16(o[4] * QSCALE, o[5] * QSCALE); w.w = cvt_pk_bf16(o[6] * QSCALE, o[7] * QSCALE);
                        *(u32x4*)(QR + (size_t)row * 512 + (u.pn - 6) * 256 + wc * 64 + bj * 32 + 8 * fq) = w; }
                    else { w.x = cvt_pk_bf16(o[0], o[1]); w.y = cvt_pk_bf16(o[2], o[3]); w.z = cvt_pk_bf16(o[4], o[5]); w.w = cvt_pk_bf16(o[6], o[7]);
                        *(u32x4*)(KV + (size_t)row * 256 + wc * 64 + bj * 32 + 8 * fq) = w; } } }
    }
};
__device__ __forceinline__ u32x4 gate8(const f32x4& v0, const f32x4& v1, const u32x4& g) {
    u32x4 w;
    w.x = cvt_pk_bf16(v0[0] * sigmoidf_(bf_lo(g.x)), v0[1] * sigmoidf_(bf_hi(g.x))); w.y = cvt_pk_bf16(v0[2] * sigmoidf_(bf_lo(g.y)), v0[3] * sigmoidf_(bf_hi(g.y)));
    w.z = cvt_pk_bf16(v1[0] * sigmoidf_(bf_lo(g.z)), v1[1] * sigmoidf_(bf_hi(g.z))); w.w = cvt_pk_bf16(v1[2] * sigmoidf_(bf_lo(g.w)), v1[3] * sigmoidf_(bf_hi(g.w))); return w; }
__device__ __forceinline__ u32x4 gate8acc(const f32x4& v0, const f32x4& v1, const u32x4& g, const u32x4& o) {
    u32x4 w;
    w.x = cvt_pk_bf16(bf_lo(o.x) + v0[0] * sigmoidf_(bf_lo(g.x)), bf_hi(o.x) + v0[1] * sigmoidf_(bf_hi(g.x))); w.y = cvt_pk_bf16(bf_lo(o.y) + v0[2] * sigmoidf_(bf_lo(g.y)), bf_hi(o.y) + v0[3] * sigmoidf_(bf_hi(g.y)));
    w.z = cvt_pk_bf16(bf_lo(o.z) + v1[0] * sigmoidf_(bf_lo(g.z)), bf_hi(o.z) + v1[1] * sigmoidf_(bf_hi(g.z))); w.w = cvt_pk_bf16(bf_lo(o.w) + v1[2] * sigmoidf_(bf_lo(g.w)), bf_hi(o.w) + v1[3] * sigmoidf_(bf_hi(g.w))); return w; }
struct EpiGate {
    static constexpr int PERM = 2;
    bf16_t* O; const bf16_t* Pg; LAS unsigned char* sh;
    __device__ __forceinline__ void operator()(const f32x4 (&acc)[2][2][4][2], const Unit& u, int wr, int wc, int fr, int fq) const {
        LAS unsigned char* my = sh + (wr * 4 + wc) * CSH_SLICE; const int lane = fq * 16 + fr, r8 = lane >> 3, c8 = lane & 7;
        LAS unsigned char* wp = my + fr * CSH_STR + fq * 16; const LAS unsigned char* rp = my + r8 * CSH_STR + c8 * 16;
        const int rowb = u.pm * BM + wr * 64 + r8, colb = u.pn * BM + wc * 64 + 8 * c8;
#pragma unroll
        for (int ai = 0; ai < 2; ++ai)
#pragma unroll
            for (int m = 0; m < 4; ++m) { const size_t row = (size_t)(rowb + ai * HALF + m * 16);
                u32x4 g[2], x[2];
#pragma unroll
                for (int hh = 0; hh < 2; ++hh) g[hh] = *(const u32x4*)(Pg + (row + 8 * hh) * NP + P_GATE + colb);
                const f32x4 a[2][2] = {{acc[ai][0][m][0], acc[ai][0][m][1]}, {acc[ai][1][m][0], acc[ai][1][m][1]}};
                relay16(a, wp, rp, x);
#pragma unroll
                for (int hh = 0; hh < 2; ++hh) *(u32x4*)(O + (row + 8 * hh) * 3072 + colb) = gate8x0(x[hh], g[hh]); }
    }
};
struct EpiMerge {
    static constexpr int PERM = 2;
    bf16_t* MG; const bf16_t* Pg; LAS unsigned char* sh;
    __device__ __forceinline__ void operator()(const f32x4 (&acc)[2][2][4][2], const Unit& u, int wr, int wc, int fr, int fq) const {
        LAS unsigned char* my = sh + (wr * 4 + wc) * CSH_SLICE; const int lane = fq * 16 + fr, r8 = lane >> 3, c8 = lane & 7;
        LAS unsigned char* wp = my + fr * CSH_STR + fq * 16; const LAS unsigned char* rp = my + r8 * CSH_STR + c8 * 16;
        const int rowb = u.pm * BM + wr * 64 + r8, colb = u.pn * BM + wc * 64 + 8 * c8; const int gcol = P_GATE + u.part * 1024 + colb;
        if (u.part == 0) {
#pragma unroll
            for (int ai = 0; ai < 2; ++ai)
#pragma unroll
                for (int m = 0; m < 4; ++m) { const size_t row = (size_t)(rowb + ai * HALF + m * 16);
                    u32x4 g[2], x[2];
#pragma unroll
                    for (int hh = 0; hh < 2; ++hh) g[hh] = *(const u32x4*)(Pg + (row + 8 * hh) * NP + gcol);
                    const f32x4 a[2][2] = {{acc[ai][0][m][0], acc[ai][0][m][1]}, {acc[ai][1][m][0], acc[ai][1][m][1]}};
                    relay16(a, wp, rp, x);
#pragma unroll
                    for (int hh = 0; hh < 2; ++hh) *(u32x4*)(MG + (row + 8 * hh) * D + colb) = gate8x0(x[hh], g[hh]); }
            return;
        }
#pragma unroll
        for (int ai = 0; ai < 2; ++ai)
#pragma unroll
            for (int m = 0; m < 4; ++m) { const size_t row = (size_t)(rowb + ai * HALF + m * 16);
                u32x4 g[2], o[2], x[2];
#pragma unroll
                for (int hh = 0; hh < 2; ++hh) { g[hh] = *(const u32x4*)(Pg + (row + 8 * hh) * NP + gcol); o[hh] = *(const u32x4*)(MG + (row + 8 * hh) * D + colb); }
                const f32x4 a[2][2] = {{acc[ai][0][m][0], acc[ai][0][m][1]}, {acc[ai][1][m][0], acc[ai][1][m][1]}};
                relay16(a, wp, rp, x);
#pragma unroll
                for (int hh = 0; hh < 2; ++hh) *(u32x4*)(MG + (row + 8 * hh) * D + colb) = gate8x(x[hh], g[hh], o[hh]); }
    }
};
struct EpiResid {
    static constexpr int PERM = 2;
    bf16_t* X; const float* modg; bf16_t* PART; const void* Xold; LAS unsigned char* sh; int oldf32; int pad_;
    __device__ __forceinline__ void operator()(const f32x4 (&acc)[2][2][4][2], const Unit& u, int wr, int wc, int fr, int fq) const {
        if (u.part >= 0) {
            LAS unsigned char* my = sh + (wr * 4 + wc) * CSH_SLICE; const int lane = fq * 16 + fr, r8 = lane >> 3, c8 = lane & 7;
            LAS unsigned char* wp = my + fr * CSH_STR + fq * 16; const LAS unsigned char* rp = my + r8 * CSH_STR + c8 * 16;
            bf16_t* pb = PART + ((size_t)u.part * TC + (u.pm * BM + wr * 64 + r8 - TL)) * D + u.pn * BM + wc * 64 + 8 * c8;
#pragma unroll
            for (int ai = 0; ai < 2; ++ai)
#pragma unroll
                for (int m = 0; m < 4; ++m) { u32x4 x[2];
                    const f32x4 a[2][2] = {{acc[ai][0][m][0], acc[ai][0][m][1]}, {acc[ai][1][m][0], acc[ai][1][m][1]}};
                    relay16(a, wp, rp, x);
                    bf16_t* rowp = pb + (size_t)(ai * HALF + m * 16) * D;
                    *(u32x4*)rowp = x[0]; *(u32x4*)(rowp + (size_t)8 * D) = x[1]; }
            return;
        }
        const float* mg = modg + (size_t)mod_row(u.pm * BM) * 6144 + u.pn * BM + wc * 64 + 8 * fq;
        f32x4 gv[2][2];
#pragma unroll
        for (int bj = 0; bj < 2; ++bj)
#pragma unroll
            for (int n = 0; n < 2; ++n) gv[bj][n] = *(const f32x4*)(mg + bj * 32 + n * 4);
        LAS unsigned char* my = sh + (wr * 4 + wc) * CSH_SLICE; const int lane = fq * 16 + fr, r8 = lane >> 3, c8 = lane & 7;
        LAS unsigned char* wp = my + fr * CSH_STR + fq * 16; const LAS unsigned char* rp = my + r8 * CSH_STR + c8 * 16;
        const size_t ro0 = (size_t)(u.pm * BM + wr * 64 + r8) * D + u.pn * BM + wc * 64 + 8 * c8;
#pragma unroll
        for (int ai = 0; ai < 2; ++ai)
#pragma unroll
            for (int m = 0; m < 4; ++m) { const size_t ro = ro0 + (size_t)(ai * HALF + m * 16) * D;
                f32x4 oa[2][2];
#pragma unroll
                for (int hh = 0; hh < 2; ++hh) { const size_t rr = ro + (size_t)hh * 8 * D;
                    if (oldf32) { oa[hh][0] = *(const f32x4*)((const float*)Xold + rr); oa[hh][1] = *(const f32x4*)((const float*)Xold + rr + 4); }
                    else { const u32x4 w = *(const u32x4*)((const bf16_t*)Xold + rr); oa[hh][0] = (f32x4){__uint_as_float(w.x), __uint_as_float(w.y), __uint_as_float(w.z), __uint_as_float(w.w)}; oa[hh][1] = oa[hh][0]; } }
#pragma unroll
                for (int bj = 0; bj < 2; ++bj) { const f32x4 v0 = gv[bj][0] * acc[ai][bj][m][0], v1 = gv[bj][1] * acc[ai][bj][m][1];
                    u32x4 w; w.x = cvt_pk_bf16(v0[0], v0[1]); w.y = cvt_pk_bf16(v0[2], v0[3]); w.z = cvt_pk_bf16(v1[0], v1[1]); w.w = cvt_pk_bf16(v1[2], v1[3]);
                    *(LAS u32x4*)(wp + bj * 64) = w; }
                asm volatile("" ::: "memory"); __builtin_amdgcn_wave_barrier();
                u32x4 dx[2]; dx[0] = *(const LAS u32x4*)rp; dx[1] = *(const LAS u32x4*)(rp + 8 * CSH_STR);
                asm volatile("" ::: "memory"); __builtin_amdgcn_wave_barrier();
#pragma unroll
                for (int hh = 0; hh < 2; ++hh) { float o[8], dl[8]; unpack8(dx[hh], dl);
                    if (oldf32) { o[0] = oa[hh][0][0]; o[1] = oa[hh][0][1]; o[2] = oa[hh][0][2]; o[3] = oa[hh][0][3]; o[4] = oa[hh][1][0]; o[5] = oa[hh][1][1]; o[6] = oa[hh][1][2]; o[7] = oa[hh][1][3]; }
                    else { u32x4 w; w.x = __float_as_uint(oa[hh][0][0]); w.y = __float_as_uint(oa[hh][0][1]); w.z = __float_as_uint(oa[hh][0][2]); w.w = __float_as_uint(oa[hh][0][3]); unpack8(w, o); }
#pragma unroll
                    for (int e = 0; e < 8; ++e) o[e] += dl[e];
                    *(u32x4*)(X + ro + (size_t)hh * 8 * D) = pack8(o); } }
    }
};
struct EpiSwiglu {
    static constexpr bool PERM = true;
    bf16_t* O;
    __device__ __forceinline__ void operator()(const f32x4 (&acc)[2][2][4][2], const Unit& u, int wr, int wc, int fr, int fq) const {
        const int row0 = u.pm * BM + wr * 64 + fr; const int chunk = u.pn * 4 + wc;
#pragma unroll
        for (int ai = 0; ai < 2; ++ai)
#pragma unroll
            for (int m = 0; m < 4; ++m) { const int row = row0 + ai * HALF + m * 16; bf16_t* rowp = O + ((size_t)(row >> 1) * (DFF / 32) + chunk) * 64 + (row & 1) * 32 + 8 * fq;
                const f32x4 a0 = acc[ai][0][m][0], a1 = acc[ai][0][m][1], b0 = acc[ai][1][m][0], b1 = acc[ai][1][m][1];
                u32x4 w; w.x = cvt_pk_bf16(swg_(a0[0], b0[0]), swg_(a0[1], b0[1])); w.y = cvt_pk_bf16(swg_(a0[2], b0[2]), swg_(a0[3], b0[3]));
                w.z = cvt_pk_bf16(swg_(a1[0], b1[0]), swg_(a1[1], b1[1])); w.w = cvt_pk_bf16(swg_(a1[2], b1[2]), swg_(a1[3], b1[3]));
                *(u32x4*)rowp = w; }
    }
};
}

#define XB_TMO      128
#define XB_XCNT(j)  (256  + 64 * (j))
#define XB_XSUB(j)  (1280 + 64 * (j))
#define XB_XGEN(j)  (2304 + 64 * (j))
#define XB_TOP      3328
#define XB_TOPGEN   3392
#define XCD_BAR_WORDS 3456
#define XB_SPIN_CAP (1u << 18)
__device__ __forceinline__ unsigned xb_ld(unsigned* p)              { return __hip_atomic_load(p, __ATOMIC_RELAXED, __HIP_MEMORY_SCOPE_AGENT); }
__device__ __forceinline__ unsigned xb_add(unsigned* p, unsigned v) { return __hip_atomic_fetch_add(p, v, __ATOMIC_RELAXED, __HIP_MEMORY_SCOPE_AGENT); }
__device__ __forceinline__ unsigned xb_xcc_id() { return (unsigned)__builtin_amdgcn_s_getreg((3 << 11) | 20) & 0xFu; }
#define XB_SPIN(cond, bar) do { unsigned _sp = 0; while (cond) { __builtin_amdgcn_s_sleep(4); \
    if ((++_sp & 255u) == 0u) { if (xb_ld(&(bar)[XB_TMO])) break; if (_sp > XB_SPIN_CAP) { atomicAdd(&(bar)[XB_TMO], 1u); break; } } } } while (0)
struct XcdBarrier { unsigned* bar; unsigned x; volatile LAS unsigned* st; };
__device__ __forceinline__ XcdBarrier xcd_barrier_post(unsigned* bar, volatile LAS unsigned* st) {
    XcdBarrier b; b.bar = bar; b.x = (unsigned)__builtin_amdgcn_readfirstlane((int)xb_xcc_id()); b.st = st;
    if (threadIdx.x == 0) (void)xb_add(&bar[XB_XCNT(b.x)], 1u);
    return b;
}
__device__ __forceinline__ void xcd_barrier_complete(unsigned* bar, unsigned x, unsigned& nloc, unsigned& nx) {
    const unsigned G = gridDim.x * gridDim.y * gridDim.z;
    unsigned sum, cnt, mine, sp = 0u;
    for (;;) {
        sum = 0u; cnt = 0u; mine = 0u;
#pragma unroll
        for (unsigned j = 0; j < 16; ++j) { const unsigned c = xb_ld(&bar[XB_XCNT(j)]); sum += c; cnt += (c > 0u) ? 1u : 0u; mine = (j == x) ? c : mine; }
        if (sum == G) break;
        __builtin_amdgcn_s_sleep(1);
        if ((++sp & 255u) == 0u) { if (xb_ld(&bar[XB_TMO])) break; if (sp > XB_SPIN_CAP) { atomicAdd(&bar[XB_TMO], 1u); break; } }
    }
    nloc = mine > 0u ? mine : 1u; nx = cnt > 0u ? cnt : 1u;
}
template <bool FIRST> __device__ __forceinline__ void xcd_barrier_t(const XcdBarrier& b, const Ctx cx) {
    asm volatile("s_waitcnt vmcnt(0)" ::: "memory");
    __syncthreads();
    if (tidx(cx) == 0) {
        unsigned* bar = b.bar; unsigned bx = b.x; OPQ_S(bar); OPQ_S(bx);
        __builtin_amdgcn_s_waitcnt(0);
        unsigned nloc = b.st[0], nx = b.st[1];
        if (FIRST) { if (nloc == 0u) { xcd_barrier_complete(bar, bx, nloc, nx); b.st[0] = nloc; b.st[1] = nx; } }
        const unsigned old = xb_add(&bar[XB_XSUB(bx)], 1u);
        const unsigned gen = old / nloc;
        if (old + 1u == (gen + 1u) * nloc) {
            __builtin_amdgcn_fence(__ATOMIC_RELEASE, "agent");
            asm volatile("s_waitcnt vmcnt(0)" ::: "memory");
            const unsigned og = xb_add(&bar[XB_TOP], 1u);
            const unsigned tg = og / nx;
            if (og + 1u == (tg + 1u) * nx) xb_add(&bar[XB_TOPGEN], 1u);
            else XB_SPIN(xb_ld(&bar[XB_TOPGEN]) == tg, bar);
            __builtin_amdgcn_fence(__ATOMIC_ACQUIRE, "agent");
            xb_add(&bar[XB_XGEN(bx)], 1u);
            asm volatile("s_waitcnt vmcnt(0)" ::: "memory");
        } else {
            XB_SPIN(xb_ld(&bar[XB_XGEN(bx)]) == gen, bar);
            __builtin_amdgcn_fence(__ATOMIC_ACQUIRE, "agent");
            asm volatile("s_waitcnt vmcnt(0)" ::: "memory");
        }
    }
    __syncthreads();
}
__device__ __forceinline__ void xcd_barrier_first(const XcdBarrier& b, const Ctx cx) { xcd_barrier_t<true>(b, cx); }
__device__ __forceinline__ void xcd_barrier(const XcdBarrier& b, const Ctx cx) { xcd_barrier_t<false>(b, cx); }

constexpr int LDS_TEXP = 139264, LDS_BARW = LDS_TEXP + 1024, LDS_SBASE = LDS_BARW + 16, LDS_CSH = LDS_SBASE + 64 + 176 + 256, LDS_BYTES = LDS_CSH + 8 * pg8::CSH_SLICE;
constexpr int CW_BAR = 4096;

#define MMA16(acc, afrag, bfrag) acc = __builtin_amdgcn_mfma_f32_16x16x32_bf16(bfrag, afrag, acc, 0, 0, 0)
typedef short s16x4 __attribute__((ext_vector_type(4)));
constexpr int STR64 = 144, STR128 = 272;
__device__ __forceinline__ bf16x8 frag_row(const LAS unsigned char* img, int r, int k0, int stride) { return *(const LAS bf16x8*)(img + r * stride + k0 * 2); }
__device__ __forceinline__ bf16x8 frag_tr(const LAS unsigned char* img, int rowlo, int rowhi, int x0, int stride, int fr) {
    const int q = fr >> 2, p = fr & 3;
    const s16x4 lo = __builtin_amdgcn_ds_read_tr16_b64_v4i16((LAS s16x4*)(img + (rowlo + q) * stride + x0 * 2 + 8 * p));
    const s16x4 hi = __builtin_amdgcn_ds_read_tr16_b64_v4i16((LAS s16x4*)(img + (rowhi + q) * stride + x0 * 2 + 8 * p));
    return __builtin_shufflevector(lo, hi, 0, 1, 2, 3, 4, 5, 6, 7);
}

struct CvtJob { const float* s0; const float* s1; bf16_t* dst; int ldw, ldd, kd0, K, Nd, kind; };
__device__ __forceinline__ CvtJob mkjob(const float* s0, const float* s1, bf16_t* dst, int ldw, int ldd, int kd0, int K, int Nd, int kind) { CvtJob j; j.s0 = s0; j.s1 = s1; j.dst = dst; j.ldw = ldw; j.ldd = ldd; j.kd0 = kd0; j.K = K; j.Nd = Nd; j.kind = kind; return j; }
constexpr int CV_STR = 144;
__device__ __forceinline__ void cvt_src(const CvtJob& j, int n0, int n, const float*& src, int& col) {
    const int nh = n0 + (n & 32); src = j.s0; int sc = nh;
    if (j.kind == 1) { sc = nh < 3840 ? nh : (nh < 6912 ? nh + 32 : (nh < 6944 ? nh - 3072 : -1)); }
    else if (j.kind == 2) { const int tj = nh >> 8, r = nh & 255; if (r < 128) { sc = tj * 128 + r; } else { src = j.s1; sc = tj * 128 + r - 128; } }
    col = sc < 0 ? -1 : sc + (n & 31);
}
__device__ __forceinline__ void ph_convert(const CvtJob& j, LAS unsigned char* lds, const Ctx cx, int& rot) {
    const int tid = tidx(cx), c16 = tid & 15, kr = tid >> 4, lane = tid & 63, wid = tid >> 6, fr = lane & 15, fq = lane >> 4;
    const int kch = j.K / 256, nitems = (j.Nd / 64) * kch;
    int first = cx.bid - rot; if (first < 0) first += cx.nb;
    f32x4 v[8];
    auto issue = [&](int it) { const int nbk = it / kch, kc = it % kch, n0 = nbk * 64, k0 = kc * 256; const float* src; int col; cvt_src(j, n0, c16 * 4, src, col);
#pragma unroll
        for (int p = 0; p < 8; ++p) v[p] = col >= 0 ? *(const f32x4*)(src + (size_t)(k0 + p * 32 + kr) * j.ldw + col) : (f32x4){0.f, 0.f, 0.f, 0.f}; };
    if (first < nitems) issue(first);
    for (int it = first; it < nitems; it += cx.nb) {
        const int nbk = it / kch, kc = it % kch, n0 = nbk * 64, k0 = kc * 256;
        if (j.kind == 1 && n0 >= P_QA && n0 < P_VA) {
            const int e = (c16 * 4) & 31, blk = (c16 * 4) & 32;
#pragma unroll
            for (int p = 0; p < 8; ++p) { const unsigned w0 = cvt_pk_bf16(v[p][0], v[p][1]), w1 = cvt_pk_bf16(v[p][2], v[p][3]); LAS bf16_t* rowp = (LAS bf16_t*)(lds + (p * 32 + kr) * CV_STR) + blk;
#pragma unroll
                for (int q = 0; q < 4; ++q) { const int ee = e + q, pos = ee < 16 ? 2 * ee : 2 * (ee - 16) + 1; const unsigned w = q < 2 ? w0 : w1; rowp[pos] = (bf16_t)((q & 1) ? (w >> 16) : (w & 0xffffu)); } }
        } else {
        const float wsc = (j.kind == 2) ? ((((n0 + ((c16 * 4) & 32)) & 255) < 128) ? -LOG2E : -1.0f / LOG2E) : (j.kind == 1 && n0 + c16 * 4 >= P_GATE && n0 + c16 * 4 < P_AG) ? -LOG2E : 1.0f;
#pragma unroll
        for (int p = 0; p < 8; ++p) { u32x2 w; w.x = cvt_pk_bf16(v[p][0] * wsc, v[p][1] * wsc); w.y = cvt_pk_bf16(v[p][2] * wsc, v[p][3] * wsc); *(LAS u32x2*)(lds + (p * 32 + kr) * CV_STR + c16 * 8) = w; }
        }
        LDS_BAR();
        if (it + cx.nb < nitems) issue(it + cx.nb);
        { const int kq = wid & 3, nh = wid >> 2, r8 = lane >> 3, c8 = lane & 7;
          LAS unsigned char* my = lds + 256 * CV_STR + wid * (16 * CV_STR); LAS unsigned char* wp = my + fr * CV_STR + fq * 16; const LAS unsigned char* rp = my + (2 * r8 + (c8 >> 2)) * CV_STR + (c8 & 3) * 16;
#pragma unroll
          for (int q = 0; q < 2; ++q) { const int nb = nh * 2 + q;
              const bf16x8 oa = frag_tr(lds, (8 * kq + fq) * 8, (8 * kq + fq) * 8 + 4, nb * 16, CV_STR, fr), ob = frag_tr(lds, (8 * kq + 4 + fq) * 8, (8 * kq + 4 + fq) * 8 + 4, nb * 16, CV_STR, fr);
              *(LAS bf16x8*)wp = oa; *(LAS bf16x8*)(wp + 64) = ob;
              asm volatile("" ::: "memory"); __builtin_amdgcn_wave_barrier();
              const bf16x8 x0 = *(const LAS bf16x8*)rp, x1 = *(const LAS bf16x8*)(rp + 64);
              asm volatile("" ::: "memory"); __builtin_amdgcn_wave_barrier();
              bf16_t* dp = j.dst + ((size_t)(((n0 + nb * 16) >> 1) + r8) * (j.ldd >> 5) + ((j.kd0 + k0 + 64 * kq) >> 5)) * 64 + 8 * c8;
              *(bf16x8*)dp = x0; *(bf16x8*)(dp + 64) = x1; } }
        LDS_BAR();
    }
    rot = (rot + nitems) % cx.nb;
}

__device__ __forceinline__ void ph_init(const float* x, const float* ctx, float* XS, f32x2* CS, const Ctx cx) {
    (void)x; (void)ctx; (void)XS;
    if (cx.bid == cx.nb - 1) for (int i = tidx(cx); i < 64 * 16; i += 512) { const int pos = i >> 4, f = i & 15; const float inv = powf(10000.0f, -(float)f / 16.0f); const float a = (float)pos * inv; CS[i] = (f32x2){cosf(a), sinf(a)}; }
}
__device__ __forceinline__ void ph_mod(const float* c, const float* c_ctx, const float* w_mod, const float* b_mod, float* MOD, LAS unsigned char* lds, const Ctx cx) {
    if (cx.bid >= DEPTH * 48) return;
    LAS float* sv = (LAS float*)lds; LAS float* red = sv + 9 * 1024;
    const int tid = tidx(cx);
    for (int i = tid; i < 9 * 1024; i += 512) { const float v = i < 8192 ? c[i] : c_ctx[i - 8192]; sv[i] = siluf_(v); }
    __syncthreads();
    const int c4 = (tid & 31) * 4, kg = tid >> 5;
    for (int it = cx.bid; it < DEPTH * 48; it += cx.nb) {
        const int l = it / 48, n0 = (it % 48) * 128;
        const float* w = w_mod + ((size_t)l * D + kg * 64) * 6144 + n0 + c4;
        f32x4 a[9];
#pragma unroll
        for (int r = 0; r < 9; ++r) a[r] = (f32x4){0.f, 0.f, 0.f, 0.f};
#pragma unroll 1
        for (int k0 = 0; k0 < 64; k0 += 8) { f32x4 wv[8];
#pragma unroll
            for (int u = 0; u < 8; ++u) wv[u] = *(const f32x4*)(w + (size_t)(k0 + u) * 6144);
#pragma unroll
            for (int u = 0; u < 8; ++u)
#pragma unroll
                for (int r = 0; r < 9; ++r) a[r] = a[r] + wv[u] * sv[r * 1024 + kg * 64 + k0 + u]; }
#pragma unroll
        for (int r = 0; r < 9; ++r) *(LAS f32x4*)(red + (kg * 9 + r) * 128 + c4) = a[r];
        __syncthreads();
        for (int i = tid; i < 9 * 128; i += 512) { const int r = i >> 7, cc = i & 127; float sacc = b_mod[(size_t)l * 6144 + n0 + cc];
#pragma unroll
            for (int g = 0; g < 16; ++g) sacc += red[(g * 9 + r) * 128 + cc];
            MOD[((size_t)l * 9 + r) * 6144 + n0 + cc] = sacc; }
        __syncthreads();
    }
}

struct NormArgs { bf16_t* XS; const void* Xl; const void* Xc; int lf32, cf32; bf16_t* H;
                  const float* g; const float* mod_shift; const float* mod_scale;
                  const bf16_t* Y; const int* POS; const float* TOPKp; const float* mod_g5prev;
                  const float* router; float* TOPK; unsigned* cnt; int nrows;
                  const bf16_t* PART; const float* mod_gpart; int npart; };
template <bool ROUTE> __device__ __forceinline__ void ph_norm(const NormArgs& a, bool combine, LAS unsigned char* lds, const Ctx cx) {
    const int lane = tidx(cx) & 63, wid = tidx(cx) >> 6;
    LAS unsigned* hist = (LAS unsigned*)(lds + LDS_SBASE);
    LAS float* rtab = (LAS float*)lds;
    if (ROUTE) { __syncthreads(); if (tidx(cx) < 8) hist[tidx(cx)] = 0u;
        for (int f = tidx(cx); f < 8192; f += 512) { const int e = f & 7, ln = (f >> 3) & 63, jq = f >> 9; rtab[f] = a.router[(size_t)(4 * (ln + 64 * (jq >> 2)) + (jq & 3)) * 8 + e]; }
        __syncthreads(); }
    f32x4 gq[4];
#pragma unroll
    for (int j = 0; j < 4; ++j) gq[j] = *(const f32x4*)(a.g + 4 * (lane + 64 * j));
    f32x4 xn[4];
    { const int r0 = cx.bid * 8 + wid; if (r0 < a.nrows) { const bool f = r0 < TL ? a.lf32 : a.cf32; const void* rp = r0 < TL ? a.Xl : a.Xc;
#pragma unroll
        for (int j = 0; j < 4; ++j) xn[j] = ldx_raw(rp, f, (size_t)r0 * D + 4 * (lane + 64 * j)); } }
    int cs1 = 0, cs2 = 0; float cp1 = 0.f, cp2 = 0.f; u32x2 y1n[4], y2n[4];
    if (combine) { const int rk = cx.bid * 8 + wid + lane * (cx.nb * 8);
        if (rk < a.nrows) { cs1 = a.POS[2 * rk]; cs2 = a.POS[2 * rk + 1]; cp1 = a.TOPKp[4 * rk + 2]; cp2 = a.TOPKp[4 * rk + 3]; }
        if (cx.bid * 8 + wid < a.nrows) { const int s1 = __builtin_amdgcn_readlane(cs1, 0), s2 = __builtin_amdgcn_readlane(cs2, 0);
#pragma unroll
            for (int j = 0; j < 4; ++j) { const int cc = 4 * (lane + 64 * j); y1n[j] = *(const u32x2*)(a.Y + (size_t)s1 * D + cc); y2n[j] = *(const u32x2*)(a.Y + (size_t)s2 * D + cc); } } }
    int it = 0;
    for (int row = cx.bid * 8 + wid; row < a.nrows; row += cx.nb * 8, ++it) {
        const int mr = mod_row(row);
        bf16_t* xr = a.XS + (size_t)row * D; const bool fcur = row < TL ? a.lf32 : a.cf32;
        f32x4 x[4], shq[4], scq[4];
#pragma unroll
        for (int j = 0; j < 4; ++j) { x[j] = cvx(xn[j], fcur); shq[j] = *(const f32x4*)(a.mod_shift + (size_t)mr * 6144 + 4 * (lane + 64 * j)); scq[j] = *(const f32x4*)(a.mod_scale + (size_t)mr * 6144 + 4 * (lane + 64 * j)); }
        if (row + cx.nb * 8 < a.nrows) {
            const int rn = row + cx.nb * 8; const bool f = rn < TL ? a.lf32 : a.cf32; const void* rp = rn < TL ? a.Xl : a.Xc;
#pragma unroll
            for (int j = 0; j < 4; ++j) xn[j] = ldx_raw(rp, f, (size_t)rn * D + 4 * (lane + 64 * j)); }
        if (combine) {
            const float p1 = __int_as_float(__builtin_amdgcn_readlane(__float_as_int(cp1), it)), p2 = __int_as_float(__builtin_amdgcn_readlane(__float_as_int(cp2), it));
            u32x2 y1c[4], y2c[4];
#pragma unroll
            for (int j = 0; j < 4; ++j) { y1c[j] = y1n[j]; y2c[j] = y2n[j]; }
            if (row + cx.nb * 8 < a.nrows) { const int s1 = __builtin_amdgcn_readlane(cs1, it + 1), s2 = __builtin_amdgcn_readlane(cs2, it + 1);
#pragma unroll
                for (int j = 0; j < 4; ++j) { const int cc = 4 * (lane + 64 * j); y1n[j] = *(const u32x2*)(a.Y + (size_t)s1 * D + cc); y2n[j] = *(const u32x2*)(a.Y + (size_t)s2 * D + cc); } }
#pragma unroll
            for (int j = 0; j < 4; ++j) { const int cc = 4 * (lane + 64 * j);
                const u32x2 y1 = y1c[j], y2 = y2c[j];
                const f32x4 mg = *(const f32x4*)(a.mod_g5prev + (size_t)mr * 6144 + cc);
                f32x4 e; e[0] = p1 * bf_lo(y1.x) + p2 * bf_lo(y2.x); e[1] = p1 * bf_hi(y1.x) + p2 * bf_hi(y2.x); e[2] = p1 * bf_lo(y1.y) + p2 * bf_lo(y2.y); e[3] = p1 * bf_hi(y1.y) + p2 * bf_hi(y2.y);
                x[j] = x[j] + mg * e; stx(xr + cc, x[j]); }
        }
        if (a.PART != nullptr && row >= TL) {
#pragma unroll
            for (int j = 0; j < 4; ++j) { const int cc = 4 * (lane + 64 * j); const bf16_t* pp = a.PART + (size_t)(row - TL) * D + cc;
                u32x2 pw[7];
#pragma unroll
                for (int q = 0; q < 6; ++q) pw[q] = *(const u32x2*)(pp + (size_t)q * TC * D);
                pw[6] = (a.npart == 7) ? *(const u32x2*)(pp + (size_t)6 * TC * D) : (u32x2){0u, 0u};
                f32x4 e = (f32x4){0.f, 0.f, 0.f, 0.f};
#pragma unroll
                for (int q = 0; q < 7; ++q) e = e + (f32x4){bf_lo(pw[q].x), bf_hi(pw[q].x), bf_lo(pw[q].y), bf_hi(pw[q].y)};
                const f32x4 mg = *(const f32x4*)(a.mod_gpart + (size_t)8 * 6144 + cc);
                x[j] = x[j] + mg * e; stx(xr + cc, x[j]); }
        }
        float ss = 0.f;
#pragma unroll
        for (int j = 0; j < 4; ++j) ss += x[j][0] * x[j][0] + x[j][1] * x[j][1] + x[j][2] * x[j][2] + x[j][3] * x[j][3];
        ss = wave_total(ss);
        const float rs = rsqrtf(ss * (1.0f / D) + EPS);
        f32x4 h[4];
#pragma unroll
        for (int j = 0; j < 4; ++j) { const int cc = 4 * (lane + 64 * j);
            h[j] = (x[j] * rs * gq[j]) * (scq[j] + 1.0f) + shq[j];
            u32x2 w; w.x = cvt_pk_bf16(h[j][0], h[j][1]); w.y = cvt_pk_bf16(h[j][2], h[j][3]);
            *(u32x2*)(a.H + (size_t)row * D + cc) = w; }
        if (ROUTE) {
            float lg[8];
#pragma unroll
            for (int e = 0; e < 8; ++e) lg[e] = 0.f;
#pragma unroll
            for (int j = 0; j < 4; ++j)
#pragma unroll
                for (int q = 0; q < 4; ++q) { const LAS float* rw = rtab + ((j * 4 + q) * 64 + lane) * 8; const f32x4 r0 = *(const LAS f32x4*)rw, r1 = *(const LAS f32x4*)(rw + 4); const float hv = h[j][q];
                    lg[0] += hv * r0[0]; lg[1] += hv * r0[1]; lg[2] += hv * r0[2]; lg[3] += hv * r0[3]; lg[4] += hv * r1[0]; lg[5] += hv * r1[1]; lg[6] += hv * r1[2]; lg[7] += hv * r1[3]; }
#pragma unroll
            for (int e = 0; e < 8; ++e) lg[e] = wave_total(lg[e]);
            if (lane == 0) {
                int e1 = 0; float v1 = lg[0];
#pragma unroll
                for (int e = 1; e < 8; ++e) if (lg[e] > v1) { v1 = lg[e]; e1 = e; }
                int e2 = -1; float v2 = -3.0e38f;
#pragma unroll
                for (int e = 0; e < 8; ++e) if (e != e1 && lg[e] > v2) { v2 = lg[e]; e2 = e; }
                const float p2 = 1.0f / (1.0f + __expf(v1 - v2)), p1 = 1.0f - p2;
                float* tk = a.TOPK + 4 * (size_t)row; tk[0] = __int_as_float(e1); tk[1] = __int_as_float(e2); tk[2] = p1; tk[3] = p2;
                lds_add(hist + e1, 1u); lds_add(hist + e2, 1u);
            }
        }
    }
    if (ROUTE) { __syncthreads(); if (tidx(cx) < 8) { const unsigned v = hist[tidx(cx)]; if (v) atomicAdd(a.cnt + tidx(cx), v); } __syncthreads(); }
}

__device__ __forceinline__ void ph_route(const float* TOPK, const bf16_t* H, bf16_t* HS, int* POS, unsigned* ctl, int j, int nrows, LAS unsigned char* lds, const Ctx cx) {
    LAS unsigned* sbase = (LAS unsigned*)(lds + LDS_SBASE);
    const int lane = tidx(cx) & 63, wid = tidx(cx) >> 6;
    __syncthreads();
    if (tidx(cx) == 0) { unsigned b = 0; for (int e = 0; e < 8; ++e) { sbase[e] = b; b += (xb_ld(ctl + CW_CNT + j * 64 + e) + 255u) & ~255u; } sbase[8] = b; }
    __syncthreads();
    if (cx.bid == 0) {
        if (tidx(cx) < 256) { const unsigned r0 = tidx(cx) * 256u; int e = 0;
            for (int q = 1; q < 8; ++q) if (r0 >= sbase[q]) e = q;
            ctl[CW_TEXP + j * 256 + tidx(cx)] = (unsigned)e; }
        if (tidx(cx) == 0) ctl[CW_NT + j] = sbase[8] / 256u;
    }
    for (int i = cx.bid * 8 + wid; i < 8 * 256; i += cx.nb * 8) { const int e = i >> 8, r = i & 255; const unsigned s = sbase[e] + xb_ld(ctl + CW_CNT + j * 64 + e) + r;
        if (s < sbase[e + 1]) {
#pragma unroll
            for (int q = 0; q < 2; ++q) ((u32x4*)(HS + (size_t)s * D))[lane + 64 * q] = ((const u32x4*)H)[lane + 64 * q]; } }
    LAS unsigned* wcnt = sbase + 16; LAS unsigned* wbase = sbase + 24;
    if (tidx(cx) < 8) wcnt[tidx(cx)] = 0u;
    const int nk = nrows / (cx.nb * 8); const int myrow = cx.bid * 8 + wid + lane * (cx.nb * 8); const bool own = lane < nk;
    int e1 = 0, e2 = 0; if (own) { const f32x2 t = *(const f32x2*)(TOPK + 4 * (size_t)myrow); e1 = __float_as_int(t[0]); e2 = __float_as_int(t[1]); }
    __syncthreads();
    if (own) { lds_add(wcnt + e1, 1u); lds_add(wcnt + e2, 1u); }
    __syncthreads();
    if (tidx(cx) < 8) { const unsigned n = wcnt[tidx(cx)]; wbase[tidx(cx)] = sbase[tidx(cx)] + (n ? atomicAdd(ctl + CW_FILL + j * 64 + tidx(cx), n) : 0u); wcnt[tidx(cx)] = 0u; }
    __syncthreads();
    int s1 = 0, s2 = 0;
    if (own) { s1 = (int)(wbase[e1] + lds_add(wcnt + e1, 1u)); s2 = (int)(wbase[e2] + lds_add(wcnt + e2, 1u)); POS[2 * myrow] = s1; POS[2 * myrow + 1] = s2; }
    u32x4 v[9][2];
#pragma unroll
    for (int k = 0; k < 9; ++k) if (k < nk) { const u32x4* src = (const u32x4*)(H + (size_t)(cx.bid * 8 + wid + k * (cx.nb * 8)) * D); v[k][0] = src[lane]; v[k][1] = src[lane + 64]; }
#pragma unroll
    for (int k = 0; k < 9; ++k) if (k < nk) { const int d1 = __builtin_amdgcn_readlane(s1, k), d2 = __builtin_amdgcn_readlane(s2, k);
        u32x4* o1 = (u32x4*)(HS + (size_t)d1 * D); u32x4* o2 = (u32x4*)(HS + (size_t)d2 * D);
        o1[lane] = v[k][0]; o1[lane + 64] = v[k][1]; o2[lane] = v[k][0]; o2[lane + 64] = v[k][1]; }
    __syncthreads();
}

struct CvIn { u32x4 cc[3], cu[3], cb; };
__device__ __forceinline__ void ph_conv(const bf16_t* P, bf16_t* BR, const float* conv_w, int nrows, const Ctx cx) {
    const int tid = tidx(cx), lane = tid & 63, wid = tid >> 6; const int c0 = lane * 8;
    float cw[3][8];
#pragma unroll
    for (int d = 0; d < 3; ++d)
#pragma unroll
        for (int e = 0; e < 8; ++e) cw[d][e] = conv_w[d * 512 + c0 + e];
    auto seqpos = [&](int row, int& sp, int& slen) { const bool lat = row < TL; sp = lat ? (row & (SEQ - 1)) : ((row - TL) & (CTXL - 1)); slen = lat ? SEQ : CTXL; };
    auto load = [&](int row, CvIn& in) { const bf16_t* pr = P + (size_t)row * NP; int sp, slen; seqpos(row, sp, slen);
#pragma unroll
        for (int d = 0; d < 3; ++d) { const int sq = sp + d - 1; const bool ok = sq >= 0 && sq < slen; const bf16_t* q = pr + (ptrdiff_t)(ok ? d - 1 : 0) * NP;
            in.cc[d] = *(const u32x4*)(q + P_CC + c0); in.cu[d] = *(const u32x4*)(q + P_CU + c0); }
        in.cb = *(const u32x4*)(pr + P_CB + c0); };
    const int stride = cx.nb * 8; int row = cx.bid * 8 + wid; CvIn cur, nxt;
    if (row < nrows) load(row, cur);
    for (; row < nrows; row += stride) {
        const int rn = row + stride; const bool hn = rn < nrows;
        if (hn) load(rn, nxt);
        int sp, slen; seqpos(row, sp, slen);
        float y[8];
#pragma unroll
        for (int e = 0; e < 8; ++e) y[e] = 0.f;
#pragma unroll
        for (int d = 0; d < 3; ++d) { const int sq = sp + d - 1; const float m = (sq >= 0 && sq < slen) ? 1.0f : 0.0f; float cv[8], uv[8]; unpack8(cur.cc[d], cv); unpack8(cur.cu[d], uv);
#pragma unroll
            for (int e = 0; e < 8; ++e) y[e] += (cv[e] * uv[e]) * (cw[d][e] * m); }
        float bv[8]; unpack8(cur.cb, bv);
#pragma unroll
        for (int e = 0; e < 8; ++e) y[e] *= bv[e];
        *(u32x4*)(BR + (size_t)row * 1536 + c0) = pack8(y);
        if (hn) cur = nxt;
    }
}

__device__ __forceinline__ void ph_final(const bf16_t* XS, const bf16_t* Y, const int* POS, const float* TOPK, const float* mod_g5, const float* g, float* out, const Ctx cx) {
    const int lane = tidx(cx) & 63, wid = tidx(cx) >> 6;
    f32x4 gq[4];
#pragma unroll
    for (int j = 0; j < 4; ++j) gq[j] = *(const f32x4*)(g + 4 * (lane + 64 * j));
    const int stride = cx.nb * 8; int row = cx.bid * 8 + wid;
    f32x4 xn[4]; u32x2 y1n[4], y2n[4]; float p1n = 0.f, p2n = 0.f;
    int cs1 = 0, cs2 = 0; float cp1 = 0.f, cp2 = 0.f;
    { const int rk = cx.bid * 8 + wid + lane * stride; if (rk < TL) { cs1 = POS[2 * rk]; cs2 = POS[2 * rk + 1]; cp1 = TOPK[4 * rk + 2]; cp2 = TOPK[4 * rk + 3]; } }
    auto fetch = [&](int r, int k) { const int s1 = __builtin_amdgcn_readlane(cs1, k), s2 = __builtin_amdgcn_readlane(cs2, k);
        p1n = __int_as_float(__builtin_amdgcn_readlane(__float_as_int(cp1), k)); p2n = __int_as_float(__builtin_amdgcn_readlane(__float_as_int(cp2), k));
#pragma unroll
        for (int j = 0; j < 4; ++j) { const int cc = 4 * (lane + 64 * j); xn[j] = ldx_raw(XS, false, (size_t)r * D + cc); y1n[j] = *(const u32x2*)(Y + (size_t)s1 * D + cc); y2n[j] = *(const u32x2*)(Y + (size_t)s2 * D + cc); } };
    if (row < TL) fetch(row, 0);
    int it = 0;
    for (; row < TL; row += stride, ++it) {
        const int mr = mod_row(row);
        f32x4 x[4]; u32x2 y1[4], y2[4]; const float p1 = p1n, p2 = p2n;
#pragma unroll
        for (int j = 0; j < 4; ++j) { x[j] = cvx(xn[j], false); y1[j] = y1n[j]; y2[j] = y2n[j]; }
        if (row + stride < TL) fetch(row + stride, it + 1);
        float ss = 0.f;
#pragma unroll
        for (int j = 0; j < 4; ++j) { const int cc = 4 * (lane + 64 * j);
            const f32x4 mg = *(const f32x4*)(mod_g5 + (size_t)mr * 6144 + cc);
            f32x4 e; e[0] = p1 * bf_lo(y1[j].x) + p2 * bf_lo(y2[j].x); e[1] = p1 * bf_hi(y1[j].x) + p2 * bf_hi(y2[j].x); e[2] = p1 * bf_lo(y1[j].y) + p2 * bf_lo(y2[j].y); e[3] = p1 * bf_hi(y1[j].y) + p2 * bf_hi(y2[j].y);
            x[j] = x[j] + mg * e; ss += x[j][0] * x[j][0] + x[j][1] * x[j][1] + x[j][2] * x[j][2] + x[j][3] * x[j][3]; }
        ss = wave_total(ss); const float rs = rsqrtf(ss * (1.0f / D) + EPS);
#pragma unroll
        for (int j = 0; j < 4; ++j) { const int cc = 4 * (lane + 64 * j); *(f32x4*)(out + (size_t)row * D + cc) = x[j] * rs * gq[j]; }
    }
}

__device__ __forceinline__ float wave_incl_scan(float v) {
    v += __int_as_float(__builtin_amdgcn_update_dpp(0, __float_as_int(v), 0x111, 0xF, 0xF, true));
    v += __int_as_float(__builtin_amdgcn_update_dpp(0, __float_as_int(v), 0x112, 0xF, 0xF, true));
    v += __int_as_float(__builtin_amdgcn_update_dpp(0, __float_as_int(v), 0x114, 0xF, 0xF, true));
    v += __int_as_float(__builtin_amdgcn_update_dpp(0, __float_as_int(v), 0x118, 0xF, 0xF, true));
    v += __int_as_float(__builtin_amdgcn_update_dpp(0, __float_as_int(v), 0x142, 0xA, 0xF, false));
    v += __int_as_float(__builtin_amdgcn_update_dpp(0, __float_as_int(v), 0x143, 0xC, 0xF, false));
    return v;
}
__device__ __forceinline__ float lsig16(float z) { const float e = __builtin_amdgcn_exp2f(fmaxf(z, -80.0f) * -LOG2E); return __builtin_amdgcn_logf(1.0f + e) * (-0.6931471805599453f / 16.0f); }
__device__ __forceinline__ void gla_wave_decay(const bf16_t* P, int row0, int t, int h, int d, int ch0, const float* gla_w2, const float* gla_b, float (&b)[16]) {
    const u32x4* ap = (const u32x4*)(P + (size_t)(row0 + t) * NP + P_AG + d * 16);
    float a[16]; unpack8(ap[0], a); unpack8(ap[1], a + 8);
    const float* w2 = gla_w2 + (size_t)d * 16 * 256 + h * 64 + ch0; const float* bb = gla_b + d * 256 + h * 64 + ch0;
#pragma unroll
    for (int i = 0; i < 16; ++i) b[i] = bb[i];
#pragma unroll
    for (int r = 0; r < 16; ++r)
#pragma unroll
        for (int i = 0; i < 16; ++i) b[i] = __builtin_fmaf(a[r], w2[r * 256 + i], b[i]);
#pragma unroll
    for (int i = 0; i < 16; ++i) b[i] = wave_incl_scan(lsig16(b[i]));
}

constexpr int G_QD = 0, G_KI = G_QD + 2 * 64 * STR64, G_AT = G_KI + 2 * 64 * STR64, G_VI = G_AT + 2 * 64 * STR64, G_SE = G_VI + 64 * STR128, G_RED = G_SE + 2 * 64 * STR128, G_END = G_RED + 512;
constexpr int G1_KR = G_KI, G1_AR = G_KI + 64 * STR64, G1_ASTR = 80, G1_W2 = 73728, G1_T = G1_W2 + 16384;
struct G1In { u32x4 vv[2], kraw, araw; float bb[16]; };
__device__ __forceinline__ void g1_load(G1In& in, const bf16_t* P, const float* gla_b, int ci, int h, int tid) {
    const int row0 = ci * 64;
    { const int w = tid >> 6; const float* bb = gla_b + (w >> 2) * 256 + h * 64 + (w & 3) * 16;
#pragma unroll
      for (int i = 0; i < 16; ++i) in.bb[i] = bb[i]; }
#pragma unroll
    for (int q = 0; q < 2; ++q) { const int id = tid + 512 * q, r = id >> 4, c16 = id & 15; in.vv[q] = *(const u32x4*)(P + (size_t)(row0 + r) * NP + P_VG + h * 128 + c16 * 8); }
    in.kraw = *(const u32x4*)(P + (size_t)(row0 + (tid >> 3)) * NP + P_KG + h * 64 + (tid & 7) * 8);
    in.araw = (u32x4){0u, 0u, 0u, 0u}; if (tid < 256) in.araw = *(const u32x4*)(P + (size_t)(row0 + (tid >> 2)) * NP + P_AG + (tid & 3) * 8);
}
__device__ __forceinline__ void g1_w2_fill(const float* gla_w2, LAS unsigned char* lds, int tid) {
    const int d = tid >> 8, col = tid & 255; float v[16];
#pragma unroll
    for (int r = 0; r < 16; ++r) v[r] = gla_w2[(d * 16 + r) * 256 + col];
    *(LAS u32x4*)(lds + G1_W2 + tid * 32) = pack8(v); *(LAS u32x4*)(lds + G1_W2 + tid * 32 + 16) = pack8(v + 8);
}
typedef const float __attribute__((address_space(4)))* CFPtr;
__device__ __forceinline__ void gla_state_unit(const G1In& in, G1In& nxt, int vnext  , const bf16_t* P, int ci, int h, const float* gla_w2, const float* gla_b, bf16_t* DS, float* DEC, f16_t* BC, LAS unsigned char* lds, const Ctx cx) {
    const int tid = tidx(cx), lane = tid & 63, wid = __builtin_amdgcn_readfirstlane(tid >> 6), fr = lane & 15, fq = lane >> 4;
    LAS unsigned char* Ke = lds + G_QD; LAS unsigned char* Vi = lds + G_VI; LAS unsigned char* Kr = lds + G1_KR; LAS unsigned char* Ar = lds + G1_AR;
    {
#pragma unroll
      for (int q = 0; q < 2; ++q) { const int id = tid + 512 * q, r = id >> 4, c16 = id & 15; *(LAS u32x4*)(Vi + r * STR128 + c16 * 16) = in.vv[q]; }
      *(LAS u32x4*)(Kr + (tid >> 3) * STR64 + (tid & 7) * 16) = in.kraw;
      if (tid < 256) *(LAS u32x4*)(Ar + (tid >> 2) * G1_ASTR + (tid & 3) * 16) = in.araw; }
    if (vnext >= 0) g1_load(nxt, P, gla_b, vnext >> 2, vnext & 3, tid);
    LDS_BAR();
    const size_t ub = ((size_t)ci * 4 + h) * 2;
    { const int d = wid >> 2, ch0 = (wid & 3) * 16, t = d ? 63 - lane : lane; float b[16];
      const LAS u32x4* kp = (const LAS u32x4*)(Kr + t * STR64 + ch0 * 2); const u32x4 k0 = kp[0], k1 = kp[1];
      { const bf16x8 zf = (bf16x8){0, 0, 0, 0, 0, 0, 0, 0};
        const bf16x8 wf = fq < 2 ? *(const LAS bf16x8*)(lds + G1_W2 + ((d * 256 + h * 64 + ch0 + fr) * 16 + 8 * fq) * 2) : zf;
        LAS unsigned char* T = lds + G1_T + wid * 2048;
#pragma unroll
        for (int ps = 0; ps < 2; ++ps) {
#pragma unroll
            for (int tb = 0; tb < 2; ++tb) { const bf16x8 af = fq < 2 ? *(const LAS bf16x8*)(Ar + ((ps * 2 + tb) * 16 + fr) * G1_ASTR + (d * 16 + 8 * fq) * 2) : zf;
                f32x4 pacc = (f32x4){0.f, 0.f, 0.f, 0.f}; MMA16(pacc, af, wf);
                *(LAS f32x4*)(T + (tb * 16 + fr) * 64 + fq * 16) = pacc; }
            asm volatile("" ::: "memory"); __builtin_amdgcn_wave_barrier();
            if ((t >> 5) == ps) {
#pragma unroll
                for (int q = 0; q < 4; ++q) { const f32x4 pv = *(const LAS f32x4*)(T + (t & 31) * 64 + q * 16); b[4 * q] = pv[0]; b[4 * q + 1] = pv[1]; b[4 * q + 2] = pv[2]; b[4 * q + 3] = pv[3]; } }
            asm volatile("" ::: "memory"); __builtin_amdgcn_wave_barrier(); } }
#pragma unroll
      for (int i = 0; i < 16; ++i) b[i] += in.bb[i];
#pragma unroll
      for (int i = 0; i < 16; ++i) b[i] = wave_incl_scan(lsig16(b[i]));
      { f16_t* bp = BC + ((ub + d) * 64 + ch0) * 64 + t;
#pragma unroll
        for (int i = 0; i < 16; ++i) bp[i * 64] = (f16_t)b[i]; }
      float kf[16], o[16]; unpack8(k0, kf); unpack8(k1, kf + 8);
#pragma unroll
      for (int i = 0; i < 16; ++i) { const float bt = __int_as_float(__builtin_amdgcn_readlane(__float_as_int(b[i]), 63)); o[i] = kf[i] * __expf(bt - b[i]); b[i] = bt; }
      *(LAS u32x4*)(Ke + d * 64 * STR64 + t * STR64 + ch0 * 2) = pack8(o); *(LAS u32x4*)(Ke + d * 64 * STR64 + t * STR64 + ch0 * 2 + 16) = pack8(o + 8);
      if (lane < 16) { float dv = b[0];
#pragma unroll
          for (int i = 1; i < 16; ++i) dv = (lane == i) ? b[i] : dv;
          DEC[(ub + d) * 64 + ch0 + lane] = __expf(dv); } }
    LDS_BAR();
    { const int d = wid >> 2, mt = wid & 3; f32x4 acc[8];
#pragma unroll
      for (int n = 0; n < 8; ++n) acc[n] = (f32x4){0.f, 0.f, 0.f, 0.f};
#pragma unroll
      for (int s = 0; s < 2; ++s) { const int r0 = 32 * s + 8 * fq; const bf16x8 af = frag_tr(Ke + d * 64 * STR64, r0, r0 + 4, mt * 16, STR64, fr);
#pragma unroll
          for (int n = 0; n < 8; ++n) { const bf16x8 bfr = frag_tr(Vi, r0, r0 + 4, n * 16, STR128, fr); MMA16(acc[n], af, bfr); } }
      LAS unsigned char* my = lds + G_AT + wid * (16 * STR64); const int r8 = lane >> 3, c8 = lane & 7;
      bf16_t* dst = DS + ((ub + d) * 64 + mt * 16 + r8) * 128 + 8 * c8;
#pragma unroll
      for (int p = 0; p < 2; ++p) {
#pragma unroll
          for (int q = 0; q < 4; ++q) { const f32x4 v = acc[4 * p + q]; u32x2 w; w.x = cvt_pk_bf16(v[0], v[1]); w.y = cvt_pk_bf16(v[2], v[3]); *(LAS u32x2*)(my + fr * STR64 + q * 32 + fq * 8) = w; }
          asm volatile("" ::: "memory"); __builtin_amdgcn_wave_barrier();
          const u32x4 x0 = *(const LAS u32x4*)(my + r8 * STR64 + c8 * 16), x1 = *(const LAS u32x4*)(my + (r8 + 8) * STR64 + c8 * 16);
          asm volatile("" ::: "memory"); __builtin_amdgcn_wave_barrier();
          *(u32x4*)(dst + p * 64) = x0; *(u32x4*)(dst + 8 * 128 + p * 64) = x1; } }
    LDS_BAR();
}

__device__ __forceinline__ void ph_gla_scan2(const bf16_t* DS, const float* DEC, bf16_t* SE, const Ctx cx) {
    const int tid = tidx(cx);
    for (int vi = cx.bid * 512 + tid; vi < 64 * 2048; vi += cx.nb * 512) {
        const int sid = vi >> 11, dk = (vi >> 5) & 63, dvq = vi & 31; const int b = sid >> 3, h = (sid >> 1) & 3, d = sid & 1;
        auto offs = [&](int st, size_t& ub, size_t& eo) { const int ci = st < 4 ? (256 + 4 * b + (d ? 3 - st : st)) : (32 * b + (d ? 35 - st : st - 4)); ub = ((size_t)ci * 4 + h) * 2 + d; eo = (ub * 64 + dk) * 128 + dvq * 4; };
        f32x4 S = (f32x4){0.f, 0.f, 0.f, 0.f};
        u32x2 dsn[12]; float dcn[12];
#pragma unroll
        for (int j = 0; j < 12; ++j) { size_t ub, eo; offs(j, ub, eo); dcn[j] = DEC[ub * 64 + dk]; dsn[j] = *(const u32x2*)(DS + eo); }
#pragma unroll 1
        for (int bt = 0; bt < 3; ++bt) {
            u32x2 ds[12]; float dc[12];
#pragma unroll
            for (int j = 0; j < 12; ++j) { ds[j] = dsn[j]; dc[j] = dcn[j]; }
            if (bt < 2) {
#pragma unroll
                for (int j = 0; j < 12; ++j) { size_t ub, eo; offs((bt + 1) * 12 + j, ub, eo); dcn[j] = DEC[ub * 64 + dk]; dsn[j] = *(const u32x2*)(DS + eo); } }
#pragma unroll
            for (int j = 0; j < 12; ++j) { size_t ub, eo; offs(bt * 12 + j, ub, eo);
                u32x2 w; w.x = cvt_pk_bf16(S[0], S[1]); w.y = cvt_pk_bf16(S[2], S[3]); *(u32x2*)(SE + eo) = w;
                S = S * dc[j] + (f32x4){bf_lo(ds[j].x), bf_hi(ds[j].x), bf_lo(ds[j].y), bf_hi(ds[j].y)}; }
        }
    }
}

struct G3In { u32x4 vv[2], sv[4], qraw, kraw; float bb[16]; };
__device__ __forceinline__ void g3_load(G3In& in, const bf16_t* P, int ci, int h, const f16_t* BC, const bf16_t* SE, int tid) {
    const int lane = tid & 63, wid = __builtin_amdgcn_readfirstlane(tid >> 6); const int row0 = ci * 64; const size_t ub = ((size_t)ci * 4 + h) * 2;
#pragma unroll
    for (int q = 0; q < 2; ++q) { const int id = tid + 512 * q, r = id >> 4, c16 = id & 15; in.vv[q] = *(const u32x4*)(P + (size_t)(row0 + r) * NP + P_VG + h * 128 + c16 * 8); }
#pragma unroll
    for (int q = 0; q < 4; ++q) { const int id = tid + 512 * q, r = id >> 4, c16 = id & 15; in.sv[q] = *(const u32x4*)(SE + (ub * 64 + r) * 128 + c16 * 8); }
    const int d = wid >> 2, ch0 = (wid & 3) * 16, t = d ? 63 - lane : lane;
    { const bf16_t* pr = P + (size_t)(row0 + (tid >> 3)) * NP + h * 64 + (tid & 7) * 8; in.qraw = *(const u32x4*)(pr + P_QG); in.kraw = *(const u32x4*)(pr + P_KG); }
    const f16_t* bp = BC + ((ub + d) * 64 + ch0) * 64 + t;
#pragma unroll
    for (int i = 0; i < 16; ++i) in.bb[i] = (float)bp[i * 64];
}
__device__ __forceinline__ void gla_out_unit(const G3In& in, const bf16_t* P, int ci, int h, const float* gng, bf16_t* BR, LAS unsigned char* lds, const Ctx cx) {
    const int tid = tidx(cx), lane = tid & 63, wid = __builtin_amdgcn_readfirstlane(tid >> 6), fr = lane & 15, fq = lane >> 4; const int row0 = ci * 64;
    LAS unsigned char* Qd = lds + G_QD; LAS unsigned char* Ki = lds + G_KI; LAS unsigned char* Vi = lds + G_VI; LAS unsigned char* Se = lds + G_SE; LAS unsigned char* At = lds + G_AT;
    { LAS unsigned char* Qr = At; LAS unsigned char* Kr = At + 64 * STR64;
      *(LAS u32x4*)(Qr + (tid >> 3) * STR64 + (tid & 7) * 16) = in.qraw; *(LAS u32x4*)(Kr + (tid >> 3) * STR64 + (tid & 7) * 16) = in.kraw; }
#pragma unroll
    for (int q = 0; q < 2; ++q) { const int id = tid + 512 * q, r = id >> 4, c16 = id & 15; *(LAS u32x4*)(Vi + r * STR128 + c16 * 16) = in.vv[q]; }
#pragma unroll
    for (int q = 0; q < 4; ++q) { const int id = tid + 512 * q, r = id >> 4, c16 = id & 15; *(LAS u32x4*)(Se + r * STR128 + c16 * 16) = in.sv[q]; }
    LDS_BAR();
    { const int d = wid >> 2, ch0 = (wid & 3) * 16, t = d ? 63 - lane : lane; float b[16];
      const LAS u32x4* qp = (const LAS u32x4*)(At + t * STR64 + ch0 * 2); const LAS u32x4* kp = (const LAS u32x4*)(At + 64 * STR64 + t * STR64 + ch0 * 2);
      const u32x4 q0 = qp[0], q1 = qp[1], k0 = kp[0], k1 = kp[1];
#pragma unroll
      for (int i = 0; i < 16; ++i) b[i] = in.bb[i];
      float qf[16], kf[16]; unpack8(q0, qf); unpack8(q1, qf + 8); unpack8(k0, kf); unpack8(k1, kf + 8);
#pragma unroll
      for (int i = 0; i < 16; ++i) { const float e = __expf(b[i]); qf[i] = qf[i] * 0.125f * e; kf[i] = kf[i] * __builtin_amdgcn_rcpf(e); }
      LAS unsigned char* qd = Qd + d * 64 * STR64 + t * STR64 + ch0 * 2; LAS unsigned char* ki = Ki + d * 64 * STR64 + t * STR64 + ch0 * 2;
      *(LAS u32x4*)qd = pack8(qf); *(LAS u32x4*)(qd + 16) = pack8(qf + 8); *(LAS u32x4*)ki = pack8(kf); *(LAS u32x4*)(ki + 16) = pack8(kf + 8); }
    LDS_BAR();
    { const int d = wid >> 2, mt = wid & 3; f32x4 acc[4];
#pragma unroll
      for (int n = 0; n < 4; ++n) acc[n] = (f32x4){0.f, 0.f, 0.f, 0.f};
#pragma unroll
      for (int s = 0; s < 2; ++s) { const bf16x8 af = frag_row(Qd + d * 64 * STR64, mt * 16 + fr, 32 * s + 8 * fq, STR64);
#pragma unroll
          for (int n = 0; n < 4; ++n) { const bf16x8 bfr = frag_row(Ki + d * 64 * STR64, n * 16 + fr, 32 * s + 8 * fq, STR64); MMA16(acc[n], af, bfr); } }
      const int l = mt * 16 + fr;
#pragma unroll
      for (int n = 0; n < 4; ++n) { float v[4];
#pragma unroll
          for (int j = 0; j < 4; ++j) { const bool keep = (n == mt) ? (d ? (4 * fq + j >= fr) : (4 * fq + j <= fr)) : (d ? (n > mt) : (n < mt)); v[j] = keep ? acc[n][j] : 0.f; }
          u32x2 w; w.x = cvt_pk_bf16(v[0], v[1]); w.y = cvt_pk_bf16(v[2], v[3]); *(LAS u32x2*)(At + d * 64 * STR64 + l * STR64 + (n * 16 + 4 * fq) * 2) = w; } }
    LDS_BAR();
    { const int mt = wid & 3, nh = wid >> 2; f32x4 acc[4];
      const int l = mt * 16 + fr; const size_t row = (size_t)row0 + l;
      u32x2 rw[4]; f32x4 gg[4];
#pragma unroll
      for (int n = 0; n < 4; ++n) { const int v0 = (nh * 4 + n) * 16 + 4 * fq; rw[n] = *(const u32x2*)(P + row * NP + P_RG + h * 128 + v0); gg[n] = *(const f32x4*)(gng + h * 128 + v0); }
#pragma unroll
      for (int n = 0; n < 4; ++n) acc[n] = (f32x4){0.f, 0.f, 0.f, 0.f};
#pragma unroll
      for (int d = 0; d < 2; ++d)
#pragma unroll
          for (int s = 0; s < 2; ++s) { const int r0 = 32 * s + 8 * fq;
              const bf16x8 af = frag_row(At + d * 64 * STR64, mt * 16 + fr, r0, STR64), aq = frag_row(Qd + d * 64 * STR64, mt * 16 + fr, r0, STR64);
#pragma unroll
              for (int n = 0; n < 4; ++n) { const int x0 = (nh * 4 + n) * 16;
                  const bf16x8 bv = frag_tr(Vi, r0, r0 + 4, x0, STR128, fr); MMA16(acc[n], af, bv);
                  const bf16x8 bs = frag_tr(Se + d * 64 * STR128, r0, r0 + 4, x0, STR128, fr); MMA16(acc[n], aq, bs); } }
      float ss = 0.f;
#pragma unroll
      for (int n = 0; n < 4; ++n) ss += acc[n][0] * acc[n][0] + acc[n][1] * acc[n][1] + acc[n][2] * acc[n][2] + acc[n][3] * acc[n][3];
      ss = row4_sum(ss);
      LAS float* red = (LAS float*)(lds + G_RED);
      if (fq == 0) red[l * 2 + nh] = ss;
      LDS_BAR();
      const float rs = rsqrtf((red[l * 2] + red[l * 2 + 1]) * (1.0f / 128.0f) + EPS);
#pragma unroll
      for (int n = 0; n < 4; ++n) { const int v0 = (nh * 4 + n) * 16 + 4 * fq;
          const float y0 = acc[n][0] * rs * gg[n][0] * siluf_(bf_lo(rw[n].x)), y1 = acc[n][1] * rs * gg[n][1] * siluf_(bf_hi(rw[n].x)), y2 = acc[n][2] * rs * gg[n][2] * siluf_(bf_lo(rw[n].y)), y3 = acc[n][3] * rs * gg[n][3] * siluf_(bf_hi(rw[n].y));
          u32x2 w; w.x = cvt_pk_bf16(y0, y1); w.y = cvt_pk_bf16(y2, y3); *(u32x2*)(BR + row * 1536 + 1024 + h * 128 + v0) = w; } }
    LDS_BAR();
}

constexpr float ATT_THR = 8.0f;
constexpr int A_KBUF = 0, A_VBUF = 64 * STR64, A_BUF = 2 * 64 * STR64;
__device__ __forceinline__ void attn_unit(const bf16_t* QR, const bf16_t* KV, bf16_t* BR, const float* sink, int b, int kh, int qrow0  , int qpos0  , LAS unsigned char* lds, const Ctx cx) {
    const int tid = tidx(cx), lane = tid & 63, wid = tid >> 6, fr = lane & 15, fq = lane >> 4; const int hq = wid >> 1, qh = wid & 1;
    const bool lat = qpos0 >= 0;
    int kt0 = 0, kt1 = 0; if (lat) { kt0 = (qpos0 >> 6) - 2; if (kt0 < 0) kt0 = 0; kt1 = (qpos0 >> 6) + 4; if (kt1 > 32) kt1 = 32; }
    const int ntile = (kt1 - kt0) + 4;
    bf16x8 qf[4][2];
#pragma unroll
    for (int mt = 0; mt < 4; ++mt)
#pragma unroll
        for (int ks = 0; ks < 2; ++ks) qf[mt][ks] = *(const bf16x8*)(QR + (size_t)(qrow0 + 64 * qh + 16 * mt + fr) * 512 + (4 * kh + hq) * 64 + 32 * ks + 8 * fq);
    const float sk = sink[4 * kh + hq] * LOG2E;
    f32x4 oacc[4][4]; float mrun[4], lrun[4];
#pragma unroll
    for (int mt = 0; mt < 4; ++mt) { mrun[mt] = sk; lrun[mt] = (fq == 0) ? 1.0f : 0.0f;
#pragma unroll
        for (int dt = 0; dt < 4; ++dt) oacc[mt][dt] = (f32x4){0.f, 0.f, 0.f, 0.f}; }
    const int sr = tid >> 3, sc = tid & 7;
    auto tile_row0 = [&](int t) -> int { return t < (kt1 - kt0) ? b * SEQ + (kt0 + t) * 64 : TL + b * CTXL + (t - (kt1 - kt0)) * 64; };
    u32x4 kreg, vreg;
    { const bf16_t* src = KV + (size_t)(tile_row0(0) + sr) * 256 + kh * 64 + sc * 8; kreg = *(const u32x4*)src; vreg = *(const u32x4*)(src + 128); }
    *(LAS u32x4*)(lds + A_KBUF + sr * STR64 + sc * 16) = kreg; *(LAS u32x4*)(lds + A_VBUF + sr * STR64 + sc * 16) = vreg;
    __syncthreads();
    for (int t = 0; t < ntile; ++t) {
        LAS unsigned char* Kb = lds + (t & 1) * A_BUF + A_KBUF; LAS unsigned char* Vb = lds + (t & 1) * A_BUF + A_VBUF;
        if (t + 1 < ntile) { const bf16_t* src = KV + (size_t)(tile_row0(t + 1) + sr) * 256 + kh * 64 + sc * 8; kreg = *(const u32x4*)src; vreg = *(const u32x4*)(src + 128); }
        const bool latt = t < (kt1 - kt0); const int kpos0 = (kt0 + t) * 64;
        const int qlo = qpos0 + 64 * qh;
        const bool active = !latt || (kpos0 + 63 >= qlo - 128 && kpos0 <= qlo + 63 + 128);
        const bool needmask = latt && (kpos0 > qlo + 65 || kpos0 < qlo - 65);
        if (active) {
            u32x4 pf[4][2];
            { bf16x8 kf[4][2];
#pragma unroll
              for (int nt = 0; nt < 4; ++nt)
#pragma unroll
                  for (int ks = 0; ks < 2; ++ks) kf[nt][ks] = frag_row(Kb, nt * 16 + fr, 32 * ks + 8 * fq, STR64);
#pragma unroll
              for (int mt = 0; mt < 4; ++mt) {
                f32x4 s[4];
                const float nm = -mrun[mt];
#pragma unroll
                for (int nt = 0; nt < 4; ++nt) { s[nt] = (f32x4){nm, nm, nm, nm}; MMA16(s[nt], qf[mt][0], kf[nt][0]); MMA16(s[nt], qf[mt][1], kf[nt][1]); }
                if (needmask) { const int qp = qlo + 16 * mt + fr;
#pragma unroll
                    for (int nt = 0; nt < 4; ++nt)
#pragma unroll
                        for (int j = 0; j < 4; ++j) { const int dlt = kpos0 + nt * 16 + 4 * fq + j - qp; if (dlt > 128 || dlt < -128) s[nt][j] = -3.0e38f; } }
                float mx = vmax2(vmax2(s[0][0], s[0][1]), s[0][2]);
                mx = vmax2(vmax2(mx, s[0][3]), s[1][0]); mx = vmax2(vmax2(mx, s[1][1]), s[1][2]); mx = vmax2(vmax2(mx, s[1][3]), s[2][0]); mx = vmax2(vmax2(mx, s[2][1]), s[2][2]);
                mx = vmax2(vmax2(mx, s[2][3]), s[3][0]); mx = vmax2(vmax2(mx, s[3][1]), s[3][2]); mx = vmax2(mx, s[3][3]);
                mx = row4_max(mx);
                if (__builtin_amdgcn_ballot_w64(mx > ATT_THR) != 0ull) {
                    const float d = mx > ATT_THR ? mx : 0.f; const float alpha = __builtin_amdgcn_exp2f(-d); mrun[mt] += d; lrun[mt] *= alpha;
#pragma unroll
                    for (int dt = 0; dt < 4; ++dt) oacc[mt][dt] = oacc[mt][dt] * alpha;
#pragma unroll
                    for (int nt = 0; nt < 4; ++nt) s[nt] = s[nt] - d; }
                float ps = 0.f;
#pragma unroll
                for (int nt = 0; nt < 4; ++nt)
#pragma unroll
                    for (int j = 0; j < 4; ++j) { const float p = __builtin_amdgcn_exp2f(s[nt][j]); s[nt][j] = p; ps += p; }
                lrun[mt] += ps;
                pf[mt][0].x = cvt_pk_bf16(s[0][0], s[0][1]); pf[mt][0].y = cvt_pk_bf16(s[0][2], s[0][3]); pf[mt][0].z = cvt_pk_bf16(s[1][0], s[1][1]); pf[mt][0].w = cvt_pk_bf16(s[1][2], s[1][3]);
                pf[mt][1].x = cvt_pk_bf16(s[2][0], s[2][1]); pf[mt][1].y = cvt_pk_bf16(s[2][2], s[2][3]); pf[mt][1].z = cvt_pk_bf16(s[3][0], s[3][1]); pf[mt][1].w = cvt_pk_bf16(s[3][2], s[3][3]);
              } }
#pragma unroll
            for (int dt = 0; dt < 4; ++dt) {
                const bf16x8 v0 = frag_tr(Vb, 4 * fq, 16 + 4 * fq, dt * 16, STR64, fr), v1 = frag_tr(Vb, 32 + 4 * fq, 48 + 4 * fq, dt * 16, STR64, fr);
#pragma unroll
                for (int mt = 0; mt < 4; ++mt) { MMA16(oacc[mt][dt], __builtin_bit_cast(bf16x8, pf[mt][0]), v0); MMA16(oacc[mt][dt], __builtin_bit_cast(bf16x8, pf[mt][1]), v1); } }
        }
        if (t + 1 < ntile) { LAS unsigned char* nb_ = lds + ((t + 1) & 1) * A_BUF; *(LAS u32x4*)(nb_ + A_KBUF + sr * STR64 + sc * 16) = kreg; *(LAS u32x4*)(nb_ + A_VBUF + sr * STR64 + sc * 16) = vreg; }
        __syncthreads();
    }
#pragma unroll
    for (int mt = 0; mt < 4; ++mt) { const float l = row4_sum(lrun[mt]); const float inv = 1.0f / l;
        bf16_t* op = BR + (size_t)(qrow0 + 64 * qh + 16 * mt + fr) * 1536 + 512 + (4 * kh + hq) * 64 + 4 * fq;
#pragma unroll
        for (int dt = 0; dt < 4; ++dt) { u32x2 w; w.x = cvt_pk_bf16(oacc[mt][dt][0] * inv, oacc[mt][dt][1] * inv); w.y = cvt_pk_bf16(oacc[mt][dt][2] * inv, oacc[mt][dt][3] * inv); *(u32x2*)(op + dt * 16) = w; } }
}

__device__ __forceinline__ void ph_mixA(const bf16_t* P, const bf16_t* QR, const bf16_t* KV, bf16_t* BR, const float* sink, const float* gla_w2, const float* gla_b, bf16_t* DS, float* DEC, f16_t* BC, bool ctxq, LAS unsigned char* lds, const Ctx cx) {
    for (int u = cx.bid; u < 256; u += cx.nb) { const int b = u >> 5, n = (u >> 1) & 15, kh = u & 1; attn_unit(QR, KV, BR, sink, b, kh, b * SEQ + n * 128, n * 128, lds, cx); }
    if (cx.nb == 256) {
        const int n = (cx.bid >> 1) & 15; const bool edge = (n == 0 || n == 15);
        if (ctxq && edge) { const int b = cx.bid >> 5, kh = cx.bid & 1; attn_unit(QR, KV, BR, sink, b, kh, TL + b * CTXL + (n == 15 ? 128 : 0), -1000000, lds, cx); }
        int rank; if (!ctxq) rank = cx.bid; else { const int blk = cx.bid >> 5, w = cx.bid & 31; rank = edge ? -1 : blk * 28 + (w - 2); }
        const int nv = (rank >= 0 && rank < 128) ? 5 : 4;
        G1In cur, nxt; g1_load(cur, P, gla_b, cx.bid >> 2, cx.bid & 3, tidx(cx));
        g1_w2_fill(gla_w2, lds, tidx(cx));
#pragma unroll 1
        for (int k = 0; k < nv; ++k) { const int v = k < 4 ? cx.bid + 256 * k : 1024 + rank; const int vn = (k + 1 < nv) ? ((k + 1) < 4 ? cx.bid + 256 * (k + 1) : 1024 + rank) : -1;
            gla_state_unit(cur, nxt, vn, P, v >> 2, v & 3, gla_w2, gla_b, DS, DEC, BC, lds, cx);
            if (vn >= 0) cur = nxt; }
        return;
    }
    g1_w2_fill(gla_w2, lds, tidx(cx));
    const int nsmall = (ctxq ? 32 : 0) + 1152;
    for (int u = cx.bid; u < nsmall; u += cx.nb) {
        int v = u;
        if (ctxq) { if (v < 32) { const int b = v >> 2, n = (v >> 1) & 1, kh = v & 1; attn_unit(QR, KV, BR, sink, b, kh, TL + b * CTXL + n * 128, -1000000, lds, cx); continue; } v -= 32; }
        { G1In cur, nxt; g1_load(cur, P, gla_b, v >> 2, v & 3, tidx(cx)); gla_state_unit(cur, nxt, -1, P, v >> 2, v & 3, gla_w2, gla_b, DS, DEC, BC, lds, cx); }
    }
}
__device__ __forceinline__ void ph_mixC(const bf16_t* P, const f16_t* BC, const bf16_t* SE, const float* gng, bf16_t* BR, int nchunks, LAS unsigned char* lds, const Ctx cx) {
    const int n = nchunks * 4; int u = cx.bid; G3In cur, nx1, nx2;
    if (u < n) g3_load(cur, P, u >> 2, u & 3, BC, SE, tidx(cx));
    if (u + cx.nb < n) { const int u1 = u + cx.nb; g3_load(nx1, P, u1 >> 2, u1 & 3, BC, SE, tidx(cx)); }
#pragma unroll 1
    for (; u < n; u += cx.nb) { const int u2 = u + 2 * cx.nb;
        if (u2 < n) g3_load(nx2, P, u2 >> 2, u2 & 3, BC, SE, tidx(cx));
        gla_out_unit(cur, P, u >> 2, u & 3, gng, BR, lds, cx);
        cur = nx1; nx1 = nx2; }
}

template <int MODE, class Epi, int ABLK = 0> __device__ __forceinline__ void ph_gemm(LAS unsigned char* lds, const bf16_t* A, const bf16_t* Bt, int lda, int ldb, int K, int nM, int nN, const Epi& E, unsigned* ctl, int moe_j, size_t bexp, const Ctx cx) {
    pg8::Prob<MODE> P; P.A = A; P.Bt = Bt; P.lda = lda; P.ldb = ldb; P.K = K; P.nM = nM; P.nN = nN; P.G = cx.nb; P.c = cx.bid; P.texp = (LAS int*)(lds + LDS_TEXP); P.bexp = bexp; P.nctx = (MODE == 3) ? moe_j : 0;
    if (MODE == 2) {
        __syncthreads();
        if (tidx(cx) < 256) ((LAS int*)(lds + LDS_TEXP))[tidx(cx)] = (int)xb_ld(ctl + CW_TEXP + moe_j * 256 + tidx(cx));
        P.nM = (int)xb_ld(ctl + CW_NT + moe_j);
        __syncthreads();
    }
    pg8::gemm_phase<Epi, pg8::Prob<MODE>, ABLK>(lds, P, E, cx);
}

__device__ __forceinline__ bool idle_ctx(unsigned* ctl, int j, int nN, Ctx& cx) {
    const int U = (int)xb_ld(ctl + CW_NT + j) * nN, rounds = (U + cx.nb - 1) / cx.nb, nidle = rounds * cx.nb - U;
    if (nidle < 64) return true;
    const int first = cx.nb - nidle; if (cx.bid < first) return false;
    cx.bid -= first; cx.nb = nidle; return true;
}

struct MKP { const float* in[24]; float* out; char* ws; };
typedef const MKP __attribute__((address_space(4)))* KPtr;
__device__ __forceinline__ KPtr kp() { KPtr q = (KPtr)__builtin_amdgcn_kernarg_segment_ptr(); OPQ_S(q); return q; }
#define IN_(i) ((const float*)q->in[i])
#define WSP(off) (ws + (off))

__global__ void __launch_bounds__(512, 2) mk_fwd(MKP p_unused) {
    extern __shared__ __attribute__((aligned(16))) unsigned char shm[];
    LAS unsigned char* lds = (LAS unsigned char*)shm;
    const int nb = gridDim.x; const int wv = __builtin_amdgcn_readfirstlane((int)(threadIdx.x >> 6));
    XcdBarrier bar;
    { KPtr q = kp(); char* ws = q->ws;
      if (threadIdx.x == 0) *(LAS u32x4*)(lds + LDS_BARW) = (u32x4){0u, 0u, 0u, 0u};
      __syncthreads();
      bar = xcd_barrier_post((unsigned*)WSP(WS_CTL) + CW_BAR, (volatile LAS unsigned*)(lds + LDS_BARW)); }

    { KPtr q = kp(); char* ws = q->ws; Ctx cx; cx.bid = blockIdx.x; cx.nb = nb; cx.wv = wv; OPQ_S(cx.bid); OPQ_S(cx.wv);
      ph_init(IN_(0), IN_(2), (float*)nullptr, (f32x2*)WSP(WS_CS), cx);
      ph_mod(IN_(1), IN_(3), IN_(4), IN_(5), (float*)WSP(WS_MOD), lds, cx);
      __syncthreads(); }
    { int rot = 0;
#pragma unroll 1
      for (int l = 0; l < DEPTH; ++l) {
          KPtr q = kp(); char* ws = q->ws; Ctx cx; cx.bid = blockIdx.x; cx.nb = nb; cx.wv = wv; OPQ_S(cx.bid); OPQ_S(cx.wv);
          ph_convert(mkjob(IN_(8) + (size_t)l * D * DIN, nullptr, (bf16_t*)WSP(WS_WIN) + (size_t)l * NP * D, DIN, D, 0, D, NP, 1), lds, cx, rot);
          ph_convert(mkjob(IN_(15) + (size_t)l * D * D, nullptr, (bf16_t*)WSP(WS_WO3) + (size_t)l * D * D, D, D, 0, D, D, 0), lds, cx, rot);
#pragma unroll 1
          for (int i = 0; i < 3; ++i) {
              ph_convert(mkjob(IN_(14) + ((size_t)l * 3 + i) * 512 * D, nullptr, (bf16_t*)WSP(WS_WBR) + (size_t)l * D * 1536, D, 1536, i * 512, 512, 1024, 0), lds, cx, rot);
          }
      }
#pragma unroll 1
      for (int j = 0; j < 2; ++j) {
          KPtr q = kp(); char* ws = q->ws; Ctx cx; cx.bid = blockIdx.x; cx.nb = nb; cx.wv = wv; OPQ_S(cx.bid); OPQ_S(cx.wv);
          ph_convert(mkjob(IN_(16) + (size_t)j * D * DFF, IN_(17) + (size_t)j * D * DFF, (bf16_t*)WSP(WS_WUPD) + (size_t)j * NUP * D, DFF, D, 0, D, NUP, 2), lds, cx, rot);
          ph_convert(mkjob(IN_(18) + (size_t)j * DFF * D, nullptr, (bf16_t*)WSP(WS_WDND) + (size_t)j * D * DFF, D, DFF, 0, DFF, D, 0), lds, cx, rot);
      }
    }
    { Ctx cx; cx.bid = 0; cx.nb = nb; cx.wv = wv; OPQ_S(cx.wv); xcd_barrier_first(bar, cx); }

#pragma unroll 1
    for (int l = 0; l < DEPTH; ++l) {
        const bool last = (l == DEPTH - 1), moe = (l & 1); const int j = l >> 1; const int nrows = last ? TL : T; const int nMr = nrows / 256;
        { KPtr q = kp(); char* ws = q->ws; Ctx cx; cx.bid = blockIdx.x; cx.nb = nb; cx.wv = wv; OPQ_S(cx.bid); OPQ_S(cx.wv); const float* modl = (const float*)WSP(WS_MOD) + (size_t)l * 9 * 6144;
          NormArgs a; a.XS = (bf16_t*)WSP(WS_XS); a.lf32 = a.cf32 = (l == 0); a.Xl = l ? (const void*)WSP(WS_XS) : (const void*)IN_(0); a.Xc = l ? (const void*)WSP(WS_XS) : (const void*)(IN_(2) - (size_t)TL * D); a.H = (bf16_t*)WSP(WS_H); a.g = IN_(6) + l * D; a.mod_shift = modl; a.mod_scale = modl + 1024; a.nrows = T;
          a.Y = (const bf16_t*)WSP(WS_YB); a.POS = (const int*)WSP(WS_POS); a.TOPKp = (const float*)WSP(WS_TOPK); a.mod_g5prev = (const float*)WSP(WS_MOD) + (size_t)(l > 0 ? l - 1 : 0) * 9 * 6144 + 5 * 1024; a.router = nullptr; a.TOPK = nullptr; a.cnt = nullptr;
          a.npart = 7; a.PART = (l == 1 || l == 3) ? (const bf16_t*)WSP(WS_PART) : nullptr; a.mod_gpart = (const float*)WSP(WS_MOD) + (size_t)(l > 0 ? l - 1 : 0) * 9 * 6144 + 5 * 1024;
          ph_norm<false>(a, l == 2, lds, cx); }
        { Ctx cx; cx.bid = 0; cx.nb = nb; cx.wv = wv; OPQ_S(cx.wv); xcd_barrier(bar, cx); }
        { KPtr q = kp(); char* ws = q->ws; Ctx cx; cx.bid = blockIdx.x; cx.nb = nb; cx.wv = wv; OPQ_S(cx.bid); OPQ_S(cx.wv);
          pg8::EpiWin E{(bf16_t*)WSP(WS_PH), (bf16_t*)WSP(WS_QR), (bf16_t*)WSP(WS_KV), (const f32x2*)WSP(WS_CS), lds + LDS_CSH}; ph_gemm<0>(lds, (const bf16_t*)WSP(WS_H), (const bf16_t*)WSP(WS_WIN) + (size_t)l * NP * D, D, D, D, T / 256, NP / 256, E, nullptr, 0, 0, cx); }
        { Ctx cx; cx.bid = 0; cx.nb = nb; cx.wv = wv; OPQ_S(cx.wv); xcd_barrier(bar, cx); }
        { KPtr q = kp(); char* ws = q->ws; Ctx cx; cx.bid = blockIdx.x; cx.nb = nb; cx.wv = wv; OPQ_S(cx.bid); OPQ_S(cx.wv);
          ph_mixA((const bf16_t*)WSP(WS_PH), (const bf16_t*)WSP(WS_QR), (const bf16_t*)WSP(WS_KV), (bf16_t*)WSP(WS_BR), IN_(10) + l * 8, IN_(11) + (size_t)l * 2 * 16 * 256, IN_(12) + (size_t)l * 2 * 256,
                  (bf16_t*)WSP(WS_R3), (float*)WSP(WS_DEC), (f16_t*)WSP(WS_YB), !last, lds, cx); }
        { Ctx cx; cx.bid = 0; cx.nb = nb; cx.wv = wv; OPQ_S(cx.wv); xcd_barrier(bar, cx); }
        { KPtr q = kp(); char* ws = q->ws; Ctx cx; cx.bid = blockIdx.x; cx.nb = nb; cx.wv = wv; OPQ_S(cx.bid); OPQ_S(cx.wv);
          ph_gla_scan2((const bf16_t*)WSP(WS_R3), (const float*)WSP(WS_DEC), (bf16_t*)(WSP(WS_R3) + (size_t)2 * T * 512 * 4), cx); }
        { Ctx cx; cx.bid = 0; cx.nb = nb; cx.wv = wv; OPQ_S(cx.wv); xcd_barrier(bar, cx); }
        { KPtr q = kp(); char* ws = q->ws; Ctx cx; cx.bid = blockIdx.x; cx.nb = nb; cx.wv = wv; OPQ_S(cx.bid); OPQ_S(cx.wv);
          ph_conv((const bf16_t*)WSP(WS_PH), (bf16_t*)WSP(WS_BR), IN_(9) + (size_t)l * 3 * 512, nrows, cx);
          ph_mixC((const bf16_t*)WSP(WS_PH), (const f16_t*)WSP(WS_YB), (const bf16_t*)(WSP(WS_R3) + (size_t)2 * T * 512 * 4), IN_(13) + l * 512, (bf16_t*)WSP(WS_BR), nrows / 64, lds, cx); }
        { Ctx cx; cx.bid = 0; cx.nb = nb; cx.wv = wv; OPQ_S(cx.wv); xcd_barrier(bar, cx); }
        { KPtr q = kp(); char* ws = q->ws; Ctx cx; cx.bid = blockIdx.x; cx.nb = nb; cx.wv = wv; OPQ_S(cx.bid); OPQ_S(cx.wv);
          constexpr size_t MG3C_OFF = (size_t)TL * D * 2;
          if (!last) { pg8::EpiGate E{(bf16_t*)(WSP(WS_R3) + MG3C_OFF), (const bf16_t*)WSP(WS_PH) + (size_t)TL * NP, lds + LDS_CSH}; ph_gemm<1>(lds, (const bf16_t*)WSP(WS_BR) + (size_t)TL * 1536, (const bf16_t*)WSP(WS_WBR) + (size_t)l * D * 1536, 1536, 1536, 512, 8, 12, E, nullptr, 0, 0, cx); }
          { pg8::EpiMerge E{(bf16_t*)WSP(WS_R3), (const bf16_t*)WSP(WS_PH), lds + LDS_CSH}; ph_gemm<4>(lds, (const bf16_t*)WSP(WS_BR), (const bf16_t*)WSP(WS_WBR) + (size_t)l * D * 1536, 1536, 1536, 1536, 64, 4, E, nullptr, 0, 0, cx); } }
        { Ctx cx; cx.bid = 0; cx.nb = nb; cx.wv = wv; OPQ_S(cx.wv); xcd_barrier(bar, cx); }
        { KPtr q = kp(); char* ws = q->ws; Ctx cx; cx.bid = blockIdx.x; cx.nb = nb; cx.wv = wv; OPQ_S(cx.bid); OPQ_S(cx.wv);
          constexpr size_t MG3C_OFF = (size_t)TL * D * 2;
          pg8::EpiResid E{(bf16_t*)WSP(WS_XS), (const float*)WSP(WS_MOD) + (size_t)l * 9 * 6144 + 2 * 1024, (bf16_t*)WSP(WS_PART), l ? (const void*)WSP(WS_XS) : (const void*)IN_(0), lds + LDS_CSH, l == 0, 0};
          if (!last) ph_gemm<5>(lds, (const bf16_t*)(WSP(WS_R3) + MG3C_OFF) - (size_t)TL * 3072, (const bf16_t*)WSP(WS_WO3) + (size_t)l * D * D, 3072, D, 512, 8, 4, E, nullptr, 0, 0, cx);
          ph_gemm<0>(lds, (const bf16_t*)WSP(WS_R3), (const bf16_t*)WSP(WS_WO3) + (size_t)l * D * D, D, D, D, 64, 4, E, nullptr, 0, 0, cx); }
        { Ctx cx; cx.bid = 0; cx.nb = nb; cx.wv = wv; OPQ_S(cx.wv); xcd_barrier(bar, cx); }
        { KPtr q = kp(); char* ws = q->ws; Ctx cx; cx.bid = blockIdx.x; cx.nb = nb; cx.wv = wv; OPQ_S(cx.bid); OPQ_S(cx.wv); const float* modl = (const float*)WSP(WS_MOD) + (size_t)l * 9 * 6144;
          NormArgs a; a.XS = (bf16_t*)WSP(WS_XS); a.lf32 = 0; a.cf32 = (l == 0); a.Xl = (const void*)WSP(WS_XS); a.Xc = l ? (const void*)WSP(WS_XS) : (const void*)(IN_(2) - (size_t)TL * D); a.H = (bf16_t*)WSP(WS_H); a.g = IN_(7) + l * D; a.mod_shift = modl + 3 * 1024; a.mod_scale = modl + 4 * 1024; a.nrows = nrows;
          a.Y = nullptr; a.POS = nullptr; a.TOPKp = nullptr; a.mod_g5prev = nullptr; a.router = IN_(19) + (size_t)j * D * 8; a.TOPK = (float*)WSP(WS_TOPK); a.cnt = (unsigned*)WSP(WS_CTL) + CW_CNT + j * 64;
          a.npart = 6; a.PART = last ? nullptr : (const bf16_t*)WSP(WS_PART); a.mod_gpart = modl + 2 * 1024;
          if (moe) ph_norm<true>(a, false, lds, cx); else ph_norm<false>(a, false, lds, cx); }
        if (moe && j == 0) {
            int rot = 0;
#pragma unroll 1
            for (int e = 0; e < NEXP; ++e) { KPtr q = kp(); char* ws = q->ws; Ctx cx; cx.bid = blockIdx.x; cx.nb = nb; cx.wv = wv; OPQ_S(cx.bid); OPQ_S(cx.wv); const size_t eo = ((size_t)j * NEXP + e) * D * DFF;
                ph_convert(mkjob(IN_(20) + eo, IN_(21) + eo, (bf16_t*)WSP(WS_WUPM) + (size_t)e * NUP * D, DFF, D, 0, D, NUP, 2), lds, cx, rot);
            }
        }
        { Ctx cx; cx.bid = 0; cx.nb = nb; cx.wv = wv; OPQ_S(cx.wv); xcd_barrier(bar, cx); }
        if (!moe) {
            { KPtr q = kp(); char* ws = q->ws; Ctx cx; cx.bid = blockIdx.x; cx.nb = nb; cx.wv = wv; OPQ_S(cx.bid); OPQ_S(cx.wv);
              pg8::EpiSwiglu E{(bf16_t*)WSP(WS_PH)}; ph_gemm<0>(lds, (const bf16_t*)WSP(WS_H), (const bf16_t*)WSP(WS_WUPD) + (size_t)j * NUP * D, D, D, D, nMr, NUP / 256, E, nullptr, 0, 0, cx); }
            { Ctx cx; cx.bid = 0; cx.nb = nb; cx.wv = wv; OPQ_S(cx.wv); xcd_barrier(bar, cx); }
            { KPtr q = kp(); char* ws = q->ws; Ctx cx; cx.bid = blockIdx.x; cx.nb = nb; cx.wv = wv; OPQ_S(cx.bid); OPQ_S(cx.wv);
              pg8::EpiResid E{(bf16_t*)WSP(WS_XS), (const float*)WSP(WS_MOD) + (size_t)l * 9 * 6144 + 5 * 1024, (bf16_t*)WSP(WS_PART), (const void*)WSP(WS_XS), lds + LDS_CSH, 0, 0}; ph_gemm<3, pg8::EpiResid, 1>(lds, (const bf16_t*)WSP(WS_PH), (const bf16_t*)WSP(WS_WDND) + (size_t)j * D * DFF, DFF, DFF, DFF, nMr, 4, E, nullptr, last ? 0 : 224, 0, cx); }
            { Ctx cx; cx.bid = 0; cx.nb = nb; cx.wv = wv; OPQ_S(cx.wv); xcd_barrier(bar, cx); }
        } else {
            { KPtr q = kp(); char* ws = q->ws; Ctx cx; cx.bid = blockIdx.x; cx.nb = nb; cx.wv = wv; OPQ_S(cx.bid); OPQ_S(cx.wv);
              ph_route((const float*)WSP(WS_TOPK), (const bf16_t*)WSP(WS_H), (bf16_t*)WSP(WS_R3), (int*)WSP(WS_POS), (unsigned*)WSP(WS_CTL), j, nrows, lds, cx); }
            { Ctx cx; cx.bid = 0; cx.nb = nb; cx.wv = wv; OPQ_S(cx.wv); xcd_barrier(bar, cx); }
            { KPtr q = kp(); char* ws = q->ws; Ctx cx; cx.bid = blockIdx.x; cx.nb = nb; cx.wv = wv; OPQ_S(cx.bid); OPQ_S(cx.wv);
              pg8::EpiSwiglu E{(bf16_t*)WSP(WS_PH)}; ph_gemm<2>(lds, (const bf16_t*)WSP(WS_R3), (const bf16_t*)WSP(WS_WUPM), D, D, D, 0, NUP / 256, E, (unsigned*)WSP(WS_CTL), j, (size_t)NUP * D, cx);
              { Ctx c2 = cx; if (idle_ctx((unsigned*)WSP(WS_CTL), j, NUP / 256, c2)) { int rot = 0;
#pragma unroll 1
                  for (int e = 0; e < NEXP; ++e) { const size_t eo = ((size_t)j * NEXP + e) * D * DFF; ph_convert(mkjob(IN_(22) + eo, nullptr, (bf16_t*)WSP(WS_WDNM) + (size_t)e * D * DFF, D, DFF, 0, DFF, D, 0), lds, c2, rot); } } } }
            { Ctx cx; cx.bid = 0; cx.nb = nb; cx.wv = wv; OPQ_S(cx.wv); xcd_barrier(bar, cx); }
            { KPtr q = kp(); char* ws = q->ws; Ctx cx; cx.bid = blockIdx.x; cx.nb = nb; cx.wv = wv; OPQ_S(cx.bid); OPQ_S(cx.wv);
              pg8::EpiBf16 E{(bf16_t*)WSP(WS_YB), lds + LDS_CSH, D, 0}; ph_gemm<2, pg8::EpiBf16, 1>(lds, (const bf16_t*)WSP(WS_PH), (const bf16_t*)WSP(WS_WDNM), DFF, DFF, DFF, 0, 4, E, (unsigned*)WSP(WS_CTL), j, (size_t)D * DFF, cx);
              if (j == 0) { Ctx c2 = cx; if (idle_ctx((unsigned*)WSP(WS_CTL), j, 4, c2)) { int rot = 0;
#pragma unroll 1
                  for (int e = 0; e < NEXP; ++e) { const size_t eo = ((size_t)NEXP + e) * D * DFF; ph_convert(mkjob(IN_(20) + eo, IN_(21) + eo, (bf16_t*)WSP(WS_WUPM) + (size_t)e * NUP * D, DFF, D, 0, D, NUP, 2), lds, c2, rot); } } } }
            { Ctx cx; cx.bid = 0; cx.nb = nb; cx.wv = wv; OPQ_S(cx.wv); xcd_barrier(bar, cx); }
        }
    }
    { KPtr q = kp(); char* ws = q->ws; Ctx cx; cx.bid = blockIdx.x; cx.nb = nb; cx.wv = wv; OPQ_S(cx.bid); OPQ_S(cx.wv);
      ph_final((const bf16_t*)WSP(WS_XS), (const bf16_t*)WSP(WS_YB), (const int*)WSP(WS_POS), (const float*)WSP(WS_TOPK), (const float*)WSP(WS_MOD) + (size_t)3 * 9 * 6144 + 5 * 1024, IN_(23), q->out, cx); }
}

extern "C" void kernel_launch(void* const* d_in, const int* in_sizes, int n_in, void* d_out, int out_size, void* d_ws, size_t ws_size, hipStream_t stream) {
    (void)in_sizes; (void)out_size;
    if (n_in != 24 || ws_size < WS_END) return;
    static int grid = 0;
    if (!grid) {
        int dev = 0, cus = 0, per_cu = 0;
        if (hipGetDevice(&dev) != hipSuccess || hipDeviceGetAttribute(&cus, hipDeviceAttributeMultiprocessorCount, dev) != hipSuccess) return;
        if (hipFuncSetAttribute((const void*)mk_fwd, hipFuncAttributeMaxDynamicSharedMemorySize, LDS_BYTES) != hipSuccess) return;
        if (hipOccupancyMaxActiveBlocksPerMultiprocessor(&per_cu, mk_fwd, 512, LDS_BYTES) != hipSuccess || per_cu < 1) return;
        if (cus != 256) return;
        grid = cus;
    }
    (void)hipMemsetAsync((char*)d_ws + WS_CTL, 0, CTL_BYTES, stream);
    MKP p;
    for (int i = 0; i < 24; ++i) p.in[i] = (const float*)d_in[i];
    p.out = (float*)d_out; p.ws = (char*)d_ws;
    hipLaunchKernelGGL(mk_fwd, dim3(grid), dim3(512), LDS_BYTES, stream, p);
}
```
